# Optimizing an MI355X kernel written in HIP

```python
import jax
import jax.numpy as jnp
from jax import lax
import numpy as np

D_MODEL = 1024
BATCH = 8
SEQ = 2048
DEPTH = 1

GRID_W = 64
CTX_LEN = 256
HEAD_DIM = 64
A_Q_HEADS = D_MODEL // (2 * HEAD_DIM)
A_KV_HEADS = A_Q_HEADS // 4
B_Q_HEADS = D_MODEL // (2 * HEAD_DIM)
B_KV_HEADS = B_Q_HEADS // 4
A_Q_DIM = A_Q_HEADS * HEAD_DIM
A_KV_DIM = A_KV_HEADS * HEAD_DIM
B_Q_DIM = B_Q_HEADS * HEAD_DIM
B_KV_DIM = B_KV_HEADS * HEAD_DIM
PROJ_SIZES = (A_Q_DIM, A_KV_DIM, A_KV_DIM, B_Q_DIM, B_KV_DIM, B_KV_DIM)
IN_DIM = A_Q_DIM + 2 * A_KV_DIM + B_Q_DIM + 2 * B_KV_DIM
MIX_DIM = A_Q_DIM + B_Q_DIM
WINDOW = 128
BLOCK = 128
ROPE_THETA = 10000.0
N_GROUPS = 4
EXPERTS_PER_GROUP = 8
N_EXPERTS = N_GROUPS * EXPERTS_PER_GROUP
TOP_K_IN_GROUP = 2
EXPERT_FF = D_MODEL // 2
EPS = 1e-6
NEG_INF = -1e30

kernel_name = 'hymba_style_dual_attention_hier_moe_dit'


def rms_norm(x, g):
    xf = x.astype(jnp.float32)
    y = xf * lax.rsqrt(jnp.mean(xf * xf, axis=-1, keepdims=True) + EPS)
    return (y * g.astype(jnp.float32)).astype(x.dtype)


def axial_rope_tables(rows):
    row = jnp.broadcast_to(jnp.arange(rows, dtype=jnp.float32)[:, None], (rows, GRID_W)).reshape(-1)
    col = jnp.broadcast_to(jnp.arange(GRID_W, dtype=jnp.float32)[None, :], (rows, GRID_W)).reshape(-1)
    axis_dim = HEAD_DIM // 2
    inv_freq = ROPE_THETA ** (-jnp.arange(0, axis_dim, 2, dtype=jnp.float32) / axis_dim)
    ang = jnp.concatenate([row[:, None] * inv_freq, col[:, None] * inv_freq], axis=-1)
    return jnp.cos(ang), jnp.sin(ang)


def apply_rope(x, cos, sin):
    xf = x.astype(jnp.float32).reshape(*x.shape[:-1], HEAD_DIM // 2, 2)
    x0, x1 = xf[..., 0], xf[..., 1]
    cs = cos[None, :, None, :]
    sn = sin[None, :, None, :]
    out = jnp.stack([x0 * cs - x1 * sn, x0 * sn + x1 * cs], axis=-1)
    return out.reshape(x.shape).astype(x.dtype)


def project_heads(h, w_in):
    p = h @ w_in
    cuts, acc = [], 0
    for size in PROJ_SIZES[:-1]:
        acc += size
        cuts.append(acc)
    qa, ka, va, qb, kb, vb = jnp.split(p, cuts, axis=-1)
    lead = h.shape[:-1]
    return (qa.reshape(*lead, A_Q_HEADS, HEAD_DIM), ka.reshape(*lead, A_KV_HEADS, HEAD_DIM),
            va.reshape(*lead, A_KV_HEADS, HEAD_DIM), qb.reshape(*lead, B_Q_HEADS, HEAD_DIM),
            kb.reshape(*lead, B_KV_HEADS, HEAD_DIM), vb.reshape(*lead, B_KV_HEADS, HEAD_DIM))


def windowed_sink_attention(q, k, v, k_ctx, v_ctx, sink):
    bsz, n, hq, dh = q.shape
    hkv = k.shape[2]
    g = hq // hkv
    nb = n // BLOCK
    scale = dh ** -0.5
    qb = q.reshape(bsz, nb, BLOCK, hkv, g, dh)
    pad = ((0, 0), (BLOCK, BLOCK), (0, 0), (0, 0))
    kp = jnp.pad(k, pad).reshape(bsz, nb + 2, BLOCK, hkv, dh)
    vp = jnp.pad(v, pad).reshape(bsz, nb + 2, BLOCK, hkv, dh)
    kw = jnp.concatenate([kp[:, :-2], kp[:, 1:-1], kp[:, 2:]], axis=2)
    vw = jnp.concatenate([vp[:, :-2], vp[:, 1:-1], vp[:, 2:]], axis=2)
    qpos = jnp.arange(nb)[:, None, None] * BLOCK + jnp.arange(BLOCK)[None, :, None]
    kpos = jnp.arange(nb)[:, None, None] * BLOCK + jnp.arange(3 * BLOCK)[None, None, :] - BLOCK
    allowed = (jnp.abs(kpos - qpos) <= WINDOW) & (kpos >= 0) & (kpos < n)
    s_lat = jnp.einsum('bnqhgd,bnkhd->bnhgqk', qb, kw).astype(jnp.float32) * scale
    s_lat = jnp.where(allowed[None, :, None, None], s_lat, NEG_INF)
    s_ctx = jnp.einsum('bnqhgd,bchd->bnhgqc', qb, k_ctx).astype(jnp.float32) * scale
    s_sink = jnp.broadcast_to(sink.astype(jnp.float32).reshape(1, 1, hkv, g, 1, 1), s_lat.shape[:-1] + (1,))
    p = jax.nn.softmax(jnp.concatenate([s_lat, s_ctx, s_sink], axis=-1), axis=-1).astype(v.dtype)
    n_band = 3 * BLOCK
    p_lat = p[..., :n_band]
    p_ctx = p[..., n_band:n_band + k_ctx.shape[1]]
    o = (jnp.einsum('bnhgqk,bnkhd->bnqhgd', p_lat, vw)
         + jnp.einsum('bnhgqc,bchd->bnqhgd', p_ctx, v_ctx))
    return o.reshape(bsz, n, hq, dh)


def blocked_global_attention(q, k, v, k_ctx, v_ctx):
    bsz, n, hq, dh = q.shape
    hkv = k.shape[2]
    g = hq // hkv
    nb = n // BLOCK
    scale = dh ** -0.5
    k_all = jnp.concatenate([k, k_ctx], axis=1)
    v_all = jnp.concatenate([v, v_ctx], axis=1)
    q_blocks = jnp.moveaxis(q.reshape(bsz, nb, BLOCK, hkv, g, dh), 1, 0)

    def one_block(qblk):
        s = jnp.einsum('bqhgd,bkhd->bhgqk', qblk, k_all).astype(jnp.float32) * scale
        p = jax.nn.softmax(s, axis=-1).astype(v_all.dtype)
        return jnp.einsum('bhgqk,bkhd->bqhgd', p, v_all)

    o = lax.map(one_block, q_blocks)
    return jnp.moveaxis(o, 0, 1).reshape(bsz, n, hq, dh)


def context_attention(q, k, v, sink):
    bsz, n, hq, dh = q.shape
    hkv = k.shape[2]
    g = hq // hkv
    qg = q.reshape(bsz, n, hkv, g, dh)
    s = jnp.einsum('bqhgd,bkhd->bhgqk', qg, k).astype(jnp.float32) * dh ** -0.5
    if sink is not None:
        s_sink = jnp.broadcast_to(sink.astype(jnp.float32).reshape(1, hkv, g, 1, 1), s.shape[:-1] + (1,))
        s = jnp.concatenate([s, s_sink], axis=-1)
    p = jax.nn.softmax(s, axis=-1).astype(v.dtype)[..., :k.shape[1]]
    o = jnp.einsum('bhgqk,bkhd->bqhgd', p, v)
    return o.reshape(bsz, n, hq, dh)


def merge_head_groups(oa, ob, a_out_norm, b_out_norm, w_out):
    bsz, n = oa.shape[:2]
    oa = rms_norm(oa.reshape(bsz, n, A_Q_DIM), a_out_norm)
    ob = rms_norm(ob.reshape(bsz, n, B_Q_DIM), b_out_norm)
    return jnp.concatenate([oa, ob], axis=-1) @ w_out


def token_mixing(hx, hc, w_in, a_sink, b_q_norm, b_k_norm, a_out_norm, b_out_norm, w_out,
                 cos, sin, with_ctx_out):
    qa, ka, va, qb, kb, vb = project_heads(hx, w_in)
    qa_c, ka_c, va_c, qb_c, kb_c, vb_c = project_heads(hc, w_in)
    oa = windowed_sink_attention(apply_rope(qa, cos, sin), apply_rope(ka, cos, sin), va,
                                 ka_c, va_c, a_sink)
    kb_c = rms_norm(kb_c, b_k_norm)
    ob = blocked_global_attention(apply_rope(rms_norm(qb, b_q_norm), cos, sin),
                                  apply_rope(rms_norm(kb, b_k_norm), cos, sin), vb, kb_c, vb_c)
    out_x = merge_head_groups(oa, ob, a_out_norm, b_out_norm, w_out)
    if not with_ctx_out:
        return out_x, None
    oa_c = context_attention(qa_c, ka_c, va_c, a_sink)
    ob_c = context_attention(rms_norm(qb_c, b_q_norm), kb_c, vb_c, None)
    return out_x, merge_head_groups(oa_c, ob_c, a_out_norm, b_out_norm, w_out)


def hierarchical_moe(h, w_group, b_group, w_router, b_router, w_gate, w_up, w_down):
    g_logits = (h @ w_group + b_group).astype(jnp.float32)
    g_prob = jax.nn.softmax(g_logits, axis=-1)
    g_idx = jnp.argmax(g_logits, axis=-1)
    g_w = jnp.take_along_axis(g_prob, g_idx[..., None], axis=-1)
    e_logits = (h @ w_router + b_router).astype(jnp.float32)
    e_logits = e_logits.reshape(*h.shape[:-1], N_GROUPS, EXPERTS_PER_GROUP)
    sel = jnp.broadcast_to(g_idx[..., None, None], h.shape[:-1] + (1, EXPERTS_PER_GROUP))
    e_logits = jnp.take_along_axis(e_logits, sel, axis=-2)[..., 0, :]
    e_prob = jax.nn.softmax(e_logits, axis=-1)
    top_p, top_i = lax.top_k(e_prob, TOP_K_IN_GROUP)
    weights = g_w * top_p / jnp.sum(top_p, axis=-1, keepdims=True)
    expert_id = g_idx[..., None] * EXPERTS_PER_GROUP + top_i
    combine = jnp.sum(jax.nn.one_hot(expert_id, N_EXPERTS, dtype=jnp.float32) * weights[..., None],
                      axis=-2).astype(h.dtype)

    def per_sample(args):
        hs, cs = args
        gate = jnp.einsum('td,edf->tef', hs, w_gate)
        up = jnp.einsum('td,edf->tef', hs, w_up)
        act = jax.nn.silu(gate) * up * cs[..., None]
        return jnp.einsum('tef,efd->td', act, w_down)

    return lax.map(per_sample, (h, combine))


def setup_inputs(seed: int = 0) -> dict:
    key = jax.random.key(seed)
    ks = jax.random.split(key, 24)
    L, D = DEPTH, D_MODEL

    def normal(k, shape, scale):
        return jax.random.normal(k, shape, dtype=jnp.float32) * scale

    def gain(k, shape):
        return 1.0 + normal(k, shape, 0.02)

    return {
        'x': normal(ks[0], (BATCH, SEQ, D), 1.0),
        'c': normal(ks[1], (BATCH, D), 1.0),
        'ctx': normal(ks[2], (BATCH, CTX_LEN, D), 1.0),
        'c_ctx': normal(ks[3], (D,), 1.0),
        'w_mod': normal(ks[4], (L, D, 6 * D), 0.5 * D ** -0.5),
        'b_mod': normal(ks[5], (L, 6 * D), 0.02),
        'attn_pre_norm': gain(ks[6], (L, D)),
        'attn_post_norm': gain(ks[7], (L, D)),
        'w_in': normal(ks[8], (L, D, IN_DIM), D ** -0.5),
        'a_sink': normal(ks[9], (L, A_Q_HEADS), 0.5),
        'b_q_norm': gain(ks[10], (L, HEAD_DIM)),
        'b_k_norm': gain(ks[11], (L, HEAD_DIM)),
        'a_out_norm': gain(ks[12], (L, A_Q_DIM)),
        'b_out_norm': gain(ks[13], (L, B_Q_DIM)),
        'w_out': normal(ks[14], (L, MIX_DIM, D), MIX_DIM ** -0.5),
        'ffn_pre_norm': gain(ks[15], (L, D)),
        'ffn_post_norm': gain(ks[16], (L, D)),
        'w_group': normal(ks[17], (L, D, N_GROUPS), D ** -0.5),
        'b_group': normal(ks[18], (L, N_GROUPS), 0.01),
        'w_router': normal(ks[19], (L, D, N_EXPERTS), D ** -0.5),
        'b_router': normal(ks[20], (L, N_EXPERTS), 0.01),
        'w_gate': normal(ks[21], (L, N_EXPERTS, D, EXPERT_FF), D ** -0.5),
        'w_up': normal(ks[22], (L, N_EXPERTS, D, EXPERT_FF), D ** -0.5),
        'w_down': normal(ks[23], (L, N_EXPERTS, EXPERT_FF, D), EXPERT_FF ** -0.5),
    }


def reference(x, c, ctx, c_ctx, w_mod, b_mod, attn_pre_norm, attn_post_norm, w_in, a_sink,
              b_q_norm, b_k_norm, a_out_norm, b_out_norm, w_out, ffn_pre_norm, ffn_post_norm,
              w_group, b_group, w_router, b_router, w_gate, w_up, w_down):
    rows = x.shape[1] // GRID_W
    cos, sin = axial_rope_tables(rows)
    silu_c = jax.nn.silu(c)
    silu_c_ctx = jax.nn.silu(c_ctx)
    for l in range(DEPTH):
        last = l == DEPTH - 1
        mod_x = (silu_c @ w_mod[l] + b_mod[l])[:, None, :]
        mod_c = (silu_c_ctx @ w_mod[l] + b_mod[l])[None, None, :]
        sh1, sc1, g1, sh2, sc2, g2 = jnp.split(mod_x, 6, axis=-1)
        csh1, csc1, cg1, csh2, csc2, cg2 = jnp.split(mod_c, 6, axis=-1)
        hx = rms_norm(x, attn_pre_norm[l]) * (1 + sc1) + sh1
        hc = rms_norm(ctx, attn_pre_norm[l]) * (1 + csc1) + csh1
        ox, oc = token_mixing(hx, hc, w_in[l], a_sink[l], b_q_norm[l], b_k_norm[l], a_out_norm[l],
                              b_out_norm[l], w_out[l], cos, sin, not last)
        x = x + g1 * rms_norm(ox, attn_post_norm[l])
        hx = rms_norm(x, ffn_pre_norm[l]) * (1 + sc2) + sh2
        fx = hierarchical_moe(hx, w_group[l], b_group[l], w_router[l], b_router[l],
                              w_gate[l], w_up[l], w_down[l])
        x = x + g2 * rms_norm(fx, ffn_post_norm[l])
        if not last:
            ctx = ctx + cg1 * rms_norm(oc, attn_post_norm[l])
            hc = rms_norm(ctx, ffn_pre_norm[l]) * (1 + csc2) + csh2
            fc = hierarchical_moe(hc, w_group[l], b_group[l], w_router[l], b_router[l],
                                  w_gate[l], w_up[l], w_down[l])
            ctx = ctx + cg2 * rms_norm(fc, ffn_post_norm[l])
    return x
```

```cpp
#include <hip/hip_runtime.h>
#include <cstdio>
#include <cstdint>
#ifndef WCONV_IN_ATTN
#define WCONV_IN_ATTN 1
#endif

constexpr int NB = 8, T = 2048, D = 1024, CL = 256;
constexpr int ML = NB * T;
constexpr int MC = NB * CL;
constexpr int MT = ML + MC;
constexpr int NKEY = T + CL;
constexpr int NTILE = NKEY / 64;
constexpr int NQKV = 1536;
constexpr int NE = 32, EFF = 512;
constexpr int MAXPOS = 40960;
constexpr int MAXTILES = MAXPOS / 256;
constexpr float EPS = 1e-6f;
constexpr float LOG2E = 1.4426950408889634f;
constexpr float C2 = 0.125f * LOG2E;

typedef unsigned short bf16;

constexpr size_t MiB = 1u << 20;
constexpr size_t WS_CTL = 0;
constexpr size_t WS_MODX = 1 * MiB;
constexpr size_t WS_ROPE = 1 * MiB + 512 * 1024;
constexpr size_t WS_WR = 1 * MiB + 768 * 1024;
constexpr size_t WS_TOKE = 2 * MiB;
constexpr size_t WS_TOKW = WS_TOKE + 128 * 1024;
constexpr size_t WS_TOKPOS = WS_TOKW + 128 * 1024;
constexpr size_t WS_ROWIDX = WS_TOKPOS + 128 * 1024;
constexpr size_t WS_ROWW = WS_ROWIDX + 160 * 1024;
constexpr size_t WS_BLKCNT = WS_ROWW + 160 * 1024;
constexpr size_t WS_META = WS_BLKCNT + 32 * 1024;
constexpr size_t WS_WQKV = 4 * MiB;
constexpr size_t WS_WO = 7 * MiB;
constexpr size_t WS_WGU = 9 * MiB;
constexpr size_t WS_WD = 73 * MiB;
constexpr size_t WS_XN = 105 * MiB;
constexpr size_t WS_QA = 141 * MiB;
constexpr size_t WS_QB = 157 * MiB;
constexpr size_t WS_KA = 173 * MiB;
constexpr size_t WS_VA = WS_KA + 4608 * 1024;
constexpr size_t WS_KB = WS_VA + 4608 * 1024;
constexpr size_t WS_VB = WS_KB + 4608 * 1024;
constexpr size_t WS_O = 191 * MiB;
constexpr size_t WS_SSQ = 223 * MiB;
constexpr size_t WS_OX = 224 * MiB;
constexpr size_t WS_ACT = 141 * MiB;
constexpr size_t WS_Y = 181 * MiB;
constexpr size_t WS_END = 261 * MiB;

__device__ __forceinline__ unsigned f2bf(float f) { unsigned u = __builtin_bit_cast(unsigned, f); return (u + 0x7fffu + ((u >> 16) & 1u)) >> 16; }
__device__ __forceinline__ float bf2f(bf16 h) { return __builtin_bit_cast(float, (unsigned)h << 16); }
__device__ __forceinline__ float wave_sum(float v) {
#pragma unroll
    for (int o = 1; o < 64; o <<= 1) v += __shfl_xor(v, o);
    return v;
}
__device__ __forceinline__ float wave_max(float v) {
#pragma unroll
    for (int o = 1; o < 64; o <<= 1) v = fmaxf(v, __shfl_xor(v, o));
    return v;
}
__device__ __forceinline__ float silu_f(float v) { return v / (1.f + __expf(-v)); }

__host__ __device__ __forceinline__ int qkv_row(int n) { const int pn = n >> 8, j = n & 255, hh = j >> 6, d = j & 63; return pn * 256 + (d >> 5) * 128 + hh * 32 + (d & 31); }
__host__ __device__ __forceinline__ size_t q_off(int b, int h, int t, int d) { return (((size_t)(b * 8 + h) * T + t) * 64 + d); }
__host__ __device__ __forceinline__ size_t k_off(int b, int kvh, int pos, int d) { return ((size_t)((b * 2 + kvh) * NTILE + (pos >> 6)) * 4096 + (d >> 3) * 512 + (pos & 63) * 8 + (d & 7)); }
__host__ __device__ __forceinline__ size_t v_off(int b, int kvh, int pos, int d) { return ((size_t)((b * 2 + kvh) * NTILE + (pos >> 6)) * 4096 + (d >> 5) * 2048 + (pos & 63) * 32 + (d & 31)); }

struct P {
    const float *x, *c, *ctx, *c_ctx, *w_mod, *b_mod, *pre1, *post1, *w_in, *a_sink, *bqn, *bkn, *aon, *bon, *w_out, *pre2, *post2, *w_group, *b_group, *w_router, *b_router, *w_gate, *w_up, *w_down;
    float* out; unsigned char* ws;
};

#define GAS __attribute__((address_space(1)))
#define LAS __attribute__((address_space(3)))
typedef unsigned v4u __attribute__((ext_vector_type(4)));
typedef unsigned v2u __attribute__((ext_vector_type(2)));
typedef float f32x4 __attribute__((ext_vector_type(4)));
typedef float f32x16 __attribute__((ext_vector_type(16)));
typedef short bf16x8 __attribute__((ext_vector_type(8)));
typedef short s16x4 __attribute__((ext_vector_type(4)));
constexpr int NWAVES = 8, NTHR = 512;
constexpr int LDS_BYTES = 163840;
constexpr int RING_BYTES = 131072;
constexpr int MISC_OFF = 159 * 1024;
constexpr int CW_TMO = 0, CW_CODE = 1, CW_BAR = 4096;
#define LDS_WAIT() asm volatile("s_waitcnt lgkmcnt(0)" ::: "memory")
#define VM_WAIT() asm volatile("s_waitcnt vmcnt(0)" ::: "memory")
__device__ __forceinline__ unsigned pk2(float lo, float hi) { return f2bf(lo) | (f2bf(hi) << 16); }
#ifndef WT_STORES
#define WT_STORES 0
#endif
__device__ __forceinline__ void st16(void* p, v4u v) {
#if WT_STORES
    asm volatile("global_store_dwordx4 %0, %1, off sc1\n\ts_nop 1" :: "v"(p), "v"(v) : "memory");
#else
    *(v4u*)p = v;
#endif
}
__device__ __forceinline__ void st16f(void* p, f32x4 v) { st16(p, __builtin_bit_cast(v4u, v)); }
__device__ __forceinline__ void st8(void* p, v2u v) {
#if WT_STORES
    asm volatile("global_store_dwordx2 %0, %1, off sc1\n\ts_nop 1" :: "v"(p), "v"(v) : "memory");
#else
    *(v2u*)p = v;
#endif
}

#define XB_TMO      128
#define XB_XCNT(j)  (256  + 64 * (j))
#define XB_XSUB(j)  (1280 + 64 * (j))
#define XB_XGEN(j)  (2304 + 64 * (j))
#define XB_TOP      3328
#define XB_TOPGEN   3392
#define XCD_BAR_WORDS 3456
#define XB_SPIN_CAP (1u << 18)
__device__ __forceinline__ unsigned xb_ld(unsigned* p)              { return __hip_atomic_load(p, __ATOMIC_RELAXED, __HIP_MEMORY_SCOPE_AGENT); }
__device__ __forceinline__ unsigned xb_add(unsigned* p, unsigned v) { return __hip_atomic_fetch_add(p, v, __ATOMIC_RELAXED, __HIP_MEMORY_SCOPE_AGENT); }
__device__ __forceinline__ unsigned xb_xcc_id() { return (unsigned)__builtin_amdgcn_s_getreg((3 << 11) | 20) & 0xFu; }
#define XB_SPIN(cond, bar) do { unsigned _sp = 0; while (cond) { __builtin_amdgcn_s_sleep(1); \
    if ((++_sp & 255u) == 0u) { if (xb_ld(&(bar)[XB_TMO])) break; if (_sp > XB_SPIN_CAP) { atomicAdd(&(bar)[XB_TMO], 1u); break; } } } } while (0)
struct XcdBarrier { unsigned* bar; unsigned x; volatile LAS unsigned* st; };
__device__ __forceinline__ XcdBarrier xcd_barrier_post(unsigned* bar, volatile LAS unsigned* st) {
    XcdBarrier b; b.bar = bar; b.x = xb_xcc_id(); b.st = st;
    if (threadIdx.x == 0) (void)xb_add(&bar[XB_XCNT(b.x)], 1u);
    return b;
}
__device__ __forceinline__ void xcd_barrier_complete(unsigned* bar, unsigned x, unsigned& nloc, unsigned& nx) {
    const unsigned G = gridDim.x * gridDim.y * gridDim.z;
    unsigned sum, cnt, mine, sp = 0u;
    for (;;) {
        sum = 0u; cnt = 0u; mine = 0u;
#pragma unroll
        for (unsigned j = 0; j < 16; ++j) { const unsigned c = xb_ld(&bar[XB_XCNT(j)]); sum += c; cnt += (c > 0u) ? 1u : 0u; mine = (j == x) ? c : mine; }
        if (sum == G) break;
        __builtin_amdgcn_s_sleep(1);
        if ((++sp & 255u) == 0u) { if (xb_ld(&bar[XB_TMO])) break; if (sp > XB_SPIN_CAP) { atomicAdd(&bar[XB_TMO], 1u); break; } }
    }
    nloc = mine > 0u ? mine : 1u; nx = cnt > 0u ? cnt : 1u;
}
__device__ __forceinline__ void xcd_barrier(const XcdBarrier& b) {
    asm volatile("s_waitcnt vmcnt(0)" ::: "memory");
    __syncthreads();
    if (threadIdx.x == 0) {
        unsigned* bar = b.bar;
        __builtin_amdgcn_s_waitcnt(0);
        unsigned nloc = b.st[0], nx = b.st[1];
        if (nloc == 0u) { xcd_barrier_complete(bar, b.x, nloc, nx); b.st[0] = nloc; b.st[1] = nx; }
        const unsigned old = xb_add(&bar[XB_XSUB(b.x)], 1u);
        const unsigned gen = old / nloc;
        if (old + 1u == (gen + 1u) * nloc) {
            __builtin_amdgcn_fence(__ATOMIC_RELEASE, "agent");
            asm volatile("s_waitcnt vmcnt(0)" ::: "memory");
            const unsigned og = xb_add(&bar[XB_TOP], 1u);
            const unsigned tg = og / nx;
            if (og + 1u == (tg + 1u) * nx) xb_add(&bar[XB_TOPGEN], 1u);
            else XB_SPIN(xb_ld(&bar[XB_TOPGEN]) == tg, bar);
            __builtin_amdgcn_fence(__ATOMIC_ACQUIRE, "agent");
            xb_add(&bar[XB_XGEN(b.x)], 1u);
            asm volatile("s_waitcnt vmcnt(0)" ::: "memory");
        } else {
            XB_SPIN(xb_ld(&bar[XB_XGEN(b.x)]) == gen, bar);
            __builtin_amdgcn_fence(__ATOMIC_ACQUIRE, "agent");
            asm volatile("s_waitcnt vmcnt(0)" ::: "memory");
        }
    }
    __syncthreads();
}

namespace pg8 {
#define PG8_LAS __attribute__((address_space(3)))
typedef unsigned short bf16_t;
typedef short bf16x8 __attribute__((ext_vector_type(8)));
typedef float f32x4 __attribute__((ext_vector_type(4)));
typedef unsigned u32x4 __attribute__((ext_vector_type(4)));
constexpr int BM = 256, BK = 64, HALF = 128, HTB = HALF * BK * 2  , STAGE_BYTES = 8 * HTB, NXCD = 8, WGM = 8;

__host__ __device__ __forceinline__ int lds_byte(int r, int c) { const int st = (r >> 4) * 2 + (c >> 5), rr = r & 15, cc = c & 31, ob = rr * 64 + cc * 2; return st * 1024 + (ob ^ (((ob >> 9) & 1) << 5)); }
__host__ __device__ __forceinline__ void stage_rc(int b, int& R, int& C) { const int st = b / 1024, sb = b % 1024, swz = sb ^ (((sb >> 9) & 1) << 5); R = (st >> 1) * 16 + swz / 64; C = (st & 1) * 32 + (swz % 64) / 2; }
__host__ __device__ __forceinline__ int perm32(int rho) { const int n = rho >> 4, i = rho & 15; return 8 * (i >> 2) + 4 * n + (i & 3); }

struct Unit { int pm, pn; };
struct Gemm { const bf16_t* A; const bf16_t* Bt; int M, N, K; };
__device__ __forceinline__ unsigned cvt_pk_bf16(float lo, float hi) { unsigned r; asm volatile("v_cvt_pk_bf16_f32 %0, %1, %2" : "=v"(r) : "v"(lo), "v"(hi)); return r; }
template <class Epi, class Sched, bool ALIGN_EPI = false, bool SP2 = false, bool GATHER = false>
__device__ __forceinline__ void gemm_phase(PG8_LAS unsigned char* lds, const Gemm g, const Sched& S, const Epi& E) {
    const int tid = threadIdx.x, wid = __builtin_amdgcn_readfirstlane(tid >> 6), lane = tid & 63, wr = wid >> 2, wc = wid & 3, fr = lane & 15, fq = lane >> 4;
    const int K = g.K, nt = K / BK;
    unsigned voffA[2], voffB[2]; int RA[2], CA[2];
#pragma unroll
    for (int i = 0; i < 2; ++i) { int R, C; stage_rc(tid * 16 + i * 8192, R, C); const int Rb = Epi::PERM ? ((R & ~31) + perm32(R & 31)) : R;
        voffA[i] = (unsigned)(R * K + C) * 2u; voffB[i] = (unsigned)(Rb * K + C) * 2u; RA[i] = R; CA[i] = C; }
    const size_t kstep = (size_t)(BK * 2);
    const size_t hstep = (size_t)HALF * K * 2;
    const size_t tstep = 2 * hstep;
    const unsigned ldsw = (unsigned)wid * 1024u;
    const int aoff = lds_byte(wr * 64 + fr, fq * 8), boff = lds_byte(wc * 32 + fr, fq * 8);
#define PG8_SA(b, h) (((b) * 2 + (h)) * HTB)
#define PG8_SB(b, h) ((4 + (b) * 2 + (h)) * HTB)
#define PG8_STAGE(bufoff, gbase, voff) do { _Pragma("unroll") for (int _i = 0; _i < 2; ++_i) \
        __builtin_amdgcn_global_load_lds((const unsigned*)((const char*)(gbase) + (voff)[_i]), (PG8_LAS unsigned*)(lds + (bufoff) + ldsw + _i * 8192), 16, 0, 0); } while (0)
#define PG8_STAGE_A(bufoff, gbase, h, VO) do { if constexpr (GATHER) { PG8_STAGE(bufoff, gbase, VO[h]); } else { PG8_STAGE(bufoff, (gbase) + (h) * hstep, voffA); } } while (0)
#define PG8_LDA(dst, b, h) do { _Pragma("unroll") for (int m = 0; m < 4; ++m) _Pragma("unroll") for (int k = 0; k < 2; ++k) dst[m][k] = *(const PG8_LAS bf16x8*)(lds + PG8_SA(b, h) + aoff + m * 2048 + k * 1024); } while (0)
#define PG8_LDB(dst, b, h) do { _Pragma("unroll") for (int n = 0; n < 2; ++n) _Pragma("unroll") for (int k = 0; k < 2; ++k) dst[n][k] = *(const PG8_LAS bf16x8*)(lds + PG8_SB(b, h) + boff + n * 2048 + k * 1024); } while (0)
#define PG8_MMA(ai, bj, At, Bt) do { __builtin_amdgcn_s_setprio(1); _Pragma("unroll") for (int m = 0; m < 4; ++m) _Pragma("unroll") for (int n = 0; n < 2; ++n) _Pragma("unroll") for (int k = 0; k < 2; ++k) \
        acc[ai][bj][m][n] = __builtin_amdgcn_mfma_f32_16x16x32_bf16(Bt[n][k], At[m][k], acc[ai][bj][m][n], 0, 0, 0); __builtin_amdgcn_s_setprio(0); } while (0)
#define PG8_WAIT_V(n) asm volatile("s_waitcnt vmcnt(" #n ")" ::: "memory")
#define PG8_WAIT_L(n) asm volatile("s_waitcnt lgkmcnt(" #n ")" ::: "memory")
#define PG8_BAR __builtin_amdgcn_s_barrier()
#define PG8_SCHED __builtin_amdgcn_sched_barrier(0)
    Unit cur, nxt; int ui = 0;
    if (!S.next(0, cur)) return;
    f32x4 acc[2][2][4][2];
#pragma unroll
    for (int a = 0; a < 2; ++a)
#pragma unroll
        for (int b = 0; b < 2; ++b)
#pragma unroll
            for (int m = 0; m < 4; ++m)
#pragma unroll
                for (int n = 0; n < 2; ++n) acc[a][b][m][n] = (f32x4){0.f, 0.f, 0.f, 0.f};
    bf16x8 At[4][2], B0[2][2], B1[2][2];
    const char* cA = (const char*)g.A + (GATHER ? (size_t)0 : (size_t)cur.pm * tstep); const char* cB = (const char*)g.Bt + (size_t)cur.pn * tstep;
    unsigned vcur[2][2], vnxt[2][2], vsel[2][2];
#pragma unroll
    for (int h = 0; h < 2; ++h)
#pragma unroll
        for (int i = 0; i < 2; ++i) { vcur[h][i] = 0u; vnxt[h][i] = 0u; vsel[h][i] = 0u; }
    if constexpr (GATHER) {
#pragma unroll
        for (int h = 0; h < 2; ++h)
#pragma unroll
            for (int i = 0; i < 2; ++i) vcur[h][i] = ((unsigned)S.rowidx[cur.pm * BM + h * HALF + RA[i]] * (unsigned)K + (unsigned)CA[i]) * 2u;
    }
    S.a_ready(cur);
    if constexpr (SP2) {
        PG8_STAGE(PG8_SB(0, 0), cB, voffB); PG8_STAGE(PG8_SB(0, 1), cB + hstep, voffB); PG8_STAGE_A(PG8_SA(0, 0), cA, 0, vcur); PG8_STAGE_A(PG8_SA(0, 1), cA, 1, vcur);
        if (wr == 1) PG8_BAR;
        PG8_WAIT_V(2); PG8_BAR;
        PG8_STAGE(PG8_SB(1, 0), cB + kstep, voffB); PG8_STAGE_A(PG8_SA(1, 0), cA + kstep, 0, vcur); PG8_STAGE(PG8_SB(1, 1), cB + hstep + kstep, voffB);
        PG8_WAIT_V(6); PG8_BAR;
    } else {
        PG8_STAGE(PG8_SB(0, 0), cB, voffB); PG8_STAGE_A(PG8_SA(0, 0), cA, 0, vcur); PG8_STAGE(PG8_SB(0, 1), cB + hstep, voffB); PG8_STAGE_A(PG8_SA(0, 1), cA, 1, vcur);
        if (wr == 1) PG8_BAR;
        PG8_WAIT_V(4); PG8_BAR;
        PG8_STAGE(PG8_SB(1, 0), cB + kstep, voffB); PG8_STAGE_A(PG8_SA(1, 0), cA + kstep, 0, vcur); PG8_STAGE(PG8_SB(1, 1), cB + hstep + kstep, voffB);
        PG8_WAIT_V(6); PG8_BAR;
    }
    for (;;) {
        const bool has_next = S.next(ui + 1, nxt);
        if constexpr (GATHER) {
#pragma unroll
            for (int h = 0; h < 2; ++h)
#pragma unroll
                for (int i = 0; i < 2; ++i) vnxt[h][i] = has_next ? ((unsigned)S.rowidx[nxt.pm * BM + h * HALF + RA[i]] * (unsigned)K + (unsigned)CA[i]) * 2u : vcur[h][i];
        }
        const char* nA = has_next ? (const char*)g.A + (GATHER ? (size_t)0 : (size_t)nxt.pm * tstep) : cA; const char* nB = has_next ? (const char*)g.Bt + (size_t)nxt.pn * tstep : cB;
        for (int t = 0; t < nt; t += 2) {
            const bool last = (t == nt - 2);
            if constexpr (GATHER) {
#pragma unroll
                for (int h = 0; h < 2; ++h)
#pragma unroll
                    for (int i = 0; i < 2; ++i) vsel[h][i] = last ? vnxt[h][i] : vcur[h][i];
            }
            if constexpr (Epi::HAS_MID) { if (t == nt / 2) E.mid(acc, cur, wr, wc, fr, fq); }
            const char* a1 = cA + (size_t)(t + 1) * kstep;
            const char* a2 = last ? nA : cA + (size_t)(t + 2) * kstep; const char* b2 = last ? nB : cB + (size_t)(t + 2) * kstep;
            const char* a3 = a2 + kstep; const char* b3 = b2 + kstep;
            if (last && has_next) S.a_ready(nxt);
            if constexpr (SP2) {
            PG8_LDB(B0, 0, 0); PG8_LDB(B1, 0, 1); PG8_SCHED; PG8_LDA(At, 0, 0); PG8_STAGE_A(PG8_SA(1, 1), a1, 1, vcur);
            PG8_WAIT_V(8); PG8_WAIT_L(0); PG8_BAR; PG8_MMA(0, 0, At, B0); PG8_MMA(0, 1, At, B1); PG8_BAR; PG8_SCHED;
            PG8_LDA(At, 0, 1); PG8_STAGE(PG8_SB(0, 0), b2, voffB); PG8_STAGE(PG8_SB(0, 1), b2 + hstep, voffB); PG8_STAGE_A(PG8_SA(0, 0), a2, 0, vsel);
            PG8_WAIT_V(8); PG8_WAIT_L(0); PG8_BAR; PG8_MMA(1, 0, At, B0); PG8_MMA(1, 1, At, B1); PG8_BAR; PG8_SCHED;
            PG8_LDB(B0, 1, 0); PG8_LDB(B1, 1, 1); PG8_SCHED; PG8_LDA(At, 1, 0); PG8_STAGE_A(PG8_SA(0, 1), a2, 1, vsel);
            PG8_WAIT_V(8); PG8_WAIT_L(0); PG8_BAR; PG8_MMA(0, 0, At, B0); PG8_MMA(0, 1, At, B1); PG8_BAR; PG8_SCHED;
            PG8_LDA(At, 1, 1); PG8_STAGE(PG8_SB(1, 0), b3, voffB); PG8_STAGE(PG8_SB(1, 1), b3 + hstep, voffB); PG8_STAGE_A(PG8_SA(1, 0), a3, 0, vsel);
            PG8_WAIT_V(8); PG8_WAIT_L(0); PG8_BAR; PG8_MMA(1, 0, At, B0); PG8_MMA(1, 1, At, B1); PG8_BAR; PG8_SCHED;
            } else {
            PG8_LDB(B0, 0, 0); PG8_SCHED; PG8_LDA(At, 0, 0); PG8_STAGE_A(PG8_SA(1, 1), a1, 1, vcur);
            PG8_WAIT_L(8); PG8_BAR; PG8_WAIT_L(0); PG8_MMA(0, 0, At, B0); PG8_BAR; PG8_SCHED;
            PG8_LDB(B1, 0, 1); PG8_STAGE(PG8_SB(0, 0), b2, voffB);
            PG8_BAR; PG8_WAIT_L(0); PG8_MMA(0, 1, At, B1); PG8_BAR;
            PG8_LDA(At, 0, 1); PG8_STAGE_A(PG8_SA(0, 0), a2, 0, vsel);
            PG8_BAR; PG8_WAIT_L(0); PG8_MMA(1, 0, At, B0); PG8_BAR; PG8_SCHED;
            PG8_STAGE(PG8_SB(0, 1), b2 + hstep, voffB);
            PG8_WAIT_V(6); PG8_BAR; PG8_MMA(1, 1, At, B1); PG8_BAR;
            PG8_LDB(B0, 1, 0); PG8_SCHED; PG8_LDA(At, 1, 0); PG8_STAGE_A(PG8_SA(0, 1), a2, 1, vsel);
            PG8_WAIT_L(8); PG8_BAR; PG8_WAIT_L(0); PG8_MMA(0, 0, At, B0); PG8_BAR; PG8_SCHED;
            PG8_LDB(B1, 1, 1); PG8_STAGE(PG8_SB(1, 0), b3, voffB);
            PG8_BAR; PG8_WAIT_L(0); PG8_MMA(0, 1, At, B1); PG8_BAR;
            PG8_LDA(At, 1, 1); PG8_STAGE_A(PG8_SA(1, 0), a3, 0, vsel);
            PG8_BAR; PG8_WAIT_L(0); PG8_MMA(1, 0, At, B0); PG8_BAR; PG8_SCHED;
            PG8_STAGE(PG8_SB(1, 1), b3 + hstep, voffB);
            PG8_WAIT_V(6); PG8_BAR; PG8_MMA(1, 1, At, B1); PG8_BAR;
            }
        }
        if constexpr (ALIGN_EPI) { if (wr == 0) PG8_BAR; }
        if constexpr (!Epi::AFTER_DRAIN) { E(acc, cur, wr, wc, fr, fq); S.done(cur); }
        if (!has_next) break;
#pragma unroll
        for (int a = 0; a < 2; ++a)
#pragma unroll
            for (int b = 0; b < 2; ++b)
#pragma unroll
                for (int m = 0; m < 4; ++m)
#pragma unroll
                    for (int n = 0; n < 2; ++n) acc[a][b][m][n] = (f32x4){0.f, 0.f, 0.f, 0.f};
        cur = nxt; cA = nA; cB = nB; ++ui;
        if constexpr (GATHER) {
#pragma unroll
            for (int h = 0; h < 2; ++h)
#pragma unroll
                for (int i = 0; i < 2; ++i) vcur[h][i] = vnxt[h][i];
        }
        if constexpr (ALIGN_EPI) { if (wr == 1) PG8_BAR; }
    }
    PG8_WAIT_V(0);
    if constexpr (!ALIGN_EPI) { if (wr == 0) PG8_BAR; }
    PG8_BAR;
    if constexpr (Epi::AFTER_DRAIN) { E.fused(acc, cur, wr, wc, fr, fq, lds, wid, lane); S.done(cur); }
#undef PG8_SA
#undef PG8_SB
#undef PG8_STAGE
#undef PG8_STAGE_A
#undef PG8_LDA
#undef PG8_LDB
#undef PG8_MMA
#undef PG8_WAIT_V
#undef PG8_WAIT_L
#undef PG8_BAR
#undef PG8_SCHED
}
}

namespace pg8 {
struct SchedQKV {
    int G, c;
    __device__ __forceinline__ bool next(int i, Unit& u) const {
        const int L = i * G + c; if (L >= 400) return false;
        if (L < 384) { const int xcd = L & 7, off = L >> 3, w = xcd * 48 + off; u.pm = (w / 48) * 8 + ((w % 48) & 7); u.pn = (w % 48) >> 3; }
        else { const int j = L - 384; u.pm = 64 + (j >> 1); u.pn = (j & 1) ? 5 : 2; }
        return true;
    }
    __device__ __forceinline__ void a_ready(const Unit&) const {}
    __device__ __forceinline__ void done(const Unit&) const {}
};
struct EpiQKV {
    static constexpr bool PERM = true, AFTER_DRAIN = false, HAS_MID = false;
    unsigned char* ws; const float* bqn; const float* bkn;
    __device__ __forceinline__ void operator()(const f32x4 (&acc)[2][2][4][2], const Unit& u, int wr, int wc, int fr, int fq) const {
        const int pn = u.pn; const bool isctx = u.pm >= 64;
        int kind, hh;
        if (pn < 2) { kind = 0; hh = pn * 4 + wc; } else if (pn == 2) { kind = wc < 2 ? 2 : 4; hh = wc & 1; } else if (pn < 5) { kind = 1; hh = (pn - 3) * 4 + wc; } else { kind = wc < 2 ? 3 : 5; hh = wc & 1; }
        const bool rms = kind == 1 || kind == 3, rope = !isctx && kind <= 3;
        const float* gp = kind == 1 ? bqn : bkn;
        f32x4 gain[2][2];
#pragma unroll
        for (int bj = 0; bj < 2; ++bj)
#pragma unroll
            for (int n = 0; n < 2; ++n) gain[bj][n] = rms ? *(const f32x4*)(gp + 32 * bj + 8 * fq + 4 * n) : (f32x4){1.f, 1.f, 1.f, 1.f};
        const float* tab = (const float*)(ws + WS_ROPE);
        bf16* base = (bf16*)(ws + (kind == 0 ? WS_QA : kind == 1 ? WS_QB : kind == 2 ? WS_KA : kind == 3 ? WS_KB : kind == 4 ? WS_VA : WS_VB));
        const float qs = kind <= 1 ? C2 : 1.f;
#pragma unroll
        for (int ai = 0; ai < 2; ++ai)
#pragma unroll
            for (int m = 0; m < 4; ++m) {
                const int row = u.pm * BM + ai * HALF + wr * 64 + m * 16 + fr;
                int b, t, pos;
                if (!isctx) { b = row >> 11; t = row & 2047; pos = t; } else { const int cr = row - ML; b = cr >> 8; t = 0; pos = T + (cr & 255); }
                f32x4 v[2][2];
#pragma unroll
                for (int bj = 0; bj < 2; ++bj)
#pragma unroll
                    for (int n = 0; n < 2; ++n) v[bj][n] = acc[ai][bj][m][n];
                if (rms) {
                    float ss = 0.f;
#pragma unroll
                    for (int bj = 0; bj < 2; ++bj)
#pragma unroll
                        for (int n = 0; n < 2; ++n) ss += (v[bj][n].x * v[bj][n].x + v[bj][n].y * v[bj][n].y) + (v[bj][n].z * v[bj][n].z + v[bj][n].w * v[bj][n].w);
                    ss += __shfl_xor(ss, 16); ss += __shfl_xor(ss, 32);
                    const float rn = rsqrtf(ss * (1.f / 64.f) + EPS);
#pragma unroll
                    for (int bj = 0; bj < 2; ++bj)
#pragma unroll
                        for (int n = 0; n < 2; ++n) v[bj][n] = v[bj][n] * rn * gain[bj][n];
                }
                if (rope) {
#pragma unroll
                    for (int bj = 0; bj < 2; ++bj)
#pragma unroll
                        for (int n = 0; n < 2; ++n) {
                            const int tp = bj == 0 ? (t >> 6) : 32 + (t & 63);
                            const f32x4 cs = *(const f32x4*)(tab + (tp * 16 + 4 * fq + 2 * n) * 2);
                            const f32x4 x = v[bj][n];
                            v[bj][n] = (f32x4){x.x * cs.x - x.y * cs.y, x.x * cs.y + x.y * cs.x, x.z * cs.z - x.w * cs.w, x.z * cs.w + x.w * cs.z};
                        }
                }
#pragma unroll
                for (int bj = 0; bj < 2; ++bj) {
                    const f32x4 v0 = v[bj][0] * qs, v1 = v[bj][1] * qs;
                    u32x4 w; w.x = pk2(v0.x, v0.y); w.y = pk2(v0.z, v0.w); w.z = pk2(v1.x, v1.y); w.w = pk2(v1.z, v1.w);
                    const int d0 = 32 * bj + 8 * fq;
                    bf16* dst = kind <= 1 ? base + q_off(b, hh, t, d0) : kind <= 3 ? base + k_off(b, hh, pos, d0) : base + v_off(b, hh, pos, d0);
                    st16(dst, w);
                }
            }
    }
};
}


namespace pg8 {
struct SchedOne { Unit u;
    __device__ __forceinline__ bool next(int i, Unit& o) const { if (i) return false; o = u; return true; }
    __device__ __forceinline__ void a_ready(const Unit&) const {}
    __device__ __forceinline__ void done(const Unit&) const {} };
struct EpiOut {
    static constexpr bool PERM = true, AFTER_DRAIN = false, HAS_MID = true;
    bf16* OX; const LAS float* tab;
    __device__ __forceinline__ void mid(f32x4 (&acc)[2][2][4][2], const Unit&, int wr, int, int fr, int) const {
#pragma unroll
        for (int ai = 0; ai < 2; ++ai)
#pragma unroll
            for (int m = 0; m < 4; ++m) { const float f = tab[2 * (ai * HALF + wr * 64 + m * 16 + fr)];
#pragma unroll
                for (int bj = 0; bj < 2; ++bj)
#pragma unroll
                    for (int n = 0; n < 2; ++n) acc[ai][bj][m][n] = acc[ai][bj][m][n] * f; }
    }
    __device__ __forceinline__ void operator()(const f32x4 (&acc)[2][2][4][2], const Unit& u, int wr, int wc, int fr, int fq) const {
#pragma unroll
        for (int ai = 0; ai < 2; ++ai)
#pragma unroll
            for (int m = 0; m < 4; ++m) { const int r = ai * HALF + wr * 64 + m * 16 + fr; const float f = tab[2 * r + 1];
                bf16* rowp = OX + (size_t)(u.pm * BM + r) * D + u.pn * BM + wc * 32 + 8 * fq;
#pragma unroll
                for (int bj = 0; bj < 2; ++bj) { const f32x4 v0 = acc[ai][bj][m][0] * f, v1 = acc[ai][bj][m][1] * f;
                    u32x4 w; w.x = pk2(v0.x, v0.y); w.y = pk2(v0.z, v0.w); w.z = pk2(v1.x, v1.y); w.w = pk2(v1.z, v1.w);
                    st16(rowp + bj * HALF, w); } }
    }
};
struct SchedMoE {
    int G, c, nwg; const LAS int* tile_e; const int* rowidx;
    __device__ __forceinline__ bool next(int i, Unit& u) const {
        const int L = i * G + c; if (L >= nwg) return false;
        const int q = nwg >> 3, r = nwg & 7, xcd = L & 7, off = L >> 3;
        const int w = (xcd < r ? xcd * (q + 1) : r * (q + 1) + (xcd - r) * q) + off;
        u.pm = w >> 2; u.pn = tile_e[w >> 2] * 4 + (w & 3); return true;
    }
    __device__ __forceinline__ void a_ready(const Unit&) const {}
    __device__ __forceinline__ void done(const Unit&) const {}
};
__device__ __forceinline__ float silu_fast(float g) { return g * __builtin_amdgcn_rcpf(1.f + __builtin_amdgcn_exp2f(-g * LOG2E)); }
struct EpiGU {
    static constexpr bool PERM = true, AFTER_DRAIN = false, HAS_MID = false;
    bf16* ACT; const float* roww;
    __device__ __forceinline__ void operator()(const f32x4 (&acc)[2][2][4][2], const Unit& u, int wr, int wc, int fr, int fq) const {
#pragma unroll
        for (int ai = 0; ai < 2; ++ai)
#pragma unroll
            for (int m = 0; m < 4; ++m) { const int pos = u.pm * BM + ai * HALF + wr * 64 + m * 16 + fr; const float w = roww[pos];
                const f32x4 g0 = acc[ai][0][m][0], g1 = acc[ai][0][m][1], u0 = acc[ai][1][m][0], u1 = acc[ai][1][m][1];
                u32x4 o;
                o.x = pk2(silu_fast(g0.x) * u0.x * w, silu_fast(g0.y) * u0.y * w); o.y = pk2(silu_fast(g0.z) * u0.z * w, silu_fast(g0.w) * u0.w * w);
                o.z = pk2(silu_fast(g1.x) * u1.x * w, silu_fast(g1.y) * u1.y * w); o.w = pk2(silu_fast(g1.z) * u1.z * w, silu_fast(g1.w) * u1.w * w);
                st16(ACT + (size_t)pos * EFF + (u.pn & 3) * 128 + wc * 32 + 8 * fq, o); }
    }
};
struct EpiY {
    static constexpr bool PERM = true, AFTER_DRAIN = false, HAS_MID = false;
    bf16* Y;
    __device__ __forceinline__ void operator()(const f32x4 (&acc)[2][2][4][2], const Unit& u, int wr, int wc, int fr, int fq) const {
#pragma unroll
        for (int ai = 0; ai < 2; ++ai)
#pragma unroll
            for (int m = 0; m < 4; ++m) { bf16* rowp = Y + (size_t)(u.pm * BM + ai * HALF + wr * 64 + m * 16 + fr) * D + (u.pn & 3) * BM + wc * 32 + 8 * fq;
#pragma unroll
                for (int bj = 0; bj < 2; ++bj) { const f32x4 v0 = acc[ai][bj][m][0], v1 = acc[ai][bj][m][1];
                    u32x4 w; w.x = pk2(v0.x, v0.y); w.y = pk2(v0.z, v0.w); w.z = pk2(v1.x, v1.y); w.w = pk2(v1.z, v1.w);
                    st16(rowp + bj * HALF, w); } }
    }
};
}

namespace att {
typedef __attribute__((address_space(3))) const char* lds_cptr;
typedef short v4i16_t __attribute__((ext_vector_type(4)));
constexpr int NSLOT = 4, SLOTB = 16384, OST_PITCH = 144, OST_WAVE = 32 * OST_PITCH, OST_OFF = 98304;
static_assert(OST_OFF + 8 * OST_WAVE <= 147456 && NSLOT * SLOTB <= 65536, "attention LDS");
__device__ __forceinline__ int crow(int r, int hi) { return (r & 3) + 8 * (r >> 2) + 4 * hi; }
__device__ __forceinline__ unsigned cvtpk(float lo, float hi) { typedef float f2 __attribute__((ext_vector_type(2))); typedef __bf16 b2 __attribute__((ext_vector_type(2))); f2 v = {lo, hi}; b2 b = __builtin_convertvector(v, b2); return __builtin_bit_cast(unsigned, b); }
__device__ __forceinline__ s16x4 vtr(lds_cptr p) { return __builtin_bit_cast(s16x4, __builtin_amdgcn_ds_read_tr16_b64_v4i16((__attribute__((address_space(3))) v4i16_t*)p)); }
__device__ __forceinline__ float swapmax(float m) { auto rr = __builtin_amdgcn_permlane32_swap(__float_as_uint(m), __float_as_uint(m), false, false); return fmaxf(__uint_as_float(rr[0]), __uint_as_float(rr[1])); }
__device__ __forceinline__ float swapsum(float m) { auto rr = __builtin_amdgcn_permlane32_swap(__float_as_uint(m), __float_as_uint(m), false, false); return __uint_as_float(rr[0]) + __uint_as_float(rr[1]); }

__device__ __forceinline__ void glds16(const void* gsrc, unsigned lds_dst) { unsigned keep;
    asm volatile("s_mov_b32 %0, m0\n\ts_mov_b32 m0, %2\n\ts_nop 0\n\tglobal_load_lds_dwordx4 %1, off\n\ts_mov_b32 m0, %0" : "=&s"(keep) : "v"(gsrc), "s"(lds_dst) : "memory"); }
__device__ __forceinline__ float max3f(float a, float b, float c) { float r; asm("v_max3_f32 %0, %1, %2, %3" : "=v"(r) : "v"(a), "v"(b), "v"(c)); return r; }
__device__ __forceinline__ float max2f(float a, float b) { float r; asm("v_max_f32_e32 %0, %1, %2" : "=v"(r) : "v"(a), "v"(b)); return r; }
constexpr int WC_PER_WAVE = 24, WC_LDS = 65536;
struct WConv { int next, j0, j1, gstep, cm1, cm2; };
struct WItem { const float* src; int N; bf16* dst; int dpitch; };
__device__ __forceinline__ WItem wc_decode(const P& p, int hidx, int& k0, int& n0, int& drow0) {
    const int item = hidx >> 1, kh = hidx & 1; WItem w;
    if (item < 16384) { const int up = item >= 8192, r = item & 8191, e = r >> 8, q = r & 255, kb = q >> 4, nb = q & 15; n0 = nb * 32;
        w.src = (up ? p.w_up : p.w_gate) + (size_t)e * 1024 * 512; w.N = 512; w.dst = (bf16*)(p.ws + WS_WGU) + (size_t)e * 1024 * 1024; w.dpitch = 1024;
        drow0 = (n0 >> 7) * 256 + up * 128 + (n0 & 127); k0 = kb * 64 + kh * 32; }
    else { const int r = item - 16384, e = r >> 8, q = r & 255, kb = q >> 5, nb = q & 31; n0 = nb * 32;
        w.src = p.w_down + (size_t)e * 512 * 1024; w.N = 1024; w.dst = (bf16*)(p.ws + WS_WD) + (size_t)e * 1024 * 512; w.dpitch = 512; drow0 = n0; k0 = kb * 64 + kh * 32; }
    return w;
}
__device__ __forceinline__ void glds16(const void* gsrc, unsigned lds_dst);
__device__ __forceinline__ void wc_issue(const P& p, int gw, int ord, unsigned ldsbuf, int lane) {
    int k0, n0, drow0; const WItem w = wc_decode(p, gw + 2048 * ord, k0, n0, drow0);
#pragma unroll
    for (int q = 0; q < 4; ++q) { const int kl = 8 * q + (lane >> 3), f4 = (lane & 7) ^ ((q >> 1) * 4);
        glds16(w.src + (size_t)(k0 + kl) * w.N + n0 + f4 * 4, (unsigned)__builtin_amdgcn_readfirstlane(ldsbuf + q * 1024)); }
}
__device__ __forceinline__ void wc_consume(const P& p, int gw, int ord, LAS unsigned char* buf, int lane) {
    int k0, n0, drow0; const WItem w = wc_decode(p, gw + 2048 * ord, k0, n0, drow0);
    const int n = lane >> 1, kh = lane & 1;
    const LAS float* s = (const LAS float*)buf + (16 * kh) * 32 + 4 * ((n >> 2) ^ (4 * kh)) + (n & 3);
    float v[16];
#pragma unroll
    for (int i = 0; i < 16; ++i) v[i] = s[i * 32];
    v4u o0, o1;
    o0.x = cvtpk(v[0], v[1]); o0.y = cvtpk(v[2], v[3]); o0.z = cvtpk(v[4], v[5]); o0.w = cvtpk(v[6], v[7]);
    o1.x = cvtpk(v[8], v[9]); o1.y = cvtpk(v[10], v[11]); o1.z = cvtpk(v[12], v[13]); o1.w = cvtpk(v[14], v[15]);
    bf16* d = w.dst + (size_t)(drow0 + n) * w.dpitch + k0 + 16 * kh;
    *(v4u*)d = o0; *(v4u*)(d + 8) = o1;
}
constexpr float THR = 8.f;
template <int GRP, int ABL = 0>
__device__ __forceinline__ void attn_unit(const P& p, LAS unsigned char* lds, int b, int kvh, int qb, WConv& wc, int gw, bf16x8 (&qr)[4], int& gt0, bool first, int ngrp, int nb, int nkvh, int nqb) {
    const int tid = threadIdx.x, lane = tid & 63, r32 = lane & 31, hi = lane >> 5;
    const int wid = __builtin_amdgcn_readfirstlane(tid >> 6);
    const int h = kvh * 4 + (wid >> 1);
    const int q0w = qb * 64 + (wid & 1) * 32, qpos = q0w + r32;
    const bf16* Qp = (const bf16*)(p.ws + (GRP ? WS_QB : WS_QA)) + q_off(b, h, qpos, 0);
    if (first) {
#pragma unroll
        for (int d0 = 0; d0 < 4; ++d0) qr[d0] = *(const bf16x8*)(Qp + 16 * d0 + 8 * hi);
    }
    asm volatile("" : "+v"(qr[0]), "+v"(qr[1]), "+v"(qr[2]), "+v"(qr[3]));
    const char* Kt = (const char*)(p.ws + (GRP ? WS_KB : WS_KA)) + (size_t)(b * 2 + kvh) * NTILE * 8192 + wid * 1024 + lane * 16;
    const char* Vt = (const char*)(p.ws + (GRP ? WS_VB : WS_VA)) + (size_t)(b * 2 + kvh) * NTILE * 8192 + wid * 1024 + lane * 16;
    const unsigned lds0 = (unsigned)(uintptr_t)lds;
    int jlo = 0, nband = NTILE, NT = NTILE;
    if (GRP == 0) { jlo = qb - 2 < 0 ? 0 : qb - 2; const int jhi = qb + 2 > 31 ? 31 : qb + 2; nband = jhi - jlo + 1; NT = nband + 4; }
#define ATT_TILE(i) ((i) < nband ? jlo + (i) : 32 + ((i) - nband))
#define ATT_ISSUE(i) do { if (ABL & 1) break; const int tl_ = ATT_TILE(i); const int sl_ = ((gt0 + (i)) & 3) * SLOTB; \
        glds16(Kt + (size_t)tl_ * 8192, (unsigned)__builtin_amdgcn_readfirstlane(lds0 + sl_ + wid * 1024)); \
        glds16(Vt + (size_t)tl_ * 8192, (unsigned)__builtin_amdgcn_readfirstlane(lds0 + sl_ + 8192 + wid * 1024)); } while (0)
#define ATT_WAIT(n) do { if (ABL & 1) break; if ((n) >= 2) asm volatile("s_waitcnt vmcnt(4)" ::: "memory"); else if ((n) == 1) asm volatile("s_waitcnt vmcnt(2)" ::: "memory"); else asm volatile("s_waitcnt vmcnt(0)" ::: "memory"); } while (0)
#define ATT_WAITN(n) do { if (ABL & 1) break; switch (n) { case 0: asm volatile("s_waitcnt vmcnt(0)" ::: "memory"); break; case 2: asm volatile("s_waitcnt vmcnt(2)" ::: "memory"); break; \
        case 4: asm volatile("s_waitcnt vmcnt(4)" ::: "memory"); break; case 6: asm volatile("s_waitcnt vmcnt(6)" ::: "memory"); break; case 8: asm volatile("s_waitcnt vmcnt(8)" ::: "memory"); break; \
        case 10: asm volatile("s_waitcnt vmcnt(10)" ::: "memory"); break; case 12: asm volatile("s_waitcnt vmcnt(12)" ::: "memory"); break; default: asm volatile("s_waitcnt vmcnt(14)" ::: "memory"); break; } } while (0)
#define ATT_BAR() do { asm volatile("" ::: "memory"); __builtin_amdgcn_s_barrier(); asm volatile("" ::: "memory"); } while (0)
#define SBAR() __builtin_amdgcn_sched_barrier(0)
#define MF(a, b, c) __builtin_amdgcn_mfma_f32_32x32x16_bf16(a, b, c, 0, 0, 0)
#define KFRAG(dst, base, k) dst = *(const __attribute__((address_space(3))) bf16x8*)((base) + ((k) >> 1) * 2048 + ((k) & 1) * 512)
    float m, l;
    m = 0.f; l = 0.f;
    f32x16 o0, o1, sA0, sA1, sB0, sB1; const f32x16 zero16 = {0.f, 0.f, 0.f, 0.f, 0.f, 0.f, 0.f, 0.f, 0.f, 0.f, 0.f, 0.f, 0.f, 0.f, 0.f, 0.f};
#pragma unroll
    for (int r = 0; r < 16; ++r) { o0[r] = 0.f; o1[r] = 0.f; sB0[r] = 0.f; sB1[r] = 0.f; }
    const lds_cptr kp0 = (lds_cptr)lds + hi * 1024 + r32 * 16;
    const lds_cptr vp0 = (lds_cptr)lds + 8192 + ((lane >> 4) & 1) * 32 + (lane & 3) * 8 + (4 * hi + ((lane & 15) >> 2)) * 64;
#define ATT_MASK(S0, S1, t) do { if (GRP == 0) { const int tl = ATT_TILE(t); if (tl < 32 && (tl == qb - 2 || tl == qb + 2)) { const int kb = tl * 64; \
        _Pragma("unroll") for (int r = 0; r < 16; ++r) { const int dd = kb + crow(r, hi) - qpos; if (dd > 128 || dd < -128) S0[r] = -1e30f; if (dd + 32 > 128 || dd + 32 < -128) S1[r] = -1e30f; } } } } while (0)
#define ATT_DECIDE(S0, S1, mxv) do { float mx_ = swapmax(mxv); \
        if (__builtin_expect(__any(mx_ > THR), 0)) { const float dl = fmaxf(mx_, 0.f), alpha = __builtin_amdgcn_exp2f(-dl); m += dl; l *= alpha; \
            _Pragma("unroll") for (int r = 0; r < 16; ++r) { S0[r] -= dl; S1[r] -= dl; o0[r] *= alpha; o1[r] *= alpha; } } } while (0)
    wc.cm1 = 0; wc.cm2 = 0;
    if (first) { ATT_ISSUE(0); ATT_ISSUE(1); ATT_ISSUE(2); ATT_WAIT(2); ATT_BAR(); }
    {
        bf16x8 kf[8];
#pragma unroll
        for (int k = 0; k < 8; ++k) KFRAG(kf[k], kp0 + (gt0 & 3) * SLOTB, k);
        SBAR();
        sA0 = MF(kf[0], qr[0], zero16); sA1 = MF(kf[1], qr[0], zero16);
#pragma unroll
        for (int d0 = 1; d0 < 4; ++d0) { sA0 = MF(kf[2 * d0], qr[d0], sA0); sA1 = MF(kf[2 * d0 + 1], qr[d0], sA1); }
        ATT_MASK(sA0, sA1, 0);
        asm volatile("s_nop 15\n\ts_nop 7" : "+v"(sA0), "+v"(sA1));
        float a = max3f(sA0[0], sA0[1], sA1[0]), c = max3f(sA0[2], sA0[3], sA1[1]); a = max3f(a, sA1[2], sA1[3]);
#pragma unroll
        for (int r = 4; r < 16; r += 4) { a = max3f(a, sA0[r], sA0[r + 1]); c = max3f(c, sA0[r + 2], sA0[r + 3]); a = max3f(a, sA1[r], sA1[r + 1]); c = max3f(c, sA1[r + 2], sA1[r + 3]); }
        ATT_DECIDE(sA0, sA1, max2f(a, c));
    }
#define ATT_STEP(SC0, SC1, SN0, SN1, t, HN) do { \
        constexpr bool hn_ = HN;                                      \
        ATT_WAITN(wc.cm2 + wc.cm1 + ((t) + 2 < NT ? 2 : 0));         \
        ATT_BAR(); \
        if ((t) + 3 < NT) ATT_ISSUE((t) + 3); \
        if (WCONV_IN_ATTN) { int c_ = 0; const int bs_ = (wc.gstep % 3 == 0) ? 0 : 2;     \
            if (bs_ < 2) { LAS unsigned char* wb_ = lds + WC_LDS + wid * 4096; int jb_ = wc.j0; \
                if (jb_ >= 0) { wc_consume(p, gw, jb_, wb_, lane); jb_ = -1; c_ += 2; } \
                if (wc.next < WC_PER_WAVE) { asm volatile("s_waitcnt lgkmcnt(0)" ::: "memory"); wc_issue(p, gw, wc.next, lds0 + WC_LDS + wid * 4096, lane); jb_ = wc.next++; c_ += 4; } \
                wc.j0 = jb_; } \
            wc.cm2 = wc.cm1; wc.cm1 = c_; wc.gstep++; } \
        if (!hn_ && ngrp >= 0 && !(ABL & 1)) {                       \
            const bf16* nQ = (const bf16*)(p.ws + (ngrp ? WS_QB : WS_QA)) + q_off(nb, nkvh * 4 + (wid >> 1), nqb * 64 + (wid & 1) * 32 + r32, 0); \
            _Pragma("unroll") for (int d0 = 0; d0 < 4; ++d0) qr[d0] = *(const bf16x8*)(nQ + 16 * d0 + 8 * hi); \
            const char* nK = (const char*)(p.ws + (ngrp ? WS_KB : WS_KA)) + (size_t)(nb * 2 + nkvh) * NTILE * 8192 + wid * 1024 + lane * 16; \
            const char* nV = (const char*)(p.ws + (ngrp ? WS_VB : WS_VA)) + (size_t)(nb * 2 + nkvh) * NTILE * 8192 + wid * 1024 + lane * 16; \
            const int njlo = ngrp ? 0 : (nqb - 2 < 0 ? 0 : nqb - 2); \
            _Pragma("unroll") for (int i_ = 0; i_ < 3; ++i_) { const int sl_ = ((gt0 + NT + i_) & 3) * SLOTB; \
                glds16(nK + (size_t)(njlo + i_) * 8192, (unsigned)__builtin_amdgcn_readfirstlane(lds0 + sl_ + wid * 1024)); \
                glds16(nV + (size_t)(njlo + i_) * 8192, (unsigned)__builtin_amdgcn_readfirstlane(lds0 + sl_ + 8192 + wid * 1024)); } } \
        const lds_cptr kp_ = kp0 + ((gt0 + (t) + 1) & 3) * SLOTB; const lds_cptr vp_ = vp0 + ((gt0 + (t)) & 3) * SLOTB; \
        bf16x8 kf[8]; s16x4 vlo[8], vhi[8]; \
        if (hn_) { _Pragma("unroll") for (int k = 0; k < 8; ++k) KFRAG(kf[k], kp_, k); } \
        SBAR(); \
        float rs_ = 0.f; v4u pw[4]; _Pragma("unroll") for (int q_ = 0; q_ < 4; ++q_) pw[q_] = (v4u){0u, 0u, 0u, 0u}; \
        _Pragma("unroll") for (int g = 0; g < 8; ++g) {             \
            if (hn_) { if (g == 0) SN0 = MF(kf[0], qr[0], zero16); else if (g == 1) SN1 = MF(kf[1], qr[0], zero16); else if (g & 1) SN1 = MF(kf[g], qr[g >> 1], SN1); else SN0 = MF(kf[g], qr[g >> 1], SN0); } \
            if (g < 4) { _Pragma("unroll") for (int e = 0; e < 4; ++e) { SC0[4 * g + e] = __builtin_amdgcn_exp2f(SC0[4 * g + e]); rs_ += SC0[4 * g + e]; } \
                         pw[g >> 1][2 * (g & 1)] = cvtpk(SC0[4 * g], SC0[4 * g + 1]); pw[g >> 1][2 * (g & 1) + 1] = cvtpk(SC0[4 * g + 2], SC0[4 * g + 3]); \
                         asm volatile("" : "+v"(SC0), "+v"(pw[g >> 1]), "+v"(rs_)); } \
            else { const int g4 = g - 4;   \
                         vlo[g4] = vtr(vp_ + g4 * 1024); vhi[g4] = vtr(vp_ + g4 * 1024 + 512); vlo[4 + g4] = vtr(vp_ + 4096 + g4 * 1024); vhi[4 + g4] = vtr(vp_ + 4096 + g4 * 1024 + 512); \
                         _Pragma("unroll") for (int e = 0; e < 4; ++e) { SC1[4 * g4 + e] = __builtin_amdgcn_exp2f(SC1[4 * g4 + e]); rs_ += SC1[4 * g4 + e]; } \
                         pw[2 + (g4 >> 1)][2 * (g4 & 1)] = cvtpk(SC1[4 * g4], SC1[4 * g4 + 1]); pw[2 + (g4 >> 1)][2 * (g4 & 1) + 1] = cvtpk(SC1[4 * g4 + 2], SC1[4 * g4 + 3]); \
                         asm volatile("" : "+v"(SC1), "+v"(pw[2 + (g4 >> 1)]), "+v"(rs_)); } \
            SBAR(); } \
        l += rs_; \
        if (hn_) { ATT_MASK(SN0, SN1, (t) + 1); if (__builtin_expect(__any(m != 0.f), 0)) { _Pragma("unroll") for (int r = 0; r < 16; ++r) { SN0[r] -= m; SN1[r] -= m; } } \
                   asm volatile("s_nop 15\n\ts_nop 7" : "+v"(SN0), "+v"(SN1)); } \
        float ma_ = -3.0e38f, mc_ = -3.0e38f; \
        _Pragma("unroll") for (int g = 0; g < 8; ++g) {             \
            const int ks = g >> 1; const bf16x8 pf = __builtin_bit_cast(bf16x8, pw[ks]); \
            if (g & 1) { const bf16x8 v1 = (bf16x8){vlo[4 + ks][0], vlo[4 + ks][1], vlo[4 + ks][2], vlo[4 + ks][3], vhi[4 + ks][0], vhi[4 + ks][1], vhi[4 + ks][2], vhi[4 + ks][3]}; o1 = MF(v1, pf, o1); } \
            else { const bf16x8 v0 = (bf16x8){vlo[ks][0], vlo[ks][1], vlo[ks][2], vlo[ks][3], vhi[ks][0], vhi[ks][1], vhi[ks][2], vhi[ks][3]}; o0 = MF(v0, pf, o0); } \
            if (hn_) { if (g < 4) { ma_ = max3f(ma_, SN0[4 * g], SN0[4 * g + 1]); mc_ = max3f(mc_, SN0[4 * g + 2], SN0[4 * g + 3]); } \
                       else { ma_ = max3f(ma_, SN1[4 * (g - 4)], SN1[4 * (g - 4) + 1]); mc_ = max3f(mc_, SN1[4 * (g - 4) + 2], SN1[4 * (g - 4) + 3]); } \
                       asm volatile("" : "+v"(ma_), "+v"(mc_)); } \
            SBAR(); } \
        if (hn_) ATT_DECIDE(SN0, SN1, max2f(ma_, mc_)); \
    } while (0)
    {
        int t = 0;
        for (; t + 2 < NT; t += 2) { ATT_STEP(sA0, sA1, sB0, sB1, t, true); ATT_STEP(sB0, sB1, sA0, sA1, t + 1, true); }
        if (t + 2 == NT) { ATT_STEP(sA0, sA1, sB0, sB1, t, true); ATT_STEP(sB0, sB1, sA0, sA1, t + 1, false); }
        else { ATT_STEP(sA0, sA1, sB0, sB1, t, false); }
    }
#undef ATT_STEP
#undef ATT_DECIDE
#undef ATT_MASK
#undef KFRAG
#undef MF
#undef SBAR
#undef ATT_TILE
#undef ATT_ISSUE
#undef ATT_WAIT
    float ltot = swapsum(l); if (GRP == 0) ltot += __builtin_amdgcn_exp2f(p.a_sink[h] * LOG2E - m);
    const float inv = 1.f / ltot;
    int lane_e = lane; asm volatile("" : "+v"(lane_e));
    const int r32e = lane_e & 31, hie = lane_e >> 5;
    LAS unsigned char* ost = lds + OST_OFF + wid * OST_WAVE;
#pragma unroll
    for (int g = 0; g < 4; ++g) {
        v2u w0, w1;
        w0.x = cvtpk(o0[4 * g] * inv, o0[4 * g + 1] * inv); w0.y = cvtpk(o0[4 * g + 2] * inv, o0[4 * g + 3] * inv);
        w1.x = cvtpk(o1[4 * g] * inv, o1[4 * g + 1] * inv); w1.y = cvtpk(o1[4 * g + 2] * inv, o1[4 * g + 3] * inv);
        *(LAS v2u*)(ost + r32e * OST_PITCH + (8 * g + 4 * hie) * 2) = w0;
        *(LAS v2u*)(ost + r32e * OST_PITCH + (32 + 8 * g + 4 * hie) * 2) = w1;
    }
    asm volatile("s_waitcnt lgkmcnt(0)" ::: "memory");
    bf16* Ob = (bf16*)(p.ws + (ABL ? WS_OX : WS_O)) + ((size_t)b * T + q0w) * D + GRP * 512 + h * 64;
    float* ssq = (float*)(p.ws + (ABL ? 256 * MiB : WS_SSQ)) + ((size_t)b * T + q0w) * 16 + GRP * 8 + h;
#pragma unroll
    for (int i = 0; i < 4; ++i) {
        const int row = i * 8 + (lane_e >> 3), ch = lane_e & 7;
        const v4u v = *(const LAS v4u*)(ost + row * OST_PITCH + ch * 16);
        st16(Ob + (size_t)row * D + ch * 8, v);
        float ss = 0.f;
#pragma unroll
        for (int q = 0; q < 4; ++q) { const float a = __uint_as_float(v[q] << 16), c = __uint_as_float(v[q] & 0xffff0000u); ss += a * a + c * c; }
        ss += __shfl_xor(ss, 1); ss += __shfl_xor(ss, 2); ss += __shfl_xor(ss, 4);
        if (ch == 0) ssq[(size_t)row * 16] = ss;
    }
    asm volatile("s_waitcnt vmcnt(0) lgkmcnt(0)" ::: "memory");
    ATT_BAR();
    gt0 += NT;
#undef ATT_BAR
}
template <int ABL = 0>
__device__ __forceinline__ void attn_phase(const P& p, LAS unsigned char* lds, int vcu, int G) {
    if (ABL & 64) return;
    const int wid = __builtin_amdgcn_readfirstlane(threadIdx.x >> 6), lane = threadIdx.x & 63, gw = vcu * 8 + wid;
    WConv wc; wc.next = (WCONV_IN_ATTN && G * 8 == 2048 && ABL == 0) ? 0 : WC_PER_WAVE; wc.j0 = -1; wc.j1 = -1; wc.gstep = 0; wc.cm1 = 0; wc.cm2 = 0;
    const int nB = vcu < 512 ? (512 - vcu + G - 1) / G : 0, nU = 2 * nB;
    bf16x8 qr[4]; int gt0 = 0;
#pragma unroll
    for (int d0 = 0; d0 < 4; ++d0) qr[d0] = (bf16x8){0, 0, 0, 0, 0, 0, 0, 0};
    for (int k = 0; k < nU; ++k) {
        const int grp = k < nB ? 1 : 0, u = vcu + (k < nB ? k : k - nB) * G;
        const int kn = k + 1, ngrp = kn < nU ? (kn < nB ? 1 : 0) : -1, un = vcu + (kn < nB ? kn : kn - nB) * G;
        if (grp) attn_unit<1, ABL>(p, lds, (u >> 5) >> 1, (u >> 5) & 1, u & 31, wc, gw, qr, gt0, k == 0, ngrp, (un >> 5) >> 1, (un >> 5) & 1, un & 31);
        else     attn_unit<0, ABL>(p, lds, (u >> 5) >> 1, (u >> 5) & 1, u & 31, wc, gw, qr, gt0, k == 0, ngrp, (un >> 5) >> 1, (un >> 5) & 1, un & 31);
    }
    if (WCONV_IN_ATTN && ABL == 0) {
        if (G * 8 == 2048) {
            if (wc.j0 >= 0) wc_consume(p, gw, wc.j0, lds + WC_LDS + wid * 4096, lane);
            for (; wc.next < WC_PER_WAVE; ++wc.next) { asm volatile("s_waitcnt lgkmcnt(0)" ::: "memory"); wc_issue(p, gw, wc.next, (unsigned)(uintptr_t)lds + WC_LDS + wid * 4096, lane);
                asm volatile("s_waitcnt vmcnt(0)" ::: "memory"); wc_consume(p, gw, wc.next, lds + WC_LDS + wid * 4096, lane); }
        } else {
            for (int hx = gw; hx < 49152; hx += G * 8) { asm volatile("s_waitcnt lgkmcnt(0)" ::: "memory"); wc_issue(p, hx & 2047, hx >> 11, (unsigned)(uintptr_t)lds + WC_LDS + wid * 4096, lane);
                asm volatile("s_waitcnt vmcnt(0)" ::: "memory"); wc_consume(p, hx & 2047, hx >> 11, lds + WC_LDS + wid * 4096, lane); }
        }
    }
}
}

struct Frame {
    LAS unsigned char* lds;
    volatile LAS unsigned* MISC;
    int tid, lane, wave, vcu, G;
};

__device__ __forceinline__ void p0_transpose_item(const float* W, int N, bf16* WT, int dpitch, int drow0, int k0, int n0, LAS float* scr, int lane, const float* gain) {
#pragma unroll
    for (int i = 0; i < 32; ++i) { const int kk = 2 * i + (lane >> 5); float v = W[(size_t)(k0 + kk) * N + n0 + (lane & 31)]; if (gain) v *= gain[kk]; scr[kk * 33 + (lane & 31)] = v; }
    LDS_WAIT(); asm volatile("" ::: "memory");
    const int c = lane & 7;
#pragma unroll
    for (int j = 0; j < 4; ++j) { const int n = (lane >> 3) + 8 * j; const LAS float* s = scr + (8 * c) * 33 + n;
        v4u o; o.x = pk2(s[0 * 33], s[1 * 33]); o.y = pk2(s[2 * 33], s[3 * 33]); o.z = pk2(s[4 * 33], s[5 * 33]); o.w = pk2(s[6 * 33], s[7 * 33]);
        *(GAS v4u*)(WT + (size_t)(drow0 + n) * dpitch + k0 + 8 * c) = o; }
    LDS_WAIT(); asm volatile("" ::: "memory");
}
__device__ __forceinline__ void p0_prologue(const P& p, Frame& F) {
    float* modx = (float*)(p.ws + WS_MODX);
    if (F.vcu < 96) {
        LAS float* s = (LAS float*)F.lds;
        LAS float* part = (LAS float*)(F.lds + 40960);
        for (int i = F.tid; i < 9 * D; i += NTHR) { const int r = i >> 10, k = i & 1023; const float v = r < 8 ? p.c[r * D + k] : p.c_ctx[k]; s[i] = silu_f(v); }
        __syncthreads();
        const int n = F.vcu * 64 + F.lane; float acc[9];
#pragma unroll
        for (int r = 0; r < 9; ++r) acc[r] = 0.f;
        const float* wp = p.w_mod + (size_t)(F.wave * 128) * 6144 + n;
#pragma unroll 4
        for (int k4 = 0; k4 < 128; k4 += 4) {
            float wv[4];
#pragma unroll
            for (int j = 0; j < 4; ++j) wv[j] = wp[(size_t)(k4 + j) * 6144];
#pragma unroll
            for (int r = 0; r < 9; ++r) { const f32x4 sv = *(const LAS f32x4*)(s + r * D + F.wave * 128 + k4); acc[r] += sv.x * wv[0]; acc[r] += sv.y * wv[1]; acc[r] += sv.z * wv[2]; acc[r] += sv.w * wv[3]; }
        }
#pragma unroll
        for (int r = 0; r < 9; ++r) part[(F.wave * 9 + r) * 64 + F.lane] = acc[r];
        __syncthreads();
        for (int i = F.tid; i < 9 * 64; i += NTHR) { const int r = i >> 6, l = i & 63; float sum = 0.f;
#pragma unroll
            for (int w = 0; w < 8; ++w) sum += part[(w * 9 + r) * 64 + l];
            modx[r * 6144 + F.vcu * 64 + l] = sum + p.b_mod[F.vcu * 64 + l]; }
        __syncthreads();
    }
    if (F.vcu == 96) {
        float2* tab = (float2*)(p.ws + WS_ROPE);
        for (int idx = F.tid; idx < 96 * 16; idx += NTHR) {
            const int pos = idx >> 4, i = idx & 15;
            const float invf = exp2f(-(float)i * (13.287712379549449f / 16.f));
            const float pv = (float)(pos < 32 ? pos : pos - 32);
            float rev = pv * invf * 0.15915494309189535f; rev -= rintf(rev);
            tab[idx] = make_float2(__builtin_amdgcn_cosf(rev), __builtin_amdgcn_sinf(rev));
        }
    }
    for (int nb = F.vcu - 97; nb >= 0 && nb < 48; nb += F.G) {
        bf16* wr = (bf16*)(p.ws + WS_WR);
        for (int i = nb * 1024 + F.tid; i < (nb + 1) * 1024; i += NTHR) {
            const int j = i & 7, ln = (i >> 3) & 63, q = i >> 9, nt = q % 3, ks = q / 3;
            const int k = 32 * ks + 8 * (ln >> 4) + j, n = 16 * nt + (ln & 15);
            const float w = n < 4 ? p.w_group[k * 4 + n] : n < 36 ? p.w_router[k * 32 + (n - 4)] : 0.f;
            const unsigned hi = f2bf(w); const unsigned lo = f2bf(w - bf2f((bf16)hi));
            wr[i] = (bf16)hi; wr[48 * D + i] = (bf16)lo; }
    }
    LAS float* scr = (LAS float*)(F.lds + F.wave * 16384);
    const int gw = F.vcu * NWAVES + F.wave, NGW = F.G * NWAVES;
    constexpr int I_IN = 16 * 48, I_OUT = 16 * 32, I_G = 32 * 256, I_D = 32 * 256, NITEMS = WCONV_IN_ATTN ? I_IN + I_OUT : I_IN + I_OUT + 2 * I_G + I_D;
    for (int it = gw; it < NITEMS; it += NGW) {
        int r = it;
        if (r < I_IN) { const int kb = r / 48, nb = r % 48; p0_transpose_item(p.w_in, NQKV, (bf16*)(p.ws + WS_WQKV), D, qkv_row(nb * 32), kb * 64, nb * 32, scr, F.lane, nullptr); continue; } r -= I_IN;
        if (r < I_OUT) { const int kb = r / 32, nb = r % 32; const float* g = kb < 8 ? p.aon + kb * 64 : p.bon + (kb - 8) * 64;
            p0_transpose_item(p.w_out, D, (bf16*)(p.ws + WS_WO), D, nb * 32, kb * 64, nb * 32, scr, F.lane, g); continue; } r -= I_OUT;
        if (r < 2 * I_G) { const int up = r >= I_G; if (up) r -= I_G; const int e = r >> 8, q = r & 255, kb = q >> 4, nb = q & 15; const int j0 = nb * 32;
            p0_transpose_item((up ? p.w_up : p.w_gate) + (size_t)e * 1024 * 512, 512, (bf16*)(p.ws + WS_WGU) + (size_t)e * 1024 * 1024, D, (j0 >> 7) * 256 + up * 128 + (j0 & 127), kb * 64, j0, scr, F.lane, nullptr); continue; } r -= 2 * I_G;
        { const int e = r >> 8, q = r & 255, kb = q >> 5, nb = q & 31;
            p0_transpose_item(p.w_down + (size_t)e * 512 * 1024, D, (bf16*)(p.ws + WS_WD) + (size_t)e * 1024 * 512, EFF, nb * 32, kb * 64, nb * 32, scr, F.lane, nullptr); }
    }
}
__device__ __forceinline__ void p1_norm(const P& p, Frame& F) {
    const int gw = F.vcu * NWAVES + F.wave, NGW = F.G * NWAVES;
    const float* modall = (const float*)(p.ws + WS_MODX);
    for (int r = gw; r < MT; r += NGW) {
        const float* src = r < ML ? p.x + (size_t)r * D : p.ctx + (size_t)(r - ML) * D;
        const float* modx = modall + (r < ML ? (r / T) : 8) * 6144;
        const GAS f32x4* xr = (const GAS f32x4*)src + F.lane;
        f32x4 v[4]; float s = 0.f;
#pragma unroll
        for (int j = 0; j < 4; ++j) { v[j] = xr[64 * j]; s += (v[j].x * v[j].x + v[j].y * v[j].y) + (v[j].z * v[j].z + v[j].w * v[j].w); }
        const float rn = rsqrtf(wave_sum(s) * (1.f / D) + EPS);
        GAS v2u* o8 = (GAS v2u*)((bf16*)(p.ws + WS_XN) + (size_t)r * D) + F.lane;
#pragma unroll
        for (int j = 0; j < 4; ++j) { const int k = 4 * (F.lane + 64 * j);
            const f32x4 g = *(const f32x4*)(p.pre1 + k), sc = *(const f32x4*)(modx + 1024 + k), sh = *(const f32x4*)(modx + k);
            const f32x4 h = v[j] * rn * g * (sc + 1.f) + sh;
            v2u w; w.x = pk2(h.x, h.y); w.y = pk2(h.z, h.w); st8((void*)(o8 + 64 * j), w); }
    }
}


constexpr int LDS_X = 147456;
__device__ __forceinline__ void p4_outproj(const P& p, Frame& F) {
    LAS float* tab = (LAS float*)(F.lds + LDS_X);
    for (int i = 0;; ++i) {
        const int L = i * F.G + (int)blockIdx.x; if (L >= 256) break;
        const int xcd = L & 7, off = L >> 3, w = xcd * 32 + off;
        pg8::Unit u; u.pm = (w >> 5) * 8 + (w & 7); u.pn = (w & 31) >> 3;
        if (F.tid < 256) {
            const f32x4* s4 = (const f32x4*)((const float*)(p.ws + WS_SSQ) + (size_t)(u.pm * 256 + F.tid) * 16);
            const f32x4 a0 = s4[0], a1 = s4[1], b0 = s4[2], b1 = s4[3];
            const float sa = ((a0.x + a0.y) + (a0.z + a0.w)) + ((a1.x + a1.y) + (a1.z + a1.w)), sb = ((b0.x + b0.y) + (b0.z + b0.w)) + ((b1.x + b1.y) + (b1.z + b1.w));
            const float ra = rsqrtf(sa * (1.f / 512.f) + EPS), rb = rsqrtf(sb * (1.f / 512.f) + EPS);
            tab[2 * F.tid] = ra / rb; tab[2 * F.tid + 1] = rb;
        }
        __syncthreads();
        pg8::Gemm g{(const pg8::bf16_t*)(p.ws + WS_O), (const pg8::bf16_t*)(p.ws + WS_WO), ML, D, D};
        pg8::SchedOne S{u};
        pg8::EpiOut E{(bf16*)(p.ws + WS_OX), tab};
        pg8::gemm_phase<pg8::EpiOut, pg8::SchedOne, false, true, false>((PG8_LAS unsigned char*)F.lds, g, S, E);
    }
}
constexpr int P5_PITCH = 2064;
constexpr int P5_PART = 64 * P5_PITCH, P5_LG = 0;
static_assert(P5_PART + 8 * 16 * 48 * 4 <= MISC_OFF && 64 * 48 * 4 <= P5_PART, "P5 LDS map");
__device__ __forceinline__ void p5_rowpass(const P& p, Frame& F, int abl = 0) {
    LAS unsigned char* LO = F.lds;
    LAS float* PART = (LAS float*)(F.lds + P5_PART); LAS float* LG = (LAS float*)(F.lds + P5_LG);
    LAS int* hist = (LAS int*)(F.lds + MISC_OFF) + 64;
    const bf16* WRh = (const bf16*)(p.ws + WS_WR); const bf16* WRl = WRh + 48 * D;
    for (int rb = F.vcu; rb < ML / 64; rb += F.G) {
        if (F.tid < 32) hist[F.tid] = 0;
        const int b = (rb * 64) / T;
        const float* modx = (const float*)(p.ws + WS_MODX) + b * 6144;
        if (!(abl & 2)) {
            f32x4 gp[4], mp[4], ap[4];
#pragma unroll
            for (int j = 0; j < 4; ++j) { const int k = 256 * j + 4 * F.lane;
                gp[j] = *(const f32x4*)(modx + 2048 + k) * *(const f32x4*)(p.post1 + k);
                mp[j] = *(const f32x4*)(p.pre2 + k) * (*(const f32x4*)(modx + 4096 + k) + 1.f);
                ap[j] = *(const f32x4*)(modx + 3072 + k); }
            f32x4 xn[4]; v2u on[4];
#define P5_LOAD(rw) do { _Pragma("unroll") for (int j = 0; j < 4; ++j) { xn[j] = *(const f32x4*)(p.x + (size_t)(rw) * D + 256 * j + 4 * F.lane); \
                on[j] = *(const v2u*)((const bf16*)(p.ws + WS_OX) + (size_t)(rw) * D + 256 * j + 4 * F.lane); } } while (0)
            P5_LOAD(rb * 64 + F.wave * 8);
            for (int rr = 0; rr < 8; ++rr) {
                const int rl = F.wave * 8 + rr, row = rb * 64 + rl;
                f32x4 xv[4], ox[4]; v2u oc[4]; float ss = 0.f;
#pragma unroll
                for (int j = 0; j < 4; ++j) { xv[j] = xn[j]; oc[j] = on[j]; }
                if (rr + 1 < 8) P5_LOAD(row + 1);
#pragma unroll
                for (int j = 0; j < 4; ++j) { const v2u o2 = oc[j];
                    ox[j] = (f32x4){__uint_as_float(o2.x << 16), __uint_as_float(o2.x & 0xffff0000u), __uint_as_float(o2.y << 16), __uint_as_float(o2.y & 0xffff0000u)};
                    ss += (ox[j].x * ox[j].x + ox[j].y * ox[j].y) + (ox[j].z * ox[j].z + ox[j].w * ox[j].w); }
                const float r1 = rsqrtf(wave_sum(ss) * (1.f / D) + EPS);
                float ss2 = 0.f;
#pragma unroll
                for (int j = 0; j < 4; ++j) { xv[j] = xv[j] + gp[j] * (ox[j] * r1); st16f(p.out + (size_t)row * D + 256 * j + 4 * F.lane, xv[j]);
                    ss2 += (xv[j].x * xv[j].x + xv[j].y * xv[j].y) + (xv[j].z * xv[j].z + xv[j].w * xv[j].w); }
                const float r2 = rsqrtf(wave_sum(ss2) * (1.f / D) + EPS);
#pragma unroll
                for (int j = 0; j < 4; ++j) {
                    const f32x4 h = xv[j] * r2 * mp[j] + ap[j];
                    v2u wh; wh.x = att::cvtpk(h.x, h.y); wh.y = att::cvtpk(h.z, h.w);
                    const f32x4 hb = (f32x4){__uint_as_float(wh.x << 16), __uint_as_float(wh.x & 0xffff0000u), __uint_as_float(wh.y << 16), __uint_as_float(wh.y & 0xffff0000u)};
                    const f32x4 dl = h - hb;
                    v2u wl; wl.x = att::cvtpk(dl.x, dl.y); wl.y = att::cvtpk(dl.z, dl.w);
                    st8((bf16*)(p.ws + WS_XN) + (size_t)row * D + 256 * j + 4 * F.lane, wh);
                    *(LAS v2u*)(LO + rl * P5_PITCH + (256 * j + 4 * F.lane) * 2) = wl;
                }
            }
#undef P5_LOAD
        }
        asm volatile("s_waitcnt vmcnt(0)" ::: "memory");
        __syncthreads();
        if (F.tid == 0) { __builtin_amdgcn_fence(__ATOMIC_ACQUIRE, "agent"); asm volatile("s_waitcnt vmcnt(0)" ::: "memory"); }
        __syncthreads();
        if (abl & 1) continue;
        {
            const int gI = F.wave >> 1, kq = F.wave & 1, r16 = F.lane & 15, g4 = F.lane >> 4;
            f32x4 acc[3];
#pragma unroll
            for (int nt = 0; nt < 3; ++nt) acc[nt] = (f32x4){0.f, 0.f, 0.f, 0.f};
            const bf16* ah = (const bf16*)(p.ws + WS_XN) + (size_t)(rb * 64 + 16 * gI + r16) * D + 512 * kq + 8 * g4;
            const LAS unsigned char* al = LO + (16 * gI + r16) * P5_PITCH + (512 * kq + 8 * g4) * 2;
            const bf16* bh = WRh + (size_t)(16 * kq) * 3 * 512 + F.lane * 8; const bf16* bl = WRl + (size_t)(16 * kq) * 3 * 512 + F.lane * 8;
#pragma unroll 8
            for (int ks = 0; ks < 16; ++ks) {
                const bf16x8 a_hi = *(const bf16x8*)(ah + ks * 32), a_lo = *(const LAS bf16x8*)(al + ks * 64);
#pragma unroll
                for (int nt = 0; nt < 3; ++nt) {
                    const bf16x8 b_hi = *(const bf16x8*)(bh + (ks * 3 + nt) * 512), b_lo = *(const bf16x8*)(bl + (ks * 3 + nt) * 512);
                    acc[nt] = __builtin_amdgcn_mfma_f32_16x16x32_bf16(a_hi, b_hi, acc[nt], 0, 0, 0);
                    acc[nt] = __builtin_amdgcn_mfma_f32_16x16x32_bf16(a_hi, b_lo, acc[nt], 0, 0, 0);
                    acc[nt] = __builtin_amdgcn_mfma_f32_16x16x32_bf16(a_lo, b_hi, acc[nt], 0, 0, 0);
                }
            }
#pragma unroll
            for (int nt = 0; nt < 3; ++nt)
#pragma unroll
                for (int q = 0; q < 4; ++q) PART[(F.wave * 16 + 4 * g4 + q) * 48 + 16 * nt + r16] = acc[nt][q];
        }
        __syncthreads();
        for (int i = F.tid; i < 64 * 48; i += NTHR) { const int row = i / 48, n = i - row * 48, gI = row >> 4, r16 = row & 15;
            LG[i] = (PART[((gI * 2 + 0) * 16 + r16) * 48 + n] + PART[((gI * 2 + 1) * 16 + r16) * 48 + n]) + (n < 4 ? p.b_group[n] : n < 36 ? p.b_router[n - 4] : 0.f); }
        __syncthreads();
        if (F.tid < 64) {
            float lg[36];
#pragma unroll
            for (int c = 0; c < 36; ++c) lg[c] = LG[F.tid * 48 + c];
            int e1, e2; float w1, w2;
            {
                int g = 0; float gm = lg[0];
#pragma unroll
                for (int q = 1; q < 4; ++q) if (lg[q] > gm) { gm = lg[q]; g = q; }
                float gs = 0.f;
#pragma unroll
                for (int q = 0; q < 4; ++q) gs += __expf(lg[q] - gm);
                const float gw = 1.f / gs;
                float el[8];
#pragma unroll
                for (int q = 0; q < 8; ++q) el[q] = g == 0 ? lg[4 + q] : g == 1 ? lg[12 + q] : g == 2 ? lg[20 + q] : lg[28 + q];
                int i1 = 0; float m1 = el[0];
#pragma unroll
                for (int q = 1; q < 8; ++q) if (el[q] > m1) { m1 = el[q]; i1 = q; }
                int i2 = -1; float m2 = -3.0e38f;
#pragma unroll
                for (int q = 0; q < 8; ++q) if (q != i1 && el[q] > m2) { m2 = el[q]; i2 = q; }
                const float ex = __expf(m2 - m1);
                w1 = gw / (1.f + ex); w2 = gw * ex / (1.f + ex); e1 = g * 8 + i1; e2 = g * 8 + i2;
            }
            const int row = rb * 64 + F.tid;
            if (!(abl & 2)) { int* te = (int*)(p.ws + WS_TOKE) + row * 2; float* tw = (float*)(p.ws + WS_TOKW) + row * 2; te[0] = e1; te[1] = e2; tw[0] = w1; tw[1] = w2; }
            atomicAdd((int*)&hist[e1 & 31], 1); atomicAdd((int*)&hist[e2 & 31], 1);
        }
        __syncthreads();
        if (F.tid < 32 && !(abl & 2)) ((int*)(p.ws + WS_BLKCNT))[rb * 32 + F.tid] = hist[F.tid];
        __syncthreads();
    }
}
__device__ __forceinline__ void p6_lists(const P& p, Frame& F) {
    LAS int* ps = (LAS int*)F.lds;
    LAS int* pp = ps + 512;
    LAS int* tot = pp + 512; LAS int* pre = tot + 32; LAS int* ebase = pre + 32;
    LAS int* es = ebase + 40;
    const int* blk = (const int*)(p.ws + WS_BLKCNT);
    int* meta = (int*)(p.ws + WS_META);
    for (int rb = F.vcu; rb < ML / 64; rb += F.G) {
        { const int e = F.tid & 31, part = F.tid >> 5; int s = 0, q = 0;
#pragma unroll 4
          for (int j = 0; j < 16; ++j) { const int bb = part * 16 + j; const int v = blk[bb * 32 + e]; s += v; q += bb < rb ? v : 0; }
          ps[part * 32 + e] = s; pp[part * 32 + e] = q; }
        __syncthreads();
        if (F.tid < 32) { int s = 0, q = 0;
#pragma unroll
            for (int part = 0; part < 16; ++part) { s += ps[part * 32 + F.tid]; q += pp[part * 32 + F.tid]; }
            tot[F.tid] = s; pre[F.tid] = q; }
        __syncthreads();
        if (F.tid == 0) { int tb = 0; for (int e = 0; e < 32; ++e) { ebase[e] = tb; tb += (tot[e] + 255) >> 8; } ebase[32] = tb; }
        if (F.tid < 128) es[F.tid] = ((const int*)(p.ws + WS_TOKE))[rb * 128 + F.tid];
        __syncthreads();
        if (F.tid < 128) {
            const int e = es[F.tid]; int rank = 0;
            for (int a = 0; a < F.tid; ++a) rank += es[a] == e ? 1 : 0;
            const int pos = ebase[e] * 256 + pre[e] + rank;
            ((int*)(p.ws + WS_ROWIDX))[pos] = rb * 64 + (F.tid >> 1);
            ((float*)(p.ws + WS_ROWW))[pos] = ((const float*)(p.ws + WS_TOKW))[rb * 128 + F.tid];
            ((int*)(p.ws + WS_TOKPOS))[rb * 128 + F.tid] = pos;
        }
        if (rb < 32) {
            const int e = rb, lo = ebase[e] * 256 + tot[e], hi = ebase[e + 1] * 256;
            for (int pos = lo + F.tid; pos < hi; pos += NTHR) { ((int*)(p.ws + WS_ROWIDX))[pos] = 0; ((float*)(p.ws + WS_ROWW))[pos] = 0.f; }
            for (int t = ebase[e] + F.tid; t < ebase[e + 1]; t += NTHR) meta[128 + t] = e;
            if (F.tid == 0) { meta[e] = tot[e]; meta[64 + e] = ebase[e]; if (e == 31) { meta[64 + 32] = ebase[32]; meta[320] = ebase[32]; } }
        }
        __syncthreads();
    }
}
__device__ __forceinline__ void p78_moe(const P& p, Frame& F, bool down) {
    LAS int* tile_e = (LAS int*)(F.lds + LDS_X);
    const int* meta = (const int*)(p.ws + WS_META);
    for (int t = F.tid; t < MAXTILES; t += NTHR) tile_e[t] = meta[128 + t] & 31;
    __syncthreads();
    const int ntiles = meta[320];
    pg8::SchedMoE S{F.G, (int)blockIdx.x, ntiles * 4, tile_e, (const int*)(p.ws + WS_ROWIDX)};
    if (!down) {
        pg8::Gemm g{(const pg8::bf16_t*)(p.ws + WS_XN), (const pg8::bf16_t*)(p.ws + WS_WGU), MAXPOS, NE * 1024, D};
        pg8::EpiGU E{(bf16*)(p.ws + WS_ACT), (const float*)(p.ws + WS_ROWW)};
        pg8::gemm_phase<pg8::EpiGU, pg8::SchedMoE, true, true, true>((PG8_LAS unsigned char*)F.lds, g, S, E);
    } else {
        pg8::Gemm g{(const pg8::bf16_t*)(p.ws + WS_ACT), (const pg8::bf16_t*)(p.ws + WS_WD), MAXPOS, NE * 1024, EFF};
        pg8::EpiY E{(bf16*)(p.ws + WS_Y)};
        pg8::gemm_phase<pg8::EpiY, pg8::SchedMoE, true, true, false>((PG8_LAS unsigned char*)F.lds, g, S, E);
    }
}
__device__ __forceinline__ void p9_final(const P& p, Frame& F, float* dst) {
    const bf16* Y = (const bf16*)(p.ws + WS_Y);
    for (int rb = F.vcu; rb < ML / 64; rb += F.G) {
        const int b = (rb * 64) / T;
        const float* modx = (const float*)(p.ws + WS_MODX) + b * 6144;
        const int row0 = rb * 64 + F.wave * 8;
        f32x4 gp[4];
#pragma unroll
        for (int j = 0; j < 4; ++j) { const int k = 256 * j + 4 * F.lane; gp[j] = *(const f32x4*)(modx + 5120 + k) * *(const f32x4*)(p.post2 + k); }
        v2u ya[2][4], yc[2][4]; f32x4 xo[2][4];
        const int* tpp = (const int*)(p.ws + WS_TOKPOS) + row0 * 2;
#define P9_LOAD(buf, rw, t2) do { _Pragma("unroll") for (int j = 0; j < 4; ++j) { \
            ya[buf][j] = *(const v2u*)(Y + (size_t)(t2).x * D + 256 * j + 4 * F.lane); yc[buf][j] = *(const v2u*)(Y + (size_t)(t2).y * D + 256 * j + 4 * F.lane); \
            xo[buf][j] = *(const f32x4*)(p.out + (size_t)(rw) * D + 256 * j + 4 * F.lane); } } while (0)
#define P9_COMP(buf, rw) do { f32x4 y[4]; float ss = 0.f; \
            _Pragma("unroll") for (int j = 0; j < 4; ++j) { const v2u a = ya[buf][j], c = yc[buf][j]; \
                y[j] = (f32x4){__uint_as_float(a.x << 16) + __uint_as_float(c.x << 16), __uint_as_float(a.x & 0xffff0000u) + __uint_as_float(c.x & 0xffff0000u), \
                               __uint_as_float(a.y << 16) + __uint_as_float(c.y << 16), __uint_as_float(a.y & 0xffff0000u) + __uint_as_float(c.y & 0xffff0000u)}; \
                ss += (y[j].x * y[j].x + y[j].y * y[j].y) + (y[j].z * y[j].z + y[j].w * y[j].w); } \
            const float rn = rsqrtf(wave_sum(ss) * (1.f / D) + EPS); \
            _Pragma("unroll") for (int j = 0; j < 4; ++j) *(f32x4*)(dst + (size_t)(rw) * D + 256 * j + 4 * F.lane) = xo[buf][j] + gp[j] * (y[j] * rn); } while (0)
        int2 tpA = *(const int2*)(tpp), tpB = *(const int2*)(tpp + 2);
        P9_LOAD(0, row0, tpA);
#pragma unroll 1
        for (int rp = 0; rp < 4; ++rp) {
            const int ra = row0 + 2 * rp;
            P9_LOAD(1, ra + 1, tpB);
            int2 tpA2 = tpA, tpB2 = tpB;
            if (rp < 3) { tpA2 = *(const int2*)(tpp + 4 * rp + 4); tpB2 = *(const int2*)(tpp + 4 * rp + 6); }
            P9_COMP(0, ra);
            if (rp < 3) P9_LOAD(0, ra + 2, tpA2);
            P9_COMP(1, ra + 1);
            tpA = tpA2; tpB = tpB2;
        }
#undef P9_COMP
#undef P9_LOAD
    }
}

struct Args { P p; int ph_lo, ph_hi, li, pad; };
__global__ void __launch_bounds__(NTHR, 2) mega(Args args) {
    extern __shared__ __attribute__((aligned(16))) unsigned char lds_raw[];
    Frame F;
    F.lds = (LAS unsigned char*)lds_raw;
    F.MISC = (volatile LAS unsigned*)(F.lds + MISC_OFF);
    F.tid = threadIdx.x; F.lane = F.tid & 63; F.wave = __builtin_amdgcn_readfirstlane(F.tid >> 6);
    F.G = gridDim.x; { const int bx = blockIdx.x; F.vcu = (F.G % 8 == 0) ? (bx % 8) * (F.G / 8) + bx / 8 : bx; }
    const P& p = args.p;
    unsigned* ctl = (unsigned*)(p.ws + WS_CTL);
    for (int u = F.tid; u < (LDS_BYTES - MISC_OFF) / 4; u += NTHR) ((LAS unsigned*)(F.lds + MISC_OFF))[u] = 0u;
    __syncthreads();
    const int lo = args.ph_lo, hi = args.ph_hi;
    XcdBarrier bar; bar.bar = ctl + CW_BAR + args.li * XCD_BAR_WORDS; bar.x = 0; bar.st = nullptr;
    if (hi - lo > 1) bar = xcd_barrier_post(ctl + CW_BAR + args.li * XCD_BAR_WORDS, F.MISC + 8);
#define IN(k) (lo <= (k) && (k) < hi)
#define SEAM(k) do { if (IN(k) && IN((k) + 1)) xcd_barrier(bar); } while (0)
    if (IN(0)) { p0_prologue(p, F); SEAM(0); }
    if (IN(1)) { p1_norm(p, F); SEAM(1); }
    if (IN(2)) {
        pg8::Gemm g{(const pg8::bf16_t*)(p.ws + WS_XN), (const pg8::bf16_t*)(p.ws + WS_WQKV), MT, NQKV, D};
        pg8::SchedQKV S{F.G, (int)blockIdx.x};
        pg8::EpiQKV E{p.ws, p.bqn, p.bkn};
        pg8::gemm_phase<pg8::EpiQKV, pg8::SchedQKV, true, true, false>((PG8_LAS unsigned char*)F.lds, g, S, E);
        SEAM(2);
    }
#ifdef PROBE_ABL
    if (IN(3) && args.pad) { att::attn_phase<PROBE_ABL>(p, F.lds, F.vcu, F.G); } else
#endif
    if (IN(3)) { att::attn_phase<0>(p, F.lds, F.vcu, F.G); SEAM(3); }
    if (IN(4)) { p4_outproj(p, F); SEAM(4); }
#ifdef PROBE_ABL5
    if (IN(5) && args.pad) { p5_rowpass(p, F, PROBE_ABL5); } else
#endif
    if (IN(5)) { p5_rowpass(p, F); SEAM(5); }
    if (IN(6)) { p6_lists(p, F); SEAM(6); }
    if (IN(7)) { p78_moe(p, F, false); SEAM(7); }
    if (IN(8)) { p78_moe(p, F, true); SEAM(8); }
    if (IN(9)) { p9_final(p, F, args.pad ? (float*)(p.ws + WS_WGU) : p.out); }
#undef IN
#undef SEAM
}

#ifndef ONE_LAUNCH
#define ONE_LAUNCH 1
#endif
#ifndef FAST_MASK
#define FAST_MASK 0x3ff
#endif
static void launch_mega(const P& p, int lo, int hi, int li, int grid, hipStream_t stream) {
    Args a{}; a.p = p; a.ph_lo = lo; a.ph_hi = hi; a.li = li; a.pad = 0;
    hipLaunchKernelGGL(mega, dim3(grid), dim3(NTHR), LDS_BYTES, stream, a);
}
extern "C" void kernel_launch(void* const* d_in, const int* in_sizes, int n_in, void* d_out, int out_size, void* d_ws, size_t ws_size, hipStream_t stream) {
    static int grid = 0;
    if (grid == 0) {
        if (n_in != 24 || out_size != ML * D || ws_size < WS_END) { fprintf(stderr, "kernel_launch: unexpected shapes (n_in %d out %d ws %zu)\n", n_in, out_size, ws_size); grid = -1; return; }
        int dev = 0, cus = 0, per_cu = 0;
        if (hipGetDevice(&dev) != hipSuccess || hipDeviceGetAttribute(&cus, hipDeviceAttributeMultiprocessorCount, dev) != hipSuccess) { grid = -1; return; }
        if (hipFuncSetAttribute((const void*)mega, hipFuncAttributeMaxDynamicSharedMemorySize, LDS_BYTES) != hipSuccess) { fprintf(stderr, "kernel_launch: hipFuncSetAttribute failed\n"); grid = -1; return; }
        if (hipOccupancyMaxActiveBlocksPerMultiprocessor(&per_cu, (const void*)mega, NTHR, LDS_BYTES) != hipSuccess || per_cu < 1) { fprintf(stderr, "kernel_launch: occupancy query says %d blocks/CU\n", per_cu); (void)hipGetLastError(); grid = -1; return; }
        grid = cus;
    }
    if (grid < 0) return;
    P p{};
    const float** f = (const float**)&p;
    for (int i = 0; i < 24; ++i) f[i] = (const float*)d_in[i];
    p.out = (float*)d_out; p.ws = (unsigned char*)d_ws;
    (void)hipMemsetAsync((char*)d_ws + WS_CTL, 0, 1 * MiB, stream);
#if ONE_LAUNCH
    launch_mega(p, 0, 10, 0, grid, stream);
#else
    for (int k = 0; k < 10; ++k) {
        launch_mega(p, k, k + 1, 0, grid, stream);
#ifdef PROBE_DUP
        if (k == PROBE_DUP) for (int r_ = 0; r_ < 3; ++r_) { Args a{}; a.p = p; a.ph_lo = k; a.ph_hi = k + 1; a.li = 0; a.pad = 1; hipLaunchKernelGGL(mega, dim3(grid), dim3(NTHR), LDS_BYTES, stream, a); }
#endif
    }
#endif
}
```

```cpp
#include <hip/hip_runtime.h>
#include <cstdio>
#include <cstdint>
#ifndef WCONV_IN_ATTN
#define WCONV_IN_ATTN 1
#endif

constexpr int NB = 8, T = 2048, D = 1024, CL = 256;
constexpr int ML = NB * T;
constexpr int MC = NB * CL;
constexpr int MT = ML + MC;
constexpr int NKEY = T + CL;
constexpr int NTILE = NKEY / 64;
constexpr int NQKV = 1536;
constexpr int NE = 32, EFF = 512;
constexpr int MAXPOS = 40960;
constexpr int MAXTILES = MAXPOS / 256;
constexpr float EPS = 1e-6f;
constexpr float LOG2E = 1.4426950408889634f;
constexpr float C2 = 0.125f * LOG2E;

typedef unsigned short bf16;

constexpr size_t MiB = 1u << 20;
constexpr size_t WS_CTL = 0;
constexpr size_t WS_MODX = 1 * MiB;
constexpr size_t WS_ROPE = 1 * MiB + 512 * 1024;
constexpr size_t WS_WR = 1 * MiB + 768 * 1024;
constexpr size_t WS_TOKE = 2 * MiB;
constexpr size_t WS_TOKW = WS_TOKE + 128 * 1024;
constexpr size_t WS_TOKPOS = WS_TOKW + 128 * 1024;
constexpr size_t WS_ROWIDX = WS_TOKPOS + 128 * 1024;
constexpr size_t WS_ROWW = WS_ROWIDX + 160 * 1024;
constexpr size_t WS_BLKCNT = WS_ROWW + 160 * 1024;
constexpr size_t WS_META = WS_BLKCNT + 32 * 1024;
constexpr size_t WS_WQKV = 4 * MiB;
constexpr size_t WS_WO = 7 * MiB;
constexpr size_t WS_WGU = 9 * MiB;
constexpr size_t WS_WD = 73 * MiB;
constexpr size_t WS_XN = 105 * MiB;
constexpr size_t WS_QA = 141 * MiB;
constexpr size_t WS_QB = 157 * MiB;
constexpr size_t WS_KA = 173 * MiB;
constexpr size_t WS_VA = WS_KA + 4608 * 1024;
constexpr size_t WS_KB = WS_VA + 4608 * 1024;
constexpr size_t WS_VB = WS_KB + 4608 * 1024;
constexpr size_t WS_O = 191 * MiB;
constexpr size_t WS_SSQ = 223 * MiB;
constexpr size_t WS_OX = 261 * MiB;
constexpr size_t WS_R1 = 293 * MiB;
constexpr size_t WS_ACT = 141 * MiB;
constexpr size_t WS_Y = 181 * MiB;
constexpr size_t WS_END = 294 * MiB;

__device__ __forceinline__ unsigned f2bf(float f) { unsigned u = __builtin_bit_cast(unsigned, f); return (u + 0x7fffu + ((u >> 16) & 1u)) >> 16; }
__device__ __forceinline__ float bf2f(bf16 h) { return __builtin_bit_cast(float, (unsigned)h << 16); }
__device__ __forceinline__ float wave_sum(float v) {
#pragma unroll
    for (int o = 1; o < 64; o <<= 1) v += __shfl_xor(v, o);
    return v;
}
__device__ __forceinline__ float wave_max(float v) {
#pragma unroll
    for (int o = 1; o < 64; o <<= 1) v = fmaxf(v, __shfl_xor(v, o));
    return v;
}
__device__ __forceinline__ float silu_f(float v) { return v / (1.f + __expf(-v)); }

__host__ __device__ __forceinline__ int qkv_row(int n) { const int pn = n >> 8, j = n & 255, hh = j >> 6, d = j & 63; return pn * 256 + (d >> 5) * 128 + hh * 32 + (d & 31); }
__host__ __device__ __forceinline__ size_t q_off(int b, int h, int t, int d) { return (((size_t)(b * 8 + h) * T + t) * 64 + d); }
__host__ __device__ __forceinline__ size_t k_off(int b, int kvh, int pos, int d) { return ((size_t)((b * 2 + kvh) * NTILE + (pos >> 6)) * 4096 + (d >> 3) * 512 + (pos & 63) * 8 + (d & 7)); }
__host__ __device__ __forceinline__ size_t v_off(int b, int kvh, int pos, int d) { return ((size_t)((b * 2 + kvh) * NTILE + (pos >> 6)) * 4096 + (d >> 5) * 2048 + (pos & 63) * 32 + (d & 31)); }

struct P {
    const float *x, *c, *ctx, *c_ctx, *w_mod, *b_mod, *pre1, *post1, *w_in, *a_sink, *bqn, *bkn, *aon, *bon, *w_out, *pre2, *post2, *w_group, *b_group, *w_router, *b_router, *w_gate, *w_up, *w_down;
    float* out; unsigned char* ws;
};

#define GAS __attribute__((address_space(1)))
#define LAS __attribute__((address_space(3)))
typedef unsigned v4u __attribute__((ext_vector_type(4)));
typedef unsigned v2u __attribute__((ext_vector_type(2)));
typedef float f32x4 __attribute__((ext_vector_type(4)));
typedef float f32x16 __attribute__((ext_vector_type(16)));
typedef short bf16x8 __attribute__((ext_vector_type(8)));
typedef short s16x4 __attribute__((ext_vector_type(4)));
constexpr int NWAVES = 8, NTHR = 512;
constexpr int LDS_BYTES = 163840;
constexpr int RING_BYTES = 131072;
constexpr int MISC_OFF = 159 * 1024;
constexpr int CW_TMO = 0, CW_CODE = 1, CW_BAR = 4096;
#define LDS_WAIT() asm volatile("s_waitcnt lgkmcnt(0)" ::: "memory")
#define VM_WAIT() asm volatile("s_waitcnt vmcnt(0)" ::: "memory")
__device__ __forceinline__ unsigned pk2(float lo, float hi) { return f2bf(lo) | (f2bf(hi) << 16); }
#ifndef WT_STORES
#define WT_STORES 0
#endif
__device__ __forceinline__ void st16(void* p, v4u v) {
#if WT_STORES
    asm volatile("global_store_dwordx4 %0, %1, off sc1\n\ts_nop 1" :: "v"(p), "v"(v) : "memory");
#else
    *(v4u*)p = v;
#endif
}
__device__ __forceinline__ void st16f(void* p, f32x4 v) { st16(p, __builtin_bit_cast(v4u, v)); }
__device__ __forceinline__ void st8(void* p, v2u v) {
#if WT_STORES
    asm volatile("global_store_dwordx2 %0, %1, off sc1\n\ts_nop 1" :: "v"(p), "v"(v) : "memory");
#else
    *(v2u*)p = v;
#endif
}

#define XB_TMO      128
#define XB_XCNT(j)  (256  + 64 * (j))
#define XB_XSUB(j)  (1280 + 64 * (j))
#define XB_XGEN(j)  (2304 + 64 * (j))
#define XB_TOP      3328
#define XB_TOPGEN   3392
#define XCD_BAR_WORDS 3456
#define XB_SPIN_CAP (1u << 18)
__device__ __forceinline__ unsigned xb_ld(unsigned* p)              { return __hip_atomic_load(p, __ATOMIC_RELAXED, __HIP_MEMORY_SCOPE_AGENT); }
__device__ __forceinline__ unsigned xb_add(unsigned* p, unsigned v) { return __hip_atomic_fetch_add(p, v, __ATOMIC_RELAXED, __HIP_MEMORY_SCOPE_AGENT); }
__device__ __forceinline__ unsigned xb_xcc_id() { return (unsigned)__builtin_amdgcn_s_getreg((3 << 11) | 20) & 0xFu; }
#define XB_SPIN(cond, bar) do { unsigned _sp = 0; while (cond) { __builtin_amdgcn_s_sleep(1); \
    if ((++_sp & 255u) == 0u) { if (xb_ld(&(bar)[XB_TMO])) break; if (_sp > XB_SPIN_CAP) { atomicAdd(&(bar)[XB_TMO], 1u); break; } } } } while (0)
struct XcdBarrier { unsigned* bar; unsigned x; volatile LAS unsigned* st; };
__device__ __forceinline__ XcdBarrier xcd_barrier_post(unsigned* bar, volatile LAS unsigned* st) {
    XcdBarrier b; b.bar = bar; b.x = xb_xcc_id(); b.st = st;
    if (threadIdx.x == 0) (void)xb_add(&bar[XB_XCNT(b.x)], 1u);
    return b;
}
__device__ __forceinline__ void xcd_barrier_complete(unsigned* bar, unsigned x, unsigned& nloc, unsigned& nx) {
    const unsigned G = gridDim.x * gridDim.y * gridDim.z;
    unsigned sum, cnt, mine, sp = 0u;
    for (;;) {
        sum = 0u; cnt = 0u; mine = 0u;
#pragma unroll
        for (unsigned j = 0; j < 16; ++j) { const unsigned c = xb_ld(&bar[XB_XCNT(j)]); sum += c; cnt += (c > 0u) ? 1u : 0u; mine = (j == x) ? c : mine; }
        if (sum == G) break;
        __builtin_amdgcn_s_sleep(1);
        if ((++sp & 255u) == 0u) { if (xb_ld(&bar[XB_TMO])) break; if (sp > XB_SPIN_CAP) { atomicAdd(&bar[XB_TMO], 1u); break; } }
    }
    nloc = mine > 0u ? mine : 1u; nx = cnt > 0u ? cnt : 1u;
}
__device__ __forceinline__ void xcd_barrier(const XcdBarrier& b) {
    asm volatile("s_waitcnt vmcnt(0)" ::: "memory");
    __syncthreads();
    if (threadIdx.x == 0) {
        unsigned* bar = b.bar;
        __builtin_amdgcn_s_waitcnt(0);
        unsigned nloc = b.st[0], nx = b.st[1];
        if (nloc == 0u) { xcd_barrier_complete(bar, b.x, nloc, nx); b.st[0] = nloc; b.st[1] = nx; }
        const unsigned old = xb_add(&bar[XB_XSUB(b.x)], 1u);
        const unsigned gen = old / nloc;
        if (old + 1u == (gen + 1u) * nloc) {
            __builtin_amdgcn_fence(__ATOMIC_RELEASE, "agent");
            asm volatile("s_waitcnt vmcnt(0)" ::: "memory");
            const unsigned og = xb_add(&bar[XB_TOP], 1u);
            const unsigned tg = og / nx;
            if (og + 1u == (tg + 1u) * nx) xb_add(&bar[XB_TOPGEN], 1u);
            else XB_SPIN(xb_ld(&bar[XB_TOPGEN]) == tg, bar);
            __builtin_amdgcn_fence(__ATOMIC_ACQUIRE, "agent");
            xb_add(&bar[XB_XGEN(b.x)], 1u);
            asm volatile("s_waitcnt vmcnt(0)" ::: "memory");
        } else {
            XB_SPIN(xb_ld(&bar[XB_XGEN(b.x)]) == gen, bar);
            __builtin_amdgcn_fence(__ATOMIC_ACQUIRE, "agent");
            asm volatile("s_waitcnt vmcnt(0)" ::: "memory");
        }
    }
    __syncthreads();
}

namespace pg8 {
#define PG8_LAS __attribute__((address_space(3)))
typedef unsigned short bf16_t;
typedef short bf16x8 __attribute__((ext_vector_type(8)));
typedef float f32x4 __attribute__((ext_vector_type(4)));
typedef unsigned u32x4 __attribute__((ext_vector_type(4)));
constexpr int BM = 256, BK = 64, HALF = 128, HTB = HALF * BK * 2  , STAGE_BYTES = 8 * HTB, NXCD = 8, WGM = 8;

__host__ __device__ __forceinline__ int lds_byte(int r, int c) { const int st = (r >> 4) * 2 + (c >> 5), rr = r & 15, cc = c & 31, ob = rr * 64 + cc * 2; return st * 1024 + (ob ^ (((ob >> 9) & 1) << 5)); }
__host__ __device__ __forceinline__ void stage_rc(int b, int& R, int& C) { const int st = b / 1024, sb = b % 1024, swz = sb ^ (((sb >> 9) & 1) << 5); R = (st >> 1) * 16 + swz / 64; C = (st & 1) * 32 + (swz % 64) / 2; }
__host__ __device__ __forceinline__ int perm32(int rho) { const int n = rho >> 4, i = rho & 15; return 8 * (i >> 2) + 4 * n + (i & 3); }

struct Unit { int pm, pn; };
struct Gemm { const bf16_t* A; const bf16_t* Bt; int M, N, K; };
__device__ __forceinline__ unsigned cvt_pk_bf16(float lo, float hi) { unsigned r; asm volatile("v_cvt_pk_bf16_f32 %0, %1, %2" : "=v"(r) : "v"(lo), "v"(hi)); return r; }
template <class Epi, class Sched, bool ALIGN_EPI = false, bool SP2 = false, bool GATHER = false>
__device__ __forceinline__ void gemm_phase(PG8_LAS unsigned char* lds, const Gemm g, const Sched& S, const Epi& E) {
    const int tid = threadIdx.x, wid = __builtin_amdgcn_readfirstlane(tid >> 6), lane = tid & 63, wr = wid >> 2, wc = wid & 3, fr = lane & 15, fq = lane >> 4;
    const int K = g.K, nt = K / BK;
    unsigned voffA[2], voffB[2]; int RA[2], CA[2];
#pragma unroll
    for (int i = 0; i < 2; ++i) { int R, C; stage_rc(tid * 16 + i * 8192, R, C); const int Rb = Epi::PERM ? ((R & ~31) + perm32(R & 31)) : R;
        voffA[i] = (unsigned)(R * K + C) * 2u; voffB[i] = (unsigned)(Rb * K + C) * 2u; RA[i] = R; CA[i] = C; }
    const size_t kstep = (size_t)(BK * 2);
    const size_t hstep = (size_t)HALF * K * 2;
    const size_t tstep = 2 * hstep;
    const unsigned ldsw = (unsigned)wid * 1024u;
    const int aoff = lds_byte(wr * 64 + fr, fq * 8), boff = lds_byte(wc * 32 + fr, fq * 8);
#define PG8_SA(b, h) (((b) * 2 + (h)) * HTB)
#define PG8_SB(b, h) ((4 + (b) * 2 + (h)) * HTB)
#define PG8_STAGE(bufoff, gbase, voff) do { _Pragma("unroll") for (int _i = 0; _i < 2; ++_i) \
        __builtin_amdgcn_global_load_lds((const unsigned*)((const char*)(gbase) + (voff)[_i]), (PG8_LAS unsigned*)(lds + (bufoff) + ldsw + _i * 8192), 16, 0, 0); } while (0)
#define PG8_STAGE_A(bufoff, gbase, h, VO) do { if constexpr (GATHER) { PG8_STAGE(bufoff, gbase, VO[h]); } else { PG8_STAGE(bufoff, (gbase) + (h) * hstep, voffA); } } while (0)
#define PG8_LDA(dst, b, h) do { _Pragma("unroll") for (int m = 0; m < 4; ++m) _Pragma("unroll") for (int k = 0; k < 2; ++k) dst[m][k] = *(const PG8_LAS bf16x8*)(lds + PG8_SA(b, h) + aoff + m * 2048 + k * 1024); } while (0)
#define PG8_LDB(dst, b, h) do { _Pragma("unroll") for (int n = 0; n < 2; ++n) _Pragma("unroll") for (int k = 0; k < 2; ++k) dst[n][k] = *(const PG8_LAS bf16x8*)(lds + PG8_SB(b, h) + boff + n * 2048 + k * 1024); } while (0)
#define PG8_MMA(ai, bj, At, Bt) do { __builtin_amdgcn_s_setprio(1); _Pragma("unroll") for (int m = 0; m < 4; ++m) _Pragma("unroll") for (int n = 0; n < 2; ++n) _Pragma("unroll") for (int k = 0; k < 2; ++k) \
        acc[ai][bj][m][n] = __builtin_amdgcn_mfma_f32_16x16x32_bf16(Bt[n][k], At[m][k], acc[ai][bj][m][n], 0, 0, 0); __builtin_amdgcn_s_setprio(0); } while (0)
#define PG8_WAIT_V(n) asm volatile("s_waitcnt vmcnt(" #n ")" ::: "memory")
#define PG8_WAIT_L(n) asm volatile("s_waitcnt lgkmcnt(" #n ")" ::: "memory")
#define PG8_BAR __builtin_amdgcn_s_barrier()
#define PG8_SCHED __builtin_amdgcn_sched_barrier(0)
    Unit cur, nxt; int ui = 0;
    if (!S.next(0, cur)) return;
    f32x4 acc[2][2][4][2];
#pragma unroll
    for (int a = 0; a < 2; ++a)
#pragma unroll
        for (int b = 0; b < 2; ++b)
#pragma unroll
            for (int m = 0; m < 4; ++m)
#pragma unroll
                for (int n = 0; n < 2; ++n) acc[a][b][m][n] = (f32x4){0.f, 0.f, 0.f, 0.f};
    bf16x8 At[4][2], B0[2][2], B1[2][2];
    const char* cA = (const char*)g.A + (GATHER ? (size_t)0 : (size_t)cur.pm * tstep); const char* cB = (const char*)g.Bt + (size_t)cur.pn * tstep;
    unsigned vcur[2][2], vnxt[2][2], vsel[2][2];
#pragma unroll
    for (int h = 0; h < 2; ++h)
#pragma unroll
        for (int i = 0; i < 2; ++i) { vcur[h][i] = 0u; vnxt[h][i] = 0u; vsel[h][i] = 0u; }
    if constexpr (GATHER) {
#pragma unroll
        for (int h = 0; h < 2; ++h)
#pragma unroll
            for (int i = 0; i < 2; ++i) vcur[h][i] = ((unsigned)S.rowidx[cur.pm * BM + h * HALF + RA[i]] * (unsigned)K + (unsigned)CA[i]) * 2u;
    }
    S.a_ready(cur);
    if constexpr (SP2) {
        PG8_STAGE(PG8_SB(0, 0), cB, voffB); PG8_STAGE(PG8_SB(0, 1), cB + hstep, voffB); PG8_STAGE_A(PG8_SA(0, 0), cA, 0, vcur); PG8_STAGE_A(PG8_SA(0, 1), cA, 1, vcur);
        if (wr == 1) PG8_BAR;
        PG8_WAIT_V(2); PG8_BAR;
        PG8_STAGE(PG8_SB(1, 0), cB + kstep, voffB); PG8_STAGE_A(PG8_SA(1, 0), cA + kstep, 0, vcur); PG8_STAGE(PG8_SB(1, 1), cB + hstep + kstep, voffB);
        PG8_WAIT_V(6); PG8_BAR;
    } else {
        PG8_STAGE(PG8_SB(0, 0), cB, voffB); PG8_STAGE_A(PG8_SA(0, 0), cA, 0, vcur); PG8_STAGE(PG8_SB(0, 1), cB + hstep, voffB); PG8_STAGE_A(PG8_SA(0, 1), cA, 1, vcur);
        if (wr == 1) PG8_BAR;
        PG8_WAIT_V(4); PG8_BAR;
        PG8_STAGE(PG8_SB(1, 0), cB + kstep, voffB); PG8_STAGE_A(PG8_SA(1, 0), cA + kstep, 0, vcur); PG8_STAGE(PG8_SB(1, 1), cB + hstep + kstep, voffB);
        PG8_WAIT_V(6); PG8_BAR;
    }
    for (;;) {
        const bool has_next = S.next(ui + 1, nxt);
        if constexpr (GATHER) {
#pragma unroll
            for (int h = 0; h < 2; ++h)
#pragma unroll
                for (int i = 0; i < 2; ++i) vnxt[h][i] = has_next ? ((unsigned)S.rowidx[nxt.pm * BM + h * HALF + RA[i]] * (unsigned)K + (unsigned)CA[i]) * 2u : vcur[h][i];
        }
        const char* nA = has_next ? (const char*)g.A + (GATHER ? (size_t)0 : (size_t)nxt.pm * tstep) : cA; const char* nB = has_next ? (const char*)g.Bt + (size_t)nxt.pn * tstep : cB;
        for (int t = 0; t < nt; t += 2) {
            const bool last = (t == nt - 2);
            if constexpr (GATHER) {
#pragma unroll
                for (int h = 0; h < 2; ++h)
#pragma unroll
                    for (int i = 0; i < 2; ++i) vsel[h][i] = last ? vnxt[h][i] : vcur[h][i];
            }
            if constexpr (Epi::HAS_MID) { if (t == nt / 2) E.mid(acc, cur, wr, wc, fr, fq); }
            const char* a1 = cA + (size_t)(t + 1) * kstep;
            const char* a2 = last ? nA : cA + (size_t)(t + 2) * kstep; const char* b2 = last ? nB : cB + (size_t)(t + 2) * kstep;
            const char* a3 = a2 + kstep; const char* b3 = b2 + kstep;
            if (last && has_next) S.a_ready(nxt);
            if constexpr (SP2) {
            PG8_LDB(B0, 0, 0); PG8_LDB(B1, 0, 1); PG8_SCHED; PG8_LDA(At, 0, 0); PG8_STAGE_A(PG8_SA(1, 1), a1, 1, vcur);
            PG8_WAIT_V(8); PG8_WAIT_L(0); PG8_BAR; PG8_MMA(0, 0, At, B0); PG8_MMA(0, 1, At, B1); PG8_BAR; PG8_SCHED;
            PG8_LDA(At, 0, 1); PG8_STAGE(PG8_SB(0, 0), b2, voffB); PG8_STAGE(PG8_SB(0, 1), b2 + hstep, voffB); PG8_STAGE_A(PG8_SA(0, 0), a2, 0, vsel);
            PG8_WAIT_V(8); PG8_WAIT_L(0); PG8_BAR; PG8_MMA(1, 0, At, B0); PG8_MMA(1, 1, At, B1); PG8_BAR; PG8_SCHED;
            PG8_LDB(B0, 1, 0); PG8_LDB(B1, 1, 1); PG8_SCHED; PG8_LDA(At, 1, 0); PG8_STAGE_A(PG8_SA(0, 1), a2, 1, vsel);
            PG8_WAIT_V(8); PG8_WAIT_L(0); PG8_BAR; PG8_MMA(0, 0, At, B0); PG8_MMA(0, 1, At, B1); PG8_BAR; PG8_SCHED;
            PG8_LDA(At, 1, 1); PG8_STAGE(PG8_SB(1, 0), b3, voffB); PG8_STAGE(PG8_SB(1, 1), b3 + hstep, voffB); PG8_STAGE_A(PG8_SA(1, 0), a3, 0, vsel);
            PG8_WAIT_V(8); PG8_WAIT_L(0); PG8_BAR; PG8_MMA(1, 0, At, B0); PG8_MMA(1, 1, At, B1); PG8_BAR; PG8_SCHED;
            } else {
            PG8_LDB(B0, 0, 0); PG8_SCHED; PG8_LDA(At, 0, 0); PG8_STAGE_A(PG8_SA(1, 1), a1, 1, vcur);
            PG8_WAIT_L(8); PG8_BAR; PG8_WAIT_L(0); PG8_MMA(0, 0, At, B0); PG8_BAR; PG8_SCHED;
            PG8_LDB(B1, 0, 1); PG8_STAGE(PG8_SB(0, 0), b2, voffB);
            PG8_BAR; PG8_WAIT_L(0); PG8_MMA(0, 1, At, B1); PG8_BAR;
            PG8_LDA(At, 0, 1); PG8_STAGE_A(PG8_SA(0, 0), a2, 0, vsel);
            PG8_BAR; PG8_WAIT_L(0); PG8_MMA(1, 0, At, B0); PG8_BAR; PG8_SCHED;
            PG8_STAGE(PG8_SB(0, 1), b2 + hstep, voffB);
            PG8_WAIT_V(6); PG8_BAR; PG8_MMA(1, 1, At, B1); PG8_BAR;
            PG8_LDB(B0, 1, 0); PG8_SCHED; PG8_LDA(At, 1, 0); PG8_STAGE_A(PG8_SA(0, 1), a2, 1, vsel);
            PG8_WAIT_L(8); PG8_BAR; PG8_WAIT_L(0); PG8_MMA(0, 0, At, B0); PG8_BAR; PG8_SCHED;
            PG8_LDB(B1, 1, 1); PG8_STAGE(PG8_SB(1, 0), b3, voffB);
            PG8_BAR; PG8_WAIT_L(0); PG8_MMA(0, 1, At, B1); PG8_BAR;
            PG8_LDA(At, 1, 1); PG8_STAGE_A(PG8_SA(1, 0), a3, 0, vsel);
            PG8_BAR; PG8_WAIT_L(0); PG8_MMA(1, 0, At, B0); PG8_BAR; PG8_SCHED;
            PG8_STAGE(PG8_SB(1, 1), b3 + hstep, voffB);
            PG8_WAIT_V(6); PG8_BAR; PG8_MMA(1, 1, At, B1); PG8_BAR;
            }
        }
        if constexpr (ALIGN_EPI) { if (wr == 0) PG8_BAR; }
        if constexpr (!Epi::AFTER_DRAIN) { E(acc, cur, wr, wc, fr, fq); S.done(cur); }
        if (!has_next) break;
#pragma unroll
        for (int a = 0; a < 2; ++a)
#pragma unroll
            for (int b = 0; b < 2; ++b)
#pragma unroll
                for (int m = 0; m < 4; ++m)
#pragma unroll
                    for (int n = 0; n < 2; ++n) acc[a][b][m][n] = (f32x4){0.f, 0.f, 0.f, 0.f};
        cur = nxt; cA = nA; cB = nB; ++ui;
        if constexpr (GATHER) {
#pragma unroll
            for (int h = 0; h < 2; ++h)
#pragma unroll
                for (int i = 0; i < 2; ++i) vcur[h][i] = vnxt[h][i];
        }
        if constexpr (ALIGN_EPI) { if (wr == 1) PG8_BAR; }
    }
    PG8_WAIT_V(0);
    if constexpr (!ALIGN_EPI) { if (wr == 0) PG8_BAR; }
    PG8_BAR;
    if constexpr (Epi::AFTER_DRAIN) { E.fused(acc, cur, wr, wc, fr, fq, lds, wid, lane); S.done(cur); }
#undef PG8_SA
#undef PG8_SB
#undef PG8_STAGE
#undef PG8_STAGE_A
#undef PG8_LDA
#undef PG8_LDB
#undef PG8_MMA
#undef PG8_WAIT_V
#undef PG8_WAIT_L
#undef PG8_BAR
#undef PG8_SCHED
}
}

namespace pg8 {
struct SchedQKV {
    int G, c;
    __device__ __forceinline__ bool next(int i, Unit& u) const {
        const int L = i * G + c; if (L >= 400) return false;
        if (L < 384) { const int xcd = L & 7, off = L >> 3, w = xcd * 48 + off; u.pm = (w / 48) * 8 + ((w % 48) & 7); u.pn = (w % 48) >> 3; }
        else { const int j = L - 384; u.pm = 64 + (j >> 1); u.pn = (j & 1) ? 5 : 2; }
        return true;
    }
    __device__ __forceinline__ void a_ready(const Unit&) const {}
    __device__ __forceinline__ void done(const Unit&) const {}
};
struct EpiQKV {
    static constexpr bool PERM = true, AFTER_DRAIN = false, HAS_MID = false;
    unsigned char* ws; const float* bqn; const float* bkn;
    __device__ __forceinline__ void operator()(const f32x4 (&acc)[2][2][4][2], const Unit& u, int wr, int wc, int fr, int fq) const {
        const int pn = u.pn; const bool isctx = u.pm >= 64;
        int kind, hh;
        if (pn < 2) { kind = 0; hh = pn * 4 + wc; } else if (pn == 2) { kind = wc < 2 ? 2 : 4; hh = wc & 1; } else if (pn < 5) { kind = 1; hh = (pn - 3) * 4 + wc; } else { kind = wc < 2 ? 3 : 5; hh = wc & 1; }
        const bool rms = kind == 1 || kind == 3, rope = !isctx && kind <= 3;
        const float* gp = kind == 1 ? bqn : bkn;
        f32x4 gain[2][2];
#pragma unroll
        for (int bj = 0; bj < 2; ++bj)
#pragma unroll
            for (int n = 0; n < 2; ++n) gain[bj][n] = rms ? *(const f32x4*)(gp + 32 * bj + 8 * fq + 4 * n) : (f32x4){1.f, 1.f, 1.f, 1.f};
        const float* tab = (const float*)(ws + WS_ROPE);
        bf16* base = (bf16*)(ws + (kind == 0 ? WS_QA : kind == 1 ? WS_QB : kind == 2 ? WS_KA : kind == 3 ? WS_KB : kind == 4 ? WS_VA : WS_VB));
        const float qs = kind <= 1 ? C2 : 1.f;
#pragma unroll
        for (int ai = 0; ai < 2; ++ai)
#pragma unroll
            for (int m = 0; m < 4; ++m) {
                const int row = u.pm * BM + ai * HALF + wr * 64 + m * 16 + fr;
                int b, t, pos;
                if (!isctx) { b = row >> 11; t = row & 2047; pos = t; } else { const int cr = row - ML; b = cr >> 8; t = 0; pos = T + (cr & 255); }
                f32x4 v[2][2];
#pragma unroll
                for (int bj = 0; bj < 2; ++bj)
#pragma unroll
                    for (int n = 0; n < 2; ++n) v[bj][n] = acc[ai][bj][m][n];
                if (rms) {
                    float ss = 0.f;
#pragma unroll
                    for (int bj = 0; bj < 2; ++bj)
#pragma unroll
                        for (int n = 0; n < 2; ++n) ss += (v[bj][n].x * v[bj][n].x + v[bj][n].y * v[bj][n].y) + (v[bj][n].z * v[bj][n].z + v[bj][n].w * v[bj][n].w);
                    ss += __shfl_xor(ss, 16); ss += __shfl_xor(ss, 32);
                    const float rn = rsqrtf(ss * (1.f / 64.f) + EPS);
#pragma unroll
                    for (int bj = 0; bj < 2; ++bj)
#pragma unroll
                        for (int n = 0; n < 2; ++n) v[bj][n] = v[bj][n] * rn * gain[bj][n];
                }
                if (rope) {
#pragma unroll
                    for (int bj = 0; bj < 2; ++bj)
#pragma unroll
                        for (int n = 0; n < 2; ++n) {
                            const int tp = bj == 0 ? (t >> 6) : 32 + (t & 63);
                            const f32x4 cs = *(const f32x4*)(tab + (tp * 16 + 4 * fq + 2 * n) * 2);
                            const f32x4 x = v[bj][n];
                            v[bj][n] = (f32x4){x.x * cs.x - x.y * cs.y, x.x * cs.y + x.y * cs.x, x.z * cs.z - x.w * cs.w, x.z * cs.w + x.w * cs.z};
                        }
                }
#pragma unroll
                for (int bj = 0; bj < 2; ++bj) {
                    const f32x4 v0 = v[bj][0] * qs, v1 = v[bj][1] * qs;
                    u32x4 w; w.x = pk2(v0.x, v0.y); w.y = pk2(v0.z, v0.w); w.z = pk2(v1.x, v1.y); w.w = pk2(v1.z, v1.w);
                    const int d0 = 32 * bj + 8 * fq;
                    bf16* dst = kind <= 1 ? base + q_off(b, hh, t, d0) : kind <= 3 ? base + k_off(b, hh, pos, d0) : base + v_off(b, hh, pos, d0);
                    st16(dst, w);
                }
            }
    }
};
}


namespace pg8 {
struct SchedOne { Unit u;
    __device__ __forceinline__ bool next(int i, Unit& o) const { if (i) return false; o = u; return true; }
    __device__ __forceinline__ void a_ready(const Unit&) const {}
    __device__ __forceinline__ void done(const Unit&) const {} };
struct EpiOut {
    static constexpr bool PERM = true, AFTER_DRAIN = false, HAS_MID = true;
    bf16* OX; const LAS float* tab;
    __device__ __forceinline__ void mid(f32x4 (&acc)[2][2][4][2], const Unit&, int wr, int, int fr, int) const {
#pragma unroll
        for (int ai = 0; ai < 2; ++ai)
#pragma unroll
            for (int m = 0; m < 4; ++m) { const float f = tab[2 * (ai * HALF + wr * 64 + m * 16 + fr)];
#pragma unroll
                for (int bj = 0; bj < 2; ++bj)
#pragma unroll
                    for (int n = 0; n < 2; ++n) acc[ai][bj][m][n] = acc[ai][bj][m][n] * f; }
    }
    __device__ __forceinline__ void operator()(const f32x4 (&acc)[2][2][4][2], const Unit& u, int wr, int wc, int fr, int fq) const {
#pragma unroll
        for (int ai = 0; ai < 2; ++ai)
#pragma unroll
            for (int m = 0; m < 4; ++m) { const int r = ai * HALF + wr * 64 + m * 16 + fr; const float f = tab[2 * r + 1];
                bf16* rowp = OX + (size_t)(u.pm * BM + r) * D + u.pn * BM + wc * 32 + 8 * fq;
#pragma unroll
                for (int bj = 0; bj < 2; ++bj) { const f32x4 v0 = acc[ai][bj][m][0] * f, v1 = acc[ai][bj][m][1] * f;
                    u32x4 w; w.x = pk2(v0.x, v0.y); w.y = pk2(v0.z, v0.w); w.z = pk2(v1.x, v1.y); w.w = pk2(v1.z, v1.w);
                    st16(rowp + bj * HALF, w); } }
    }
};
struct SchedMoE {
    int G, c, nwg; const LAS int* tile_e; const int* rowidx;
    __device__ __forceinline__ bool next(int i, Unit& u) const {
        const int L = i * G + c; if (L >= nwg) return false;
        const int q = nwg >> 3, r = nwg & 7, xcd = L & 7, off = L >> 3;
        const int w = (xcd < r ? xcd * (q + 1) : r * (q + 1) + (xcd - r) * q) + off;
        u.pm = w >> 2; u.pn = tile_e[w >> 2] * 4 + (w & 3); return true;
    }
    __device__ __forceinline__ void a_ready(const Unit&) const {}
    __device__ __forceinline__ void done(const Unit&) const {}
};
__device__ __forceinline__ float silu_fast(float g) { return g * __builtin_amdgcn_rcpf(1.f + __builtin_amdgcn_exp2f(-g * LOG2E)); }
struct EpiGU {
    static constexpr bool PERM = true, AFTER_DRAIN = false, HAS_MID = false;
    bf16* ACT; const float* roww;
    __device__ __forceinline__ void operator()(const f32x4 (&acc)[2][2][4][2], const Unit& u, int wr, int wc, int fr, int fq) const {
#pragma unroll
        for (int ai = 0; ai < 2; ++ai)
#pragma unroll
            for (int m = 0; m < 4; ++m) { const int pos = u.pm * BM + ai * HALF + wr * 64 + m * 16 + fr; const float w = roww[pos];
                const f32x4 g0 = acc[ai][0][m][0], g1 = acc[ai][0][m][1], u0 = acc[ai][1][m][0], u1 = acc[ai][1][m][1];
                u32x4 o;
                o.x = pk2(silu_fast(g0.x) * u0.x * w, silu_fast(g0.y) * u0.y * w); o.y = pk2(silu_fast(g0.z) * u0.z * w, silu_fast(g0.w) * u0.w * w);
                o.z = pk2(silu_fast(g1.x) * u1.x * w, silu_fast(g1.y) * u1.y * w); o.w = pk2(silu_fast(g1.z) * u1.z * w, silu_fast(g1.w) * u1.w * w);
                st16(ACT + (size_t)pos * EFF + (u.pn & 3) * 128 + wc * 32 + 8 * fq, o); }
    }
};
struct EpiY {
    static constexpr bool PERM = true, AFTER_DRAIN = false, HAS_MID = false;
    bf16* Y;
    __device__ __forceinline__ void operator()(const f32x4 (&acc)[2][2][4][2], const Unit& u, int wr, int wc, int fr, int fq) const {
#pragma unroll
        for (int ai = 0; ai < 2; ++ai)
#pragma unroll
            for (int m = 0; m < 4; ++m) { bf16* rowp = Y + (size_t)(u.pm * BM + ai * HALF + wr * 64 + m * 16 + fr) * D + (u.pn & 3) * BM + wc * 32 + 8 * fq;
#pragma unroll
                for (int bj = 0; bj < 2; ++bj) { const f32x4 v0 = acc[ai][bj][m][0], v1 = acc[ai][bj][m][1];
                    u32x4 w; w.x = pk2(v0.x, v0.y); w.y = pk2(v0.z, v0.w); w.z = pk2(v1.x, v1.y); w.w = pk2(v1.z, v1.w);
                    st16(rowp + bj * HALF, w); } }
    }
};
}

namespace att {
typedef __attribute__((address_space(3))) const char* lds_cptr;
typedef short v4i16_t __attribute__((ext_vector_type(4)));
constexpr int NSLOT = 4, SLOTB = 16384, OST_PITCH = 144, OST_WAVE = 32 * OST_PITCH;
static_assert(8 * OST_WAVE <= 3 * SLOTB && NSLOT * SLOTB <= 65536, "attention LDS");
__device__ __forceinline__ int crow(int r, int hi) { return (r & 3) + 8 * (r >> 2) + 4 * hi; }
__device__ __forceinline__ unsigned cvtpk(float lo, float hi) { typedef float f2 __attribute__((ext_vector_type(2))); typedef __bf16 b2 __attribute__((ext_vector_type(2))); f2 v = {lo, hi}; b2 b = __builtin_convertvector(v, b2); return __builtin_bit_cast(unsigned, b); }
__device__ __forceinline__ s16x4 vtr(lds_cptr p) { return __builtin_bit_cast(s16x4, __builtin_amdgcn_ds_read_tr16_b64_v4i16((__attribute__((address_space(3))) v4i16_t*)p)); }
__device__ __forceinline__ float swapmax(float m) { auto rr = __builtin_amdgcn_permlane32_swap(__float_as_uint(m), __float_as_uint(m), false, false); return fmaxf(__uint_as_float(rr[0]), __uint_as_float(rr[1])); }
__device__ __forceinline__ float swapsum(float m) { auto rr = __builtin_amdgcn_permlane32_swap(__float_as_uint(m), __float_as_uint(m), false, false); return __uint_as_float(rr[0]) + __uint_as_float(rr[1]); }

__device__ __forceinline__ void glds16(const void* gsrc, unsigned lds_dst) { unsigned keep;
    asm volatile("s_mov_b32 %0, m0\n\ts_mov_b32 m0, %2\n\ts_nop 0\n\tglobal_load_lds_dwordx4 %1, off\n\ts_mov_b32 m0, %0" : "=&s"(keep) : "v"(gsrc), "s"(lds_dst) : "memory"); }
__device__ __forceinline__ float max3f(float a, float b, float c) { float r; asm("v_max3_f32 %0, %1, %2, %3" : "=v"(r) : "v"(a), "v"(b), "v"(c)); return r; }
__device__ __forceinline__ float max2f(float a, float b) { float r; asm("v_max_f32_e32 %0, %1, %2" : "=v"(r) : "v"(a), "v"(b)); return r; }
constexpr int WC_PER_WAVE = 24, WC_LDS = 65536;
struct WConv { int next, j0, j1, gstep, cm1, cm2; };
struct WItem { const float* src; int N; bf16* dst; int dpitch; };
__device__ __forceinline__ WItem wc_decode(const P& p, int hidx, int& k0, int& n0, int& drow0) {
    const int item = hidx >> 1, kh = hidx & 1; WItem w;
    if (item < 16384) { const int up = item >= 8192, r = item & 8191, e = r >> 8, q = r & 255, kb = q >> 4, nb = q & 15; n0 = nb * 32;
        w.src = (up ? p.w_up : p.w_gate) + (size_t)e * 1024 * 512; w.N = 512; w.dst = (bf16*)(p.ws + WS_WGU) + (size_t)e * 1024 * 1024; w.dpitch = 1024;
        drow0 = (n0 >> 7) * 256 + up * 128 + (n0 & 127); k0 = kb * 64 + kh * 32; }
    else { const int r = item - 16384, e = r >> 8, q = r & 255, kb = q >> 5, nb = q & 31; n0 = nb * 32;
        w.src = p.w_down + (size_t)e * 512 * 1024; w.N = 1024; w.dst = (bf16*)(p.ws + WS_WD) + (size_t)e * 1024 * 512; w.dpitch = 512; drow0 = n0; k0 = kb * 64 + kh * 32; }
    return w;
}
__device__ __forceinline__ void glds16(const void* gsrc, unsigned lds_dst);
__device__ __forceinline__ void wc_issue(const P& p, int gw, int ord, unsigned ldsbuf, int lane) {
    int k0, n0, drow0; const WItem w = wc_decode(p, gw + 2048 * ord, k0, n0, drow0);
#pragma unroll
    for (int q = 0; q < 4; ++q) { const int kl = 8 * q + (lane >> 3), f4 = (lane & 7) ^ ((q >> 1) * 4);
        glds16(w.src + (size_t)(k0 + kl) * w.N + n0 + f4 * 4, (unsigned)__builtin_amdgcn_readfirstlane(ldsbuf + q * 1024)); }
}
__device__ __forceinline__ void wc_consume(const P& p, int gw, int ord, LAS unsigned char* buf, int lane) {
    int k0, n0, drow0; const WItem w = wc_decode(p, gw + 2048 * ord, k0, n0, drow0);
    const int n = lane >> 1, kh = lane & 1;
    const LAS float* s = (const LAS float*)buf + (16 * kh) * 32 + 4 * ((n >> 2) ^ (4 * kh)) + (n & 3);
    float v[16];
#pragma unroll
    for (int i = 0; i < 16; ++i) v[i] = s[i * 32];
    v4u o0, o1;
    o0.x = cvtpk(v[0], v[1]); o0.y = cvtpk(v[2], v[3]); o0.z = cvtpk(v[4], v[5]); o0.w = cvtpk(v[6], v[7]);
    o1.x = cvtpk(v[8], v[9]); o1.y = cvtpk(v[10], v[11]); o1.z = cvtpk(v[12], v[13]); o1.w = cvtpk(v[14], v[15]);
    bf16* d = w.dst + (size_t)(drow0 + n) * w.dpitch + k0 + 16 * kh;
    *(v4u*)d = o0; *(v4u*)(d + 8) = o1;
}
constexpr float THR = 8.f;
template <int GRP, int ABL = 0>
__device__ __forceinline__ void attn_unit(const P& p, LAS unsigned char* lds, int b, int kvh, int qb, WConv& wc, int gw) {
    const int tid = threadIdx.x, lane = tid & 63, r32 = lane & 31, hi = lane >> 5;
    const int wid = __builtin_amdgcn_readfirstlane(tid >> 6);
    const int h = kvh * 4 + (wid >> 1);
    const int q0w = qb * 64 + (wid & 1) * 32, qpos = q0w + r32;
    const bf16* Qp = (const bf16*)(p.ws + (GRP ? WS_QB : WS_QA)) + q_off(b, h, qpos, 0);
    bf16x8 qr[4];
#pragma unroll
    for (int d0 = 0; d0 < 4; ++d0) qr[d0] = *(const bf16x8*)(Qp + 16 * d0 + 8 * hi);
    asm volatile("" : "+v"(qr[0]), "+v"(qr[1]), "+v"(qr[2]), "+v"(qr[3]));
    const char* Kt = (const char*)(p.ws + (GRP ? WS_KB : WS_KA)) + (size_t)(b * 2 + kvh) * NTILE * 8192 + wid * 1024 + lane * 16;
    const char* Vt = (const char*)(p.ws + (GRP ? WS_VB : WS_VA)) + (size_t)(b * 2 + kvh) * NTILE * 8192 + wid * 1024 + lane * 16;
    const unsigned lds0 = (unsigned)(uintptr_t)lds;
    int jlo = 0, nband = NTILE, NT = NTILE;
    if (GRP == 0) { jlo = qb - 2 < 0 ? 0 : qb - 2; const int jhi = qb + 2 > 31 ? 31 : qb + 2; nband = jhi - jlo + 1; NT = nband + 4; }
#define ATT_TILE(i) ((i) < nband ? jlo + (i) : 32 + ((i) - nband))
#define ATT_ISSUE(i) do { if (ABL & 1) break; const int tl_ = ATT_TILE(i); const int sl_ = ((i) & 3) * SLOTB; \
        glds16(Kt + (size_t)tl_ * 8192, (unsigned)__builtin_amdgcn_readfirstlane(lds0 + sl_ + wid * 1024)); \
        glds16(Vt + (size_t)tl_ * 8192, (unsigned)__builtin_amdgcn_readfirstlane(lds0 + sl_ + 8192 + wid * 1024)); } while (0)
#define ATT_WAIT(n) do { if (ABL & 1) break; if ((n) >= 2) asm volatile("s_waitcnt vmcnt(4)" ::: "memory"); else if ((n) == 1) asm volatile("s_waitcnt vmcnt(2)" ::: "memory"); else asm volatile("s_waitcnt vmcnt(0)" ::: "memory"); } while (0)
#define ATT_WAITN(n) do { if (ABL & 1) break; switch (n) { case 0: asm volatile("s_waitcnt vmcnt(0)" ::: "memory"); break; case 2: asm volatile("s_waitcnt vmcnt(2)" ::: "memory"); break; \
        case 4: asm volatile("s_waitcnt vmcnt(4)" ::: "memory"); break; case 6: asm volatile("s_waitcnt vmcnt(6)" ::: "memory"); break; case 8: asm volatile("s_waitcnt vmcnt(8)" ::: "memory"); break; \
        case 10: asm volatile("s_waitcnt vmcnt(10)" ::: "memory"); break; case 12: asm volatile("s_waitcnt vmcnt(12)" ::: "memory"); break; default: asm volatile("s_waitcnt vmcnt(14)" ::: "memory"); break; } } while (0)
#define ATT_BAR() do { asm volatile("" ::: "memory"); __builtin_amdgcn_s_barrier(); asm volatile("" ::: "memory"); } while (0)
#define SBAR() __builtin_amdgcn_sched_barrier(0)
#define MF(a, b, c) __builtin_amdgcn_mfma_f32_32x32x16_bf16(a, b, c, 0, 0, 0)
#define KFRAG(dst, base, k) dst = *(const __attribute__((address_space(3))) bf16x8*)((base) + ((k) >> 1) * 2048 + ((k) & 1) * 512)
    float m, l;
    m = 0.f; l = 0.f;
    f32x16 o0, o1, sA0, sA1, sB0, sB1; const f32x16 zero16 = {0.f, 0.f, 0.f, 0.f, 0.f, 0.f, 0.f, 0.f, 0.f, 0.f, 0.f, 0.f, 0.f, 0.f, 0.f, 0.f};
#pragma unroll
    for (int r = 0; r < 16; ++r) { o0[r] = 0.f; o1[r] = 0.f; sB0[r] = 0.f; sB1[r] = 0.f; }
    const lds_cptr kp0 = (lds_cptr)lds + hi * 1024 + r32 * 16;
    const lds_cptr vp0 = (lds_cptr)lds + 8192 + ((lane >> 4) & 1) * 32 + (lane & 3) * 8 + (4 * hi + ((lane & 15) >> 2)) * 64;
#define ATT_MASK(S0, S1, t) do { if (GRP == 0) { const int tl = ATT_TILE(t); if (tl < 32 && (tl == qb - 2 || tl == qb + 2)) { const int kb = tl * 64; \
        _Pragma("unroll") for (int r = 0; r < 16; ++r) { const int dd = kb + crow(r, hi) - qpos; if (dd > 128 || dd < -128) S0[r] = -1e30f; if (dd + 32 > 128 || dd + 32 < -128) S1[r] = -1e30f; } } } } while (0)
#define ATT_DECIDE(S0, S1, mxv) do { float mx_ = swapmax(mxv); \
        if (__builtin_expect(__any(mx_ > THR), 0)) { const float dl = fmaxf(mx_, 0.f), alpha = __builtin_amdgcn_exp2f(-dl); m += dl; l *= alpha; \
            _Pragma("unroll") for (int r = 0; r < 16; ++r) { S0[r] -= dl; S1[r] -= dl; o0[r] *= alpha; o1[r] *= alpha; } } } while (0)
    wc.cm1 = 0; wc.cm2 = 0;
    ATT_ISSUE(0); ATT_ISSUE(1); ATT_ISSUE(2);
    ATT_WAIT(2); ATT_BAR();
    {
        bf16x8 kf[8];
#pragma unroll
        for (int k = 0; k < 8; ++k) KFRAG(kf[k], kp0, k);
        SBAR();
        sA0 = MF(kf[0], qr[0], zero16); sA1 = MF(kf[1], qr[0], zero16);
#pragma unroll
        for (int d0 = 1; d0 < 4; ++d0) { sA0 = MF(kf[2 * d0], qr[d0], sA0); sA1 = MF(kf[2 * d0 + 1], qr[d0], sA1); }
        ATT_MASK(sA0, sA1, 0);
        asm volatile("s_nop 15\n\ts_nop 7" : "+v"(sA0), "+v"(sA1));
        float a = max3f(sA0[0], sA0[1], sA1[0]), c = max3f(sA0[2], sA0[3], sA1[1]); a = max3f(a, sA1[2], sA1[3]);
#pragma unroll
        for (int r = 4; r < 16; r += 4) { a = max3f(a, sA0[r], sA0[r + 1]); c = max3f(c, sA0[r + 2], sA0[r + 3]); a = max3f(a, sA1[r], sA1[r + 1]); c = max3f(c, sA1[r + 2], sA1[r + 3]); }
        ATT_DECIDE(sA0, sA1, max2f(a, c));
    }
#define ATT_STEP(SC0, SC1, SN0, SN1, t, HN) do { \
        constexpr bool hn_ = HN;                                      \
        ATT_WAITN(wc.cm2 + wc.cm1 + ((t) + 2 < NT ? 2 : 0));         \
        ATT_BAR(); \
        if ((t) + 3 < NT) ATT_ISSUE((t) + 3); \
        if (WCONV_IN_ATTN) { int c_ = 0; const int r7_ = wc.gstep % 7, bs_ = r7_ == 0 ? 0 : r7_ == 3 ? 1 : 2;     \
            if (bs_ < 2) { LAS unsigned char* wb_ = lds + WC_LDS + wid * 8192 + bs_ * 4096; int jb_ = bs_ ? wc.j1 : wc.j0; \
                if (jb_ >= 0) { wc_consume(p, gw, jb_, wb_, lane); jb_ = -1; c_ += 2; } \
                if (wc.next < WC_PER_WAVE) { asm volatile("s_waitcnt lgkmcnt(0)" ::: "memory"); wc_issue(p, gw, wc.next, lds0 + WC_LDS + wid * 8192 + bs_ * 4096, lane); jb_ = wc.next++; c_ += 4; } \
                if (bs_) wc.j1 = jb_; else wc.j0 = jb_; } \
            wc.cm2 = wc.cm1; wc.cm1 = c_; wc.gstep++; } \
        const lds_cptr kp_ = kp0 + (((t) + 1) & 3) * SLOTB; const lds_cptr vp_ = vp0 + ((t) & 3) * SLOTB; \
        bf16x8 kf[8]; s16x4 vlo[8], vhi[8]; \
        if (hn_) { _Pragma("unroll") for (int k = 0; k < 8; ++k) KFRAG(kf[k], kp_, k); } \
        SBAR(); \
        float rs_ = 0.f; v4u pw[4]; _Pragma("unroll") for (int q_ = 0; q_ < 4; ++q_) pw[q_] = (v4u){0u, 0u, 0u, 0u}; \
        _Pragma("unroll") for (int g = 0; g < 8; ++g) {             \
            if (hn_) { if (g == 0) SN0 = MF(kf[0], qr[0], zero16); else if (g == 1) SN1 = MF(kf[1], qr[0], zero16); else if (g & 1) SN1 = MF(kf[g], qr[g >> 1], SN1); else SN0 = MF(kf[g], qr[g >> 1], SN0); } \
            if (g < 4) { _Pragma("unroll") for (int e = 0; e < 4; ++e) { SC0[4 * g + e] = __builtin_amdgcn_exp2f(SC0[4 * g + e]); rs_ += SC0[4 * g + e]; } \
                         pw[g >> 1][2 * (g & 1)] = cvtpk(SC0[4 * g], SC0[4 * g + 1]); pw[g >> 1][2 * (g & 1) + 1] = cvtpk(SC0[4 * g + 2], SC0[4 * g + 3]); \
                         asm volatile("" : "+v"(SC0), "+v"(pw[g >> 1]), "+v"(rs_)); } \
            else { const int g4 = g - 4;   \
                         vlo[g4] = vtr(vp_ + g4 * 1024); vhi[g4] = vtr(vp_ + g4 * 1024 + 512); vlo[4 + g4] = vtr(vp_ + 4096 + g4 * 1024); vhi[4 + g4] = vtr(vp_ + 4096 + g4 * 1024 + 512); \
                         _Pragma("unroll") for (int e = 0; e < 4; ++e) { SC1[4 * g4 + e] = __builtin_amdgcn_exp2f(SC1[4 * g4 + e]); rs_ += SC1[4 * g4 + e]; } \
                         pw[2 + (g4 >> 1)][2 * (g4 & 1)] = cvtpk(SC1[4 * g4], SC1[4 * g4 + 1]); pw[2 + (g4 >> 1)][2 * (g4 & 1) + 1] = cvtpk(SC1[4 * g4 + 2], SC1[4 * g4 + 3]); \
                         asm volatile("" : "+v"(SC1), "+v"(pw[2 + (g4 >> 1)]), "+v"(rs_)); } \
            SBAR(); } \
        l += rs_; \
        if (hn_) { ATT_MASK(SN0, SN1, (t) + 1); if (__builtin_expect(__any(m != 0.f), 0)) { _Pragma("unroll") for (int r = 0; r < 16; ++r) { SN0[r] -= m; SN1[r] -= m; } } \
                   asm volatile("s_nop 15\n\ts_nop 7" : "+v"(SN0), "+v"(SN1)); } \
        float ma_ = -3.0e38f, mc_ = -3.0e38f; \
        _Pragma("unroll") for (int g = 0; g < 8; ++g) {             \
            const int ks = g >> 1; const bf16x8 pf = __builtin_bit_cast(bf16x8, pw[ks]); \
            if (g & 1) { const bf16x8 v1 = (bf16x8){vlo[4 + ks][0], vlo[4 + ks][1], vlo[4 + ks][2], vlo[4 + ks][3], vhi[4 + ks][0], vhi[4 + ks][1], vhi[4 + ks][2], vhi[4 + ks][3]}; o1 = MF(v1, pf, o1); } \
            else { const bf16x8 v0 = (bf16x8){vlo[ks][0], vlo[ks][1], vlo[ks][2], vlo[ks][3], vhi[ks][0], vhi[ks][1], vhi[ks][2], vhi[ks][3]}; o0 = MF(v0, pf, o0); } \
            if (hn_) { if (g < 4) { ma_ = max3f(ma_, SN0[4 * g], SN0[4 * g + 1]); mc_ = max3f(mc_, SN0[4 * g + 2], SN0[4 * g + 3]); } \
                       else { ma_ = max3f(ma_, SN1[4 * (g - 4)], SN1[4 * (g - 4) + 1]); mc_ = max3f(mc_, SN1[4 * (g - 4) + 2], SN1[4 * (g - 4) + 3]); } \
                       asm volatile("" : "+v"(ma_), "+v"(mc_)); } \
            SBAR(); } \
        if (hn_) ATT_DECIDE(SN0, SN1, max2f(ma_, mc_)); \
    } while (0)
    {
        int t = 0;
        for (; t + 2 < NT; t += 2) { ATT_STEP(sA0, sA1, sB0, sB1, t, true); ATT_STEP(sB0, sB1, sA0, sA1, t + 1, true); }
        if (t + 2 == NT) { ATT_STEP(sA0, sA1, sB0, sB1, t, true); ATT_STEP(sB0, sB1, sA0, sA1, t + 1, false); }
        else { ATT_STEP(sA0, sA1, sB0, sB1, t, false); }
    }
#undef ATT_STEP
#undef ATT_DECIDE
#undef ATT_MASK
#undef KFRAG
#undef MF
#undef SBAR
#undef ATT_TILE
#undef ATT_ISSUE
#undef ATT_WAIT
    ATT_BAR();
    float ltot = swapsum(l); if (GRP == 0) ltot += __builtin_amdgcn_exp2f(p.a_sink[h] * LOG2E - m);
    const float inv = 1.f / ltot;
    int lane_e = lane; asm volatile("" : "+v"(lane_e));
    const int r32e = lane_e & 31, hie = lane_e >> 5;
    LAS unsigned char* ost = lds + wid * OST_WAVE;
#pragma unroll
    for (int g = 0; g < 4; ++g) {
        v2u w0, w1;
        w0.x = cvtpk(o0[4 * g] * inv, o0[4 * g + 1] * inv); w0.y = cvtpk(o0[4 * g + 2] * inv, o0[4 * g + 3] * inv);
        w1.x = cvtpk(o1[4 * g] * inv, o1[4 * g + 1] * inv); w1.y = cvtpk(o1[4 * g + 2] * inv, o1[4 * g + 3] * inv);
        *(LAS v2u*)(ost + r32e * OST_PITCH + (8 * g + 4 * hie) * 2) = w0;
        *(LAS v2u*)(ost + r32e * OST_PITCH + (32 + 8 * g + 4 * hie) * 2) = w1;
    }
    asm volatile("s_waitcnt lgkmcnt(0)" ::: "memory");
    bf16* Ob = (bf16*)(p.ws + (ABL ? WS_OX : WS_O)) + ((size_t)b * T + q0w) * D + GRP * 512 + h * 64;
    float* ssq = (float*)(p.ws + (ABL ? 256 * MiB : WS_SSQ)) + ((size_t)b * T + q0w) * 16 + GRP * 8 + h;
#pragma unroll
    for (int i = 0; i < 4; ++i) {
        const int row = i * 8 + (lane_e >> 3), ch = lane_e & 7;
        const v4u v = *(const LAS v4u*)(ost + row * OST_PITCH + ch * 16);
        st16(Ob + (size_t)row * D + ch * 8, v);
        float ss = 0.f;
#pragma unroll
        for (int q = 0; q < 4; ++q) { const float a = __uint_as_float(v[q] << 16), c = __uint_as_float(v[q] & 0xffff0000u); ss += a * a + c * c; }
        ss += __shfl_xor(ss, 1); ss += __shfl_xor(ss, 2); ss += __shfl_xor(ss, 4);
        if (ch == 0) ssq[(size_t)row * 16] = ss;
    }
    asm volatile("s_waitcnt vmcnt(0) lgkmcnt(0)" ::: "memory");
    ATT_BAR();
#undef ATT_BAR
}
template <int ABL = 0>
__device__ __forceinline__ void attn_phase(const P& p, LAS unsigned char* lds, int vcu, int G) {
    if (ABL & 64) return;
    const int wid = __builtin_amdgcn_readfirstlane(threadIdx.x >> 6), lane = threadIdx.x & 63, gw = vcu * 8 + wid;
    WConv wc; wc.next = (WCONV_IN_ATTN && G * 8 == 2048 && ABL == 0) ? 0 : WC_PER_WAVE; wc.j0 = -1; wc.j1 = -1; wc.gstep = 0; wc.cm1 = 0; wc.cm2 = 0;
    for (int u = vcu; u < 512; u += G) attn_unit<1, ABL>(p, lds, (u >> 5) >> 1, (u >> 5) & 1, u & 31, wc, gw);
    for (int u = vcu; u < 512; u += G) attn_unit<0, ABL>(p, lds, (u >> 5) >> 1, (u >> 5) & 1, u & 31, wc, gw);
    if (WCONV_IN_ATTN && ABL == 0) {
        if (G * 8 == 2048) {
            if (wc.j0 >= 0) wc_consume(p, gw, wc.j0, lds + WC_LDS + wid * 8192, lane);
            if (wc.j1 >= 0) wc_consume(p, gw, wc.j1, lds + WC_LDS + wid * 8192 + 4096, lane);
            for (; wc.next < WC_PER_WAVE; ++wc.next) { asm volatile("s_waitcnt lgkmcnt(0)" ::: "memory"); wc_issue(p, gw, wc.next, (unsigned)(uintptr_t)lds + WC_LDS + wid * 8192, lane);
                asm volatile("s_waitcnt vmcnt(0)" ::: "memory"); wc_consume(p, gw, wc.next, lds + WC_LDS + wid * 8192, lane); }
        } else {
            for (int hx = gw; hx < 49152; hx += G * 8) { asm volatile("s_waitcnt lgkmcnt(0)" ::: "memory"); wc_issue(p, hx & 2047, hx >> 11, (unsigned)(uintptr_t)lds + WC_LDS + wid * 8192, lane);
                asm volatile("s_waitcnt vmcnt(0)" ::: "memory"); wc_consume(p, hx & 2047, hx >> 11, lds + WC_LDS + wid * 8192, lane); }
        }
    }
}
}

struct Frame {
    LAS unsigned char* lds;
    volatile LAS unsigned* MISC;
    int tid, lane, wave, vcu, G;
};

__device__ __forceinline__ void p0_transpose_item(const float* W, int N, bf16* WT, int dpitch, int drow0, int k0, int n0, LAS float* scr, int lane, const float* gain) {
#pragma unroll
    for (int i = 0; i < 32; ++i) { const int kk = 2 * i + (lane >> 5); float v = W[(size_t)(k0 + kk) * N + n0 + (lane & 31)]; if (gain) v *= gain[kk]; scr[kk * 33 + (lane & 31)] = v; }
    LDS_WAIT(); asm volatile("" ::: "memory");
    const int c = lane & 7;
#pragma unroll
    for (int j = 0; j < 4; ++j) { const int n = (lane >> 3) + 8 * j; const LAS float* s = scr + (8 * c) * 33 + n;
        v4u o; o.x = pk2(s[0 * 33], s[1 * 33]); o.y = pk2(s[2 * 33], s[3 * 33]); o.z = pk2(s[4 * 33], s[5 * 33]); o.w = pk2(s[6 * 33], s[7 * 33]);
        *(GAS v4u*)(WT + (size_t)(drow0 + n) * dpitch + k0 + 8 * c) = o; }
    LDS_WAIT(); asm volatile("" ::: "memory");
}
__device__ __forceinline__ void p0_prologue(const P& p, Frame& F) {
    float* modx = (float*)(p.ws + WS_MODX);
    if (F.vcu < 96) {
        LAS float* s = (LAS float*)F.lds;
        LAS float* part = (LAS float*)(F.lds + 40960);
        for (int i = F.tid; i < 9 * D; i += NTHR) { const int r = i >> 10, k = i & 1023; const float v = r < 8 ? p.c[r * D + k] : p.c_ctx[k]; s[i] = silu_f(v); }
        __syncthreads();
        const int n = F.vcu * 64 + F.lane; float acc[9];
#pragma unroll
        for (int r = 0; r < 9; ++r) acc[r] = 0.f;
        const float* wp = p.w_mod + (size_t)(F.wave * 128) * 6144 + n;
#pragma unroll 4
        for (int k4 = 0; k4 < 128; k4 += 4) {
            float wv[4];
#pragma unroll
            for (int j = 0; j < 4; ++j) wv[j] = wp[(size_t)(k4 + j) * 6144];
#pragma unroll
            for (int r = 0; r < 9; ++r) { const f32x4 sv = *(const LAS f32x4*)(s + r * D + F.wave * 128 + k4); acc[r] += sv.x * wv[0]; acc[r] += sv.y * wv[1]; acc[r] += sv.z * wv[2]; acc[r] += sv.w * wv[3]; }
        }
#pragma unroll
        for (int r = 0; r < 9; ++r) part[(F.wave * 9 + r) * 64 + F.lane] = acc[r];
        __syncthreads();
        for (int i = F.tid; i < 9 * 64; i += NTHR) { const int r = i >> 6, l = i & 63; float sum = 0.f;
#pragma unroll
            for (int w = 0; w < 8; ++w) sum += part[(w * 9 + r) * 64 + l];
            modx[r * 6144 + F.vcu * 64 + l] = sum + p.b_mod[F.vcu * 64 + l]; }
        __syncthreads();
    }
    if (F.vcu == 96) {
        float2* tab = (float2*)(p.ws + WS_ROPE);
        for (int idx = F.tid; idx < 96 * 16; idx += NTHR) {
            const int pos = idx >> 4, i = idx & 15;
            const float invf = exp2f(-(float)i * (13.287712379549449f / 16.f));
            const float pv = (float)(pos < 32 ? pos : pos - 32);
            float rev = pv * invf * 0.15915494309189535f; rev -= rintf(rev);
            tab[idx] = make_float2(__builtin_amdgcn_cosf(rev), __builtin_amdgcn_sinf(rev));
        }
    }
    for (int nb = F.vcu - 97; nb >= 0 && nb < 48; nb += F.G) {
        bf16* wr = (bf16*)(p.ws + WS_WR);
        for (int i = nb * 1024 + F.tid; i < (nb + 1) * 1024; i += NTHR) {
            const int j = i & 7, ln = (i >> 3) & 63, q = i >> 9, nt = q % 3, ks = q / 3;
            const int k = 32 * ks + 8 * (ln >> 4) + j, n = 16 * nt + (ln & 15);
            const float w = n < 4 ? p.w_group[k * 4 + n] : n < 36 ? p.w_router[k * 32 + (n - 4)] : 0.f;
            const unsigned hi = f2bf(w); const unsigned lo = f2bf(w - bf2f((bf16)hi));
            wr[i] = (bf16)hi; wr[48 * D + i] = (bf16)lo; }
    }
    LAS float* scr = (LAS float*)(F.lds + F.wave * 16384);
    const int gw = F.vcu * NWAVES + F.wave, NGW = F.G * NWAVES;
    constexpr int I_IN = 16 * 48, I_OUT = 16 * 32, I_G = 32 * 256, I_D = 32 * 256, NITEMS = WCONV_IN_ATTN ? I_IN + I_OUT : I_IN + I_OUT + 2 * I_G + I_D;
    for (int it = gw; it < NITEMS; it += NGW) {
        int r = it;
        if (r < I_IN) { const int kb = r / 48, nb = r % 48; p0_transpose_item(p.w_in, NQKV, (bf16*)(p.ws + WS_WQKV), D, qkv_row(nb * 32), kb * 64, nb * 32, scr, F.lane, nullptr); continue; } r -= I_IN;
        if (r < I_OUT) { const int kb = r / 32, nb = r % 32; const float* g = kb < 8 ? p.aon + kb * 64 : p.bon + (kb - 8) * 64;
            p0_transpose_item(p.w_out, D, (bf16*)(p.ws + WS_WO), D, nb * 32, kb * 64, nb * 32, scr, F.lane, g); continue; } r -= I_OUT;
        if (r < 2 * I_G) { const int up = r >= I_G; if (up) r -= I_G; const int e = r >> 8, q = r & 255, kb = q >> 4, nb = q & 15; const int j0 = nb * 32;
            p0_transpose_item((up ? p.w_up : p.w_gate) + (size_t)e * 1024 * 512, 512, (bf16*)(p.ws + WS_WGU) + (size_t)e * 1024 * 1024, D, (j0 >> 7) * 256 + up * 128 + (j0 & 127), kb * 64, j0, scr, F.lane, nullptr); continue; } r -= 2 * I_G;
        { const int e = r >> 8, q = r & 255, kb = q >> 5, nb = q & 31;
            p0_transpose_item(p.w_down + (size_t)e * 512 * 1024, D, (bf16*)(p.ws + WS_WD) + (size_t)e * 1024 * 512, EFF, nb * 32, kb * 64, nb * 32, scr, F.lane, nullptr); }
    }
}
__device__ __forceinline__ void p1_norm(const P& p, Frame& F) {
    const int gw = F.vcu * NWAVES + F.wave, NGW = F.G * NWAVES;
    const float* modall = (const float*)(p.ws + WS_MODX);
    for (int r = gw; r < MT; r += NGW) {
        const float* src = r < ML ? p.x + (size_t)r * D : p.ctx + (size_t)(r - ML) * D;
        const float* modx = modall + (r < ML ? (r / T) : 8) * 6144;
        const GAS f32x4* xr = (const GAS f32x4*)src + F.lane;
        f32x4 v[4]; float s = 0.f;
#pragma unroll
        for (int j = 0; j < 4; ++j) { v[j] = xr[64 * j]; s += (v[j].x * v[j].x + v[j].y * v[j].y) + (v[j].z * v[j].z + v[j].w * v[j].w); }
        const float rn = rsqrtf(wave_sum(s) * (1.f / D) + EPS);
        GAS v2u* o8 = (GAS v2u*)((bf16*)(p.ws + WS_XN) + (size_t)r * D) + F.lane;
#pragma unroll
        for (int j = 0; j < 4; ++j) { const int k = 4 * (F.lane + 64 * j);
            const f32x4 g = *(const f32x4*)(p.pre1 + k), sc = *(const f32x4*)(modx + 1024 + k), sh = *(const f32x4*)(modx + k);
            const f32x4 h = v[j] * rn * g * (sc + 1.f) + sh;
            v2u w; w.x = pk2(h.x, h.y); w.y = pk2(h.z, h.w); st8((void*)(o8 + 64 * j), w); }
    }
}


constexpr int LDS_X = 147456;
__device__ __forceinline__ void p4_outproj(const P& p, Frame& F) {
    LAS float* tab = (LAS float*)(F.lds + LDS_X);
    for (int i = 0;; ++i) {
        const int L = i * F.G + (int)blockIdx.x; if (L >= 256) break;
        const int xcd = L & 7, off = L >> 3, w = xcd * 32 + off;
        pg8::Unit u; u.pm = (w >> 5) * 8 + (w & 7); u.pn = (w & 31) >> 3;
        if (F.tid < 256) {
            const f32x4* s4 = (const f32x4*)((const float*)(p.ws + WS_SSQ) + (size_t)(u.pm * 256 + F.tid) * 16);
            const f32x4 a0 = s4[0], a1 = s4[1], b0 = s4[2], b1 = s4[3];
            const float sa = ((a0.x + a0.y) + (a0.z + a0.w)) + ((a1.x + a1.y) + (a1.z + a1.w)), sb = ((b0.x + b0.y) + (b0.z + b0.w)) + ((b1.x + b1.y) + (b1.z + b1.w));
            const float ra = rsqrtf(sa * (1.f / 512.f) + EPS), rb = rsqrtf(sb * (1.f / 512.f) + EPS);
            tab[2 * F.tid] = ra / rb; tab[2 * F.tid + 1] = rb;
        }
        __syncthreads();
        pg8::Gemm g{(const pg8::bf16_t*)(p.ws + WS_O), (const pg8::bf16_t*)(p.ws + WS_WO), ML, D, D};
        pg8::SchedOne S{u};
        pg8::EpiOut E{(bf16*)(p.ws + WS_OX), tab};
        pg8::gemm_phase<pg8::EpiOut, pg8::SchedOne, false, true, false>((PG8_LAS unsigned char*)F.lds, g, S, E);
    }
}
constexpr int P5_PITCH = 2064;
constexpr int P5_PART = 64 * P5_PITCH, P5_LG = 0;
static_assert(P5_PART + 8 * 16 * 48 * 4 <= MISC_OFF && 64 * 48 * 4 <= P5_PART, "P5 LDS map");
__device__ __forceinline__ void p5_rowpass(const P& p, Frame& F, int abl = 0) {
    LAS unsigned char* LO = F.lds;
    LAS float* PART = (LAS float*)(F.lds + P5_PART); LAS float* LG = (LAS float*)(F.lds + P5_LG);
    LAS int* hist = (LAS int*)(F.lds + MISC_OFF) + 64;
    const bf16* WRh = (const bf16*)(p.ws + WS_WR); const bf16* WRl = WRh + 48 * D;
    for (int rb = F.vcu; rb < ML / 64; rb += F.G) {
        if (F.tid < 32) hist[F.tid] = 0;
        const int b = (rb * 64) / T;
        const float* modx = (const float*)(p.ws + WS_MODX) + b * 6144;
        if (!(abl & 2)) {
            f32x4 gp[4], mp[4], ap[4];
#pragma unroll
            for (int j = 0; j < 4; ++j) { const int k = 256 * j + 4 * F.lane;
                gp[j] = *(const f32x4*)(modx + 2048 + k) * *(const f32x4*)(p.post1 + k);
                mp[j] = *(const f32x4*)(p.pre2 + k) * (*(const f32x4*)(modx + 4096 + k) + 1.f);
                ap[j] = *(const f32x4*)(modx + 3072 + k); }
            f32x4 xn[4]; v2u on[4];
#define P5_LOAD(rw) do { _Pragma("unroll") for (int j = 0; j < 4; ++j) { xn[j] = *(const f32x4*)(p.x + (size_t)(rw) * D + 256 * j + 4 * F.lane); \
                on[j] = *(const v2u*)((const bf16*)(p.ws + WS_OX) + (size_t)(rw) * D + 256 * j + 4 * F.lane); } } while (0)
            P5_LOAD(rb * 64 + F.wave * 8);
            for (int rr = 0; rr < 8; ++rr) {
                const int rl = F.wave * 8 + rr, row = rb * 64 + rl;
                f32x4 xv[4], ox[4]; v2u oc[4]; float ss = 0.f;
#pragma unroll
                for (int j = 0; j < 4; ++j) { xv[j] = xn[j]; oc[j] = on[j]; }
                if (rr + 1 < 8) P5_LOAD(row + 1);
#pragma unroll
                for (int j = 0; j < 4; ++j) { const v2u o2 = oc[j];
                    ox[j] = (f32x4){__uint_as_float(o2.x << 16), __uint_as_float(o2.x & 0xffff0000u), __uint_as_float(o2.y << 16), __uint_as_float(o2.y & 0xffff0000u)};
                    ss += (ox[j].x * ox[j].x + ox[j].y * ox[j].y) + (ox[j].z * ox[j].z + ox[j].w * ox[j].w); }
                const float r1 = rsqrtf(wave_sum(ss) * (1.f / D) + EPS);
                float ss2 = 0.f;
#pragma unroll
                for (int j = 0; j < 4; ++j) { xv[j] = xv[j] + gp[j] * (ox[j] * r1);
                    ss2 += (xv[j].x * xv[j].x + xv[j].y * xv[j].y) + (xv[j].z * xv[j].z + xv[j].w * xv[j].w); }
                const float r2 = rsqrtf(wave_sum(ss2) * (1.f / D) + EPS);
                if (F.lane == 0) ((float*)(p.ws + WS_R1))[row] = r1;
#pragma unroll
                for (int j = 0; j < 4; ++j) {
                    const f32x4 h = xv[j] * r2 * mp[j] + ap[j];
                    v2u wh; wh.x = att::cvtpk(h.x, h.y); wh.y = att::cvtpk(h.z, h.w);
                    const f32x4 hb = (f32x4){__uint_as_float(wh.x << 16), __uint_as_float(wh.x & 0xffff0000u), __uint_as_float(wh.y << 16), __uint_as_float(wh.y & 0xffff0000u)};
                    const f32x4 dl = h - hb;
                    v2u wl; wl.x = att::cvtpk(dl.x, dl.y); wl.y = att::cvtpk(dl.z, dl.w);
                    st8((bf16*)(p.ws + WS_XN) + (size_t)row * D + 256 * j + 4 * F.lane, wh);
                    *(LAS v2u*)(LO + rl * P5_PITCH + (256 * j + 4 * F.lane) * 2) = wl;
                }
            }
#undef P5_LOAD
        }
        asm volatile("s_waitcnt vmcnt(0)" ::: "memory");
        __syncthreads();
        if (F.tid == 0) { __builtin_amdgcn_fence(__ATOMIC_ACQUIRE, "agent"); asm volatile("s_waitcnt vmcnt(0)" ::: "memory"); }
        __syncthreads();
        if (abl & 1) continue;
        {
            const int gI = F.wave >> 1, kq = F.wave & 1, r16 = F.lane & 15, g4 = F.lane >> 4;
            f32x4 acc[3];
#pragma unroll
            for (int nt = 0; nt < 3; ++nt) acc[nt] = (f32x4){0.f, 0.f, 0.f, 0.f};
            const bf16* ah = (const bf16*)(p.ws + WS_XN) + (size_t)(rb * 64 + 16 * gI + r16) * D + 512 * kq + 8 * g4;
            const LAS unsigned char* al = LO + (16 * gI + r16) * P5_PITCH + (512 * kq + 8 * g4) * 2;
            const bf16* bh = WRh + (size_t)(16 * kq) * 3 * 512 + F.lane * 8; const bf16* bl = WRl + (size_t)(16 * kq) * 3 * 512 + F.lane * 8;
#pragma unroll 8
            for (int ks = 0; ks < 16; ++ks) {
                const bf16x8 a_hi = *(const bf16x8*)(ah + ks * 32), a_lo = *(const LAS bf16x8*)(al + ks * 64);
#pragma unroll
                for (int nt = 0; nt < 3; ++nt) {
                    const bf16x8 b_hi = *(const bf16x8*)(bh + (ks * 3 + nt) * 512), b_lo = *(const bf16x8*)(bl + (ks * 3 + nt) * 512);
                    acc[nt] = __builtin_amdgcn_mfma_f32_16x16x32_bf16(a_hi, b_hi, acc[nt], 0, 0, 0);
                    acc[nt] = __builtin_amdgcn_mfma_f32_16x16x32_bf16(a_hi, b_lo, acc[nt], 0, 0, 0);
                    acc[nt] = __builtin_amdgcn_mfma_f32_16x16x32_bf16(a_lo, b_hi, acc[nt], 0, 0, 0);
                }
            }
#pragma unroll
            for (int nt = 0; nt < 3; ++nt)
#pragma unroll
                for (int q = 0; q < 4; ++q) PART[(F.wave * 16 + 4 * g4 + q) * 48 + 16 * nt + r16] = acc[nt][q];
        }
        __syncthreads();
        for (int i = F.tid; i < 64 * 48; i += NTHR) { const int row = i / 48, n = i - row * 48, gI = row >> 4, r16 = row & 15;
            LG[i] = (PART[((gI * 2 + 0) * 16 + r16) * 48 + n] + PART[((gI * 2 + 1) * 16 + r16) * 48 + n]) + (n < 4 ? p.b_group[n] : n < 36 ? p.b_router[n - 4] : 0.f); }
        __syncthreads();
        if (F.tid < 64) {
            float lg[36];
#pragma unroll
            for (int c = 0; c < 36; ++c) lg[c] = LG[F.tid * 48 + c];
            int e1, e2; float w1, w2;
            {
                int g = 0; float gm = lg[0];
#pragma unroll
                for (int q = 1; q < 4; ++q) if (lg[q] > gm) { gm = lg[q]; g = q; }
                float gs = 0.f;
#pragma unroll
                for (int q = 0; q < 4; ++q) gs += __expf(lg[q] - gm);
                const float gw = 1.f / gs;
                float el[8];
#pragma unroll
                for (int q = 0; q < 8; ++q) el[q] = g == 0 ? lg[4 + q] : g == 1 ? lg[12 + q] : g == 2 ? lg[20 + q] : lg[28 + q];
                int i1 = 0; float m1 = el[0];
#pragma unroll
                for (int q = 1; q < 8; ++q) if (el[q] > m1) { m1 = el[q]; i1 = q; }
                int i2 = -1; float m2 = -3.0e38f;
#pragma unroll
                for (int q = 0; q < 8; ++q) if (q != i1 && el[q] > m2) { m2 = el[q]; i2 = q; }
                const float ex = __expf(m2 - m1);
                w1 = gw / (1.f + ex); w2 = gw * ex / (1.f + ex); e1 = g * 8 + i1; e2 = g * 8 + i2;
            }
            const int row = rb * 64 + F.tid;
            if (!(abl & 2)) { int* te = (int*)(p.ws + WS_TOKE) + row * 2; float* tw = (float*)(p.ws + WS_TOKW) + row * 2; te[0] = e1; te[1] = e2; tw[0] = w1; tw[1] = w2; }
            atomicAdd((int*)&hist[e1 & 31], 1); atomicAdd((int*)&hist[e2 & 31], 1);
        }
        __syncthreads();
        if (F.tid < 32 && !(abl & 2)) ((int*)(p.ws + WS_BLKCNT))[rb * 32 + F.tid] = hist[F.tid];
        __syncthreads();
    }
}
__device__ __forceinline__ void p6_lists(const P& p, Frame& F) {
    LAS int* ps = (LAS int*)F.lds;
    LAS int* pp = ps + 512;
    LAS int* tot = pp + 512; LAS int* pre = tot + 32; LAS int* ebase = pre + 32;
    LAS int* es = ebase + 40;
    const int* blk = (const int*)(p.ws + WS_BLKCNT);
    int* meta = (int*)(p.ws + WS_META);
    for (int rb = F.vcu; rb < ML / 64; rb += F.G) {
        { const int e = F.tid & 31, part = F.tid >> 5; int s = 0, q = 0;
#pragma unroll 4
          for (int j = 0; j < 16; ++j) { const int bb = part * 16 + j; const int v = blk[bb * 32 + e]; s += v; q += bb < rb ? v : 0; }
          ps[part * 32 + e] = s; pp[part * 32 + e] = q; }
        __syncthreads();
        if (F.tid < 32) { int s = 0, q = 0;
#pragma unroll
            for (int part = 0; part < 16; ++part) { s += ps[part * 32 + F.tid]; q += pp[part * 32 + F.tid]; }
            tot[F.tid] = s; pre[F.tid] = q; }
        __syncthreads();
        if (F.tid == 0) { int tb = 0; for (int e = 0; e < 32; ++e) { ebase[e] = tb; tb += (tot[e] + 255) >> 8; } ebase[32] = tb; }
        if (F.tid < 128) es[F.tid] = ((const int*)(p.ws + WS_TOKE))[rb * 128 + F.tid];
        __syncthreads();
        if (F.tid < 128) {
            const int e = es[F.tid]; int rank = 0;
            for (int a = 0; a < F.tid; ++a) rank += es[a] == e ? 1 : 0;
            const int pos = ebase[e] * 256 + pre[e] + rank;
            ((int*)(p.ws + WS_ROWIDX))[pos] = rb * 64 + (F.tid >> 1);
            ((float*)(p.ws + WS_ROWW))[pos] = ((const float*)(p.ws + WS_TOKW))[rb * 128 + F.tid];
            ((int*)(p.ws + WS_TOKPOS))[rb * 128 + F.tid] = pos;
        }
        if (rb < 32) {
            const int e = rb, lo = ebase[e] * 256 + tot[e], hi = ebase[e + 1] * 256;
            for (int pos = lo + F.tid; pos < hi; pos += NTHR) { ((int*)(p.ws + WS_ROWIDX))[pos] = 0; ((float*)(p.ws + WS_ROWW))[pos] = 0.f; }
            for (int t = ebase[e] + F.tid; t < ebase[e + 1]; t += NTHR) meta[128 + t] = e;
            if (F.tid == 0) { meta[e] = tot[e]; meta[64 + e] = ebase[e]; if (e == 31) { meta[64 + 32] = ebase[32]; meta[320] = ebase[32]; } }
        }
        __syncthreads();
    }
}
__device__ __forceinline__ void p78_moe(const P& p, Frame& F, bool down) {
    LAS int* tile_e = (LAS int*)(F.lds + LDS_X);
    const int* meta = (const int*)(p.ws + WS_META);
    for (int t = F.tid; t < MAXTILES; t += NTHR) tile_e[t] = meta[128 + t] & 31;
    __syncthreads();
    const int ntiles = meta[320];
    pg8::SchedMoE S{F.G, (int)blockIdx.x, ntiles * 4, tile_e, (const int*)(p.ws + WS_ROWIDX)};
    if (!down) {
        pg8::Gemm g{(const pg8::bf16_t*)(p.ws + WS_XN), (const pg8::bf16_t*)(p.ws + WS_WGU), MAXPOS, NE * 1024, D};
        pg8::EpiGU E{(bf16*)(p.ws + WS_ACT), (const float*)(p.ws + WS_ROWW)};
        pg8::gemm_phase<pg8::EpiGU, pg8::SchedMoE, true, true, true>((PG8_LAS unsigned char*)F.lds, g, S, E);
    } else {
        pg8::Gemm g{(const pg8::bf16_t*)(p.ws + WS_ACT), (const pg8::bf16_t*)(p.ws + WS_WD), MAXPOS, NE * 1024, EFF};
        pg8::EpiY E{(bf16*)(p.ws + WS_Y)};
        pg8::gemm_phase<pg8::EpiY, pg8::SchedMoE, true, true, false>((PG8_LAS unsigned char*)F.lds, g, S, E);
    }
}
__device__ __forceinline__ void p9_final(const P& p, Frame& F, float* dst) {
    const bf16* Y = (const bf16*)(p.ws + WS_Y); const bf16* OX = (const bf16*)(p.ws + WS_OX); const float* R1 = (const float*)(p.ws + WS_R1);
    for (int rb = F.vcu; rb < ML / 64; rb += F.G) {
        const int b = (rb * 64) / T;
        const float* modx = (const float*)(p.ws + WS_MODX) + b * 6144;
        const int row0 = rb * 64 + F.wave * 8;
        f32x4 gp[4], g1p[4];
#pragma unroll
        for (int j = 0; j < 4; ++j) { const int k = 256 * j + 4 * F.lane; gp[j] = *(const f32x4*)(modx + 5120 + k) * *(const f32x4*)(p.post2 + k); g1p[j] = *(const f32x4*)(modx + 2048 + k) * *(const f32x4*)(p.post1 + k); }
        v2u ya[2][4], yc[2][4], oo[2][4]; f32x4 xo[2][4]; float r1v[2];
        const int* tpp = (const int*)(p.ws + WS_TOKPOS) + row0 * 2;
#define P9_LOAD(buf, rw, t2) do { r1v[buf] = R1[rw]; _Pragma("unroll") for (int j = 0; j < 4; ++j) { \
            ya[buf][j] = *(const v2u*)(Y + (size_t)(t2).x * D + 256 * j + 4 * F.lane); yc[buf][j] = *(const v2u*)(Y + (size_t)(t2).y * D + 256 * j + 4 * F.lane); \
            oo[buf][j] = *(const v2u*)(OX + (size_t)(rw) * D + 256 * j + 4 * F.lane); xo[buf][j] = *(const f32x4*)(p.x + (size_t)(rw) * D + 256 * j + 4 * F.lane); } } while (0)
#define P9_COMP(buf, rw) do { f32x4 y[4]; float ss = 0.f; \
            _Pragma("unroll") for (int j = 0; j < 4; ++j) { const v2u a = ya[buf][j], c = yc[buf][j]; \
                y[j] = (f32x4){__uint_as_float(a.x << 16) + __uint_as_float(c.x << 16), __uint_as_float(a.x & 0xffff0000u) + __uint_as_float(c.x & 0xffff0000u), \
                               __uint_as_float(a.y << 16) + __uint_as_float(c.y << 16), __uint_as_float(a.y & 0xffff0000u) + __uint_as_float(c.y & 0xffff0000u)}; \
                ss += (y[j].x * y[j].x + y[j].y * y[j].y) + (y[j].z * y[j].z + y[j].w * y[j].w); } \
            const float rn = rsqrtf(wave_sum(ss) * (1.f / D) + EPS); \
            _Pragma("unroll") for (int j = 0; j < 4; ++j) { const v2u o2 = oo[buf][j]; \
                const f32x4 oxv = (f32x4){__uint_as_float(o2.x << 16), __uint_as_float(o2.x & 0xffff0000u), __uint_as_float(o2.y << 16), __uint_as_float(o2.y & 0xffff0000u)}; \
                const f32x4 x1 = xo[buf][j] + g1p[j] * (oxv * r1v[buf]);                   \
                *(f32x4*)(dst + (size_t)(rw) * D + 256 * j + 4 * F.lane) = x1 + gp[j] * (y[j] * rn); } } while (0)
        int2 tpA = *(const int2*)(tpp), tpB = *(const int2*)(tpp + 2);
        P9_LOAD(0, row0, tpA);
#pragma unroll 1
        for (int rp = 0; rp < 4; ++rp) {
            const int ra = row0 + 2 * rp;
            P9_LOAD(1, ra + 1, tpB);
            int2 tpA2 = tpA, tpB2 = tpB;
            if (rp < 3) { tpA2 = *(const int2*)(tpp + 4 * rp + 4); tpB2 = *(const int2*)(tpp + 4 * rp + 6); }
            P9_COMP(0, ra);
            if (rp < 3) P9_LOAD(0, ra + 2, tpA2);
            P9_COMP(1, ra + 1);
            tpA = tpA2; tpB = tpB2;
        }
#undef P9_COMP
#undef P9_LOAD
    }
}

struct Args { P p; int ph_lo, ph_hi, li, pad; };
__global__ void __launch_bounds__(NTHR, 2) mega(Args args) {
    extern __shared__ __attribute__((aligned(16))) unsigned char lds_raw[];
    Frame F;
    F.lds = (LAS unsigned char*)lds_raw;
    F.MISC = (volatile LAS unsigned*)(F.lds + MISC_OFF);
    F.tid = threadIdx.x; F.lane = F.tid & 63; F.wave = __builtin_amdgcn_readfirstlane(F.tid >> 6);
    F.G = gridDim.x; { const int bx = blockIdx.x; F.vcu = (F.G % 8 == 0) ? (bx % 8) * (F.G / 8) + bx / 8 : bx; }
    const P& p = args.p;
    unsigned* ctl = (unsigned*)(p.ws + WS_CTL);
    for (int u = F.tid; u < (LDS_BYTES - MISC_OFF) / 4; u += NTHR) ((LAS unsigned*)(F.lds + MISC_OFF))[u] = 0u;
    __syncthreads();
    const int lo = args.ph_lo, hi = args.ph_hi;
    XcdBarrier bar; bar.bar = ctl + CW_BAR + args.li * XCD_BAR_WORDS; bar.x = 0; bar.st = nullptr;
    if (hi - lo > 1) bar = xcd_barrier_post(ctl + CW_BAR + args.li * XCD_BAR_WORDS, F.MISC + 8);
#define IN(k) (lo <= (k) && (k) < hi)
#define SEAM(k) do { if (IN(k) && IN((k) + 1)) xcd_barrier(bar); } while (0)
    if (IN(0)) { p0_prologue(p, F); SEAM(0); }
    if (IN(1)) { p1_norm(p, F); SEAM(1); }
    if (IN(2)) {
        pg8::Gemm g{(const pg8::bf16_t*)(p.ws + WS_XN), (const pg8::bf16_t*)(p.ws + WS_WQKV), MT, NQKV, D};
        pg8::SchedQKV S{F.G, (int)blockIdx.x};
        pg8::EpiQKV E{p.ws, p.bqn, p.bkn};
        pg8::gemm_phase<pg8::EpiQKV, pg8::SchedQKV, true, true, false>((PG8_LAS unsigned char*)F.lds, g, S, E);
        SEAM(2);
    }
#ifdef PROBE_ABL
    if (IN(3) && args.pad) { att::attn_phase<PROBE_ABL>(p, F.lds, F.vcu, F.G); } else
#endif
    if (IN(3)) { att::attn_phase<0>(p, F.lds, F.vcu, F.G); SEAM(3); }
    if (IN(4)) { p4_outproj(p, F); SEAM(4); }
#ifdef PROBE_ABL5
    if (IN(5) && args.pad) { p5_rowpass(p, F, PROBE_ABL5); } else
#endif
    if (IN(5)) { p5_rowpass(p, F); SEAM(5); }
    if (IN(6)) { p6_lists(p, F); SEAM(6); }
    if (IN(7)) { p78_moe(p, F, false); SEAM(7); }
    if (IN(8)) { p78_moe(p, F, true); SEAM(8); }
    if (IN(9)) { p9_final(p, F, args.pad ? (float*)(p.ws + WS_WGU) : p.out); }
#undef IN
#undef SEAM
}

#ifndef ONE_LAUNCH
#define ONE_LAUNCH 1
#endif
#ifndef FAST_MASK
#define FAST_MASK 0x3ff
#endif
static void launch_mega(const P& p, int lo, int hi, int li, int grid, hipStream_t stream) {
    Args a{}; a.p = p; a.ph_lo = lo; a.ph_hi = hi; a.li = li; a.pad = 0;
    hipLaunchKernelGGL(mega, dim3(grid), dim3(NTHR), LDS_BYTES, stream, a);
}
extern "C" void kernel_launch(void* const* d_in, const int* in_sizes, int n_in, void* d_out, int out_size, void* d_ws, size_t ws_size, hipStream_t stream) {
    static int grid = 0;
    if (grid == 0) {
        if (n_in != 24 || out_size != ML * D || ws_size < WS_END) { fprintf(stderr, "kernel_launch: unexpected shapes (n_in %d out %d ws %zu)\n", n_in, out_size, ws_size); grid = -1; return; }
        int dev = 0, cus = 0, per_cu = 0;
        if (hipGetDevice(&dev) != hipSuccess || hipDeviceGetAttribute(&cus, hipDeviceAttributeMultiprocessorCount, dev) != hipSuccess) { grid = -1; return; }
        if (hipFuncSetAttribute((const void*)mega, hipFuncAttributeMaxDynamicSharedMemorySize, LDS_BYTES) != hipSuccess) { fprintf(stderr, "kernel_launch: hipFuncSetAttribute failed\n"); grid = -1; return; }
        if (hipOccupancyMaxActiveBlocksPerMultiprocessor(&per_cu, (const void*)mega, NTHR, LDS_BYTES) != hipSuccess || per_cu < 1) { fprintf(stderr, "kernel_launch: occupancy query says %d blocks/CU\n", per_cu); (void)hipGetLastError(); grid = -1; return; }
        grid = cus;
    }
    if (grid < 0) return;
    P p{};
    const float** f = (const float**)&p;
    for (int i = 0; i < 24; ++i) f[i] = (const float*)d_in[i];
    p.out = (float*)d_out; p.ws = (unsigned char*)d_ws;
    (void)hipMemsetAsync((char*)d_ws + WS_CTL, 0, 1 * MiB, stream);
#if ONE_LAUNCH
    launch_mega(p, 0, 10, 0, grid, stream);
#else
    for (int k = 0; k < 10; ++k) {
        launch_mega(p, k, k + 1, 0, grid, stream);
#ifdef PROBE_DUP
        if (k == PROBE_DUP) for (int r_ = 0; r_ < 3; ++r_) { Args a{}; a.p = p; a.ph_lo = k; a.ph_hi = k + 1; a.li = 0; a.pad = 1; hipLaunchKernelGGL(mega, dim3(grid), dim3(NTHR), LDS_BYTES, stream, a); }
#endif
    }
#endif
}
```

```cpp
#include <hip/hip_runtime.h>
#include <cstdio>
#include <cstdint>
#ifndef WCONV_IN_ATTN
#define WCONV_IN_ATTN 1
#endif

constexpr int NB = 8, T = 2048, D = 1024, CL = 256;
constexpr int ML = NB * T;
constexpr int MC = NB * CL;
constexpr int MT = ML + MC;
constexpr int NKEY = T + CL;
constexpr int NTILE = NKEY / 64;
constexpr int NQKV = 1536;
constexpr int NE = 32, EFF = 512;
constexpr int MAXPOS = 40960;
constexpr int MAXTILES = MAXPOS / 256;
constexpr float EPS = 1e-6f;
constexpr float LOG2E = 1.4426950408889634f;
constexpr float C2 = 0.125f * LOG2E;

typedef unsigned short bf16;

constexpr size_t MiB = 1u << 20;
constexpr size_t WS_CTL = 0;
constexpr size_t WS_MODX = 1 * MiB;
constexpr size_t WS_ROPE = 1 * MiB + 512 * 1024;
constexpr size_t WS_WR = 1 * MiB + 768 * 1024;
constexpr size_t WS_TOKE = 2 * MiB;
constexpr size_t WS_TOKW = WS_TOKE + 128 * 1024;
constexpr size_t WS_TOKPOS = WS_TOKW + 128 * 1024;
constexpr size_t WS_ROWIDX = WS_TOKPOS + 128 * 1024;
constexpr size_t WS_ROWW = WS_ROWIDX + 160 * 1024;
constexpr size_t WS_BLKCNT = WS_ROWW + 160 * 1024;
constexpr size_t WS_META = WS_BLKCNT + 32 * 1024;
constexpr size_t WS_WQKV = 4 * MiB;
constexpr size_t WS_WO = 7 * MiB;
constexpr size_t WS_WGU = 9 * MiB;
constexpr size_t WS_WD = 73 * MiB;
constexpr size_t WS_XN = 105 * MiB;
constexpr size_t WS_QA = 141 * MiB;
constexpr size_t WS_QB = 157 * MiB;
constexpr size_t WS_KA = 173 * MiB;
constexpr size_t WS_VA = WS_KA + 4608 * 1024;
constexpr size_t WS_KB = WS_VA + 4608 * 1024;
constexpr size_t WS_VB = WS_KB + 4608 * 1024;
constexpr size_t WS_O = 191 * MiB;
constexpr size_t WS_SSQ = 223 * MiB;
constexpr size_t WS_OX = 261 * MiB;
constexpr size_t WS_R1 = 293 * MiB;
constexpr size_t WS_ACT = 141 * MiB;
constexpr size_t WS_Y = 181 * MiB;
constexpr size_t WS_END = 294 * MiB;

__device__ __forceinline__ unsigned f2bf(float f) { unsigned u = __builtin_bit_cast(unsigned, f); return (u + 0x7fffu + ((u >> 16) & 1u)) >> 16; }
__device__ __forceinline__ float bf2f(bf16 h) { return __builtin_bit_cast(float, (unsigned)h << 16); }
__device__ __forceinline__ float wave_sum(float v) {
#pragma unroll
    for (int o = 1; o < 64; o <<= 1) v += __shfl_xor(v, o);
    return v;
}
__device__ __forceinline__ float wave_max(float v) {
#pragma unroll
    for (int o = 1; o < 64; o <<= 1) v = fmaxf(v, __shfl_xor(v, o));
    return v;
}
__device__ __forceinline__ float silu_f(float v) { return v / (1.f + __expf(-v)); }

__host__ __device__ __forceinline__ int qkv_row(int n) { const int pn = n >> 8, j = n & 255, hh = j >> 6, d = j & 63; return pn * 256 + (d >> 5) * 128 + hh * 32 + (d & 31); }
__host__ __device__ __forceinline__ size_t q_off(int b, int h, int t, int d) { return (((size_t)(b * 8 + h) * T + t) * 64 + d); }
__host__ __device__ __forceinline__ size_t k_off(int b, int kvh, int pos, int d) { return ((size_t)((b * 2 + kvh) * NTILE + (pos >> 6)) * 4096 + (d >> 3) * 512 + (pos & 63) * 8 + (d & 7)); }
__host__ __device__ __forceinline__ size_t v_off(int b, int kvh, int pos, int d) { return ((size_t)((b * 2 + kvh) * NTILE + (pos >> 6)) * 4096 + (d >> 5) * 2048 + (pos & 63) * 32 + (d & 31)); }

struct P {
    const float *x, *c, *ctx, *c_ctx, *w_mod, *b_mod, *pre1, *post1, *w_in, *a_sink, *bqn, *bkn, *aon, *bon, *w_out, *pre2, *post2, *w_group, *b_group, *w_router, *b_router, *w_gate, *w_up, *w_down;
    float* out; unsigned char* ws;
};

#define GAS __attribute__((address_space(1)))
#define LAS __attribute__((address_space(3)))
typedef unsigned v4u __attribute__((ext_vector_type(4)));
typedef unsigned v2u __attribute__((ext_vector_type(2)));
typedef float f32x4 __attribute__((ext_vector_type(4)));
typedef float f32x16 __attribute__((ext_vector_type(16)));
typedef short bf16x8 __attribute__((ext_vector_type(8)));
typedef short s16x4 __attribute__((ext_vector_type(4)));
constexpr int NWAVES = 8, NTHR = 512;
constexpr int LDS_BYTES = 163840;
constexpr int RING_BYTES = 131072;
constexpr int MISC_OFF = 159 * 1024;
constexpr int CW_TMO = 0, CW_CODE = 1, CW_BAR = 4096;
static_assert((CW_BAR + 3456) * 4 <= 64 * 1024, "control words inside the per-call memset");
#define LDS_WAIT() asm volatile("s_waitcnt lgkmcnt(0)" ::: "memory")
#define VM_WAIT() asm volatile("s_waitcnt vmcnt(0)" ::: "memory")
__device__ __forceinline__ unsigned pk2(float lo, float hi) { return f2bf(lo) | (f2bf(hi) << 16); }
#ifndef WT_STORES
#define WT_STORES 0
#endif
__device__ __forceinline__ void st16(void* p, v4u v) {
#if WT_STORES
    asm volatile("global_store_dwordx4 %0, %1, off sc1\n\ts_nop 1" :: "v"(p), "v"(v) : "memory");
#else
    *(v4u*)p = v;
#endif
}
__device__ __forceinline__ void st16f(void* p, f32x4 v) { st16(p, __builtin_bit_cast(v4u, v)); }
__device__ __forceinline__ void st8(void* p, v2u v) {
#if WT_STORES
    asm volatile("global_store_dwordx2 %0, %1, off sc1\n\ts_nop 1" :: "v"(p), "v"(v) : "memory");
#else
    *(v2u*)p = v;
#endif
}

#define XB_TMO      128
#define XB_XCNT(j)  (256  + 64 * (j))
#define XB_XSUB(j)  (1280 + 64 * (j))
#define XB_XGEN(j)  (2304 + 64 * (j))
#define XB_TOP      3328
#define XB_TOPGEN   3392
#define XCD_BAR_WORDS 3456
#define XB_SPIN_CAP (1u << 18)
__device__ __forceinline__ unsigned xb_ld(unsigned* p)              { return __hip_atomic_load(p, __ATOMIC_RELAXED, __HIP_MEMORY_SCOPE_AGENT); }
__device__ __forceinline__ unsigned xb_add(unsigned* p, unsigned v) { return __hip_atomic_fetch_add(p, v, __ATOMIC_RELAXED, __HIP_MEMORY_SCOPE_AGENT); }
__device__ __forceinline__ unsigned xb_xcc_id() { return (unsigned)__builtin_amdgcn_s_getreg((3 << 11) | 20) & 0xFu; }
#define XB_SPIN(cond, bar) do { unsigned _sp = 0; while (cond) { __builtin_amdgcn_s_sleep(1); \
    if ((++_sp & 255u) == 0u) { if (xb_ld(&(bar)[XB_TMO])) break; if (_sp > XB_SPIN_CAP) { atomicAdd(&(bar)[XB_TMO], 1u); break; } } } } while (0)
struct XcdBarrier { unsigned* bar; unsigned x; volatile LAS unsigned* st; };
__device__ __forceinline__ XcdBarrier xcd_barrier_post(unsigned* bar, volatile LAS unsigned* st) {
    XcdBarrier b; b.bar = bar; b.x = xb_xcc_id(); b.st = st;
    if (threadIdx.x == 0) (void)xb_add(&bar[XB_XCNT(b.x)], 1u);
    return b;
}
__device__ __forceinline__ void xcd_barrier_complete(unsigned* bar, unsigned x, unsigned& nloc, unsigned& nx) {
    const unsigned G = gridDim.x * gridDim.y * gridDim.z;
    unsigned sum, cnt, mine, sp = 0u;
    for (;;) {
        sum = 0u; cnt = 0u; mine = 0u;
#pragma unroll
        for (unsigned j = 0; j < 16; ++j) { const unsigned c = xb_ld(&bar[XB_XCNT(j)]); sum += c; cnt += (c > 0u) ? 1u : 0u; mine = (j == x) ? c : mine; }
        if (sum == G) break;
        __builtin_amdgcn_s_sleep(1);
        if ((++sp & 255u) == 0u) { if (xb_ld(&bar[XB_TMO])) break; if (sp > XB_SPIN_CAP) { atomicAdd(&bar[XB_TMO], 1u); break; } }
    }
    nloc = mine > 0u ? mine : 1u; nx = cnt > 0u ? cnt : 1u;
}
__device__ __forceinline__ void xcd_barrier(const XcdBarrier& b) {
    asm volatile("s_waitcnt vmcnt(0)" ::: "memory");
    __syncthreads();
    if (threadIdx.x == 0) {
        unsigned* bar = b.bar;
        __builtin_amdgcn_s_waitcnt(0);
        unsigned nloc = b.st[0], nx = b.st[1];
        if (nloc == 0u) { xcd_barrier_complete(bar, b.x, nloc, nx); b.st[0] = nloc; b.st[1] = nx; }
        const unsigned old = xb_add(&bar[XB_XSUB(b.x)], 1u);
        const unsigned gen = old / nloc;
        if (old + 1u == (gen + 1u) * nloc) {
            __builtin_amdgcn_fence(__ATOMIC_RELEASE, "agent");
            asm volatile("s_waitcnt vmcnt(0)" ::: "memory");
            const unsigned og = xb_add(&bar[XB_TOP], 1u);
            const unsigned tg = og / nx;
            if (og + 1u == (tg + 1u) * nx) xb_add(&bar[XB_TOPGEN], 1u);
            else XB_SPIN(xb_ld(&bar[XB_TOPGEN]) == tg, bar);
            __builtin_amdgcn_fence(__ATOMIC_ACQUIRE, "agent");
            xb_add(&bar[XB_XGEN(b.x)], 1u);
            asm volatile("s_waitcnt vmcnt(0)" ::: "memory");
        } else {
            XB_SPIN(xb_ld(&bar[XB_XGEN(b.x)]) == gen, bar);
            __builtin_amdgcn_fence(__ATOMIC_ACQUIRE, "agent");
            asm volatile("s_waitcnt vmcnt(0)" ::: "memory");
        }
    }
    __syncthreads();
}

namespace pg8 {
#define PG8_LAS __attribute__((address_space(3)))
typedef unsigned short bf16_t;
typedef short bf16x8 __attribute__((ext_vector_type(8)));
typedef float f32x4 __attribute__((ext_vector_type(4)));
typedef unsigned u32x4 __attribute__((ext_vector_type(4)));
constexpr int BM = 256, BK = 64, HALF = 128, HTB = HALF * BK * 2  , STAGE_BYTES = 8 * HTB, NXCD = 8, WGM = 8;

__host__ __device__ __forceinline__ int lds_byte(int r, int c) { const int st = (r >> 4) * 2 + (c >> 5), rr = r & 15, cc = c & 31, ob = rr * 64 + cc * 2; return st * 1024 + (ob ^ (((ob >> 9) & 1) << 5)); }
__host__ __device__ __forceinline__ void stage_rc(int b, int& R, int& C) { const int st = b / 1024, sb = b % 1024, swz = sb ^ (((sb >> 9) & 1) << 5); R = (st >> 1) * 16 + swz / 64; C = (st & 1) * 32 + (swz % 64) / 2; }
__host__ __device__ __forceinline__ int perm32(int rho) { const int n = rho >> 4, i = rho & 15; return 8 * (i >> 2) + 4 * n + (i & 3); }

struct Unit { int pm, pn; };
struct Gemm { const bf16_t* A; const bf16_t* Bt; int M, N, K; };
__device__ __forceinline__ unsigned cvt_pk_bf16(float lo, float hi) { unsigned r; asm volatile("v_cvt_pk_bf16_f32 %0, %1, %2" : "=v"(r) : "v"(lo), "v"(hi)); return r; }
template <class Epi, class Sched, bool ALIGN_EPI = false, bool SP2 = false, bool GATHER = false>
__device__ __forceinline__ void gemm_phase(PG8_LAS unsigned char* lds, const Gemm g, const Sched& S, const Epi& E) {
    const int tid = threadIdx.x, wid = __builtin_amdgcn_readfirstlane(tid >> 6), lane = tid & 63, wr = wid >> 2, wc = wid & 3, fr = lane & 15, fq = lane >> 4;
    const int K = g.K, nt = K / BK;
    unsigned voffA[2], voffB[2]; int RA[2], CA[2];
#pragma unroll
    for (int i = 0; i < 2; ++i) { int R, C; stage_rc(tid * 16 + i * 8192, R, C); const int Rb = Epi::PERM ? ((R & ~31) + perm32(R & 31)) : R;
        voffA[i] = (unsigned)(R * K + C) * 2u; voffB[i] = (unsigned)(Rb * K + C) * 2u; RA[i] = R; CA[i] = C; }
    const size_t kstep = (size_t)(BK * 2);
    const size_t hstep = (size_t)HALF * K * 2;
    const size_t tstep = 2 * hstep;
    const unsigned ldsw = (unsigned)wid * 1024u;
    const int aoff = lds_byte(wr * 64 + fr, fq * 8), boff = lds_byte(wc * 32 + fr, fq * 8);
#define PG8_SA(b, h) (((b) * 2 + (h)) * HTB)
#define PG8_SB(b, h) ((4 + (b) * 2 + (h)) * HTB)
#define PG8_STAGE(bufoff, gbase, voff) do { _Pragma("unroll") for (int _i = 0; _i < 2; ++_i) \
        __builtin_amdgcn_global_load_lds((const unsigned*)((const char*)(gbase) + (voff)[_i]), (PG8_LAS unsigned*)(lds + (bufoff) + ldsw + _i * 8192), 16, 0, 0); } while (0)
#define PG8_STAGE_A(bufoff, gbase, h, VO) do { if constexpr (GATHER) { PG8_STAGE(bufoff, gbase, VO[h]); } else { PG8_STAGE(bufoff, (gbase) + (h) * hstep, voffA); } } while (0)
#define PG8_LDA(dst, b, h) do { _Pragma("unroll") for (int m = 0; m < 4; ++m) _Pragma("unroll") for (int k = 0; k < 2; ++k) dst[m][k] = *(const PG8_LAS bf16x8*)(lds + PG8_SA(b, h) + aoff + m * 2048 + k * 1024); } while (0)
#define PG8_LDB(dst, b, h) do { _Pragma("unroll") for (int n = 0; n < 2; ++n) _Pragma("unroll") for (int k = 0; k < 2; ++k) dst[n][k] = *(const PG8_LAS bf16x8*)(lds + PG8_SB(b, h) + boff + n * 2048 + k * 1024); } while (0)
#define PG8_MMA(ai, bj, At, Bt) do { __builtin_amdgcn_s_setprio(1); _Pragma("unroll") for (int m = 0; m < 4; ++m) _Pragma("unroll") for (int n = 0; n < 2; ++n) _Pragma("unroll") for (int k = 0; k < 2; ++k) \
        acc[ai][bj][m][n] = __builtin_amdgcn_mfma_f32_16x16x32_bf16(Bt[n][k], At[m][k], acc[ai][bj][m][n], 0, 0, 0); __builtin_amdgcn_s_setprio(0); } while (0)
#define PG8_WAIT_V(n) asm volatile("s_waitcnt vmcnt(" #n ")" ::: "memory")
#define PG8_WAIT_L(n) asm volatile("s_waitcnt lgkmcnt(" #n ")" ::: "memory")
#define PG8_BAR __builtin_amdgcn_s_barrier()
#define PG8_SCHED __builtin_amdgcn_sched_barrier(0)
    Unit cur, nxt; int ui = 0;
    if (!S.next(0, cur)) return;
    f32x4 acc[2][2][4][2];
#pragma unroll
    for (int a = 0; a < 2; ++a)
#pragma unroll
        for (int b = 0; b < 2; ++b)
#pragma unroll
            for (int m = 0; m < 4; ++m)
#pragma unroll
                for (int n = 0; n < 2; ++n) acc[a][b][m][n] = (f32x4){0.f, 0.f, 0.f, 0.f};
    bf16x8 At[4][2], B0[2][2], B1[2][2];
    const char* cA = (const char*)g.A + (GATHER ? (size_t)0 : (size_t)cur.pm * tstep); const char* cB = (const char*)g.Bt + (size_t)cur.pn * tstep;
    unsigned vcur[2][2], vnxt[2][2], vsel[2][2];
#pragma unroll
    for (int h = 0; h < 2; ++h)
#pragma unroll
        for (int i = 0; i < 2; ++i) { vcur[h][i] = 0u; vnxt[h][i] = 0u; vsel[h][i] = 0u; }
    if constexpr (GATHER) {
#pragma unroll
        for (int h = 0; h < 2; ++h)
#pragma unroll
            for (int i = 0; i < 2; ++i) vcur[h][i] = ((unsigned)S.rowidx[cur.pm * BM + h * HALF + RA[i]] * (unsigned)K + (unsigned)CA[i]) * 2u;
    }
    S.a_ready(cur);
    if constexpr (SP2) {
        PG8_STAGE(PG8_SB(0, 0), cB, voffB); PG8_STAGE(PG8_SB(0, 1), cB + hstep, voffB); PG8_STAGE_A(PG8_SA(0, 0), cA, 0, vcur); PG8_STAGE_A(PG8_SA(0, 1), cA, 1, vcur);
        if (wr == 1) PG8_BAR;
        PG8_WAIT_V(2); PG8_BAR;
        PG8_STAGE(PG8_SB(1, 0), cB + kstep, voffB); PG8_STAGE_A(PG8_SA(1, 0), cA + kstep, 0, vcur); PG8_STAGE(PG8_SB(1, 1), cB + hstep + kstep, voffB);
        PG8_WAIT_V(6); PG8_BAR;
    } else {
        PG8_STAGE(PG8_SB(0, 0), cB, voffB); PG8_STAGE_A(PG8_SA(0, 0), cA, 0, vcur); PG8_STAGE(PG8_SB(0, 1), cB + hstep, voffB); PG8_STAGE_A(PG8_SA(0, 1), cA, 1, vcur);
        if (wr == 1) PG8_BAR;
        PG8_WAIT_V(4); PG8_BAR;
        PG8_STAGE(PG8_SB(1, 0), cB + kstep, voffB); PG8_STAGE_A(PG8_SA(1, 0), cA + kstep, 0, vcur); PG8_STAGE(PG8_SB(1, 1), cB + hstep + kstep, voffB);
        PG8_WAIT_V(6); PG8_BAR;
    }
    for (;;) {
        const bool has_next = S.next(ui + 1, nxt);
        if constexpr (GATHER) {
#pragma unroll
            for (int h = 0; h < 2; ++h)
#pragma unroll
                for (int i = 0; i < 2; ++i) vnxt[h][i] = has_next ? ((unsigned)S.rowidx[nxt.pm * BM + h * HALF + RA[i]] * (unsigned)K + (unsigned)CA[i]) * 2u : vcur[h][i];
        }
        const char* nA = has_next ? (const char*)g.A + (GATHER ? (size_t)0 : (size_t)nxt.pm * tstep) : cA; const char* nB = has_next ? (const char*)g.Bt + (size_t)nxt.pn * tstep : cB;
        for (int t = 0; t < nt; t += 2) {
            const bool last = (t == nt - 2);
            if constexpr (GATHER) {
#pragma unroll
                for (int h = 0; h < 2; ++h)
#pragma unroll
                    for (int i = 0; i < 2; ++i) vsel[h][i] = last ? vnxt[h][i] : vcur[h][i];
            }
            if constexpr (Epi::HAS_MID) { if (t == nt / 2) E.mid(acc, cur, wr, wc, fr, fq); }
            const char* a1 = cA + (size_t)(t + 1) * kstep;
            const char* a2 = last ? nA : cA + (size_t)(t + 2) * kstep; const char* b2 = last ? nB : cB + (size_t)(t + 2) * kstep;
            const char* a3 = a2 + kstep; const char* b3 = b2 + kstep;
            if (last && has_next) S.a_ready(nxt);
            if constexpr (SP2) {
            PG8_LDB(B0, 0, 0); PG8_LDB(B1, 0, 1); PG8_SCHED; PG8_LDA(At, 0, 0); PG8_STAGE_A(PG8_SA(1, 1), a1, 1, vcur);
            PG8_WAIT_V(8); PG8_WAIT_L(0); PG8_BAR; PG8_MMA(0, 0, At, B0); PG8_MMA(0, 1, At, B1); PG8_BAR; PG8_SCHED;
            PG8_LDA(At, 0, 1); PG8_STAGE(PG8_SB(0, 0), b2, voffB); PG8_STAGE(PG8_SB(0, 1), b2 + hstep, voffB); PG8_STAGE_A(PG8_SA(0, 0), a2, 0, vsel);
            PG8_WAIT_V(8); PG8_WAIT_L(0); PG8_BAR; PG8_MMA(1, 0, At, B0); PG8_MMA(1, 1, At, B1); PG8_BAR; PG8_SCHED;
            PG8_LDB(B0, 1, 0); PG8_LDB(B1, 1, 1); PG8_SCHED; PG8_LDA(At, 1, 0); PG8_STAGE_A(PG8_SA(0, 1), a2, 1, vsel);
            PG8_WAIT_V(8); PG8_WAIT_L(0); PG8_BAR; PG8_MMA(0, 0, At, B0); PG8_MMA(0, 1, At, B1); PG8_BAR; PG8_SCHED;
            PG8_LDA(At, 1, 1); PG8_STAGE(PG8_SB(1, 0), b3, voffB); PG8_STAGE(PG8_SB(1, 1), b3 + hstep, voffB); PG8_STAGE_A(PG8_SA(1, 0), a3, 0, vsel);
            PG8_WAIT_V(8); PG8_WAIT_L(0); PG8_BAR; PG8_MMA(1, 0, At, B0); PG8_MMA(1, 1, At, B1); PG8_BAR; PG8_SCHED;
            } else {
            PG8_LDB(B0, 0, 0); PG8_SCHED; PG8_LDA(At, 0, 0); PG8_STAGE_A(PG8_SA(1, 1), a1, 1, vcur);
            PG8_WAIT_L(8); PG8_BAR; PG8_WAIT_L(0); PG8_MMA(0, 0, At, B0); PG8_BAR; PG8_SCHED;
            PG8_LDB(B1, 0, 1); PG8_STAGE(PG8_SB(0, 0), b2, voffB);
            PG8_BAR; PG8_WAIT_L(0); PG8_MMA(0, 1, At, B1); PG8_BAR;
            PG8_LDA(At, 0, 1); PG8_STAGE_A(PG8_SA(0, 0), a2, 0, vsel);
            PG8_BAR; PG8_WAIT_L(0); PG8_MMA(1, 0, At, B0); PG8_BAR; PG8_SCHED;
            PG8_STAGE(PG8_SB(0, 1), b2 + hstep, voffB);
            PG8_WAIT_V(6); PG8_BAR; PG8_MMA(1, 1, At, B1); PG8_BAR;
            PG8_LDB(B0, 1, 0); PG8_SCHED; PG8_LDA(At, 1, 0); PG8_STAGE_A(PG8_SA(0, 1), a2, 1, vsel);
            PG8_WAIT_L(8); PG8_BAR; PG8_WAIT_L(0); PG8_MMA(0, 0, At, B0); PG8_BAR; PG8_SCHED;
            PG8_LDB(B1, 1, 1); PG8_STAGE(PG8_SB(1, 0), b3, voffB);
            PG8_BAR; PG8_WAIT_L(0); PG8_MMA(0, 1, At, B1); PG8_BAR;
            PG8_LDA(At, 1, 1); PG8_STAGE_A(PG8_SA(1, 0), a3, 0, vsel);
            PG8_BAR; PG8_WAIT_L(0); PG8_MMA(1, 0, At, B0); PG8_BAR; PG8_SCHED;
            PG8_STAGE(PG8_SB(1, 1), b3 + hstep, voffB);
            PG8_WAIT_V(6); PG8_BAR; PG8_MMA(1, 1, At, B1); PG8_BAR;
            }
        }
        if constexpr (ALIGN_EPI) { if (wr == 0) PG8_BAR; }
        if constexpr (!Epi::AFTER_DRAIN) { E(acc, cur, wr, wc, fr, fq); S.done(cur); }
        if (!has_next) break;
#pragma unroll
        for (int a = 0; a < 2; ++a)
#pragma unroll
            for (int b = 0; b < 2; ++b)
#pragma unroll
                for (int m = 0; m < 4; ++m)
#pragma unroll
                    for (int n = 0; n < 2; ++n) acc[a][b][m][n] = (f32x4){0.f, 0.f, 0.f, 0.f};
        cur = nxt; cA = nA; cB = nB; ++ui;
        if constexpr (GATHER) {
#pragma unroll
            for (int h = 0; h < 2; ++h)
#pragma unroll
                for (int i = 0; i < 2; ++i) vcur[h][i] = vnxt[h][i];
        }
        if constexpr (ALIGN_EPI) { if (wr == 1) PG8_BAR; }
    }
    PG8_WAIT_V(0);
    if constexpr (!ALIGN_EPI) { if (wr == 0) PG8_BAR; }
    PG8_BAR;
    if constexpr (Epi::AFTER_DRAIN) { E.fused(acc, cur, wr, wc, fr, fq, lds, wid, lane); S.done(cur); }
#undef PG8_SA
#undef PG8_SB
#undef PG8_STAGE
#undef PG8_STAGE_A
#undef PG8_LDA
#undef PG8_LDB
#undef PG8_MMA
#undef PG8_WAIT_V
#undef PG8_WAIT_L
#undef PG8_BAR
#undef PG8_SCHED
}
}

namespace pg8 {
struct SchedQKV {
    int G, c;
    __device__ __forceinline__ bool next(int i, Unit& u) const {
        const int L = i * G + c; if (L >= 400) return false;
        if (L < 384) { const int xcd = L & 7, off = L >> 3, w = xcd * 48 + off; u.pm = (w / 48) * 8 + ((w % 48) & 7); u.pn = (w % 48) >> 3; }
        else { const int j = L - 384; u.pm = 64 + (j >> 1); u.pn = (j & 1) ? 5 : 2; }
        return true;
    }
    __device__ __forceinline__ void a_ready(const Unit&) const {}
    __device__ __forceinline__ void done(const Unit&) const {}
};
struct EpiQKV {
    static constexpr bool PERM = true, AFTER_DRAIN = false, HAS_MID = false;
    unsigned char* ws; const float* bqn; const float* bkn;
    __device__ __forceinline__ void operator()(const f32x4 (&acc)[2][2][4][2], const Unit& u, int wr, int wc, int fr, int fq) const {
        const int pn = u.pn; const bool isctx = u.pm >= 64;
        int kind, hh;
        if (pn < 2) { kind = 0; hh = pn * 4 + wc; } else if (pn == 2) { kind = wc < 2 ? 2 : 4; hh = wc & 1; } else if (pn < 5) { kind = 1; hh = (pn - 3) * 4 + wc; } else { kind = wc < 2 ? 3 : 5; hh = wc & 1; }
        const bool rms = kind == 1 || kind == 3, rope = !isctx && kind <= 3;
        const float* gp = kind == 1 ? bqn : bkn;
        f32x4 gain[2][2];
#pragma unroll
        for (int bj = 0; bj < 2; ++bj)
#pragma unroll
            for (int n = 0; n < 2; ++n) gain[bj][n] = rms ? *(const f32x4*)(gp + 32 * bj + 8 * fq + 4 * n) : (f32x4){1.f, 1.f, 1.f, 1.f};
        const float* tab = (const float*)(ws + WS_ROPE);
        bf16* base = (bf16*)(ws + (kind == 0 ? WS_QA : kind == 1 ? WS_QB : kind == 2 ? WS_KA : kind == 3 ? WS_KB : kind == 4 ? WS_VA : WS_VB));
        const float qs = kind <= 1 ? C2 : 1.f;
#pragma unroll
        for (int ai = 0; ai < 2; ++ai)
#pragma unroll
            for (int m = 0; m < 4; ++m) {
                const int row = u.pm * BM + ai * HALF + wr * 64 + m * 16 + fr;
                int b, t, pos;
                if (!isctx) { b = row >> 11; t = row & 2047; pos = t; } else { const int cr = row - ML; b = cr >> 8; t = 0; pos = T + (cr & 255); }
                f32x4 v[2][2];
#pragma unroll
                for (int bj = 0; bj < 2; ++bj)
#pragma unroll
                    for (int n = 0; n < 2; ++n) v[bj][n] = acc[ai][bj][m][n];
                if (rms) {
                    float ss = 0.f;
#pragma unroll
                    for (int bj = 0; bj < 2; ++bj)
#pragma unroll
                        for (int n = 0; n < 2; ++n) ss += (v[bj][n].x * v[bj][n].x + v[bj][n].y * v[bj][n].y) + (v[bj][n].z * v[bj][n].z + v[bj][n].w * v[bj][n].w);
                    ss += __shfl_xor(ss, 16); ss += __shfl_xor(ss, 32);
                    const float rn = rsqrtf(ss * (1.f / 64.f) + EPS);
#pragma unroll
                    for (int bj = 0; bj < 2; ++bj)
#pragma unroll
                        for (int n = 0; n < 2; ++n) v[bj][n] = v[bj][n] * rn * gain[bj][n];
                }
                if (rope) {
#pragma unroll
                    for (int bj = 0; bj < 2; ++bj)
#pragma unroll
                        for (int n = 0; n < 2; ++n) {
                            const int tp = bj == 0 ? (t >> 6) : 32 + (t & 63);
                            const f32x4 cs = *(const f32x4*)(tab + (tp * 16 + 4 * fq + 2 * n) * 2);
                            const f32x4 x = v[bj][n];
                            v[bj][n] = (f32x4){x.x * cs.x - x.y * cs.y, x.x * cs.y + x.y * cs.x, x.z * cs.z - x.w * cs.w, x.z * cs.w + x.w * cs.z};
                        }
                }
#pragma unroll
                for (int bj = 0; bj < 2; ++bj) {
                    const f32x4 v0 = v[bj][0] * qs, v1 = v[bj][1] * qs;
                    u32x4 w; w.x = pk2(v0.x, v0.y); w.y = pk2(v0.z, v0.w); w.z = pk2(v1.x, v1.y); w.w = pk2(v1.z, v1.w);
                    const int d0 = 32 * bj + 8 * fq;
                    bf16* dst = kind <= 1 ? base + q_off(b, hh, t, d0) : kind <= 3 ? base + k_off(b, hh, pos, d0) : base + v_off(b, hh, pos, d0);
                    st16(dst, w);
                }
            }
    }
};
}


namespace pg8 {
struct SchedOne { Unit u;
    __device__ __forceinline__ bool next(int i, Unit& o) const { if (i) return false; o = u; return true; }
    __device__ __forceinline__ void a_ready(const Unit&) const {}
    __device__ __forceinline__ void done(const Unit&) const {} };
struct EpiOut {
    static constexpr bool PERM = true, AFTER_DRAIN = false, HAS_MID = true;
    bf16* OX; const LAS float* tab;
    __device__ __forceinline__ void mid(f32x4 (&acc)[2][2][4][2], const Unit&, int wr, int, int fr, int) const {
#pragma unroll
        for (int ai = 0; ai < 2; ++ai)
#pragma unroll
            for (int m = 0; m < 4; ++m) { const float f = tab[2 * (ai * HALF + wr * 64 + m * 16 + fr)];
#pragma unroll
                for (int bj = 0; bj < 2; ++bj)
#pragma unroll
                    for (int n = 0; n < 2; ++n) acc[ai][bj][m][n] = acc[ai][bj][m][n] * f; }
    }
    __device__ __forceinline__ void operator()(const f32x4 (&acc)[2][2][4][2], const Unit& u, int wr, int wc, int fr, int fq) const {
#pragma unroll
        for (int ai = 0; ai < 2; ++ai)
#pragma unroll
            for (int m = 0; m < 4; ++m) { const int r = ai * HALF + wr * 64 + m * 16 + fr; const float f = tab[2 * r + 1];
                bf16* rowp = OX + (size_t)(u.pm * BM + r) * D + u.pn * BM + wc * 32 + 8 * fq;
#pragma unroll
                for (int bj = 0; bj < 2; ++bj) { const f32x4 v0 = acc[ai][bj][m][0] * f, v1 = acc[ai][bj][m][1] * f;
                    u32x4 w; w.x = pk2(v0.x, v0.y); w.y = pk2(v0.z, v0.w); w.z = pk2(v1.x, v1.y); w.w = pk2(v1.z, v1.w);
                    st16(rowp + bj * HALF, w); } }
    }
};
struct SchedMoE {
    int G, c, nwg; const LAS int* tile_e; const int* rowidx;
    __device__ __forceinline__ bool next(int i, Unit& u) const {
        const int L = i * G + c; if (L >= nwg) return false;
        const int q = nwg >> 3, r = nwg & 7, xcd = L & 7, off = L >> 3;
        const int w = (xcd < r ? xcd * (q + 1) : r * (q + 1) + (xcd - r) * q) + off;
        u.pm = w >> 2; u.pn = tile_e[w >> 2] * 4 + (w & 3); return true;
    }
    __device__ __forceinline__ void a_ready(const Unit&) const {}
    __device__ __forceinline__ void done(const Unit&) const {}
};
__device__ __forceinline__ float silu_fast(float g) { return g * __builtin_amdgcn_rcpf(1.f + __builtin_amdgcn_exp2f(-g * LOG2E)); }
struct EpiGU {
    static constexpr bool PERM = true, AFTER_DRAIN = false, HAS_MID = false;
    bf16* ACT; const float* roww;
    __device__ __forceinline__ void operator()(const f32x4 (&acc)[2][2][4][2], const Unit& u, int wr, int wc, int fr, int fq) const {
#pragma unroll
        for (int ai = 0; ai < 2; ++ai)
#pragma unroll
            for (int m = 0; m < 4; ++m) { const int pos = u.pm * BM + ai * HALF + wr * 64 + m * 16 + fr; const float w = roww[pos];
                const f32x4 g0 = acc[ai][0][m][0], g1 = acc[ai][0][m][1], u0 = acc[ai][1][m][0], u1 = acc[ai][1][m][1];
                u32x4 o;
                o.x = pk2(silu_fast(g0.x) * u0.x * w, silu_fast(g0.y) * u0.y * w); o.y = pk2(silu_fast(g0.z) * u0.z * w, silu_fast(g0.w) * u0.w * w);
                o.z = pk2(silu_fast(g1.x) * u1.x * w, silu_fast(g1.y) * u1.y * w); o.w = pk2(silu_fast(g1.z) * u1.z * w, silu_fast(g1.w) * u1.w * w);
                st16(ACT + (size_t)pos * EFF + (u.pn & 3) * 128 + wc * 32 + 8 * fq, o); }
    }
};
struct EpiY {
    static constexpr bool PERM = true, AFTER_DRAIN = false, HAS_MID = false;
    bf16* Y;
    __device__ __forceinline__ void operator()(const f32x4 (&acc)[2][2][4][2], const Unit& u, int wr, int wc, int fr, int fq) const {
#pragma unroll
        for (int ai = 0; ai < 2; ++ai)
#pragma unroll
            for (int m = 0; m < 4; ++m) { bf16* rowp = Y + (size_t)(u.pm * BM + ai * HALF + wr * 64 + m * 16 + fr) * D + (u.pn & 3) * BM + wc * 32 + 8 * fq;
#pragma unroll
                for (int bj = 0; bj < 2; ++bj) { const f32x4 v0 = acc[ai][bj][m][0], v1 = acc[ai][bj][m][1];
                    u32x4 w; w.x = pk2(v0.x, v0.y); w.y = pk2(v0.z, v0.w); w.z = pk2(v1.x, v1.y); w.w = pk2(v1.z, v1.w);
                    st16(rowp + bj * HALF, w); } }
    }
};
}

namespace att {
typedef __attribute__((address_space(3))) const char* lds_cptr;
typedef short v4i16_t __attribute__((ext_vector_type(4)));
constexpr int NSLOT = 4, SLOTB = 16384, OST_PITCH = 144, OST_WAVE = 32 * OST_PITCH;
static_assert(8 * OST_WAVE <= 3 * SLOTB && NSLOT * SLOTB <= 65536, "attention LDS");
__device__ __forceinline__ int crow(int r, int hi) { return (r & 3) + 8 * (r >> 2) + 4 * hi; }
__device__ __forceinline__ unsigned cvtpk(float lo, float hi) { typedef float f2 __attribute__((ext_vector_type(2))); typedef __bf16 b2 __attribute__((ext_vector_type(2))); f2 v = {lo, hi}; b2 b = __builtin_convertvector(v, b2); return __builtin_bit_cast(unsigned, b); }
__device__ __forceinline__ s16x4 vtr(lds_cptr p) { return __builtin_bit_cast(s16x4, __builtin_amdgcn_ds_read_tr16_b64_v4i16((__attribute__((address_space(3))) v4i16_t*)p)); }
__device__ __forceinline__ float swapmax(float m) { auto rr = __builtin_amdgcn_permlane32_swap(__float_as_uint(m), __float_as_uint(m), false, false); return fmaxf(__uint_as_float(rr[0]), __uint_as_float(rr[1])); }
__device__ __forceinline__ float swapsum(float m) { auto rr = __builtin_amdgcn_permlane32_swap(__float_as_uint(m), __float_as_uint(m), false, false); return __uint_as_float(rr[0]) + __uint_as_float(rr[1]); }

__device__ __forceinline__ void glds16(const void* gsrc, unsigned lds_dst) { unsigned keep;
    asm volatile("s_mov_b32 %0, m0\n\ts_mov_b32 m0, %2\n\ts_nop 0\n\tglobal_load_lds_dwordx4 %1, off\n\ts_mov_b32 m0, %0" : "=&s"(keep) : "v"(gsrc), "s"(lds_dst) : "memory"); }
__device__ __forceinline__ float max3f(float a, float b, float c) { float r; asm("v_max3_f32 %0, %1, %2, %3" : "=v"(r) : "v"(a), "v"(b), "v"(c)); return r; }
__device__ __forceinline__ float max2f(float a, float b) { float r; asm("v_max_f32_e32 %0, %1, %2" : "=v"(r) : "v"(a), "v"(b)); return r; }
constexpr int WC_PER_WAVE = 24, WC_LDS = 65536;
struct WConv { int next, j0, j1, gstep, cm1, cm2; };
struct WItem { const float* src; int N; bf16* dst; int dpitch; };
__device__ __forceinline__ WItem wc_decode(const P& p, int hidx, int& k0, int& n0, int& drow0) {
    const int item = hidx >> 1, kh = hidx & 1; WItem w;
    if (item < 16384) { const int up = item >= 8192, r = item & 8191, e = r >> 8, q = r & 255, kb = q >> 4, nb = q & 15; n0 = nb * 32;
        w.src = (up ? p.w_up : p.w_gate) + (size_t)e * 1024 * 512; w.N = 512; w.dst = (bf16*)(p.ws + WS_WGU) + (size_t)e * 1024 * 1024; w.dpitch = 1024;
        drow0 = (n0 >> 7) * 256 + up * 128 + (n0 & 127); k0 = kb * 64 + kh * 32; }
    else { const int r = item - 16384, e = r >> 8, q = r & 255, kb = q >> 5, nb = q & 31; n0 = nb * 32;
        w.src = p.w_down + (size_t)e * 512 * 1024; w.N = 1024; w.dst = (bf16*)(p.ws + WS_WD) + (size_t)e * 1024 * 512; w.dpitch = 512; drow0 = n0; k0 = kb * 64 + kh * 32; }
    return w;
}
__device__ __forceinline__ void glds16(const void* gsrc, unsigned lds_dst);
__device__ __forceinline__ void wc_issue(const P& p, int gw, int ord, unsigned ldsbuf, int lane) {
    int k0, n0, drow0; const WItem w = wc_decode(p, gw + 2048 * ord, k0, n0, drow0);
#pragma unroll
    for (int q = 0; q < 4; ++q) { const int kl = 8 * q + (lane >> 3), f4 = (lane & 7) ^ ((q >> 1) * 4);
        glds16(w.src + (size_t)(k0 + kl) * w.N + n0 + f4 * 4, (unsigned)__builtin_amdgcn_readfirstlane(ldsbuf + q * 1024)); }
}
__device__ __forceinline__ void wc_consume(const P& p, int gw, int ord, LAS unsigned char* buf, int lane) {
    int k0, n0, drow0; const WItem w = wc_decode(p, gw + 2048 * ord, k0, n0, drow0);
    const int n = lane >> 1, kh = lane & 1;
    const LAS float* s = (const LAS float*)buf + (16 * kh) * 32 + 4 * ((n >> 2) ^ (4 * kh)) + (n & 3);
    float v[16];
#pragma unroll
    for (int i = 0; i < 16; ++i) v[i] = s[i * 32];
    v4u o0, o1;
    o0.x = cvtpk(v[0], v[1]); o0.y = cvtpk(v[2], v[3]); o0.z = cvtpk(v[4], v[5]); o0.w = cvtpk(v[6], v[7]);
    o1.x = cvtpk(v[8], v[9]); o1.y = cvtpk(v[10], v[11]); o1.z = cvtpk(v[12], v[13]); o1.w = cvtpk(v[14], v[15]);
    bf16* d = w.dst + (size_t)(drow0 + n) * w.dpitch + k0 + 16 * kh;
    *(v4u*)d = o0; *(v4u*)(d + 8) = o1;
}
constexpr float THR = 8.f;
template <int GRP, int ABL = 0>
__device__ __forceinline__ void attn_unit(const P& p, LAS unsigned char* lds, int b, int kvh, int qb, WConv& wc, int gw) {
    const int tid = threadIdx.x, lane = tid & 63, r32 = lane & 31, hi = lane >> 5;
    const int wid = __builtin_amdgcn_readfirstlane(tid >> 6);
    const int h = kvh * 4 + (wid >> 1);
    const int q0w = qb * 64 + (wid & 1) * 32, qpos = q0w + r32;
    const bf16* Qp = (const bf16*)(p.ws + (GRP ? WS_QB : WS_QA)) + q_off(b, h, qpos, 0);
    bf16x8 qr[4];
#pragma unroll
    for (int d0 = 0; d0 < 4; ++d0) qr[d0] = *(const bf16x8*)(Qp + 16 * d0 + 8 * hi);
    asm volatile("" : "+v"(qr[0]), "+v"(qr[1]), "+v"(qr[2]), "+v"(qr[3]));
    const char* Kt = (const char*)(p.ws + (GRP ? WS_KB : WS_KA)) + (size_t)(b * 2 + kvh) * NTILE * 8192 + wid * 1024 + lane * 16;
    const char* Vt = (const char*)(p.ws + (GRP ? WS_VB : WS_VA)) + (size_t)(b * 2 + kvh) * NTILE * 8192 + wid * 1024 + lane * 16;
    const unsigned lds0 = (unsigned)(uintptr_t)lds;
    int jlo = 0, nband = NTILE, NT = NTILE;
    if (GRP == 0) { jlo = qb - 2 < 0 ? 0 : qb - 2; const int jhi = qb + 2 > 31 ? 31 : qb + 2; nband = jhi - jlo + 1; NT = nband + 4; }
#define ATT_TILE(i) ((i) < nband ? jlo + (i) : 32 + ((i) - nband))
#define ATT_ISSUE(i) do { if (ABL & 1) break; const int tl_ = ATT_TILE(i); const int sl_ = ((i) & 3) * SLOTB; \
        glds16(Kt + (size_t)tl_ * 8192, (unsigned)__builtin_amdgcn_readfirstlane(lds0 + sl_ + wid * 1024)); \
        glds16(Vt + (size_t)tl_ * 8192, (unsigned)__builtin_amdgcn_readfirstlane(lds0 + sl_ + 8192 + wid * 1024)); } while (0)
#define ATT_WAIT(n) do { if (ABL & 1) break; if ((n) >= 2) asm volatile("s_waitcnt vmcnt(4)" ::: "memory"); else if ((n) == 1) asm volatile("s_waitcnt vmcnt(2)" ::: "memory"); else asm volatile("s_waitcnt vmcnt(0)" ::: "memory"); } while (0)
#define ATT_WAITN(n) do { if (ABL & 1) break; switch (n) { case 0: asm volatile("s_waitcnt vmcnt(0)" ::: "memory"); break; case 2: asm volatile("s_waitcnt vmcnt(2)" ::: "memory"); break; \
        case 4: asm volatile("s_waitcnt vmcnt(4)" ::: "memory"); break; case 6: asm volatile("s_waitcnt vmcnt(6)" ::: "memory"); break; case 8: asm volatile("s_waitcnt vmcnt(8)" ::: "memory"); break; \
        case 10: asm volatile("s_waitcnt vmcnt(10)" ::: "memory"); break; case 12: asm volatile("s_waitcnt vmcnt(12)" ::: "memory"); break; default: asm volatile("s_waitcnt vmcnt(14)" ::: "memory"); break; } } while (0)
#define ATT_BAR() do { asm volatile("" ::: "memory"); __builtin_amdgcn_s_barrier(); asm volatile("" ::: "memory"); } while (0)
#define SBAR() __builtin_amdgcn_sched_barrier(0)
#define MF(a, b, c) __builtin_amdgcn_mfma_f32_32x32x16_bf16(a, b, c, 0, 0, 0)
#define KFRAG(dst, base, k) dst = *(const __attribute__((address_space(3))) bf16x8*)((base) + ((k) >> 1) * 2048 + ((k) & 1) * 512)
    float m, l;
    m = 0.f; l = 0.f;
    f32x16 o0, o1, sA0, sA1, sB0, sB1; const f32x16 zero16 = {0.f, 0.f, 0.f, 0.f, 0.f, 0.f, 0.f, 0.f, 0.f, 0.f, 0.f, 0.f, 0.f, 0.f, 0.f, 0.f};
#pragma unroll
    for (int r = 0; r < 16; ++r) { o0[r] = 0.f; o1[r] = 0.f; sB0[r] = 0.f; sB1[r] = 0.f; }
    const lds_cptr kp0 = (lds_cptr)lds + hi * 1024 + r32 * 16;
    const lds_cptr vp0 = (lds_cptr)lds + 8192 + ((lane >> 4) & 1) * 32 + (lane & 3) * 8 + (4 * hi + ((lane & 15) >> 2)) * 64;
#define ATT_MASK(S0, S1, t) do { if (GRP == 0) { const int tl = ATT_TILE(t); if (tl < 32 && (tl == qb - 2 || tl == qb + 2)) { const int kb = tl * 64; \
        _Pragma("unroll") for (int r = 0; r < 16; ++r) { const int dd = kb + crow(r, hi) - qpos; if (dd > 128 || dd < -128) S0[r] = -1e30f; if (dd + 32 > 128 || dd + 32 < -128) S1[r] = -1e30f; } } } } while (0)
#define ATT_DECIDE(S0, S1, mxv) do { float mx_ = swapmax(mxv); \
        if (__builtin_expect(__any(mx_ > THR), 0)) { const float dl = fmaxf(mx_, 0.f), alpha = __builtin_amdgcn_exp2f(-dl); m += dl; l *= alpha; \
            _Pragma("unroll") for (int r = 0; r < 16; ++r) { S0[r] -= dl; S1[r] -= dl; o0[r] *= alpha; o1[r] *= alpha; } } } while (0)
    wc.cm1 = 0; wc.cm2 = 0;
    ATT_ISSUE(0); ATT_ISSUE(1); ATT_ISSUE(2);
    ATT_WAIT(2); ATT_BAR();
    {
        bf16x8 kf[8];
#pragma unroll
        for (int k = 0; k < 8; ++k) KFRAG(kf[k], kp0, k);
        SBAR();
        sA0 = MF(kf[0], qr[0], zero16); sA1 = MF(kf[1], qr[0], zero16);
#pragma unroll
        for (int d0 = 1; d0 < 4; ++d0) { sA0 = MF(kf[2 * d0], qr[d0], sA0); sA1 = MF(kf[2 * d0 + 1], qr[d0], sA1); }
        ATT_MASK(sA0, sA1, 0);
        asm volatile("s_nop 15\n\ts_nop 7" : "+v"(sA0), "+v"(sA1));
        float a = max3f(sA0[0], sA0[1], sA1[0]), c = max3f(sA0[2], sA0[3], sA1[1]); a = max3f(a, sA1[2], sA1[3]);
#pragma unroll
        for (int r = 4; r < 16; r += 4) { a = max3f(a, sA0[r], sA0[r + 1]); c = max3f(c, sA0[r + 2], sA0[r + 3]); a = max3f(a, sA1[r], sA1[r + 1]); c = max3f(c, sA1[r + 2], sA1[r + 3]); }
        ATT_DECIDE(sA0, sA1, max2f(a, c));
    }
#define ATT_STEP(SC0, SC1, SN0, SN1, t, HN) do { \
        constexpr bool hn_ = HN;                                      \
        ATT_WAITN(wc.cm2 + wc.cm1 + ((t) + 2 < NT ? 2 : 0));         \
        ATT_BAR(); \
        if ((t) + 3 < NT) ATT_ISSUE((t) + 3); \
        if (WCONV_IN_ATTN) { int c_ = 0; const int r7_ = wc.gstep % 7, bs_ = r7_ == 0 ? 0 : r7_ == 3 ? 1 : 2;     \
            if (bs_ < 2) { LAS unsigned char* wb_ = lds + WC_LDS + wid * 8192 + bs_ * 4096; int jb_ = bs_ ? wc.j1 : wc.j0; \
                if (jb_ >= 0) { wc_consume(p, gw, jb_, wb_, lane); jb_ = -1; c_ += 2; } \
                if (wc.next < WC_PER_WAVE) { asm volatile("s_waitcnt lgkmcnt(0)" ::: "memory"); wc_issue(p, gw, wc.next, lds0 + WC_LDS + wid * 8192 + bs_ * 4096, lane); jb_ = wc.next++; c_ += 4; } \
                if (bs_) wc.j1 = jb_; else wc.j0 = jb_; } \
            wc.cm2 = wc.cm1; wc.cm1 = c_; wc.gstep++; } \
        const lds_cptr kp_ = kp0 + (((t) + 1) & 3) * SLOTB; const lds_cptr vp_ = vp0 + ((t) & 3) * SLOTB; \
        bf16x8 kf[8]; s16x4 vlo[8], vhi[8]; \
        if (hn_) { _Pragma("unroll") for (int k = 0; k < 8; ++k) KFRAG(kf[k], kp_, k); } \
        SBAR(); \
        float rs_ = 0.f; v4u pw[4]; _Pragma("unroll") for (int q_ = 0; q_ < 4; ++q_) pw[q_] = (v4u){0u, 0u, 0u, 0u}; \
        _Pragma("unroll") for (int g = 0; g < 8; ++g) {             \
            if (hn_) { if (g == 0) SN0 = MF(kf[0], qr[0], zero16); else if (g == 1) SN1 = MF(kf[1], qr[0], zero16); else if (g & 1) SN1 = MF(kf[g], qr[g >> 1], SN1); else SN0 = MF(kf[g], qr[g >> 1], SN0); } \
            if (g < 4) { _Pragma("unroll") for (int e = 0; e < 4; ++e) { SC0[4 * g + e] = __builtin_amdgcn_exp2f(SC0[4 * g + e]); rs_ += SC0[4 * g + e]; } \
                         pw[g >> 1][2 * (g & 1)] = cvtpk(SC0[4 * g], SC0[4 * g + 1]); pw[g >> 1][2 * (g & 1) + 1] = cvtpk(SC0[4 * g + 2], SC0[4 * g + 3]); \
                         asm volatile("" : "+v"(SC0), "+v"(pw[g >> 1]), "+v"(rs_)); } \
            else { const int g4 = g - 4;   \
                         vlo[g4] = vtr(vp_ + g4 * 1024); vhi[g4] = vtr(vp_ + g4 * 1024 + 512); vlo[4 + g4] = vtr(vp_ + 4096 + g4 * 1024); vhi[4 + g4] = vtr(vp_ + 4096 + g4 * 1024 + 512); \
                         _Pragma("unroll") for (int e = 0; e < 4; ++e) { SC1[4 * g4 + e] = __builtin_amdgcn_exp2f(SC1[4 * g4 + e]); rs_ += SC1[4 * g4 + e]; } \
                         pw[2 + (g4 >> 1)][2 * (g4 & 1)] = cvtpk(SC1[4 * g4], SC1[4 * g4 + 1]); pw[2 + (g4 >> 1)][2 * (g4 & 1) + 1] = cvtpk(SC1[4 * g4 + 2], SC1[4 * g4 + 3]); \
                         asm volatile("" : "+v"(SC1), "+v"(pw[2 + (g4 >> 1)]), "+v"(rs_)); } \
            SBAR(); } \
        l += rs_; \
        if (hn_) { ATT_MASK(SN0, SN1, (t) + 1); if (__builtin_expect(__any(m != 0.f), 0)) { _Pragma("unroll") for (int r = 0; r < 16; ++r) { SN0[r] -= m; SN1[r] -= m; } } \
                   asm volatile("s_nop 15\n\ts_nop 7" : "+v"(SN0), "+v"(SN1)); } \
        float ma_ = -3.0e38f, mc_ = -3.0e38f; \
        _Pragma("unroll") for (int g = 0; g < 8; ++g) {             \
            const int ks = g >> 1; const bf16x8 pf = __builtin_bit_cast(bf16x8, pw[ks]); \
            if (g & 1) { const bf16x8 v1 = (bf16x8){vlo[4 + ks][0], vlo[4 + ks][1], vlo[4 + ks][2], vlo[4 + ks][3], vhi[4 + ks][0], vhi[4 + ks][1], vhi[4 + ks][2], vhi[4 + ks][3]}; o1 = MF(v1, pf, o1); } \
            else { const bf16x8 v0 = (bf16x8){vlo[ks][0], vlo[ks][1], vlo[ks][2], vlo[ks][3], vhi[ks][0], vhi[ks][1], vhi[ks][2], vhi[ks][3]}; o0 = MF(v0, pf, o0); } \
            if (hn_) { if (g < 4) { ma_ = max3f(ma_, SN0[4 * g], SN0[4 * g + 1]); mc_ = max3f(mc_, SN0[4 * g + 2], SN0[4 * g + 3]); } \
                       else { ma_ = max3f(ma_, SN1[4 * (g - 4)], SN1[4 * (g - 4) + 1]); mc_ = max3f(mc_, SN1[4 * (g - 4) + 2], SN1[4 * (g - 4) + 3]); } \
                       asm volatile("" : "+v"(ma_), "+v"(mc_)); } \
            SBAR(); } \
        if (hn_) ATT_DECIDE(SN0, SN1, max2f(ma_, mc_)); \
    } while (0)
    {
        int t = 0;
        for (; t + 2 < NT; t += 2) { ATT_STEP(sA0, sA1, sB0, sB1, t, true); ATT_STEP(sB0, sB1, sA0, sA1, t + 1, true); }
        if (t + 2 == NT) { ATT_STEP(sA0, sA1, sB0, sB1, t, true); ATT_STEP(sB0, sB1, sA0, sA1, t + 1, false); }
        else { ATT_STEP(sA0, sA1, sB0, sB1, t, false); }
    }
#undef ATT_STEP
#undef ATT_DECIDE
#undef ATT_MASK
#undef KFRAG
#undef MF
#undef SBAR
#undef ATT_TILE
#undef ATT_ISSUE
#undef ATT_WAIT
    ATT_BAR();
    float ltot = swapsum(l); if (GRP == 0) ltot += __builtin_amdgcn_exp2f(p.a_sink[h] * LOG2E - m);
    const float inv = 1.f / ltot;
    int lane_e = lane; asm volatile("" : "+v"(lane_e));
    const int r32e = lane_e & 31, hie = lane_e >> 5;
    LAS unsigned char* ost = lds + wid * OST_WAVE;
#pragma unroll
    for (int g = 0; g < 4; ++g) {
        v2u w0, w1;
        w0.x = cvtpk(o0[4 * g] * inv, o0[4 * g + 1] * inv); w0.y = cvtpk(o0[4 * g + 2] * inv, o0[4 * g + 3] * inv);
        w1.x = cvtpk(o1[4 * g] * inv, o1[4 * g + 1] * inv); w1.y = cvtpk(o1[4 * g + 2] * inv, o1[4 * g + 3] * inv);
        *(LAS v2u*)(ost + r32e * OST_PITCH + (8 * g + 4 * hie) * 2) = w0;
        *(LAS v2u*)(ost + r32e * OST_PITCH + (32 + 8 * g + 4 * hie) * 2) = w1;
    }
    asm volatile("s_waitcnt lgkmcnt(0)" ::: "memory");
    bf16* Ob = (bf16*)(p.ws + (ABL ? WS_OX : WS_O)) + ((size_t)b * T + q0w) * D + GRP * 512 + h * 64;
    float* ssq = (float*)(p.ws + (ABL ? 256 * MiB : WS_SSQ)) + ((size_t)b * T + q0w) * 16 + GRP * 8 + h;
#pragma unroll
    for (int i = 0; i < 4; ++i) {
        const int row = i * 8 + (lane_e >> 3), ch = lane_e & 7;
        const v4u v = *(const LAS v4u*)(ost + row * OST_PITCH + ch * 16);
        st16(Ob + (size_t)row * D + ch * 8, v);
        float ss = 0.f;
#pragma unroll
        for (int q = 0; q < 4; ++q) { const float a = __uint_as_float(v[q] << 16), c = __uint_as_float(v[q] & 0xffff0000u); ss += a * a + c * c; }
        ss += __shfl_xor(ss, 1); ss += __shfl_xor(ss, 2); ss += __shfl_xor(ss, 4);
        if (ch == 0) ssq[(size_t)row * 16] = ss;
    }
    asm volatile("s_waitcnt vmcnt(0) lgkmcnt(0)" ::: "memory");
    ATT_BAR();
#undef ATT_BAR
}
template <int ABL = 0>
__device__ __forceinline__ void attn_phase(const P& p, LAS unsigned char* lds, int vcu, int G) {
    if (ABL & 64) return;
    const int wid = __builtin_amdgcn_readfirstlane(threadIdx.x >> 6), lane = threadIdx.x & 63, gw = vcu * 8 + wid;
    WConv wc; wc.next = (WCONV_IN_ATTN && G * 8 == 2048 && ABL == 0) ? 0 : WC_PER_WAVE; wc.j0 = -1; wc.j1 = -1; wc.gstep = 0; wc.cm1 = 0; wc.cm2 = 0;
    for (int u = vcu; u < 512; u += G) attn_unit<1, ABL>(p, lds, (u >> 5) >> 1, (u >> 5) & 1, u & 31, wc, gw);
    for (int u = vcu; u < 512; u += G) attn_unit<0, ABL>(p, lds, (u >> 5) >> 1, (u >> 5) & 1, u & 31, wc, gw);
    if (WCONV_IN_ATTN && ABL == 0) {
        if (G * 8 == 2048) {
            if (wc.j0 >= 0) wc_consume(p, gw, wc.j0, lds + WC_LDS + wid * 8192, lane);
            if (wc.j1 >= 0) wc_consume(p, gw, wc.j1, lds + WC_LDS + wid * 8192 + 4096, lane);
            for (; wc.next < WC_PER_WAVE; ++wc.next) { asm volatile("s_waitcnt lgkmcnt(0)" ::: "memory"); wc_issue(p, gw, wc.next, (unsigned)(uintptr_t)lds + WC_LDS + wid * 8192, lane);
                asm volatile("s_waitcnt vmcnt(0)" ::: "memory"); wc_consume(p, gw, wc.next, lds + WC_LDS + wid * 8192, lane); }
        } else {
            for (int hx = gw; hx < 49152; hx += G * 8) { asm volatile("s_waitcnt lgkmcnt(0)" ::: "memory"); wc_issue(p, hx & 2047, hx >> 11, (unsigned)(uintptr_t)lds + WC_LDS + wid * 8192, lane);
                asm volatile("s_waitcnt vmcnt(0)" ::: "memory"); wc_consume(p, hx & 2047, hx >> 11, lds + WC_LDS + wid * 8192, lane); }
        }
    }
}
}

struct Frame {
    LAS unsigned char* lds;
    volatile LAS unsigned* MISC;
    int tid, lane, wave, vcu, G;
};

__device__ __forceinline__ void p0_transpose_item(const float* W, int N, bf16* WT, int dpitch, int drow0, int k0, int n0, LAS float* scr, int lane, const float* gain) {
#pragma unroll
    for (int i = 0; i < 32; ++i) { const int kk = 2 * i + (lane >> 5); float v = W[(size_t)(k0 + kk) * N + n0 + (lane & 31)]; if (gain) v *= gain[kk]; scr[kk * 33 + (lane & 31)] = v; }
    LDS_WAIT(); asm volatile("" ::: "memory");
    const int c = lane & 7;
#pragma unroll
    for (int j = 0; j < 4; ++j) { const int n = (lane >> 3) + 8 * j; const LAS float* s = scr + (8 * c) * 33 + n;
        v4u o; o.x = pk2(s[0 * 33], s[1 * 33]); o.y = pk2(s[2 * 33], s[3 * 33]); o.z = pk2(s[4 * 33], s[5 * 33]); o.w = pk2(s[6 * 33], s[7 * 33]);
        *(GAS v4u*)(WT + (size_t)(drow0 + n) * dpitch + k0 + 8 * c) = o; }
    LDS_WAIT(); asm volatile("" ::: "memory");
}
__device__ __forceinline__ void p0_prologue(const P& p, Frame& F) {
    float* modx = (float*)(p.ws + WS_MODX);
    if (F.vcu < 96) {
        LAS float* s = (LAS float*)F.lds;
        LAS float* part = (LAS float*)(F.lds + 40960);
        for (int i = F.tid; i < 9 * D; i += NTHR) { const int r = i >> 10, k = i & 1023; const float v = r < 8 ? p.c[r * D + k] : p.c_ctx[k]; s[i] = silu_f(v); }
        __syncthreads();
        const int n = F.vcu * 64 + F.lane; float acc[9];
#pragma unroll
        for (int r = 0; r < 9; ++r) acc[r] = 0.f;
        const float* wp = p.w_mod + (size_t)(F.wave * 128) * 6144 + n;
#pragma unroll 4
        for (int k4 = 0; k4 < 128; k4 += 4) {
            float wv[4];
#pragma unroll
            for (int j = 0; j < 4; ++j) wv[j] = wp[(size_t)(k4 + j) * 6144];
#pragma unroll
            for (int r = 0; r < 9; ++r) { const f32x4 sv = *(const LAS f32x4*)(s + r * D + F.wave * 128 + k4); acc[r] += sv.x * wv[0]; acc[r] += sv.y * wv[1]; acc[r] += sv.z * wv[2]; acc[r] += sv.w * wv[3]; }
        }
#pragma unroll
        for (int r = 0; r < 9; ++r) part[(F.wave * 9 + r) * 64 + F.lane] = acc[r];
        __syncthreads();
        for (int i = F.tid; i < 9 * 64; i += NTHR) { const int r = i >> 6, l = i & 63; float sum = 0.f;
#pragma unroll
            for (int w = 0; w < 8; ++w) sum += part[(w * 9 + r) * 64 + l];
            modx[r * 6144 + F.vcu * 64 + l] = sum + p.b_mod[F.vcu * 64 + l]; }
        __syncthreads();
    }
    if (F.vcu == 96) {
        float2* tab = (float2*)(p.ws + WS_ROPE);
        for (int idx = F.tid; idx < 96 * 16; idx += NTHR) {
            const int pos = idx >> 4, i = idx & 15;
            const float invf = exp2f(-(float)i * (13.287712379549449f / 16.f));
            const float pv = (float)(pos < 32 ? pos : pos - 32);
            float rev = pv * invf * 0.15915494309189535f; rev -= rintf(rev);
            tab[idx] = make_float2(__builtin_amdgcn_cosf(rev), __builtin_amdgcn_sinf(rev));
        }
    }
    for (int nb = F.vcu - 97; nb >= 0 && nb < 48; nb += F.G) {
        bf16* wr = (bf16*)(p.ws + WS_WR);
        for (int i = nb * 1024 + F.tid; i < (nb + 1) * 1024; i += NTHR) {
            const int j = i & 7, ln = (i >> 3) & 63, q = i >> 9, nt = q % 3, ks = q / 3;
            const int k = 32 * ks + 8 * (ln >> 4) + j, n = 16 * nt + (ln & 15);
            const float w = n < 4 ? p.w_group[k * 4 + n] : n < 36 ? p.w_router[k * 32 + (n - 4)] : 0.f;
            const unsigned hi = f2bf(w); const unsigned lo = f2bf(w - bf2f((bf16)hi));
            wr[i] = (bf16)hi; wr[48 * D + i] = (bf16)lo; }
    }
    LAS float* scr = (LAS float*)(F.lds + F.wave * 16384);
    const int gw = F.vcu * NWAVES + F.wave, NGW = F.G * NWAVES;
    constexpr int I_IN = 16 * 48, I_OUT = 16 * 32, I_G = 32 * 256, I_D = 32 * 256, NITEMS = WCONV_IN_ATTN ? I_IN + I_OUT : I_IN + I_OUT + 2 * I_G + I_D;
    for (int it = gw; it < NITEMS; it += NGW) {
        int r = it;
        if (r < I_IN) { const int kb = r / 48, nb = r % 48; p0_transpose_item(p.w_in, NQKV, (bf16*)(p.ws + WS_WQKV), D, qkv_row(nb * 32), kb * 64, nb * 32, scr, F.lane, nullptr); continue; } r -= I_IN;
        if (r < I_OUT) { const int kb = r / 32, nb = r % 32; const float* g = kb < 8 ? p.aon + kb * 64 : p.bon + (kb - 8) * 64;
            p0_transpose_item(p.w_out, D, (bf16*)(p.ws + WS_WO), D, nb * 32, kb * 64, nb * 32, scr, F.lane, g); continue; } r -= I_OUT;
        if (r < 2 * I_G) { const int up = r >= I_G; if (up) r -= I_G; const int e = r >> 8, q = r & 255, kb = q >> 4, nb = q & 15; const int j0 = nb * 32;
            p0_transpose_item((up ? p.w_up : p.w_gate) + (size_t)e * 1024 * 512, 512, (bf16*)(p.ws + WS_WGU) + (size_t)e * 1024 * 1024, D, (j0 >> 7) * 256 + up * 128 + (j0 & 127), kb * 64, j0, scr, F.lane, nullptr); continue; } r -= 2 * I_G;
        { const int e = r >> 8, q = r & 255, kb = q >> 5, nb = q & 31;
            p0_transpose_item(p.w_down + (size_t)e * 512 * 1024, D, (bf16*)(p.ws + WS_WD) + (size_t)e * 1024 * 512, EFF, nb * 32, kb * 64, nb * 32, scr, F.lane, nullptr); }
    }
}
__device__ __forceinline__ void p1_norm(const P& p, Frame& F) {
    const int gw = F.vcu * NWAVES + F.wave, NGW = F.G * NWAVES;
    const float* modall = (const float*)(p.ws + WS_MODX);
    for (int r = gw; r < MT; r += NGW) {
        const float* src = r < ML ? p.x + (size_t)r * D : p.ctx + (size_t)(r - ML) * D;
        const float* modx = modall + (r < ML ? (r / T) : 8) * 6144;
        const GAS f32x4* xr = (const GAS f32x4*)src + F.lane;
        f32x4 v[4]; float s = 0.f;
#pragma unroll
        for (int j = 0; j < 4; ++j) { v[j] = xr[64 * j]; s += (v[j].x * v[j].x + v[j].y * v[j].y) + (v[j].z * v[j].z + v[j].w * v[j].w); }
        const float rn = rsqrtf(wave_sum(s) * (1.f / D) + EPS);
        GAS v2u* o8 = (GAS v2u*)((bf16*)(p.ws + WS_XN) + (size_t)r * D) + F.lane;
#pragma unroll
        for (int j = 0; j < 4; ++j) { const int k = 4 * (F.lane + 64 * j);
            const f32x4 g = *(const f32x4*)(p.pre1 + k), sc = *(const f32x4*)(modx + 1024 + k), sh = *(const f32x4*)(modx + k);
            const f32x4 h = v[j] * rn * g * (sc + 1.f) + sh;
            v2u w; w.x = pk2(h.x, h.y); w.y = pk2(h.z, h.w); st8((void*)(o8 + 64 * j), w); }
    }
}


constexpr int LDS_X = 147456;
__device__ __forceinline__ void p4_outproj(const P& p, Frame& F) {
    LAS float* tab = (LAS float*)(F.lds + LDS_X);
    for (int i = 0;; ++i) {
        const int L = i * F.G + (int)blockIdx.x; if (L >= 256) break;
        const int xcd = L & 7, off = L >> 3, w = xcd * 32 + off;
        pg8::Unit u; u.pm = (w >> 5) * 8 + (w & 7); u.pn = (w & 31) >> 3;
        if (F.tid < 256) {
            const f32x4* s4 = (const f32x4*)((const float*)(p.ws + WS_SSQ) + (size_t)(u.pm * 256 + F.tid) * 16);
            const f32x4 a0 = s4[0], a1 = s4[1], b0 = s4[2], b1 = s4[3];
            const float sa = ((a0.x + a0.y) + (a0.z + a0.w)) + ((a1.x + a1.y) + (a1.z + a1.w)), sb = ((b0.x + b0.y) + (b0.z + b0.w)) + ((b1.x + b1.y) + (b1.z + b1.w));
            const float ra = rsqrtf(sa * (1.f / 512.f) + EPS), rb = rsqrtf(sb * (1.f / 512.f) + EPS);
            tab[2 * F.tid] = ra / rb; tab[2 * F.tid + 1] = rb;
        }
        __syncthreads();
        pg8::Gemm g{(const pg8::bf16_t*)(p.ws + WS_O), (const pg8::bf16_t*)(p.ws + WS_WO), ML, D, D};
        pg8::SchedOne S{u};
        pg8::EpiOut E{(bf16*)(p.ws + WS_OX), tab};
        pg8::gemm_phase<pg8::EpiOut, pg8::SchedOne, false, true, false>((PG8_LAS unsigned char*)F.lds, g, S, E);
    }
}
constexpr int P5_PITCH = 2064;
constexpr int P5_PART = 64 * P5_PITCH, P5_LG = 0;
static_assert(P5_PART + 8 * 16 * 48 * 4 <= MISC_OFF && 64 * 48 * 4 <= P5_PART, "P5 LDS map");
__device__ __forceinline__ void p5_rowpass(const P& p, Frame& F, int abl = 0) {
    LAS unsigned char* LO = F.lds;
    LAS float* PART = (LAS float*)(F.lds + P5_PART); LAS float* LG = (LAS float*)(F.lds + P5_LG);
    LAS int* hist = (LAS int*)(F.lds + MISC_OFF) + 64;
    const bf16* WRh = (const bf16*)(p.ws + WS_WR); const bf16* WRl = WRh + 48 * D;
    for (int rb = F.vcu; rb < ML / 64; rb += F.G) {
        if (F.tid < 32) hist[F.tid] = 0;
        const int b = (rb * 64) / T;
        const float* modx = (const float*)(p.ws + WS_MODX) + b * 6144;
        if (!(abl & 2)) {
            f32x4 gp[4], mp[4], ap[4];
#pragma unroll
            for (int j = 0; j < 4; ++j) { const int k = 256 * j + 4 * F.lane;
                gp[j] = *(const f32x4*)(modx + 2048 + k) * *(const f32x4*)(p.post1 + k);
                mp[j] = *(const f32x4*)(p.pre2 + k) * (*(const f32x4*)(modx + 4096 + k) + 1.f);
                ap[j] = *(const f32x4*)(modx + 3072 + k); }
            f32x4 xn[4]; v2u on[4];
#define P5_LOAD(rw) do { _Pragma("unroll") for (int j = 0; j < 4; ++j) { xn[j] = *(const f32x4*)(p.x + (size_t)(rw) * D + 256 * j + 4 * F.lane); \
                on[j] = *(const v2u*)((const bf16*)(p.ws + WS_OX) + (size_t)(rw) * D + 256 * j + 4 * F.lane); } } while (0)
            P5_LOAD(rb * 64 + F.wave * 8);
            for (int rr = 0; rr < 8; ++rr) {
                const int rl = F.wave * 8 + rr, row = rb * 64 + rl;
                f32x4 xv[4], ox[4]; v2u oc[4]; float ss = 0.f;
#pragma unroll
                for (int j = 0; j < 4; ++j) { xv[j] = xn[j]; oc[j] = on[j]; }
                if (rr + 1 < 8) P5_LOAD(row + 1);
#pragma unroll
                for (int j = 0; j < 4; ++j) { const v2u o2 = oc[j];
                    ox[j] = (f32x4){__uint_as_float(o2.x << 16), __uint_as_float(o2.x & 0xffff0000u), __uint_as_float(o2.y << 16), __uint_as_float(o2.y & 0xffff0000u)};
                    ss += (ox[j].x * ox[j].x + ox[j].y * ox[j].y) + (ox[j].z * ox[j].z + ox[j].w * ox[j].w); }
                const float r1 = rsqrtf(wave_sum(ss) * (1.f / D) + EPS);
                float ss2 = 0.f;
#pragma unroll
                for (int j = 0; j < 4; ++j) { xv[j] = xv[j] + gp[j] * (ox[j] * r1);
                    ss2 += (xv[j].x * xv[j].x + xv[j].y * xv[j].y) + (xv[j].z * xv[j].z + xv[j].w * xv[j].w); }
                const float r2 = rsqrtf(wave_sum(ss2) * (1.f / D) + EPS);
                if (F.lane == 0) ((float*)(p.ws + WS_R1))[row] = r1;
#pragma unroll
                for (int j = 0; j < 4; ++j) {
                    const f32x4 h = xv[j] * r2 * mp[j] + ap[j];
                    v2u wh; wh.x = att::cvtpk(h.x, h.y); wh.y = att::cvtpk(h.z, h.w);
                    const f32x4 hb = (f32x4){__uint_as_float(wh.x << 16), __uint_as_float(wh.x & 0xffff0000u), __uint_as_float(wh.y << 16), __uint_as_float(wh.y & 0xffff0000u)};
                    const f32x4 dl = h - hb;
                    v2u wl; wl.x = att::cvtpk(dl.x, dl.y); wl.y = att::cvtpk(dl.z, dl.w);
                    st8((bf16*)(p.ws + WS_XN) + (size_t)row * D + 256 * j + 4 * F.lane, wh);
                    *(LAS v2u*)(LO + rl * P5_PITCH + (256 * j + 4 * F.lane) * 2) = wl;
                }
            }
#undef P5_LOAD
        }
        asm volatile("s_waitcnt vmcnt(0)" ::: "memory");
        __syncthreads();
        if (F.tid == 0) { __builtin_amdgcn_fence(__ATOMIC_ACQUIRE, "agent"); asm volatile("s_waitcnt vmcnt(0)" ::: "memory"); }
        __syncthreads();
        if (abl & 1) continue;
        {
            const int gI = F.wave >> 1, kq = F.wave & 1, r16 = F.lane & 15, g4 = F.lane >> 4;
            f32x4 acc[3];
#pragma unroll
            for (int nt = 0; nt < 3; ++nt) acc[nt] = (f32x4){0.f, 0.f, 0.f, 0.f};
            const bf16* ah = (const bf16*)(p.ws + WS_XN) + (size_t)(rb * 64 + 16 * gI + r16) * D + 512 * kq + 8 * g4;
            const LAS unsigned char* al = LO + (16 * gI + r16) * P5_PITCH + (512 * kq + 8 * g4) * 2;
            const bf16* bh = WRh + (size_t)(16 * kq) * 3 * 512 + F.lane * 8; const bf16* bl = WRl + (size_t)(16 * kq) * 3 * 512 + F.lane * 8;
#pragma unroll 8
            for (int ks = 0; ks < 16; ++ks) {
                const bf16x8 a_hi = *(const bf16x8*)(ah + ks * 32), a_lo = *(const LAS bf16x8*)(al + ks * 64);
#pragma unroll
                for (int nt = 0; nt < 3; ++nt) {
                    const bf16x8 b_hi = *(const bf16x8*)(bh + (ks * 3 + nt) * 512), b_lo = *(const bf16x8*)(bl + (ks * 3 + nt) * 512);
                    acc[nt] = __builtin_amdgcn_mfma_f32_16x16x32_bf16(a_hi, b_hi, acc[nt], 0, 0, 0);
                    acc[nt] = __builtin_amdgcn_mfma_f32_16x16x32_bf16(a_hi, b_lo, acc[nt], 0, 0, 0);
                    acc[nt] = __builtin_amdgcn_mfma_f32_16x16x32_bf16(a_lo, b_hi, acc[nt], 0, 0, 0);
                }
            }
#pragma unroll
            for (int nt = 0; nt < 3; ++nt)
#pragma unroll
                for (int q = 0; q < 4; ++q) PART[(F.wave * 16 + 4 * g4 + q) * 48 + 16 * nt + r16] = acc[nt][q];
        }
        __syncthreads();
        for (int i = F.tid; i < 64 * 48; i += NTHR) { const int row = i / 48, n = i - row * 48, gI = row >> 4, r16 = row & 15;
            LG[i] = (PART[((gI * 2 + 0) * 16 + r16) * 48 + n] + PART[((gI * 2 + 1) * 16 + r16) * 48 + n]) + (n < 4 ? p.b_group[n] : n < 36 ? p.b_router[n - 4] : 0.f); }
        __syncthreads();
        if (F.tid < 64) {
            float lg[36];
#pragma unroll
            for (int c = 0; c < 36; ++c) lg[c] = LG[F.tid * 48 + c];
            int e1, e2; float w1, w2;
            {
                int g = 0; float gm = lg[0];
#pragma unroll
                for (int q = 1; q < 4; ++q) if (lg[q] > gm) { gm = lg[q]; g = q; }
                float gs = 0.f;
#pragma unroll
                for (int q = 0; q < 4; ++q) gs += __expf(lg[q] - gm);
                const float gw = 1.f / gs;
                float el[8];
#pragma unroll
                for (int q = 0; q < 8; ++q) el[q] = g == 0 ? lg[4 + q] : g == 1 ? lg[12 + q] : g == 2 ? lg[20 + q] : lg[28 + q];
                int i1 = 0; float m1 = el[0];
#pragma unroll
                for (int q = 1; q < 8; ++q) if (el[q] > m1) { m1 = el[q]; i1 = q; }
                int i2 = -1; float m2 = -3.0e38f;
#pragma unroll
                for (int q = 0; q < 8; ++q) if (q != i1 && el[q] > m2) { m2 = el[q]; i2 = q; }
                const float ex = __expf(m2 - m1);
                w1 = gw / (1.f + ex); w2 = gw * ex / (1.f + ex); e1 = g * 8 + i1; e2 = g * 8 + i2;
            }
            const int row = rb * 64 + F.tid;
            if (!(abl & 2)) { int* te = (int*)(p.ws + WS_TOKE) + row * 2; float* tw = (float*)(p.ws + WS_TOKW) + row * 2; te[0] = e1; te[1] = e2; tw[0] = w1; tw[1] = w2; }
            atomicAdd((int*)&hist[e1 & 31], 1); atomicAdd((int*)&hist[e2 & 31], 1);
        }
        __syncthreads();
        if (F.tid < 32 && !(abl & 2)) ((int*)(p.ws + WS_BLKCNT))[rb * 32 + F.tid] = hist[F.tid];
        __syncthreads();
    }
}
__device__ __forceinline__ void p6_lists(const P& p, Frame& F) {
    LAS int* ps = (LAS int*)F.lds;
    LAS int* pp = ps + 512;
    LAS int* tot = pp + 512; LAS int* pre = tot + 32; LAS int* ebase = pre + 32;
    LAS int* es = ebase + 40;
    const int* blk = (const int*)(p.ws + WS_BLKCNT);
    int* meta = (int*)(p.ws + WS_META);
    for (int rb = F.vcu; rb < ML / 64; rb += F.G) {
        { const int e = F.tid & 31, part = F.tid >> 5; int s = 0, q = 0;
#pragma unroll 4
          for (int j = 0; j < 16; ++j) { const int bb = part * 16 + j; const int v = blk[bb * 32 + e]; s += v; q += bb < rb ? v : 0; }
          ps[part * 32 + e] = s; pp[part * 32 + e] = q; }
        __syncthreads();
        if (F.tid < 32) { int s = 0, q = 0;
#pragma unroll
            for (int part = 0; part < 16; ++part) { s += ps[part * 32 + F.tid]; q += pp[part * 32 + F.tid]; }
            tot[F.tid] = s; pre[F.tid] = q; }
        __syncthreads();
        if (F.tid == 0) { int tb = 0; for (int e = 0; e < 32; ++e) { ebase[e] = tb; tb += (tot[e] + 255) >> 8; } ebase[32] = tb; }
        if (F.tid < 128) es[F.tid] = ((const int*)(p.ws + WS_TOKE))[rb * 128 + F.tid];
        __syncthreads();
        if (F.tid < 128) {
            const int e = es[F.tid]; int rank = 0;
            for (int a = 0; a < F.tid; ++a) rank += es[a] == e ? 1 : 0;
            const int pos = ebase[e] * 256 + pre[e] + rank;
            ((int*)(p.ws + WS_ROWIDX))[pos] = rb * 64 + (F.tid >> 1);
            ((float*)(p.ws + WS_ROWW))[pos] = ((const float*)(p.ws + WS_TOKW))[rb * 128 + F.tid];
            ((int*)(p.ws + WS_TOKPOS))[rb * 128 + F.tid] = pos;
        }
        if (rb < 32) {
            const int e = rb, lo = ebase[e] * 256 + tot[e], hi = ebase[e + 1] * 256;
            for (int pos = lo + F.tid; pos < hi; pos += NTHR) { ((int*)(p.ws + WS_ROWIDX))[pos] = 0; ((float*)(p.ws + WS_ROWW))[pos] = 0.f; }
            for (int t = ebase[e] + F.tid; t < ebase[e + 1]; t += NTHR) meta[128 + t] = e;
            if (F.tid == 0) { meta[e] = tot[e]; meta[64 + e] = ebase[e]; if (e == 31) { meta[64 + 32] = ebase[32]; meta[320] = ebase[32]; } }
        }
        __syncthreads();
    }
}
__device__ __forceinline__ void p78_moe(const P& p, Frame& F, bool down) {
    LAS int* tile_e = (LAS int*)(F.lds + LDS_X);
    const int* meta = (const int*)(p.ws + WS_META);
    for (int t = F.tid; t < MAXTILES; t += NTHR) tile_e[t] = meta[128 + t] & 31;
    __syncthreads();
    const int ntiles = meta[320];
    pg8::SchedMoE S{F.G, (int)blockIdx.x, ntiles * 4, tile_e, (const int*)(p.ws + WS_ROWIDX)};
    if (!down) {
        pg8::Gemm g{(const pg8::bf16_t*)(p.ws + WS_XN), (const pg8::bf16_t*)(p.ws + WS_WGU), MAXPOS, NE * 1024, D};
        pg8::EpiGU E{(bf16*)(p.ws + WS_ACT), (const float*)(p.ws + WS_ROWW)};
        pg8::gemm_phase<pg8::EpiGU, pg8::SchedMoE, true, true, true>((PG8_LAS unsigned char*)F.lds, g, S, E);
    } else {
        pg8::Gemm g{(const pg8::bf16_t*)(p.ws + WS_ACT), (const pg8::bf16_t*)(p.ws + WS_WD), MAXPOS, NE * 1024, EFF};
        pg8::EpiY E{(bf16*)(p.ws + WS_Y)};
        pg8::gemm_phase<pg8::EpiY, pg8::SchedMoE, true, true, false>((PG8_LAS unsigned char*)F.lds, g, S, E);
    }
}
__device__ __forceinline__ void p9_final(const P& p, Frame& F, float* dst) {
    const bf16* Y = (const bf16*)(p.ws + WS_Y); const bf16* OX = (const bf16*)(p.ws + WS_OX); const float* R1 = (const float*)(p.ws + WS_R1);
    for (int rb = F.vcu; rb < ML / 64; rb += F.G) {
        const int b = (rb * 64) / T;
        const float* modx = (const float*)(p.ws + WS_MODX) + b * 6144;
        const int row0 = rb * 64 + F.wave * 8;
        f32x4 gp[4], g1p[4];
#pragma unroll
        for (int j = 0; j < 4; ++j) { const int k = 256 * j + 4 * F.lane; gp[j] = *(const f32x4*)(modx + 5120 + k) * *(const f32x4*)(p.post2 + k); g1p[j] = *(const f32x4*)(modx + 2048 + k) * *(const f32x4*)(p.post1 + k); }
        v2u ya[2][4], yc[2][4], oo[2][4]; f32x4 xo[2][4]; float r1v[2];
        const int* tpp = (const int*)(p.ws + WS_TOKPOS) + row0 * 2;
#define P9_LOAD(buf, rw, t2) do { r1v[buf] = R1[rw]; _Pragma("unroll") for (int j = 0; j < 4; ++j) { \
            ya[buf][j] = *(const v2u*)(Y + (size_t)(t2).x * D + 256 * j + 4 * F.lane); yc[buf][j] = *(const v2u*)(Y + (size_t)(t2).y * D + 256 * j + 4 * F.lane); \
            oo[buf][j] = *(const v2u*)(OX + (size_t)(rw) * D + 256 * j + 4 * F.lane); xo[buf][j] = *(const f32x4*)(p.x + (size_t)(rw) * D + 256 * j + 4 * F.lane); } } while (0)
#define P9_COMP(buf, rw) do { f32x4 y[4]; float ss = 0.f; \
            _Pragma("unroll") for (int j = 0; j < 4; ++j) { const v2u a = ya[buf][j], c = yc[buf][j]; \
                y[j] = (f32x4){__uint_as_float(a.x << 16) + __uint_as_float(c.x << 16), __uint_as_float(a.x & 0xffff0000u) + __uint_as_float(c.x & 0xffff0000u), \
                               __uint_as_float(a.y << 16) + __uint_as_float(c.y << 16), __uint_as_float(a.y & 0xffff0000u) + __uint_as_float(c.y & 0xffff0000u)}; \
                ss += (y[j].x * y[j].x + y[j].y * y[j].y) + (y[j].z * y[j].z + y[j].w * y[j].w); } \
            const float rn = rsqrtf(wave_sum(ss) * (1.f / D) + EPS); \
            _Pragma("unroll") for (int j = 0; j < 4; ++j) { const v2u o2 = oo[buf][j]; \
                const f32x4 oxv = (f32x4){__uint_as_float(o2.x << 16), __uint_as_float(o2.x & 0xffff0000u), __uint_as_float(o2.y << 16), __uint_as_float(o2.y & 0xffff0000u)}; \
                const f32x4 x1 = xo[buf][j] + g1p[j] * (oxv * r1v[buf]);                   \
                *(f32x4*)(dst + (size_t)(rw) * D + 256 * j + 4 * F.lane) = x1 + gp[j] * (y[j] * rn); } } while (0)
        int2 tpA = *(const int2*)(tpp), tpB = *(const int2*)(tpp + 2);
        P9_LOAD(0, row0, tpA);
#pragma unroll 1
        for (int rp = 0; rp < 4; ++rp) {
            const int ra = row0 + 2 * rp;
            P9_LOAD(1, ra + 1, tpB);
            int2 tpA2 = tpA, tpB2 = tpB;
            if (rp < 3) { tpA2 = *(const int2*)(tpp + 4 * rp + 4); tpB2 = *(const int2*)(tpp + 4 * rp + 6); }
            P9_COMP(0, ra);
            if (rp < 3) P9_LOAD(0, ra + 2, tpA2);
            P9_COMP(1, ra + 1);
            tpA = tpA2; tpB = tpB2;
        }
#undef P9_COMP
#undef P9_LOAD
    }
}

struct Args { P p; int ph_lo, ph_hi, li, pad; };
__global__ void __launch_bounds__(NTHR, 2) mega(Args args) {
    extern __shared__ __attribute__((aligned(16))) unsigned char lds_raw[];
    Frame F;
    F.lds = (LAS unsigned char*)lds_raw;
    F.MISC = (volatile LAS unsigned*)(F.lds + MISC_OFF);
    F.tid = threadIdx.x; F.lane = F.tid & 63; F.wave = __builtin_amdgcn_readfirstlane(F.tid >> 6);
    F.G = gridDim.x; { const int bx = blockIdx.x; F.vcu = (F.G % 8 == 0) ? (bx % 8) * (F.G / 8) + bx / 8 : bx; }
    const P& p = args.p;
    unsigned* ctl = (unsigned*)(p.ws + WS_CTL);
    for (int u = F.tid; u < (LDS_BYTES - MISC_OFF) / 4; u += NTHR) ((LAS unsigned*)(F.lds + MISC_OFF))[u] = 0u;
    __syncthreads();
    const int lo = args.ph_lo, hi = args.ph_hi;
    XcdBarrier bar; bar.bar = ctl + CW_BAR + args.li * XCD_BAR_WORDS; bar.x = 0; bar.st = nullptr;
    if (hi - lo > 1) bar = xcd_barrier_post(ctl + CW_BAR + args.li * XCD_BAR_WORDS, F.MISC + 8);
#define IN(k) (lo <= (k) && (k) < hi)
#define SEAM(k) do { if (IN(k) && IN((k) + 1)) xcd_barrier(bar); } while (0)
    if (IN(0)) { p0_prologue(p, F); SEAM(0); }
    if (IN(1)) { p1_norm(p, F); SEAM(1); }
    if (IN(2)) {
        pg8::Gemm g{(const pg8::bf16_t*)(p.ws + WS_XN), (const pg8::bf16_t*)(p.ws + WS_WQKV), MT, NQKV, D};
        pg8::SchedQKV S{F.G, (int)blockIdx.x};
        pg8::EpiQKV E{p.ws, p.bqn, p.bkn};
        pg8::gemm_phase<pg8::EpiQKV, pg8::SchedQKV, true, true, false>((PG8_LAS unsigned char*)F.lds, g, S, E);
        SEAM(2);
    }
#ifdef PROBE_ABL
    if (IN(3) && args.pad) { att::attn_phase<PROBE_ABL>(p, F.lds, F.vcu, F.G); } else
#endif
    if (IN(3)) { att::attn_phase<0>(p, F.lds, F.vcu, F.G); SEAM(3); }
    if (IN(4)) { p4_outproj(p, F); SEAM(4); }
#ifdef PROBE_ABL5
    if (IN(5) && args.pad) { p5_rowpass(p, F, PROBE_ABL5); } else
#endif
    if (IN(5)) { p5_rowpass(p, F); SEAM(5); }
    if (IN(6)) { p6_lists(p, F); SEAM(6); }
    if (IN(7)) { p78_moe(p, F, false); SEAM(7); }
    if (IN(8)) { p78_moe(p, F, true); SEAM(8); }
    if (IN(9)) { p9_final(p, F, args.pad ? (float*)(p.ws + WS_WGU) : p.out); }
#undef IN
#undef SEAM
}

#ifndef ONE_LAUNCH
#define ONE_LAUNCH 1
#endif
#ifndef FAST_MASK
#define FAST_MASK 0x3ff
#endif
static void launch_mega(const P& p, int lo, int hi, int li, int grid, hipStream_t stream) {
    Args a{}; a.p = p; a.ph_lo = lo; a.ph_hi = hi; a.li = li; a.pad = 0;
    hipLaunchKernelGGL(mega, dim3(grid), dim3(NTHR), LDS_BYTES, stream, a);
}
extern "C" void kernel_launch(void* const* d_in, const int* in_sizes, int n_in, void* d_out, int out_size, void* d_ws, size_t ws_size, hipStream_t stream) {
    static int grid = 0;
    if (grid == 0) {
        if (n_in != 24 || out_size != ML * D || ws_size < WS_END) { fprintf(stderr, "kernel_launch: unexpected shapes (n_in %d out %d ws %zu)\n", n_in, out_size, ws_size); grid = -1; return; }
        int dev = 0, cus = 0, per_cu = 0;
        if (hipGetDevice(&dev) != hipSuccess || hipDeviceGetAttribute(&cus, hipDeviceAttributeMultiprocessorCount, dev) != hipSuccess) { grid = -1; return; }
        if (hipFuncSetAttribute((const void*)mega, hipFuncAttributeMaxDynamicSharedMemorySize, LDS_BYTES) != hipSuccess) { fprintf(stderr, "kernel_launch: hipFuncSetAttribute failed\n"); grid = -1; return; }
        if (hipOccupancyMaxActiveBlocksPerMultiprocessor(&per_cu, (const void*)mega, NTHR, LDS_BYTES) != hipSuccess || per_cu < 1) { fprintf(stderr, "kernel_launch: occupancy query says %d blocks/CU\n", per_cu); (void)hipGetLastError(); grid = -1; return; }
        grid = cus;
    }
    if (grid < 0) return;
    P p{};
    const float** f = (const float**)&p;
    for (int i = 0; i < 24; ++i) f[i] = (const float*)d_in[i];
    p.out = (float*)d_out; p.ws = (unsigned char*)d_ws;
    (void)hipMemsetAsync((char*)d_ws + WS_CTL, 0, 64 * 1024, stream);
#if ONE_LAUNCH
    launch_mega(p, 0, 10, 0, grid, stream);
#else
    for (int k = 0; k < 10; ++k) {
        launch_mega(p, k, k + 1, 0, grid, stream);
#ifdef PROBE_DUP
        if (k == PROBE_DUP) for (int r_ = 0; r_ < 3; ++r_) { Args a{}; a.p = p; a.ph_lo = k; a.ph_hi = k + 1; a.li = 0; a.pad = 1; hipLaunchKernelGGL(mega, dim3(grid), dim3(NTHR), LDS_BYTES, stream, a); }
#endif
    }
#endif
}
```

```cpp
#include <hip/hip_runtime.h>
#include <cstdio>
#include <cstdint>
#ifndef WCONV_IN_ATTN
#define WCONV_IN_ATTN 1
#endif

constexpr int NB = 8, T = 2048, D = 1024, CL = 256;
constexpr int ML = NB * T;
constexpr int MC = NB * CL;
constexpr int MT = ML + MC;
constexpr int NKEY = T + CL;
constexpr int NTILE = NKEY / 64;
constexpr int NQKV = 1536;
constexpr int NE = 32, EFF = 512;
constexpr int MAXPOS = 40960;
constexpr int MAXTILES = MAXPOS / 256;
constexpr float EPS = 1e-6f;
constexpr float LOG2E = 1.4426950408889634f;
constexpr float C2 = 0.125f * LOG2E;

typedef unsigned short bf16;

constexpr size_t MiB = 1u << 20;
constexpr size_t WS_CTL = 0;
constexpr size_t WS_MODX = 1 * MiB;
constexpr size_t WS_ROPE = 1 * MiB + 512 * 1024;
constexpr size_t WS_WR = 1 * MiB + 768 * 1024;
constexpr size_t WS_TOKE = 2 * MiB;
constexpr size_t WS_TOKW = WS_TOKE + 128 * 1024;
constexpr size_t WS_TOKPOS = WS_TOKW + 128 * 1024;
constexpr size_t WS_ROWIDX = WS_TOKPOS + 128 * 1024;
constexpr size_t WS_ROWW = WS_ROWIDX + 160 * 1024;
constexpr size_t WS_BLKCNT = WS_ROWW + 160 * 1024;
constexpr size_t WS_META = WS_BLKCNT + 32 * 1024;
constexpr size_t WS_WQKV = 4 * MiB;
constexpr size_t WS_WO = 7 * MiB;
constexpr size_t WS_WGU = 9 * MiB;
constexpr size_t WS_WD = 73 * MiB;
constexpr size_t WS_XN = 105 * MiB;
constexpr size_t WS_QA = 141 * MiB;
constexpr size_t WS_QB = 157 * MiB;
constexpr size_t WS_KA = 173 * MiB;
constexpr size_t WS_VA = WS_KA + 4608 * 1024;
constexpr size_t WS_KB = WS_VA + 4608 * 1024;
constexpr size_t WS_VB = WS_KB + 4608 * 1024;
constexpr size_t WS_O = 191 * MiB;
constexpr size_t WS_SSQ = 223 * MiB;
constexpr size_t WS_OX = 261 * MiB;
constexpr size_t WS_R1 = 293 * MiB;
constexpr size_t WS_ACT = 141 * MiB;
constexpr size_t WS_Y = 181 * MiB;
constexpr size_t WS_END = 294 * MiB;

__device__ __forceinline__ unsigned f2bf(float f) { unsigned u = __builtin_bit_cast(unsigned, f); return (u + 0x7fffu + ((u >> 16) & 1u)) >> 16; }
__device__ __forceinline__ float bf2f(bf16 h) { return __builtin_bit_cast(float, (unsigned)h << 16); }
__device__ __forceinline__ float wave_sum(float v) {
#pragma unroll
    for (int o = 1; o < 64; o <<= 1) v += __shfl_xor(v, o);
    return v;
}
__device__ __forceinline__ float wave_max(float v) {
#pragma unroll
    for (int o = 1; o < 64; o <<= 1) v = fmaxf(v, __shfl_xor(v, o));
    return v;
}
__device__ __forceinline__ float silu_f(float v) { return v / (1.f + __expf(-v)); }

__host__ __device__ __forceinline__ int qkv_row(int n) { const int pn = n >> 8, j = n & 255, hh = j >> 6, d = j & 63; return pn * 256 + (d >> 5) * 128 + hh * 32 + (d & 31); }
__host__ __device__ __forceinline__ size_t q_off(int b, int h, int t, int d) { return (((size_t)(b * 8 + h) * T + t) * 64 + d); }
__host__ __device__ __forceinline__ size_t k_off(int b, int kvh, int pos, int d) { return ((size_t)((b * 2 + kvh) * NTILE + (pos >> 6)) * 4096 + (d >> 3) * 512 + (pos & 63) * 8 + (d & 7)); }
__host__ __device__ __forceinline__ size_t v_off(int b, int kvh, int pos, int d) { return ((size_t)((b * 2 + kvh) * NTILE + (pos >> 6)) * 4096 + (d >> 5) * 2048 + (pos & 63) * 32 + (d & 31)); }

struct P {
    const float *x, *c, *ctx, *c_ctx, *w_mod, *b_mod, *pre1, *post1, *w_in, *a_sink, *bqn, *bkn, *aon, *bon, *w_out, *pre2, *post2, *w_group, *b_group, *w_router, *b_router, *w_gate, *w_up, *w_down;
    float* out; unsigned char* ws;
};

#define GAS __attribute__((address_space(1)))
#define LAS __attribute__((address_space(3)))
typedef unsigned v4u __attribute__((ext_vector_type(4)));
typedef unsigned v2u __attribute__((ext_vector_type(2)));
typedef float f32x4 __attribute__((ext_vector_type(4)));
typedef float f32x16 __attribute__((ext_vector_type(16)));
typedef short bf16x8 __attribute__((ext_vector_type(8)));
typedef short s16x4 __attribute__((ext_vector_type(4)));
constexpr int NWAVES = 8, NTHR = 512;
constexpr int LDS_BYTES = 163840;
constexpr int RING_BYTES = 131072;
constexpr int MISC_OFF = 159 * 1024;
constexpr int CW_TMO = 0, CW_CODE = 1, CW_BAR = 4096;
static_assert((CW_BAR + 3456) * 4 <= 64 * 1024, "control words inside the per-call memset");
#define LDS_WAIT() asm volatile("s_waitcnt lgkmcnt(0)" ::: "memory")
#define VM_WAIT() asm volatile("s_waitcnt vmcnt(0)" ::: "memory")
__device__ __forceinline__ unsigned pk2(float lo, float hi) { return f2bf(lo) | (f2bf(hi) << 16); }
#ifndef WT_STORES
#define WT_STORES 0
#endif
__device__ __forceinline__ void st16(void* p, v4u v) {
#if WT_STORES
    asm volatile("global_store_dwordx4 %0, %1, off sc1\n\ts_nop 1" :: "v"(p), "v"(v) : "memory");
#else
    *(v4u*)p = v;
#endif
}
__device__ __forceinline__ void st16f(void* p, f32x4 v) { st16(p, __builtin_bit_cast(v4u, v)); }
__device__ __forceinline__ void st8(void* p, v2u v) {
#if WT_STORES
    asm volatile("global_store_dwordx2 %0, %1, off sc1\n\ts_nop 1" :: "v"(p), "v"(v) : "memory");
#else
    *(v2u*)p = v;
#endif
}

#define XB_TMO      128
#define XB_XCNT(j)  (256  + 64 * (j))
#define XB_XSUB(j)  (1280 + 64 * (j))
#define XB_XGEN(j)  (2304 + 64 * (j))
#define XB_TOP      3328
#define XB_TOPGEN   3392
#define XCD_BAR_WORDS 3456
#define XB_SPIN_CAP (1u << 18)
__device__ __forceinline__ unsigned xb_ld(unsigned* p)              { return __hip_atomic_load(p, __ATOMIC_RELAXED, __HIP_MEMORY_SCOPE_AGENT); }
__device__ __forceinline__ unsigned xb_add(unsigned* p, unsigned v) { return __hip_atomic_fetch_add(p, v, __ATOMIC_RELAXED, __HIP_MEMORY_SCOPE_AGENT); }
__device__ __forceinline__ unsigned xb_xcc_id() { return (unsigned)__builtin_amdgcn_s_getreg((3 << 11) | 20) & 0xFu; }
#define XB_SPIN(cond, bar) do { unsigned _sp = 0; while (cond) { __builtin_amdgcn_s_sleep(1); \
    if ((++_sp & 255u) == 0u) { if (xb_ld(&(bar)[XB_TMO])) break; if (_sp > XB_SPIN_CAP) { atomicAdd(&(bar)[XB_TMO], 1u); break; } } } } while (0)
struct XcdBarrier { unsigned* bar; unsigned x; volatile LAS unsigned* st; };
__device__ __forceinline__ XcdBarrier xcd_barrier_post(unsigned* bar, volatile LAS unsigned* st) {
    XcdBarrier b; b.bar = bar; b.x = xb_xcc_id(); b.st = st;
    if (threadIdx.x == 0) (void)xb_add(&bar[XB_XCNT(b.x)], 1u);
    return b;
}
__device__ __forceinline__ void xcd_barrier_complete(unsigned* bar, unsigned x, unsigned& nloc, unsigned& nx) {
    const unsigned G = gridDim.x * gridDim.y * gridDim.z;
    unsigned sum, cnt, mine, sp = 0u;
    for (;;) {
        sum = 0u; cnt = 0u; mine = 0u;
#pragma unroll
        for (unsigned j = 0; j < 16; ++j) { const unsigned c = xb_ld(&bar[XB_XCNT(j)]); sum += c; cnt += (c > 0u) ? 1u : 0u; mine = (j == x) ? c : mine; }
        if (sum == G) break;
        __builtin_amdgcn_s_sleep(1);
        if ((++sp & 255u) == 0u) { if (xb_ld(&bar[XB_TMO])) break; if (sp > XB_SPIN_CAP) { atomicAdd(&bar[XB_TMO], 1u); break; } }
    }
    nloc = mine > 0u ? mine : 1u; nx = cnt > 0u ? cnt : 1u;
}
__device__ __forceinline__ void xcd_barrier(const XcdBarrier& b) {
    asm volatile("s_waitcnt vmcnt(0)" ::: "memory");
    __syncthreads();
    if (threadIdx.x == 0) {
        unsigned* bar = b.bar;
        __builtin_amdgcn_s_waitcnt(0);
        unsigned nloc = b.st[0], nx = b.st[1];
        if (nloc == 0u) { xcd_barrier_complete(bar, b.x, nloc, nx); b.st[0] = nloc; b.st[1] = nx; }
        const unsigned old = xb_add(&bar[XB_XSUB(b.x)], 1u);
        const unsigned gen = old / nloc;
        if (old + 1u == (gen + 1u) * nloc) {
            __builtin_amdgcn_fence(__ATOMIC_RELEASE, "agent");
            asm volatile("s_waitcnt vmcnt(0)" ::: "memory");
            const unsigned og = xb_add(&bar[XB_TOP], 1u);
            const unsigned tg = og / nx;
            if (og + 1u == (tg + 1u) * nx) xb_add(&bar[XB_TOPGEN], 1u);
            else XB_SPIN(xb_ld(&bar[XB_TOPGEN]) == tg, bar);
            __builtin_amdgcn_fence(__ATOMIC_ACQUIRE, "agent");
            xb_add(&bar[XB_XGEN(b.x)], 1u);
            asm volatile("s_waitcnt vmcnt(0)" ::: "memory");
        } else {
            XB_SPIN(xb_ld(&bar[XB_XGEN(b.x)]) == gen, bar);
            __builtin_amdgcn_fence(__ATOMIC_ACQUIRE, "agent");
            asm volatile("s_waitcnt vmcnt(0)" ::: "memory");
        }
    }
    __syncthreads();
}

namespace pg8 {
#define PG8_LAS __attribute__((address_space(3)))
typedef unsigned short bf16_t;
typedef short bf16x8 __attribute__((ext_vector_type(8)));
typedef float f32x4 __attribute__((ext_vector_type(4)));
typedef unsigned u32x4 __attribute__((ext_vector_type(4)));
constexpr int BM = 256, BK = 64, HALF = 128, HTB = HALF * BK * 2  , STAGE_BYTES = 8 * HTB, NXCD = 8, WGM = 8;

__host__ __device__ __forceinline__ int lds_byte(int r, int c) { const int st = (r >> 4) * 2 + (c >> 5), rr = r & 15, cc = c & 31, ob = rr * 64 + cc * 2; return st * 1024 + (ob ^ (((ob >> 9) & 1) << 5)); }
__host__ __device__ __forceinline__ void stage_rc(int b, int& R, int& C) { const int st = b / 1024, sb = b % 1024, swz = sb ^ (((sb >> 9) & 1) << 5); R = (st >> 1) * 16 + swz / 64; C = (st & 1) * 32 + (swz % 64) / 2; }
__host__ __device__ __forceinline__ int perm32(int rho) { const int n = rho >> 4, i = rho & 15; return 8 * (i >> 2) + 4 * n + (i & 3); }

struct Unit { int pm, pn; };
struct Gemm { const bf16_t* A; const bf16_t* Bt; int M, N, K; };
__device__ __forceinline__ unsigned cvt_pk_bf16(float lo, float hi) { unsigned r; asm volatile("v_cvt_pk_bf16_f32 %0, %1, %2" : "=v"(r) : "v"(lo), "v"(hi)); return r; }
template <class Epi, class Sched, bool ALIGN_EPI = false, bool SP2 = false, bool GATHER = false>
__device__ __forceinline__ void gemm_phase(PG8_LAS unsigned char* lds, const Gemm g, const Sched& S, const Epi& E) {
    const int tid = threadIdx.x, wid = __builtin_amdgcn_readfirstlane(tid >> 6), lane = tid & 63, wr = wid >> 2, wc = wid & 3, fr = lane & 15, fq = lane >> 4;
    const int K = g.K, nt = K / BK;
    unsigned voffA[2], voffB[2]; int RA[2], CA[2];
#pragma unroll
    for (int i = 0; i < 2; ++i) { int R, C; stage_rc(tid * 16 + i * 8192, R, C); const int Rb = Epi::PERM ? ((R & ~31) + perm32(R & 31)) : R;
        voffA[i] = (unsigned)(R * K + C) * 2u; voffB[i] = (unsigned)(Rb * K + C) * 2u; RA[i] = R; CA[i] = C; }
    const size_t kstep = (size_t)(BK * 2);
    const size_t hstep = (size_t)HALF * K * 2;
    const size_t tstep = 2 * hstep;
    const unsigned ldsw = (unsigned)wid * 1024u;
    const int aoff = lds_byte(wr * 64 + fr, fq * 8), boff = lds_byte(wc * 32 + fr, fq * 8);
#define PG8_SA(b, h) (((b) * 2 + (h)) * HTB)
#define PG8_SB(b, h) ((4 + (b) * 2 + (h)) * HTB)
#define PG8_STAGE(bufoff, gbase, voff) do { _Pragma("unroll") for (int _i = 0; _i < 2; ++_i) \
        __builtin_amdgcn_global_load_lds((const unsigned*)((const char*)(gbase) + (voff)[_i]), (PG8_LAS unsigned*)(lds + (bufoff) + ldsw + _i * 8192), 16, 0, 0); } while (0)
#define PG8_STAGE_A(bufoff, gbase, h, VO) do { if constexpr (GATHER) { PG8_STAGE(bufoff, gbase, VO[h]); } else { PG8_STAGE(bufoff, (gbase) + (h) * hstep, voffA); } } while (0)
#define PG8_LDA(dst, b, h) do { _Pragma("unroll") for (int m = 0; m < 4; ++m) _Pragma("unroll") for (int k = 0; k < 2; ++k) dst[m][k] = *(const PG8_LAS bf16x8*)(lds + PG8_SA(b, h) + aoff + m * 2048 + k * 1024); } while (0)
#define PG8_LDB(dst, b, h) do { _Pragma("unroll") for (int n = 0; n < 2; ++n) _Pragma("unroll") for (int k = 0; k < 2; ++k) dst[n][k] = *(const PG8_LAS bf16x8*)(lds + PG8_SB(b, h) + boff + n * 2048 + k * 1024); } while (0)
#define PG8_MMA(ai, bj, At, Bt) do { __builtin_amdgcn_s_setprio(1); _Pragma("unroll") for (int m = 0; m < 4; ++m) _Pragma("unroll") for (int n = 0; n < 2; ++n) _Pragma("unroll") for (int k = 0; k < 2; ++k) \
        acc[ai][bj][m][n] = __builtin_amdgcn_mfma_f32_16x16x32_bf16(Bt[n][k], At[m][k], acc[ai][bj][m][n], 0, 0, 0); __builtin_amdgcn_s_setprio(0); } while (0)
#define PG8_WAIT_V(n) asm volatile("s_waitcnt vmcnt(" #n ")" ::: "memory")
#define PG8_WAIT_L(n) asm volatile("s_waitcnt lgkmcnt(" #n ")" ::: "memory")
#define PG8_BAR __builtin_amdgcn_s_barrier()
#define PG8_SCHED __builtin_amdgcn_sched_barrier(0)
    Unit cur, nxt; int ui = 0;
    if (!S.next(0, cur)) return;
    f32x4 acc[2][2][4][2];
#pragma unroll
    for (int a = 0; a < 2; ++a)
#pragma unroll
        for (int b = 0; b < 2; ++b)
#pragma unroll
            for (int m = 0; m < 4; ++m)
#pragma unroll
                for (int n = 0; n < 2; ++n) acc[a][b][m][n] = (f32x4){0.f, 0.f, 0.f, 0.f};
    bf16x8 At[4][2], B0[2][2], B1[2][2];
    const char* cA = (const char*)g.A + (GATHER ? (size_t)0 : (size_t)cur.pm * tstep); const char* cB = (const char*)g.Bt + (size_t)cur.pn * tstep;
    unsigned vcur[2][2], vnxt[2][2], vsel[2][2];
#pragma unroll
    for (int h = 0; h < 2; ++h)
#pragma unroll
        for (int i = 0; i < 2; ++i) { vcur[h][i] = 0u; vnxt[h][i] = 0u; vsel[h][i] = 0u; }
    if constexpr (GATHER) {
#pragma unroll
        for (int h = 0; h < 2; ++h)
#pragma unroll
            for (int i = 0; i < 2; ++i) vcur[h][i] = ((unsigned)S.rowidx[cur.pm * BM + h * HALF + RA[i]] * (unsigned)K + (unsigned)CA[i]) * 2u;
    }
    S.a_ready(cur);
    if constexpr (SP2) {
        PG8_STAGE(PG8_SB(0, 0), cB, voffB); PG8_STAGE(PG8_SB(0, 1), cB + hstep, voffB); PG8_STAGE_A(PG8_SA(0, 0), cA, 0, vcur); PG8_STAGE_A(PG8_SA(0, 1), cA, 1, vcur);
        if (wr == 1) PG8_BAR;
        PG8_WAIT_V(2); PG8_BAR;
        PG8_STAGE(PG8_SB(1, 0), cB + kstep, voffB); PG8_STAGE_A(PG8_SA(1, 0), cA + kstep, 0, vcur); PG8_STAGE(PG8_SB(1, 1), cB + hstep + kstep, voffB);
        PG8_WAIT_V(6); PG8_BAR;
    } else {
        PG8_STAGE(PG8_SB(0, 0), cB, voffB); PG8_STAGE_A(PG8_SA(0, 0), cA, 0, vcur); PG8_STAGE(PG8_SB(0, 1), cB + hstep, voffB); PG8_STAGE_A(PG8_SA(0, 1), cA, 1, vcur);
        if (wr == 1) PG8_BAR;
        PG8_WAIT_V(4); PG8_BAR;
        PG8_STAGE(PG8_SB(1, 0), cB + kstep, voffB); PG8_STAGE_A(PG8_SA(1, 0), cA + kstep, 0, vcur); PG8_STAGE(PG8_SB(1, 1), cB + hstep + kstep, voffB);
        PG8_WAIT_V(6); PG8_BAR;
    }
    for (;;) {
        const bool has_next = S.next(ui + 1, nxt);
        if constexpr (GATHER) {
#pragma unroll
            for (int h = 0; h < 2; ++h)
#pragma unroll
                for (int i = 0; i < 2; ++i) vnxt[h][i] = has_next ? ((unsigned)S.rowidx[nxt.pm * BM + h * HALF + RA[i]] * (unsigned)K + (unsigned)CA[i]) * 2u : vcur[h][i];
        }
        const char* nA = has_next ? (const char*)g.A + (GATHER ? (size_t)0 : (size_t)nxt.pm * tstep) : cA; const char* nB = has_next ? (const char*)g.Bt + (size_t)nxt.pn * tstep : cB;
        for (int t = 0; t < nt; t += 2) {
            const bool last = (t == nt - 2);
            if constexpr (GATHER) {
#pragma unroll
                for (int h = 0; h < 2; ++h)
#pragma unroll
                    for (int i = 0; i < 2; ++i) vsel[h][i] = last ? vnxt[h][i] : vcur[h][i];
            }
            if constexpr (Epi::HAS_MID) { if (t == nt / 2) E.mid(acc, cur, wr, wc, fr, fq); }
            const char* a1 = cA + (size_t)(t + 1) * kstep;
            const char* a2 = last ? nA : cA + (size_t)(t + 2) * kstep; const char* b2 = last ? nB : cB + (size_t)(t + 2) * kstep;
            const char* a3 = a2 + kstep; const char* b3 = b2 + kstep;
            if (last && has_next) S.a_ready(nxt);
            if constexpr (SP2) {
            PG8_LDB(B0, 0, 0); PG8_LDB(B1, 0, 1); PG8_SCHED; PG8_LDA(At, 0, 0); PG8_STAGE_A(PG8_SA(1, 1), a1, 1, vcur);
            PG8_WAIT_V(8); PG8_WAIT_L(0); PG8_BAR; PG8_MMA(0, 0, At, B0); PG8_MMA(0, 1, At, B1); PG8_BAR; PG8_SCHED;
            PG8_LDA(At, 0, 1); PG8_STAGE(PG8_SB(0, 0), b2, voffB); PG8_STAGE(PG8_SB(0, 1), b2 + hstep, voffB); PG8_STAGE_A(PG8_SA(0, 0), a2, 0, vsel);
            PG8_WAIT_V(8); PG8_WAIT_L(0); PG8_BAR; PG8_MMA(1, 0, At, B0); PG8_MMA(1, 1, At, B1); PG8_BAR; PG8_SCHED;
            PG8_LDB(B0, 1, 0); PG8_LDB(B1, 1, 1); PG8_SCHED; PG8_LDA(At, 1, 0); PG8_STAGE_A(PG8_SA(0, 1), a2, 1, vsel);
            PG8_WAIT_V(8); PG8_WAIT_L(0); PG8_BAR; PG8_MMA(0, 0, At, B0); PG8_MMA(0, 1, At, B1); PG8_BAR; PG8_SCHED;
            PG8_LDA(At, 1, 1); PG8_STAGE(PG8_SB(1, 0), b3, voffB); PG8_STAGE(PG8_SB(1, 1), b3 + hstep, voffB); PG8_STAGE_A(PG8_SA(1, 0), a3, 0, vsel);
            PG8_WAIT_V(8); PG8_WAIT_L(0); PG8_BAR; PG8_MMA(1, 0, At, B0); PG8_MMA(1, 1, At, B1); PG8_BAR; PG8_SCHED;
            } else {
            PG8_LDB(B0, 0, 0); PG8_SCHED; PG8_LDA(At, 0, 0); PG8_STAGE_A(PG8_SA(1, 1), a1, 1, vcur);
            PG8_WAIT_L(8); PG8_BAR; PG8_WAIT_L(0); PG8_MMA(0, 0, At, B0); PG8_BAR; PG8_SCHED;
            PG8_LDB(B1, 0, 1); PG8_STAGE(PG8_SB(0, 0), b2, voffB);
            PG8_BAR; PG8_WAIT_L(0); PG8_MMA(0, 1, At, B1); PG8_BAR;
            PG8_LDA(At, 0, 1); PG8_STAGE_A(PG8_SA(0, 0), a2, 0, vsel);
            PG8_BAR; PG8_WAIT_L(0); PG8_MMA(1, 0, At, B0); PG8_BAR; PG8_SCHED;
            PG8_STAGE(PG8_SB(0, 1), b2 + hstep, voffB);
            PG8_WAIT_V(6); PG8_BAR; PG8_MMA(1, 1, At, B1); PG8_BAR;
            PG8_LDB(B0, 1, 0); PG8_SCHED; PG8_LDA(At, 1, 0); PG8_STAGE_A(PG8_SA(0, 1), a2, 1, vsel);
            PG8_WAIT_L(8); PG8_BAR; PG8_WAIT_L(0); PG8_MMA(0, 0, At, B0); PG8_BAR; PG8_SCHED;
            PG8_LDB(B1, 1, 1); PG8_STAGE(PG8_SB(1, 0), b3, voffB);
            PG8_BAR; PG8_WAIT_L(0); PG8_MMA(0, 1, At, B1); PG8_BAR;
            PG8_LDA(At, 1, 1); PG8_STAGE_A(PG8_SA(1, 0), a3, 0, vsel);
            PG8_BAR; PG8_WAIT_L(0); PG8_MMA(1, 0, At, B0); PG8_BAR; PG8_SCHED;
            PG8_STAGE(PG8_SB(1, 1), b3 + hstep, voffB);
            PG8_WAIT_V(6); PG8_BAR; PG8_MMA(1, 1, At, B1); PG8_BAR;
            }
        }
        if constexpr (ALIGN_EPI) { if (wr == 0) PG8_BAR; }
        if constexpr (!Epi::AFTER_DRAIN) { E(acc, cur, wr, wc, fr, fq); S.done(cur); }
        if (!has_next) break;
#pragma unroll
        for (int a = 0; a < 2; ++a)
#pragma unroll
            for (int b = 0; b < 2; ++b)
#pragma unroll
                for (int m = 0; m < 4; ++m)
#pragma unroll
                    for (int n = 0; n < 2; ++n) acc[a][b][m][n] = (f32x4){0.f, 0.f, 0.f, 0.f};
        cur = nxt; cA = nA; cB = nB; ++ui;
        if constexpr (GATHER) {
#pragma unroll
            for (int h = 0; h < 2; ++h)
#pragma unroll
                for (int i = 0; i < 2; ++i) vcur[h][i] = vnxt[h][i];
        }
        if constexpr (ALIGN_EPI) { if (wr == 1) PG8_BAR; }
    }
    PG8_WAIT_V(0);
    if constexpr (!ALIGN_EPI) { if (wr == 0) PG8_BAR; }
    PG8_BAR;
    if constexpr (Epi::AFTER_DRAIN) { E.fused(acc, cur, wr, wc, fr, fq, lds, wid, lane); S.done(cur); }
#undef PG8_SA
#undef PG8_SB
#undef PG8_STAGE
#undef PG8_STAGE_A
#undef PG8_LDA
#undef PG8_LDB
#undef PG8_MMA
#undef PG8_WAIT_V
#undef PG8_WAIT_L
#undef PG8_BAR
#undef PG8_SCHED
}
}

namespace pg8 {
struct SchedQKV {
    int G, c;
    __device__ __forceinline__ bool next(int i, Unit& u) const {
        const int L = i * G + c; if (L >= 400) return false;
        if (L < 384) { const int xcd = L & 7, off = L >> 3, w = xcd * 48 + off; u.pm = (w / 48) * 8 + ((w % 48) & 7); u.pn = (w % 48) >> 3; }
        else { const int j = L - 384; u.pm = 64 + (j >> 1); u.pn = (j & 1) ? 5 : 2; }
        return true;
    }
    __device__ __forceinline__ void a_ready(const Unit&) const {}
    __device__ __forceinline__ void done(const Unit&) const {}
};
struct EpiQKV {
    static constexpr bool PERM = true, AFTER_DRAIN = false, HAS_MID = false;
    unsigned char* ws; const float* bqn; const float* bkn;
    __device__ __forceinline__ void operator()(const f32x4 (&acc)[2][2][4][2], const Unit& u, int wr, int wc, int fr, int fq) const {
        const int pn = u.pn; const bool isctx = u.pm >= 64;
        int kind, hh;
        if (pn < 2) { kind = 0; hh = pn * 4 + wc; } else if (pn == 2) { kind = wc < 2 ? 2 : 4; hh = wc & 1; } else if (pn < 5) { kind = 1; hh = (pn - 3) * 4 + wc; } else { kind = wc < 2 ? 3 : 5; hh = wc & 1; }
        const bool rms = kind == 1 || kind == 3, rope = !isctx && kind <= 3;
        const float* gp = kind == 1 ? bqn : bkn;
        f32x4 gain[2][2];
#pragma unroll
        for (int bj = 0; bj < 2; ++bj)
#pragma unroll
            for (int n = 0; n < 2; ++n) gain[bj][n] = rms ? *(const f32x4*)(gp + 32 * bj + 8 * fq + 4 * n) : (f32x4){1.f, 1.f, 1.f, 1.f};
        const float* tab = (const float*)(ws + WS_ROPE);
        bf16* base = (bf16*)(ws + (kind == 0 ? WS_QA : kind == 1 ? WS_QB : kind == 2 ? WS_KA : kind == 3 ? WS_KB : kind == 4 ? WS_VA : WS_VB));
        const float qs = kind <= 1 ? C2 : 1.f;
#pragma unroll
        for (int ai = 0; ai < 2; ++ai)
#pragma unroll
            for (int m = 0; m < 4; ++m) {
                const int row = u.pm * BM + ai * HALF + wr * 64 + m * 16 + fr;
                int b, t, pos;
                if (!isctx) { b = row >> 11; t = row & 2047; pos = t; } else { const int cr = row - ML; b = cr >> 8; t = 0; pos = T + (cr & 255); }
                f32x4 v[2][2];
#pragma unroll
                for (int bj = 0; bj < 2; ++bj)
#pragma unroll
                    for (int n = 0; n < 2; ++n) v[bj][n] = acc[ai][bj][m][n];
                if (rms) {
                    float ss = 0.f;
#pragma unroll
                    for (int bj = 0; bj < 2; ++bj)
#pragma unroll
                        for (int n = 0; n < 2; ++n) ss += (v[bj][n].x * v[bj][n].x + v[bj][n].y * v[bj][n].y) + (v[bj][n].z * v[bj][n].z + v[bj][n].w * v[bj][n].w);
                    ss += __shfl_xor(ss, 16); ss += __shfl_xor(ss, 32);
                    const float rn = rsqrtf(ss * (1.f / 64.f) + EPS);
#pragma unroll
                    for (int bj = 0; bj < 2; ++bj)
#pragma unroll
                        for (int n = 0; n < 2; ++n) v[bj][n] = v[bj][n] * rn * gain[bj][n];
                }
                if (rope) {
#pragma unroll
                    for (int bj = 0; bj < 2; ++bj)
#pragma unroll
                        for (int n = 0; n < 2; ++n) {
                            const int tp = bj == 0 ? (t >> 6) : 32 + (t & 63);
                            const f32x4 cs = *(const f32x4*)(tab + (tp * 16 + 4 * fq + 2 * n) * 2);
                            const f32x4 x = v[bj][n];
                            v[bj][n] = (f32x4){x.x * cs.x - x.y * cs.y, x.x * cs.y + x.y * cs.x, x.z * cs.z - x.w * cs.w, x.z * cs.w + x.w * cs.z};
                        }
                }
#pragma unroll
                for (int bj = 0; bj < 2; ++bj) {
                    const f32x4 v0 = v[bj][0] * qs, v1 = v[bj][1] * qs;
                    u32x4 w; w.x = pk2(v0.x, v0.y); w.y = pk2(v0.z, v0.w); w.z = pk2(v1.x, v1.y); w.w = pk2(v1.z, v1.w);
                    const int d0 = 32 * bj + 8 * fq;
                    bf16* dst = kind <= 1 ? base + q_off(b, hh, t, d0) : kind <= 3 ? base + k_off(b, hh, pos, d0) : base + v_off(b, hh, pos, d0);
                    st16(dst, w);
                }
            }
    }
};
}


namespace pg8 {
struct SchedOne { Unit u;
    __device__ __forceinline__ bool next(int i, Unit& o) const { if (i) return false; o = u; return true; }
    __device__ __forceinline__ void a_ready(const Unit&) const {}
    __device__ __forceinline__ void done(const Unit&) const {} };
struct EpiOut {
    static constexpr bool PERM = true, AFTER_DRAIN = false, HAS_MID = true;
    bf16* OX; const LAS float* tab;
    __device__ __forceinline__ void mid(f32x4 (&acc)[2][2][4][2], const Unit&, int wr, int, int fr, int) const {
#pragma unroll
        for (int ai = 0; ai < 2; ++ai)
#pragma unroll
            for (int m = 0; m < 4; ++m) { const float f = tab[2 * (ai * HALF + wr * 64 + m * 16 + fr)];
#pragma unroll
                for (int bj = 0; bj < 2; ++bj)
#pragma unroll
                    for (int n = 0; n < 2; ++n) acc[ai][bj][m][n] = acc[ai][bj][m][n] * f; }
    }
    __device__ __forceinline__ void operator()(const f32x4 (&acc)[2][2][4][2], const Unit& u, int wr, int wc, int fr, int fq) const {
#pragma unroll
        for (int ai = 0; ai < 2; ++ai)
#pragma unroll
            for (int m = 0; m < 4; ++m) { const int r = ai * HALF + wr * 64 + m * 16 + fr; const float f = tab[2 * r + 1];
                bf16* rowp = OX + (size_t)(u.pm * BM + r) * D + u.pn * BM + wc * 32 + 8 * fq;
#pragma unroll
                for (int bj = 0; bj < 2; ++bj) { const f32x4 v0 = acc[ai][bj][m][0] * f, v1 = acc[ai][bj][m][1] * f;
                    u32x4 w; w.x = pk2(v0.x, v0.y); w.y = pk2(v0.z, v0.w); w.z = pk2(v1.x, v1.y); w.w = pk2(v1.z, v1.w);
                    st16(rowp + bj * HALF, w); } }
    }
};
struct SchedMoE {
    int G, c, nwg; const LAS int* tile_e; const int* rowidx;
    __device__ __forceinline__ bool next(int i, Unit& u) const {
        const int L = i * G + c; if (L >= nwg) return false;
        const int q = nwg >> 3, r = nwg & 7, xcd = L & 7, off = L >> 3;
        const int w = (xcd < r ? xcd * (q + 1) : r * (q + 1) + (xcd - r) * q) + off;
        u.pm = w >> 2; u.pn = tile_e[w >> 2] * 4 + (w & 3); return true;
    }
    __device__ __forceinline__ void a_ready(const Unit&) const {}
    __device__ __forceinline__ void done(const Unit&) const {}
};
__device__ __forceinline__ float silu_fast(float g) { return g * __builtin_amdgcn_rcpf(1.f + __builtin_amdgcn_exp2f(-g * LOG2E)); }
struct EpiGU {
    static constexpr bool PERM = true, AFTER_DRAIN = false, HAS_MID = false;
    bf16* ACT; const float* roww;
    __device__ __forceinline__ void operator()(const f32x4 (&acc)[2][2][4][2], const Unit& u, int wr, int wc, int fr, int fq) const {
#pragma unroll
        for (int ai = 0; ai < 2; ++ai)
#pragma unroll
            for (int m = 0; m < 4; ++m) { const int pos = u.pm * BM + ai * HALF + wr * 64 + m * 16 + fr; const float w = roww[pos];
                const f32x4 g0 = acc[ai][0][m][0], g1 = acc[ai][0][m][1], u0 = acc[ai][1][m][0], u1 = acc[ai][1][m][1];
                u32x4 o;
                o.x = pk2(silu_fast(g0.x) * u0.x * w, silu_fast(g0.y) * u0.y * w); o.y = pk2(silu_fast(g0.z) * u0.z * w, silu_fast(g0.w) * u0.w * w);
                o.z = pk2(silu_fast(g1.x) * u1.x * w, silu_fast(g1.y) * u1.y * w); o.w = pk2(silu_fast(g1.z) * u1.z * w, silu_fast(g1.w) * u1.w * w);
                st16(ACT + (size_t)pos * EFF + (u.pn & 3) * 128 + wc * 32 + 8 * fq, o); }
    }
};
struct EpiY {
    static constexpr bool PERM = true, AFTER_DRAIN = false, HAS_MID = false;
    bf16* Y;
    __device__ __forceinline__ void operator()(const f32x4 (&acc)[2][2][4][2], const Unit& u, int wr, int wc, int fr, int fq) const {
#pragma unroll
        for (int ai = 0; ai < 2; ++ai)
#pragma unroll
            for (int m = 0; m < 4; ++m) { bf16* rowp = Y + (size_t)(u.pm * BM + ai * HALF + wr * 64 + m * 16 + fr) * D + (u.pn & 3) * BM + wc * 32 + 8 * fq;
#pragma unroll
                for (int bj = 0; bj < 2; ++bj) { const f32x4 v0 = acc[ai][bj][m][0], v1 = acc[ai][bj][m][1];
                    u32x4 w; w.x = pk2(v0.x, v0.y); w.y = pk2(v0.z, v0.w); w.z = pk2(v1.x, v1.y); w.w = pk2(v1.z, v1.w);
                    st16(rowp + bj * HALF, w); } }
    }
};
}

namespace att {
typedef __attribute__((address_space(3))) const char* lds_cptr;
typedef short v4i16_t __attribute__((ext_vector_type(4)));
constexpr int NSLOT = 4, SLOTB = 16384, OST_PITCH = 144, OST_WAVE = 32 * OST_PITCH;
static_assert(8 * OST_WAVE <= 3 * SLOTB && NSLOT * SLOTB <= 65536, "attention LDS");
__device__ __forceinline__ int crow(int r, int hi) { return (r & 3) + 8 * (r >> 2) + 4 * hi; }
__device__ __forceinline__ unsigned cvtpk(float lo, float hi) { typedef float f2 __attribute__((ext_vector_type(2))); typedef __bf16 b2 __attribute__((ext_vector_type(2))); f2 v = {lo, hi}; b2 b = __builtin_convertvector(v, b2); return __builtin_bit_cast(unsigned, b); }
__device__ __forceinline__ s16x4 vtr(lds_cptr p) { return __builtin_bit_cast(s16x4, __builtin_amdgcn_ds_read_tr16_b64_v4i16((__attribute__((address_space(3))) v4i16_t*)p)); }
__device__ __forceinline__ float swapmax(float m) { auto rr = __builtin_amdgcn_permlane32_swap(__float_as_uint(m), __float_as_uint(m), false, false); return fmaxf(__uint_as_float(rr[0]), __uint_as_float(rr[1])); }
__device__ __forceinline__ float swapsum(float m) { auto rr = __builtin_amdgcn_permlane32_swap(__float_as_uint(m), __float_as_uint(m), false, false); return __uint_as_float(rr[0]) + __uint_as_float(rr[1]); }

__device__ __forceinline__ void glds16(const void* gsrc, unsigned lds_dst) { unsigned keep;
    asm volatile("s_mov_b32 %0, m0\n\ts_mov_b32 m0, %2\n\ts_nop 0\n\tglobal_load_lds_dwordx4 %1, off\n\ts_mov_b32 m0, %0" : "=&s"(keep) : "v"(gsrc), "s"(lds_dst) : "memory"); }
__device__ __forceinline__ float max3f(float a, float b, float c) { float r; asm("v_max3_f32 %0, %1, %2, %3" : "=v"(r) : "v"(a), "v"(b), "v"(c)); return r; }
__device__ __forceinline__ float max2f(float a, float b) { float r; asm("v_max_f32_e32 %0, %1, %2" : "=v"(r) : "v"(a), "v"(b)); return r; }
constexpr int WC_PER_WAVE = 24, WC_LDS = 65536;
struct WConv { int next, j0, j1, gstep, cm1, cm2; };
struct WItem { const float* src; int N; bf16* dst; int dpitch; };
__device__ __forceinline__ WItem wc_decode(const P& p, int hidx, int& k0, int& n0, int& drow0) {
    const int item = hidx >> 1, kh = hidx & 1; WItem w;
    if (item < 16384) { const int up = item >= 8192, r = item & 8191, e = r >> 8, q = r & 255, kb = q >> 4, nb = q & 15; n0 = nb * 32;
        w.src = (up ? p.w_up : p.w_gate) + (size_t)e * 1024 * 512; w.N = 512; w.dst = (bf16*)(p.ws + WS_WGU) + (size_t)e * 1024 * 1024; w.dpitch = 1024;
        drow0 = (n0 >> 7) * 256 + up * 128 + (n0 & 127); k0 = kb * 64 + kh * 32; }
    else { const int r = item - 16384, e = r >> 8, q = r & 255, kb = q >> 5, nb = q & 31; n0 = nb * 32;
        w.src = p.w_down + (size_t)e * 512 * 1024; w.N = 1024; w.dst = (bf16*)(p.ws + WS_WD) + (size_t)e * 1024 * 512; w.dpitch = 512; drow0 = n0; k0 = kb * 64 + kh * 32; }
    return w;
}
__device__ __forceinline__ void glds16(const void* gsrc, unsigned lds_dst);
__device__ __forceinline__ void glds16_nt(const void* gsrc, unsigned lds_dst) { unsigned keep;
    asm volatile("s_mov_b32 %0, m0\n\ts_mov_b32 m0, %2\n\ts_nop 0\n\tglobal_load_lds_dwordx4 %1, off nt\n\ts_mov_b32 m0, %0" : "=&s"(keep) : "v"(gsrc), "s"(lds_dst) : "memory"); }
__device__ __forceinline__ void wc_issue(const P& p, int gw, int ord, unsigned ldsbuf, int lane) {
    int k0, n0, drow0; const WItem w = wc_decode(p, gw + 2048 * ord, k0, n0, drow0);
#pragma unroll
    for (int q = 0; q < 4; ++q) { const int kl = 8 * q + (lane >> 3), f4 = (lane & 7) ^ ((q >> 1) * 4);
        glds16_nt(w.src + (size_t)(k0 + kl) * w.N + n0 + f4 * 4, (unsigned)__builtin_amdgcn_readfirstlane(ldsbuf + q * 1024)); }
}
__device__ __forceinline__ void wc_consume(const P& p, int gw, int ord, LAS unsigned char* buf, int lane) {
    int k0, n0, drow0; const WItem w = wc_decode(p, gw + 2048 * ord, k0, n0, drow0);
    const int n = lane >> 1, kh = lane & 1;
    const LAS float* s = (const LAS float*)buf + (16 * kh) * 32 + 4 * ((n >> 2) ^ (4 * kh)) + (n & 3);
    float v[16];
#pragma unroll
    for (int i = 0; i < 16; ++i) v[i] = s[i * 32];
    v4u o0, o1;
    o0.x = cvtpk(v[0], v[1]); o0.y = cvtpk(v[2], v[3]); o0.z = cvtpk(v[4], v[5]); o0.w = cvtpk(v[6], v[7]);
    o1.x = cvtpk(v[8], v[9]); o1.y = cvtpk(v[10], v[11]); o1.z = cvtpk(v[12], v[13]); o1.w = cvtpk(v[14], v[15]);
    bf16* d = w.dst + (size_t)(drow0 + n) * w.dpitch + k0 + 16 * kh;
    __builtin_nontemporal_store(o0, (v4u*)d); __builtin_nontemporal_store(o1, (v4u*)(d + 8));
}
constexpr float THR = 8.f;
template <int GRP, int ABL = 0>
__device__ __forceinline__ void attn_unit(const P& p, LAS unsigned char* lds, int b, int kvh, int qb, WConv& wc, int gw) {
    const int tid = threadIdx.x, lane = tid & 63, r32 = lane & 31, hi = lane >> 5;
    const int wid = __builtin_amdgcn_readfirstlane(tid >> 6);
    const int h = kvh * 4 + (wid >> 1);
    const int q0w = qb * 64 + (wid & 1) * 32, qpos = q0w + r32;
    const bf16* Qp = (const bf16*)(p.ws + (GRP ? WS_QB : WS_QA)) + q_off(b, h, qpos, 0);
    bf16x8 qr[4];
#pragma unroll
    for (int d0 = 0; d0 < 4; ++d0) qr[d0] = *(const bf16x8*)(Qp + 16 * d0 + 8 * hi);
    asm volatile("" : "+v"(qr[0]), "+v"(qr[1]), "+v"(qr[2]), "+v"(qr[3]));
    const char* Kt = (const char*)(p.ws + (GRP ? WS_KB : WS_KA)) + (size_t)(b * 2 + kvh) * NTILE * 8192 + wid * 1024 + lane * 16;
    const char* Vt = (const char*)(p.ws + (GRP ? WS_VB : WS_VA)) + (size_t)(b * 2 + kvh) * NTILE * 8192 + wid * 1024 + lane * 16;
    const unsigned lds0 = (unsigned)(uintptr_t)lds;
    int jlo = 0, nband = NTILE, NT = NTILE;
    if (GRP == 0) { jlo = qb - 2 < 0 ? 0 : qb - 2; const int jhi = qb + 2 > 31 ? 31 : qb + 2; nband = jhi - jlo + 1; NT = nband + 4; }
#define ATT_TILE(i) ((i) < nband ? jlo + (i) : 32 + ((i) - nband))
#define ATT_ISSUE(i) do { if (ABL & 1) break; const int tl_ = ATT_TILE(i); const int sl_ = ((i) & 3) * SLOTB; \
        glds16(Kt + (size_t)tl_ * 8192, (unsigned)__builtin_amdgcn_readfirstlane(lds0 + sl_ + wid * 1024)); \
        glds16(Vt + (size_t)tl_ * 8192, (unsigned)__builtin_amdgcn_readfirstlane(lds0 + sl_ + 8192 + wid * 1024)); } while (0)
#define ATT_WAIT(n) do { if (ABL & 1) break; if ((n) >= 2) asm volatile("s_waitcnt vmcnt(4)" ::: "memory"); else if ((n) == 1) asm volatile("s_waitcnt vmcnt(2)" ::: "memory"); else asm volatile("s_waitcnt vmcnt(0)" ::: "memory"); } while (0)
#define ATT_WAITN(n) do { if (ABL & 1) break; switch (n) { case 0: asm volatile("s_waitcnt vmcnt(0)" ::: "memory"); break; case 2: asm volatile("s_waitcnt vmcnt(2)" ::: "memory"); break; \
        case 4: asm volatile("s_waitcnt vmcnt(4)" ::: "memory"); break; case 6: asm volatile("s_waitcnt vmcnt(6)" ::: "memory"); break; case 8: asm volatile("s_waitcnt vmcnt(8)" ::: "memory"); break; \
        case 10: asm volatile("s_waitcnt vmcnt(10)" ::: "memory"); break; case 12: asm volatile("s_waitcnt vmcnt(12)" ::: "memory"); break; default: asm volatile("s_waitcnt vmcnt(14)" ::: "memory"); break; } } while (0)
#define ATT_BAR() do { asm volatile("" ::: "memory"); __builtin_amdgcn_s_barrier(); asm volatile("" ::: "memory"); } while (0)
#define SBAR() __builtin_amdgcn_sched_barrier(0)
#define MF(a, b, c) __builtin_amdgcn_mfma_f32_32x32x16_bf16(a, b, c, 0, 0, 0)
#define KFRAG(dst, base, k) dst = *(const __attribute__((address_space(3))) bf16x8*)((base) + ((k) >> 1) * 2048 + ((k) & 1) * 512)
    float m, l;
    m = 0.f; l = 0.f;
    f32x16 o0, o1, sA0, sA1, sB0, sB1; const f32x16 zero16 = {0.f, 0.f, 0.f, 0.f, 0.f, 0.f, 0.f, 0.f, 0.f, 0.f, 0.f, 0.f, 0.f, 0.f, 0.f, 0.f};
#pragma unroll
    for (int r = 0; r < 16; ++r) { o0[r] = 0.f; o1[r] = 0.f; sB0[r] = 0.f; sB1[r] = 0.f; }
    const lds_cptr kp0 = (lds_cptr)lds + hi * 1024 + r32 * 16;
    const lds_cptr vp0 = (lds_cptr)lds + 8192 + ((lane >> 4) & 1) * 32 + (lane & 3) * 8 + (4 * hi + ((lane & 15) >> 2)) * 64;
#define ATT_MASK(S0, S1, t) do { if (GRP == 0) { const int tl = ATT_TILE(t); if (tl < 32 && (tl == qb - 2 || tl == qb + 2)) { const int kb = tl * 64; \
        _Pragma("unroll") for (int r = 0; r < 16; ++r) { const int dd = kb + crow(r, hi) - qpos; if (dd > 128 || dd < -128) S0[r] = -1e30f; if (dd + 32 > 128 || dd + 32 < -128) S1[r] = -1e30f; } } } } while (0)
#define ATT_DECIDE(S0, S1, mxv) do { float mx_ = swapmax(mxv); \
        if (__builtin_expect(__any(mx_ > THR), 0)) { const float dl = fmaxf(mx_, 0.f), alpha = __builtin_amdgcn_exp2f(-dl); m += dl; l *= alpha; \
            _Pragma("unroll") for (int r = 0; r < 16; ++r) { S0[r] -= dl; S1[r] -= dl; o0[r] *= alpha; o1[r] *= alpha; } } } while (0)
    wc.cm1 = 0; wc.cm2 = 0;
    ATT_ISSUE(0); ATT_ISSUE(1); ATT_ISSUE(2);
    ATT_WAIT(2); ATT_BAR();
    {
        bf16x8 kf[8];
#pragma unroll
        for (int k = 0; k < 8; ++k) KFRAG(kf[k], kp0, k);
        SBAR();
        sA0 = MF(kf[0], qr[0], zero16); sA1 = MF(kf[1], qr[0], zero16);
#pragma unroll
        for (int d0 = 1; d0 < 4; ++d0) { sA0 = MF(kf[2 * d0], qr[d0], sA0); sA1 = MF(kf[2 * d0 + 1], qr[d0], sA1); }
        ATT_MASK(sA0, sA1, 0);
        asm volatile("s_nop 15\n\ts_nop 7" : "+v"(sA0), "+v"(sA1));
        float a = max3f(sA0[0], sA0[1], sA1[0]), c = max3f(sA0[2], sA0[3], sA1[1]); a = max3f(a, sA1[2], sA1[3]);
#pragma unroll
        for (int r = 4; r < 16; r += 4) { a = max3f(a, sA0[r], sA0[r + 1]); c = max3f(c, sA0[r + 2], sA0[r + 3]); a = max3f(a, sA1[r], sA1[r + 1]); c = max3f(c, sA1[r + 2], sA1[r + 3]); }
        ATT_DECIDE(sA0, sA1, max2f(a, c));
    }
#define ATT_STEP(SC0, SC1, SN0, SN1, t, HN) do { \
        constexpr bool hn_ = HN;                                      \
        ATT_WAITN(wc.cm2 + wc.cm1 + ((t) + 2 < NT ? 2 : 0));         \
        ATT_BAR(); \
        if ((t) + 3 < NT) ATT_ISSUE((t) + 3); \
        if (WCONV_IN_ATTN) { int c_ = 0; const int r7_ = wc.gstep % 7, bs_ = r7_ == 0 ? 0 : r7_ == 3 ? 1 : 2;     \
            if (bs_ < 2) { LAS unsigned char* wb_ = lds + WC_LDS + wid * 8192 + bs_ * 4096; int jb_ = bs_ ? wc.j1 : wc.j0; \
                if (jb_ >= 0) { wc_consume(p, gw, jb_, wb_, lane); jb_ = -1; c_ += 2; } \
                if (wc.next < WC_PER_WAVE) { asm volatile("s_waitcnt lgkmcnt(0)" ::: "memory"); wc_issue(p, gw, wc.next, lds0 + WC_LDS + wid * 8192 + bs_ * 4096, lane); jb_ = wc.next++; c_ += 4; } \
                if (bs_) wc.j1 = jb_; else wc.j0 = jb_; } \
            wc.cm2 = wc.cm1; wc.cm1 = c_; wc.gstep++; } \
        const lds_cptr kp_ = kp0 + (((t) + 1) & 3) * SLOTB; const lds_cptr vp_ = vp0 + ((t) & 3) * SLOTB; \
        bf16x8 kf[8]; s16x4 vlo[8], vhi[8]; \
        if (hn_) { _Pragma("unroll") for (int k = 0; k < 8; ++k) KFRAG(kf[k], kp_, k); } \
        SBAR(); \
        float rs_ = 0.f; v4u pw[4]; _Pragma("unroll") for (int q_ = 0; q_ < 4; ++q_) pw[q_] = (v4u){0u, 0u, 0u, 0u}; \
        _Pragma("unroll") for (int g = 0; g < 8; ++g) {             \
            if (hn_) { if (g == 0) SN0 = MF(kf[0], qr[0], zero16); else if (g == 1) SN1 = MF(kf[1], qr[0], zero16); else if (g & 1) SN1 = MF(kf[g], qr[g >> 1], SN1); else SN0 = MF(kf[g], qr[g >> 1], SN0); } \
            if (g < 4) { _Pragma("unroll") for (int e = 0; e < 4; ++e) { SC0[4 * g + e] = __builtin_amdgcn_exp2f(SC0[4 * g + e]); rs_ += SC0[4 * g + e]; } \
                         pw[g >> 1][2 * (g & 1)] = cvtpk(SC0[4 * g], SC0[4 * g + 1]); pw[g >> 1][2 * (g & 1) + 1] = cvtpk(SC0[4 * g + 2], SC0[4 * g + 3]); \
                         asm volatile("" : "+v"(SC0), "+v"(pw[g >> 1]), "+v"(rs_)); } \
            else { const int g4 = g - 4;   \
                         vlo[g4] = vtr(vp_ + g4 * 1024); vhi[g4] = vtr(vp_ + g4 * 1024 + 512); vlo[4 + g4] = vtr(vp_ + 4096 + g4 * 1024); vhi[4 + g4] = vtr(vp_ + 4096 + g4 * 1024 + 512); \
                         _Pragma("unroll") for (int e = 0; e < 4; ++e) { SC1[4 * g4 + e] = __builtin_amdgcn_exp2f(SC1[4 * g4 + e]); rs_ += SC1[4 * g4 + e]; } \
                         pw[2 + (g4 >> 1)][2 * (g4 & 1)] = cvtpk(SC1[4 * g4], SC1[4 * g4 + 1]); pw[2 + (g4 >> 1)][2 * (g4 & 1) + 1] = cvtpk(SC1[4 * g4 + 2], SC1[4 * g4 + 3]); \
                         asm volatile("" : "+v"(SC1), "+v"(pw[2 + (g4 >> 1)]), "+v"(rs_)); } \
            SBAR(); } \
        l += rs_; \
        if (hn_) { ATT_MASK(SN0, SN1, (t) + 1); if (__builtin_expect(__any(m != 0.f), 0)) { _Pragma("unroll") for (int r = 0; r < 16; ++r) { SN0[r] -= m; SN1[r] -= m; } } \
                   asm volatile("s_nop 15\n\ts_nop 7" : "+v"(SN0), "+v"(SN1)); } \
        float ma_ = -3.0e38f, mc_ = -3.0e38f; \
        _Pragma("unroll") for (int g = 0; g < 8; ++g) {             \
            const int ks = g >> 1; const bf16x8 pf = __builtin_bit_cast(bf16x8, pw[ks]); \
            if (g & 1) { const bf16x8 v1 = (bf16x8){vlo[4 + ks][0], vlo[4 + ks][1], vlo[4 + ks][2], vlo[4 + ks][3], vhi[4 + ks][0], vhi[4 + ks][1], vhi[4 + ks][2], vhi[4 + ks][3]}; o1 = MF(v1, pf, o1); } \
            else { const bf16x8 v0 = (bf16x8){vlo[ks][0], vlo[ks][1], vlo[ks][2], vlo[ks][3], vhi[ks][0], vhi[ks][1], vhi[ks][2], vhi[ks][3]}; o0 = MF(v0, pf, o0); } \
            if (hn_) { if (g < 4) { ma_ = max3f(ma_, SN0[4 * g], SN0[4 * g + 1]); mc_ = max3f(mc_, SN0[4 * g + 2], SN0[4 * g + 3]); } \
                       else { ma_ = max3f(ma_, SN1[4 * (g - 4)], SN1[4 * (g - 4) + 1]); mc_ = max3f(mc_, SN1[4 * (g - 4) + 2], SN1[4 * (g - 4) + 3]); } \
                       asm volatile("" : "+v"(ma_), "+v"(mc_)); } \
            SBAR(); } \
        if (hn_) ATT_DECIDE(SN0, SN1, max2f(ma_, mc_)); \
    } while (0)
    {
        int t = 0;
        for (; t + 2 < NT; t += 2) { ATT_STEP(sA0, sA1, sB0, sB1, t, true); ATT_STEP(sB0, sB1, sA0, sA1, t + 1, true); }
        if (t + 2 == NT) { ATT_STEP(sA0, sA1, sB0, sB1, t, true); ATT_STEP(sB0, sB1, sA0, sA1, t + 1, false); }
        else { ATT_STEP(sA0, sA1, sB0, sB1, t, false); }
    }
#undef ATT_STEP
#undef ATT_DECIDE
#undef ATT_MASK
#undef KFRAG
#undef MF
#undef SBAR
#undef ATT_TILE
#undef ATT_ISSUE
#undef ATT_WAIT
    ATT_BAR();
    float ltot = swapsum(l); if (GRP == 0) ltot += __builtin_amdgcn_exp2f(p.a_sink[h] * LOG2E - m);
    const float inv = 1.f / ltot;
    int lane_e = lane; asm volatile("" : "+v"(lane_e));
    const int r32e = lane_e & 31, hie = lane_e >> 5;
    LAS unsigned char* ost = lds + wid * OST_WAVE;
#pragma unroll
    for (int g = 0; g < 4; ++g) {
        v2u w0, w1;
        w0.x = cvtpk(o0[4 * g] * inv, o0[4 * g + 1] * inv); w0.y = cvtpk(o0[4 * g + 2] * inv, o0[4 * g + 3] * inv);
        w1.x = cvtpk(o1[4 * g] * inv, o1[4 * g + 1] * inv); w1.y = cvtpk(o1[4 * g + 2] * inv, o1[4 * g + 3] * inv);
        *(LAS v2u*)(ost + r32e * OST_PITCH + (8 * g + 4 * hie) * 2) = w0;
        *(LAS v2u*)(ost + r32e * OST_PITCH + (32 + 8 * g + 4 * hie) * 2) = w1;
    }
    asm volatile("s_waitcnt lgkmcnt(0)" ::: "memory");
    bf16* Ob = (bf16*)(p.ws + (ABL ? WS_OX : WS_O)) + ((size_t)b * T + q0w) * D + GRP * 512 + h * 64;
    float* ssq = (float*)(p.ws + (ABL ? 256 * MiB : WS_SSQ)) + ((size_t)b * T + q0w) * 16 + GRP * 8 + h;
#pragma unroll
    for (int i = 0; i < 4; ++i) {
        const int row = i * 8 + (lane_e >> 3), ch = lane_e & 7;
        const v4u v = *(const LAS v4u*)(ost + row * OST_PITCH + ch * 16);
        st16(Ob + (size_t)row * D + ch * 8, v);
        float ss = 0.f;
#pragma unroll
        for (int q = 0; q < 4; ++q) { const float a = __uint_as_float(v[q] << 16), c = __uint_as_float(v[q] & 0xffff0000u); ss += a * a + c * c; }
        ss += __shfl_xor(ss, 1); ss += __shfl_xor(ss, 2); ss += __shfl_xor(ss, 4);
        if (ch == 0) ssq[(size_t)row * 16] = ss;
    }
    asm volatile("s_waitcnt vmcnt(0) lgkmcnt(0)" ::: "memory");
    ATT_BAR();
#undef ATT_BAR
}
template <int ABL = 0>
__device__ __forceinline__ void attn_phase(const P& p, LAS unsigned char* lds, int vcu, int G) {
    if (ABL & 64) return;
    const int wid = __builtin_amdgcn_readfirstlane(threadIdx.x >> 6), lane = threadIdx.x & 63, gw = vcu * 8 + wid;
    WConv wc; wc.next = (WCONV_IN_ATTN && G * 8 == 2048 && ABL == 0) ? 0 : WC_PER_WAVE; wc.j0 = -1; wc.j1 = -1; wc.gstep = 0; wc.cm1 = 0; wc.cm2 = 0;
    for (int u = vcu; u < 512; u += G) attn_unit<1, ABL>(p, lds, (u >> 5) >> 1, (u >> 5) & 1, u & 31, wc, gw);
    for (int u = vcu; u < 512; u += G) attn_unit<0, ABL>(p, lds, (u >> 5) >> 1, (u >> 5) & 1, u & 31, wc, gw);
    if (WCONV_IN_ATTN && ABL == 0) {
        if (G * 8 == 2048) {
            if (wc.j0 >= 0) wc_consume(p, gw, wc.j0, lds + WC_LDS + wid * 8192, lane);
            if (wc.j1 >= 0) wc_consume(p, gw, wc.j1, lds + WC_LDS + wid * 8192 + 4096, lane);
            for (; wc.next < WC_PER_WAVE; ++wc.next) { asm volatile("s_waitcnt lgkmcnt(0)" ::: "memory"); wc_issue(p, gw, wc.next, (unsigned)(uintptr_t)lds + WC_LDS + wid * 8192, lane);
                asm volatile("s_waitcnt vmcnt(0)" ::: "memory"); wc_consume(p, gw, wc.next, lds + WC_LDS + wid * 8192, lane); }
        } else {
            for (int hx = gw; hx < 49152; hx += G * 8) { asm volatile("s_waitcnt lgkmcnt(0)" ::: "memory"); wc_issue(p, hx & 2047, hx >> 11, (unsigned)(uintptr_t)lds + WC_LDS + wid * 8192, lane);
                asm volatile("s_waitcnt vmcnt(0)" ::: "memory"); wc_consume(p, hx & 2047, hx >> 11, lds + WC_LDS + wid * 8192, lane); }
        }
    }
}
}

struct Frame {
    LAS unsigned char* lds;
    volatile LAS unsigned* MISC;
    int tid, lane, wave, vcu, G;
};

__device__ __forceinline__ void p0_transpose_item(const float* W, int N, bf16* WT, int dpitch, int drow0, int k0, int n0, LAS float* scr, int lane, const float* gain) {
#pragma unroll
    for (int i = 0; i < 32; ++i) { const int kk = 2 * i + (lane >> 5); float v = W[(size_t)(k0 + kk) * N + n0 + (lane & 31)]; if (gain) v *= gain[kk]; scr[kk * 33 + (lane & 31)] = v; }
    LDS_WAIT(); asm volatile("" ::: "memory");
    const int c = lane & 7;
#pragma unroll
    for (int j = 0; j < 4; ++j) { const int n = (lane >> 3) + 8 * j; const LAS float* s = scr + (8 * c) * 33 + n;
        v4u o; o.x = pk2(s[0 * 33], s[1 * 33]); o.y = pk2(s[2 * 33], s[3 * 33]); o.z = pk2(s[4 * 33], s[5 * 33]); o.w = pk2(s[6 * 33], s[7 * 33]);
        *(GAS v4u*)(WT + (size_t)(drow0 + n) * dpitch + k0 + 8 * c) = o; }
    LDS_WAIT(); asm volatile("" ::: "memory");
}
__device__ __forceinline__ void p0_prologue(const P& p, Frame& F) {
    float* modx = (float*)(p.ws + WS_MODX);
    if (F.vcu < 96) {
        LAS float* s = (LAS float*)F.lds;
        LAS float* part = (LAS float*)(F.lds + 40960);
        for (int i = F.tid; i < 9 * D; i += NTHR) { const int r = i >> 10, k = i & 1023; const float v = r < 8 ? p.c[r * D + k] : p.c_ctx[k]; s[i] = silu_f(v); }
        __syncthreads();
        const int n = F.vcu * 64 + F.lane; float acc[9];
#pragma unroll
        for (int r = 0; r < 9; ++r) acc[r] = 0.f;
        const float* wp = p.w_mod + (size_t)(F.wave * 128) * 6144 + n;
#pragma unroll 4
        for (int k4 = 0; k4 < 128; k4 += 4) {
            float wv[4];
#pragma unroll
            for (int j = 0; j < 4; ++j) wv[j] = wp[(size_t)(k4 + j) * 6144];
#pragma unroll
            for (int r = 0; r < 9; ++r) { const f32x4 sv = *(const LAS f32x4*)(s + r * D + F.wave * 128 + k4); acc[r] += sv.x * wv[0]; acc[r] += sv.y * wv[1]; acc[r] += sv.z * wv[2]; acc[r] += sv.w * wv[3]; }
        }
#pragma unroll
        for (int r = 0; r < 9; ++r) part[(F.wave * 9 + r) * 64 + F.lane] = acc[r];
        __syncthreads();
        for (int i = F.tid; i < 9 * 64; i += NTHR) { const int r = i >> 6, l = i & 63; float sum = 0.f;
#pragma unroll
            for (int w = 0; w < 8; ++w) sum += part[(w * 9 + r) * 64 + l];
            modx[r * 6144 + F.vcu * 64 + l] = sum + p.b_mod[F.vcu * 64 + l]; }
        __syncthreads();
    }
    if (F.vcu == 96) {
        float2* tab = (float2*)(p.ws + WS_ROPE);
        for (int idx = F.tid; idx < 96 * 16; idx += NTHR) {
            const int pos = idx >> 4, i = idx & 15;
            const float invf = exp2f(-(float)i * (13.287712379549449f / 16.f));
            const float pv = (float)(pos < 32 ? pos : pos - 32);
            float rev = pv * invf * 0.15915494309189535f; rev -= rintf(rev);
            tab[idx] = make_float2(__builtin_amdgcn_cosf(rev), __builtin_amdgcn_sinf(rev));
        }
    }
    for (int nb = F.vcu - 97; nb >= 0 && nb < 48; nb += F.G) {
        bf16* wr = (bf16*)(p.ws + WS_WR);
        for (int i = nb * 1024 + F.tid; i < (nb + 1) * 1024; i += NTHR) {
            const int j = i & 7, ln = (i >> 3) & 63, q = i >> 9, nt = q % 3, ks = q / 3;
            const int k = 32 * ks + 8 * (ln >> 4) + j, n = 16 * nt + (ln & 15);
            const float w = n < 4 ? p.w_group[k * 4 + n] : n < 36 ? p.w_router[k * 32 + (n - 4)] : 0.f;
            const unsigned hi = f2bf(w); const unsigned lo = f2bf(w - bf2f((bf16)hi));
            wr[i] = (bf16)hi; wr[48 * D + i] = (bf16)lo; }
    }
    LAS float* scr = (LAS float*)(F.lds + F.wave * 16384);
    const int gw = F.vcu * NWAVES + F.wave, NGW = F.G * NWAVES;
    constexpr int I_IN = 16 * 48, I_OUT = 16 * 32, I_G = 32 * 256, I_D = 32 * 256, NITEMS = WCONV_IN_ATTN ? I_IN + I_OUT : I_IN + I_OUT + 2 * I_G + I_D;
    for (int it = gw; it < NITEMS; it += NGW) {
        int r = it;
        if (r < I_IN) { const int kb = r / 48, nb = r % 48; p0_transpose_item(p.w_in, NQKV, (bf16*)(p.ws + WS_WQKV), D, qkv_row(nb * 32), kb * 64, nb * 32, scr, F.lane, nullptr); continue; } r -= I_IN;
        if (r < I_OUT) { const int kb = r / 32, nb = r % 32; const float* g = kb < 8 ? p.aon + kb * 64 : p.bon + (kb - 8) * 64;
            p0_transpose_item(p.w_out, D, (bf16*)(p.ws + WS_WO), D, nb * 32, kb * 64, nb * 32, scr, F.lane, g); continue; } r -= I_OUT;
        if (r < 2 * I_G) { const int up = r >= I_G; if (up) r -= I_G; const int e = r >> 8, q = r & 255, kb = q >> 4, nb = q & 15; const int j0 = nb * 32;
            p0_transpose_item((up ? p.w_up : p.w_gate) + (size_t)e * 1024 * 512, 512, (bf16*)(p.ws + WS_WGU) + (size_t)e * 1024 * 1024, D, (j0 >> 7) * 256 + up * 128 + (j0 & 127), kb * 64, j0, scr, F.lane, nullptr); continue; } r -= 2 * I_G;
        { const int e = r >> 8, q = r & 255, kb = q >> 5, nb = q & 31;
            p0_transpose_item(p.w_down + (size_t)e * 512 * 1024, D, (bf16*)(p.ws + WS_WD) + (size_t)e * 1024 * 512, EFF, nb * 32, kb * 64, nb * 32, scr, F.lane, nullptr); }
    }
}
__device__ __forceinline__ void p1_norm(const P& p, Frame& F) {
    const int gw = F.vcu * NWAVES + F.wave, NGW = F.G * NWAVES;
    const float* modall = (const float*)(p.ws + WS_MODX);
    for (int r = gw; r < MT; r += NGW) {
        const float* src = r < ML ? p.x + (size_t)r * D : p.ctx + (size_t)(r - ML) * D;
        const float* modx = modall + (r < ML ? (r / T) : 8) * 6144;
        const GAS f32x4* xr = (const GAS f32x4*)src + F.lane;
        f32x4 v[4]; float s = 0.f;
#pragma unroll
        for (int j = 0; j < 4; ++j) { v[j] = xr[64 * j]; s += (v[j].x * v[j].x + v[j].y * v[j].y) + (v[j].z * v[j].z + v[j].w * v[j].w); }
        const float rn = rsqrtf(wave_sum(s) * (1.f / D) + EPS);
        GAS v2u* o8 = (GAS v2u*)((bf16*)(p.ws + WS_XN) + (size_t)r * D) + F.lane;
#pragma unroll
        for (int j = 0; j < 4; ++j) { const int k = 4 * (F.lane + 64 * j);
            const f32x4 g = *(const f32x4*)(p.pre1 + k), sc = *(const f32x4*)(modx + 1024 + k), sh = *(const f32x4*)(modx + k);
            const f32x4 h = v[j] * rn * g * (sc + 1.f) + sh;
            v2u w; w.x = pk2(h.x, h.y); w.y = pk2(h.z, h.w); st8((void*)(o8 + 64 * j), w); }
    }
}


constexpr int LDS_X = 147456;
__device__ __forceinline__ void p4_outproj(const P& p, Frame& F) {
    LAS float* tab = (LAS float*)(F.lds + LDS_X);
    for (int i = 0;; ++i) {
        const int L = i * F.G + (int)blockIdx.x; if (L >= 256) break;
        const int xcd = L & 7, off = L >> 3, w = xcd * 32 + off;
        pg8::Unit u; u.pm = (w >> 5) * 8 + (w & 7); u.pn = (w & 31) >> 3;
        if (F.tid < 256) {
            const f32x4* s4 = (const f32x4*)((const float*)(p.ws + WS_SSQ) + (size_t)(u.pm * 256 + F.tid) * 16);
            const f32x4 a0 = s4[0], a1 = s4[1], b0 = s4[2], b1 = s4[3];
            const float sa = ((a0.x + a0.y) + (a0.z + a0.w)) + ((a1.x + a1.y) + (a1.z + a1.w)), sb = ((b0.x + b0.y) + (b0.z + b0.w)) + ((b1.x + b1.y) + (b1.z + b1.w));
            const float ra = rsqrtf(sa * (1.f / 512.f) + EPS), rb = rsqrtf(sb * (1.f / 512.f) + EPS);
            tab[2 * F.tid] = ra / rb; tab[2 * F.tid + 1] = rb;
        }
        __syncthreads();
        pg8::Gemm g{(const pg8::bf16_t*)(p.ws + WS_O), (const pg8::bf16_t*)(p.ws + WS_WO), ML, D, D};
        pg8::SchedOne S{u};
        pg8::EpiOut E{(bf16*)(p.ws + WS_OX), tab};
        pg8::gemm_phase<pg8::EpiOut, pg8::SchedOne, false, true, false>((PG8_LAS unsigned char*)F.lds, g, S, E);
    }
}
constexpr int P5_PITCH = 2064;
constexpr int P5_PART = 64 * P5_PITCH, P5_LG = 0;
static_assert(P5_PART + 8 * 16 * 48 * 4 <= MISC_OFF && 64 * 48 * 4 <= P5_PART, "P5 LDS map");
__device__ __forceinline__ void p5_rowpass(const P& p, Frame& F, int abl = 0) {
    LAS unsigned char* LO = F.lds;
    LAS float* PART = (LAS float*)(F.lds + P5_PART); LAS float* LG = (LAS float*)(F.lds + P5_LG);
    LAS int* hist = (LAS int*)(F.lds + MISC_OFF) + 64;
    const bf16* WRh = (const bf16*)(p.ws + WS_WR); const bf16* WRl = WRh + 48 * D;
    for (int rb = F.vcu; rb < ML / 64; rb += F.G) {
        if (F.tid < 32) hist[F.tid] = 0;
        const int b = (rb * 64) / T;
        const float* modx = (const float*)(p.ws + WS_MODX) + b * 6144;
        if (!(abl & 2)) {
            f32x4 gp[4], mp[4], ap[4];
#pragma unroll
            for (int j = 0; j < 4; ++j) { const int k = 256 * j + 4 * F.lane;
                gp[j] = *(const f32x4*)(modx + 2048 + k) * *(const f32x4*)(p.post1 + k);
                mp[j] = *(const f32x4*)(p.pre2 + k) * (*(const f32x4*)(modx + 4096 + k) + 1.f);
                ap[j] = *(const f32x4*)(modx + 3072 + k); }
            f32x4 xn[4]; v2u on[4];
#define P5_LOAD(rw) do { _Pragma("unroll") for (int j = 0; j < 4; ++j) { xn[j] = *(const f32x4*)(p.x + (size_t)(rw) * D + 256 * j + 4 * F.lane); \
                on[j] = *(const v2u*)((const bf16*)(p.ws + WS_OX) + (size_t)(rw) * D + 256 * j + 4 * F.lane); } } while (0)
            P5_LOAD(rb * 64 + F.wave * 8);
            for (int rr = 0; rr < 8; ++rr) {
                const int rl = F.wave * 8 + rr, row = rb * 64 + rl;
                f32x4 xv[4], ox[4]; v2u oc[4]; float ss = 0.f;
#pragma unroll
                for (int j = 0; j < 4; ++j) { xv[j] = xn[j]; oc[j] = on[j]; }
                if (rr + 1 < 8) P5_LOAD(row + 1);
#pragma unroll
                for (int j = 0; j < 4; ++j) { const v2u o2 = oc[j];
                    ox[j] = (f32x4){__uint_as_float(o2.x << 16), __uint_as_float(o2.x & 0xffff0000u), __uint_as_float(o2.y << 16), __uint_as_float(o2.y & 0xffff0000u)};
                    ss += (ox[j].x * ox[j].x + ox[j].y * ox[j].y) + (ox[j].z * ox[j].z + ox[j].w * ox[j].w); }
                const float r1 = rsqrtf(wave_sum(ss) * (1.f / D) + EPS);
                float ss2 = 0.f;
#pragma unroll
                for (int j = 0; j < 4; ++j) { xv[j] = xv[j] + gp[j] * (ox[j] * r1);
                    ss2 += (xv[j].x * xv[j].x + xv[j].y * xv[j].y) + (xv[j].z * xv[j].z + xv[j].w * xv[j].w); }
                const float r2 = rsqrtf(wave_sum(ss2) * (1.f / D) + EPS);
                if (F.lane == 0) ((float*)(p.ws + WS_R1))[row] = r1;
#pragma unroll
                for (int j = 0; j < 4; ++j) {
                    const f32x4 h = xv[j] * r2 * mp[j] + ap[j];
                    v2u wh; wh.x = att::cvtpk(h.x, h.y); wh.y = att::cvtpk(h.z, h.w);
                    const f32x4 hb = (f32x4){__uint_as_float(wh.x << 16), __uint_as_float(wh.x & 0xffff0000u), __uint_as_float(wh.y << 16), __uint_as_float(wh.y & 0xffff0000u)};
                    const f32x4 dl = h - hb;
                    v2u wl; wl.x = att::cvtpk(dl.x, dl.y); wl.y = att::cvtpk(dl.z, dl.w);
                    st8((bf16*)(p.ws + WS_XN) + (size_t)row * D + 256 * j + 4 * F.lane, wh);
                    *(LAS v2u*)(LO + rl * P5_PITCH + (256 * j + 4 * F.lane) * 2) = wl;
                }
            }
#undef P5_LOAD
        }
        asm volatile("s_waitcnt vmcnt(0)" ::: "memory");
        __syncthreads();
        if (F.tid == 0) { __builtin_amdgcn_fence(__ATOMIC_ACQUIRE, "agent"); asm volatile("s_waitcnt vmcnt(0)" ::: "memory"); }
        __syncthreads();
        if (abl & 1) continue;
        {
            const int gI = F.wave >> 1, kq = F.wave & 1, r16 = F.lane & 15, g4 = F.lane >> 4;
            f32x4 acc[3];
#pragma unroll
            for (int nt = 0; nt < 3; ++nt) acc[nt] = (f32x4){0.f, 0.f, 0.f, 0.f};
            const bf16* ah = (const bf16*)(p.ws + WS_XN) + (size_t)(rb * 64 + 16 * gI + r16) * D + 512 * kq + 8 * g4;
            const LAS unsigned char* al = LO + (16 * gI + r16) * P5_PITCH + (512 * kq + 8 * g4) * 2;
            const bf16* bh = WRh + (size_t)(16 * kq) * 3 * 512 + F.lane * 8; const bf16* bl = WRl + (size_t)(16 * kq) * 3 * 512 + F.lane * 8;
#pragma unroll 8
            for (int ks = 0; ks < 16; ++ks) {
                const bf16x8 a_hi = *(const bf16x8*)(ah + ks * 32), a_lo = *(const LAS bf16x8*)(al + ks * 64);
#pragma unroll
                for (int nt = 0; nt < 3; ++nt) {
                    const bf16x8 b_hi = *(const bf16x8*)(bh + (ks * 3 + nt) * 512), b_lo = *(const bf16x8*)(bl + (ks * 3 + nt) * 512);
                    acc[nt] = __builtin_amdgcn_mfma_f32_16x16x32_bf16(a_hi, b_hi, acc[nt], 0, 0, 0);
                    acc[nt] = __builtin_amdgcn_mfma_f32_16x16x32_bf16(a_hi, b_lo, acc[nt], 0, 0, 0);
                    acc[nt] = __builtin_amdgcn_mfma_f32_16x16x32_bf16(a_lo, b_hi, acc[nt], 0, 0, 0);
                }
            }
#pragma unroll
            for (int nt = 0; nt < 3; ++nt)
#pragma unroll
                for (int q = 0; q < 4; ++q) PART[(F.wave * 16 + 4 * g4 + q) * 48 + 16 * nt + r16] = acc[nt][q];
        }
        __syncthreads();
        for (int i = F.tid; i < 64 * 48; i += NTHR) { const int row = i / 48, n = i - row * 48, gI = row >> 4, r16 = row & 15;
            LG[i] = (PART[((gI * 2 + 0) * 16 + r16) * 48 + n] + PART[((gI * 2 + 1) * 16 + r16) * 48 + n]) + (n < 4 ? p.b_group[n] : n < 36 ? p.b_router[n - 4] : 0.f); }
        __syncthreads();
        if (F.tid < 64) {
            float lg[36];
#pragma unroll
            for (int c = 0; c < 36; ++c) lg[c] = LG[F.tid * 48 + c];
            int e1, e2; float w1, w2;
            {
                int g = 0; float gm = lg[0];
#pragma unroll
                for (int q = 1; q < 4; ++q) if (lg[q] > gm) { gm = lg[q]; g = q; }
                float gs = 0.f;
#pragma unroll
                for (int q = 0; q < 4; ++q) gs += __expf(lg[q] - gm);
                const float gw = 1.f / gs;
                float el[8];
#pragma unroll
                for (int q = 0; q < 8; ++q) el[q] = g == 0 ? lg[4 + q] : g == 1 ? lg[12 + q] : g == 2 ? lg[20 + q] : lg[28 + q];
                int i1 = 0; float m1 = el[0];
#pragma unroll
                for (int q = 1; q < 8; ++q) if (el[q] > m1) { m1 = el[q]; i1 = q; }
                int i2 = -1; float m2 = -3.0e38f;
#pragma unroll
                for (int q = 0; q < 8; ++q) if (q != i1 && el[q] > m2) { m2 = el[q]; i2 = q; }
                const float ex = __expf(m2 - m1);
                w1 = gw / (1.f + ex); w2 = gw * ex / (1.f + ex); e1 = g * 8 + i1; e2 = g * 8 + i2;
            }
            const int row = rb * 64 + F.tid;
            if (!(abl & 2)) { int* te = (int*)(p.ws + WS_TOKE) + row * 2; float* tw = (float*)(p.ws + WS_TOKW) + row * 2; te[0] = e1; te[1] = e2; tw[0] = w1; tw[1] = w2; }
            atomicAdd((int*)&hist[e1 & 31], 1); atomicAdd((int*)&hist[e2 & 31], 1);
        }
        __syncthreads();
        if (F.tid < 32 && !(abl & 2)) ((int*)(p.ws + WS_BLKCNT))[rb * 32 + F.tid] = hist[F.tid];
        __syncthreads();
    }
}
__device__ __forceinline__ void p6_lists(const P& p, Frame& F) {
    LAS int* ps = (LAS int*)F.lds;
    LAS int* pp = ps + 512;
    LAS int* tot = pp + 512; LAS int* pre = tot + 32; LAS int* ebase = pre + 32;
    LAS int* es = ebase + 40;
    const int* blk = (const int*)(p.ws + WS_BLKCNT);
    int* meta = (int*)(p.ws + WS_META);
    for (int rb = F.vcu; rb < ML / 64; rb += F.G) {
        { const int e = F.tid & 31, part = F.tid >> 5; int s = 0, q = 0;
#pragma unroll 4
          for (int j = 0; j < 16; ++j) { const int bb = part * 16 + j; const int v = blk[bb * 32 + e]; s += v; q += bb < rb ? v : 0; }
          ps[part * 32 + e] = s; pp[part * 32 + e] = q; }
        __syncthreads();
        if (F.tid < 32) { int s = 0, q = 0;
#pragma unroll
            for (int part = 0; part < 16; ++part) { s += ps[part * 32 + F.tid]; q += pp[part * 32 + F.tid]; }
            tot[F.tid] = s; pre[F.tid] = q; }
        __syncthreads();
        if (F.tid == 0) { int tb = 0; for (int e = 0; e < 32; ++e) { ebase[e] = tb; tb += (tot[e] + 255) >> 8; } ebase[32] = tb; }
        if (F.tid < 128) es[F.tid] = ((const int*)(p.ws + WS_TOKE))[rb * 128 + F.tid];
        __syncthreads();
        if (F.tid < 128) {
            const int e = es[F.tid]; int rank = 0;
            for (int a = 0; a < F.tid; ++a) rank += es[a] == e ? 1 : 0;
            const int pos = ebase[e] * 256 + pre[e] + rank;
            ((int*)(p.ws + WS_ROWIDX))[pos] = rb * 64 + (F.tid >> 1);
            ((float*)(p.ws + WS_ROWW))[pos] = ((const float*)(p.ws + WS_TOKW))[rb * 128 + F.tid];
            ((int*)(p.ws + WS_TOKPOS))[rb * 128 + F.tid] = pos;
        }
        if (rb < 32) {
            const int e = rb, lo = ebase[e] * 256 + tot[e], hi = ebase[e + 1] * 256;
            for (int pos = lo + F.tid; pos < hi; pos += NTHR) { ((int*)(p.ws + WS_ROWIDX))[pos] = 0; ((float*)(p.ws + WS_ROWW))[pos] = 0.f; }
            for (int t = ebase[e] + F.tid; t < ebase[e + 1]; t += NTHR) meta[128 + t] = e;
            if (F.tid == 0) { meta[e] = tot[e]; meta[64 + e] = ebase[e]; if (e == 31) { meta[64 + 32] = ebase[32]; meta[320] = ebase[32]; } }
        }
        __syncthreads();
    }
}
__device__ __forceinline__ void p78_moe(const P& p, Frame& F, bool down) {
    LAS int* tile_e = (LAS int*)(F.lds + LDS_X);
    const int* meta = (const int*)(p.ws + WS_META);
    for (int t = F.tid; t < MAXTILES; t += NTHR) tile_e[t] = meta[128 + t] & 31;
    __syncthreads();
    const int ntiles = meta[320];
    pg8::SchedMoE S{F.G, (int)blockIdx.x, ntiles * 4, tile_e, (const int*)(p.ws + WS_ROWIDX)};
    if (!down) {
        pg8::Gemm g{(const pg8::bf16_t*)(p.ws + WS_XN), (const pg8::bf16_t*)(p.ws + WS_WGU), MAXPOS, NE * 1024, D};
        pg8::EpiGU E{(bf16*)(p.ws + WS_ACT), (const float*)(p.ws + WS_ROWW)};
        pg8::gemm_phase<pg8::EpiGU, pg8::SchedMoE, true, true, true>((PG8_LAS unsigned char*)F.lds, g, S, E);
    } else {
        pg8::Gemm g{(const pg8::bf16_t*)(p.ws + WS_ACT), (const pg8::bf16_t*)(p.ws + WS_WD), MAXPOS, NE * 1024, EFF};
        pg8::EpiY E{(bf16*)(p.ws + WS_Y)};
        pg8::gemm_phase<pg8::EpiY, pg8::SchedMoE, true, true, false>((PG8_LAS unsigned char*)F.lds, g, S, E);
    }
}
__device__ __forceinline__ void p9_final(const P& p, Frame& F, float* dst) {
    const bf16* Y = (const bf16*)(p.ws + WS_Y); const bf16* OX = (const bf16*)(p.ws + WS_OX); const float* R1 = (const float*)(p.ws + WS_R1);
    for (int rb = F.vcu; rb < ML / 64; rb += F.G) {
        const int b = (rb * 64) / T;
        const float* modx = (const float*)(p.ws + WS_MODX) + b * 6144;
        const int row0 = rb * 64 + F.wave * 8;
        f32x4 gp[4], g1p[4];
#pragma unroll
        for (int j = 0; j < 4; ++j) { const int k = 256 * j + 4 * F.lane; gp[j] = *(const f32x4*)(modx + 5120 + k) * *(const f32x4*)(p.post2 + k); g1p[j] = *(const f32x4*)(modx + 2048 + k) * *(const f32x4*)(p.post1 + k); }
        v2u ya[2][4], yc[2][4], oo[2][4]; f32x4 xo[2][4]; float r1v[2];
        const int* tpp = (const int*)(p.ws + WS_TOKPOS) + row0 * 2;
#define P9_LOAD(buf, rw, t2) do { r1v[buf] = R1[rw]; _Pragma("unroll") for (int j = 0; j < 4; ++j) { \
            ya[buf][j] = *(const v2u*)(Y + (size_t)(t2).x * D + 256 * j + 4 * F.lane); yc[buf][j] = *(const v2u*)(Y + (size_t)(t2).y * D + 256 * j + 4 * F.lane); \
            oo[buf][j] = *(const v2u*)(OX + (size_t)(rw) * D + 256 * j + 4 * F.lane); xo[buf][j] = *(const f32x4*)(p.x + (size_t)(rw) * D + 256 * j + 4 * F.lane); } } while (0)
#define P9_COMP(buf, rw) do { f32x4 y[4]; float ss = 0.f; \
            _Pragma("unroll") for (int j = 0; j < 4; ++j) { const v2u a = ya[buf][j], c = yc[buf][j]; \
                y[j] = (f32x4){__uint_as_float(a.x << 16) + __uint_as_float(c.x << 16), __uint_as_float(a.x & 0xffff0000u) + __uint_as_float(c.x & 0xffff0000u), \
                               __uint_as_float(a.y << 16) + __uint_as_float(c.y << 16), __uint_as_float(a.y & 0xffff0000u) + __uint_as_float(c.y & 0xffff0000u)}; \
                ss += (y[j].x * y[j].x + y[j].y * y[j].y) + (y[j].z * y[j].z + y[j].w * y[j].w); } \
            const float rn = rsqrtf(wave_sum(ss) * (1.f / D) + EPS); \
            _Pragma("unroll") for (int j = 0; j < 4; ++j) { const v2u o2 = oo[buf][j]; \
                const f32x4 oxv = (f32x4){__uint_as_float(o2.x << 16), __uint_as_float(o2.x & 0xffff0000u), __uint_as_float(o2.y << 16), __uint_as_float(o2.y & 0xffff0000u)}; \
                const f32x4 x1 = xo[buf][j] + g1p[j] * (oxv * r1v[buf]);                   \
                *(f32x4*)(dst + (size_t)(rw) * D + 256 * j + 4 * F.lane) = x1 + gp[j] * (y[j] * rn); } } while (0)
        int2 tpA = *(const int2*)(tpp), tpB = *(const int2*)(tpp + 2);
        P9_LOAD(0, row0, tpA);
#pragma unroll 1
        for (int rp = 0; rp < 4; ++rp) {
            const int ra = row0 + 2 * rp;
            P9_LOAD(1, ra + 1, tpB);
            int2 tpA2 = tpA, tpB2 = tpB;
            if (rp < 3) { tpA2 = *(const int2*)(tpp + 4 * rp + 4); tpB2 = *(const int2*)(tpp + 4 * rp + 6); }
            P9_COMP(0, ra);
            if (rp < 3) P9_LOAD(0, ra + 2, tpA2);
            P9_COMP(1, ra + 1);
            tpA = tpA2; tpB = tpB2;
        }
#undef P9_COMP
#undef P9_LOAD
    }
}

struct Args { P p; int ph_lo, ph_hi, li, pad; };
__global__ void __launch_bounds__(NTHR, 2) mega(Args args) {
    extern __shared__ __attribute__((aligned(16))) unsigned char lds_raw[];
    Frame F;
    F.lds = (LAS unsigned char*)lds_raw;
    F.MISC = (volatile LAS unsigned*)(F.lds + MISC_OFF);
    F.tid = threadIdx.x; F.lane = F.tid & 63; F.wave = __builtin_amdgcn_readfirstlane(F.tid >> 6);
    F.G = gridDim.x; { const int bx = blockIdx.x; F.vcu = (F.G % 8 == 0) ? (bx % 8) * (F.G / 8) + bx / 8 : bx; }
    const P& p = args.p;
    unsigned* ctl = (unsigned*)(p.ws + WS_CTL);
    for (int u = F.tid; u < (LDS_BYTES - MISC_OFF) / 4; u += NTHR) ((LAS unsigned*)(F.lds + MISC_OFF))[u] = 0u;
    __syncthreads();
    const int lo = args.ph_lo, hi = args.ph_hi;
    XcdBarrier bar; bar.bar = ctl + CW_BAR + args.li * XCD_BAR_WORDS; bar.x = 0; bar.st = nullptr;
    if (hi - lo > 1) bar = xcd_barrier_post(ctl + CW_BAR + args.li * XCD_BAR_WORDS, F.MISC + 8);
#define IN(k) (lo <= (k) && (k) < hi)
#define SEAM(k) do { if (IN(k) && IN((k) + 1)) xcd_barrier(bar); } while (0)
    if (IN(0)) { p0_prologue(p, F); SEAM(0); }
    if (IN(1)) { p1_norm(p, F); SEAM(1); }
    if (IN(2)) {
        pg8::Gemm g{(const pg8::bf16_t*)(p.ws + WS_XN), (const pg8::bf16_t*)(p.ws + WS_WQKV), MT, NQKV, D};
        pg8::SchedQKV S{F.G, (int)blockIdx.x};
        pg8::EpiQKV E{p.ws, p.bqn, p.bkn};
        pg8::gemm_phase<pg8::EpiQKV, pg8::SchedQKV, true, true, false>((PG8_LAS unsigned char*)F.lds, g, S, E);
        SEAM(2);
    }
#ifdef PROBE_ABL
    if (IN(3) && args.pad) { att::attn_phase<PROBE_ABL>(p, F.lds, F.vcu, F.G); } else
#endif
    if (IN(3)) { att::attn_phase<0>(p, F.lds, F.vcu, F.G); SEAM(3); }
    if (IN(4)) { p4_outproj(p, F); SEAM(4); }
#ifdef PROBE_ABL5
    if (IN(5) && args.pad) { p5_rowpass(p, F, PROBE_ABL5); } else
#endif
    if (IN(5)) { p5_rowpass(p, F); SEAM(5); }
    if (IN(6)) { p6_lists(p, F); SEAM(6); }
    if (IN(7)) { p78_moe(p, F, false); SEAM(7); }
    if (IN(8)) { p78_moe(p, F, true); SEAM(8); }
    if (IN(9)) { p9_final(p, F, args.pad ? (float*)(p.ws + WS_WGU) : p.out); }
#undef IN
#undef SEAM
}

#ifndef ONE_LAUNCH
#define ONE_LAUNCH 1
#endif
#ifndef FAST_MASK
#define FAST_MASK 0x3ff
#endif
static void launch_mega(const P& p, int lo, int hi, int li, int grid, hipStream_t stream) {
    Args a{}; a.p = p; a.ph_lo = lo; a.ph_hi = hi; a.li = li; a.pad = 0;
    hipLaunchKernelGGL(mega, dim3(grid), dim3(NTHR), LDS_BYTES, stream, a);
}
extern "C" void kernel_launch(void* const* d_in, const int* in_sizes, int n_in, void* d_out, int out_size, void* d_ws, size_t ws_size, hipStream_t stream) {
    static int grid = 0;
    if (grid == 0) {
        if (n_in != 24 || out_size != ML * D || ws_size < WS_END) { fprintf(stderr, "kernel_launch: unexpected shapes (n_in %d out %d ws %zu)\n", n_in, out_size, ws_size); grid = -1; return; }
        int dev = 0, cus = 0, per_cu = 0;
        if (hipGetDevice(&dev) != hipSuccess || hipDeviceGetAttribute(&cus, hipDeviceAttributeMultiprocessorCount, dev) != hipSuccess) { grid = -1; return; }
        if (hipFuncSetAttribute((const void*)mega, hipFuncAttributeMaxDynamicSharedMemorySize, LDS_BYTES) != hipSuccess) { fprintf(stderr, "kernel_launch: hipFuncSetAttribute failed\n"); grid = -1; return; }
        if (hipOccupancyMaxActiveBlocksPerMultiprocessor(&per_cu, (const void*)mega, NTHR, LDS_BYTES) != hipSuccess || per_cu < 1) { fprintf(stderr, "kernel_launch: occupancy query says %d blocks/CU\n", per_cu); (void)hipGetLastError(); grid = -1; return; }
        grid = cus;
    }
    if (grid < 0) return;
    P p{};
    const float** f = (const float**)&p;
    for (int i = 0; i < 24; ++i) f[i] = (const float*)d_in[i];
    p.out = (float*)d_out; p.ws = (unsigned char*)d_ws;
    (void)hipMemsetAsync((char*)d_ws + WS_CTL, 0, 64 * 1024, stream);
#if ONE_LAUNCH
    launch_mega(p, 0, 10, 0, grid, stream);
#else
    for (int k = 0; k < 10; ++k) {
        launch_mega(p, k, k + 1, 0, grid, stream);
#ifdef PROBE_DUP
        if (k == PROBE_DUP) for (int r_ = 0; r_ < 3; ++r_) { Args a{}; a.p = p; a.ph_lo = k; a.ph_hi = k + 1; a.li = 0; a.pad = 1; hipLaunchKernelGGL(mega, dim3(grid), dim3(NTHR), LDS_BYTES, stream, a); }
#endif
    }
#endif
}
```

```cpp
#include <hip/hip_runtime.h>
#include <cstdio>
#include <cstdint>
#ifndef WCONV_IN_ATTN
#define WCONV_IN_ATTN 1
#endif

constexpr int NB = 8, T = 2048, D = 1024, CL = 256;
constexpr int ML = NB * T;
constexpr int MC = NB * CL;
constexpr int MT = ML + MC;
constexpr int NKEY = T + CL;
constexpr int NTILE = NKEY / 64;
constexpr int NQKV = 1536;
constexpr int NE = 32, EFF = 512;
constexpr int MAXPOS = 40960;
constexpr int MAXTILES = MAXPOS / 256;
constexpr float EPS = 1e-6f;
constexpr float LOG2E = 1.4426950408889634f;
constexpr float C2 = 0.125f * LOG2E;

typedef unsigned short bf16;

constexpr size_t MiB = 1u << 20;
constexpr size_t WS_CTL = 0;
constexpr size_t WS_MODX = 1 * MiB;
constexpr size_t WS_ROPE = 1 * MiB + 512 * 1024;
constexpr size_t WS_WR = 1 * MiB + 768 * 1024;
constexpr size_t WS_TOKE = 2 * MiB;
constexpr size_t WS_TOKW = WS_TOKE + 128 * 1024;
constexpr size_t WS_TOKPOS = WS_TOKW + 128 * 1024;
constexpr size_t WS_ROWIDX = WS_TOKPOS + 128 * 1024;
constexpr size_t WS_ROWW = WS_ROWIDX + 160 * 1024;
constexpr size_t WS_BLKCNT = WS_ROWW + 160 * 1024;
constexpr size_t WS_META = WS_BLKCNT + 32 * 1024;
constexpr size_t WS_WQKV = 4 * MiB;
constexpr size_t WS_WO = 7 * MiB;
constexpr size_t WS_WGU = 9 * MiB;
constexpr size_t WS_WD = 73 * MiB;
constexpr size_t WS_XN = 105 * MiB;
constexpr size_t WS_QA = 141 * MiB;
constexpr size_t WS_QB = 157 * MiB;
constexpr size_t WS_KA = 173 * MiB;
constexpr size_t WS_VA = WS_KA + 4608 * 1024;
constexpr size_t WS_KB = WS_VA + 4608 * 1024;
constexpr size_t WS_VB = WS_KB + 4608 * 1024;
constexpr size_t WS_O = 191 * MiB;
constexpr size_t WS_SSQ = 223 * MiB;
constexpr size_t WS_OX = 261 * MiB;
constexpr size_t WS_R1 = 293 * MiB;
constexpr size_t WS_ACT = 141 * MiB;
constexpr size_t WS_Y = 181 * MiB;
constexpr size_t WS_END = 294 * MiB;

__device__ __forceinline__ unsigned f2bf(float f) { unsigned u = __builtin_bit_cast(unsigned, f); return (u + 0x7fffu + ((u >> 16) & 1u)) >> 16; }
__device__ __forceinline__ float bf2f(bf16 h) { return __builtin_bit_cast(float, (unsigned)h << 16); }
__device__ __forceinline__ float wave_sum(float v) {
#pragma unroll
    for (int o = 1; o < 64; o <<= 1) v += __shfl_xor(v, o);
    return v;
}
__device__ __forceinline__ float wave_max(float v) {
#pragma unroll
    for (int o = 1; o < 64; o <<= 1) v = fmaxf(v, __shfl_xor(v, o));
    return v;
}
__device__ __forceinline__ float silu_f(float v) { return v / (1.f + __expf(-v)); }

__host__ __device__ __forceinline__ int qkv_row(int n) { const int pn = n >> 8, j = n & 255, hh = j >> 6, d = j & 63; return pn * 256 + (d >> 5) * 128 + hh * 32 + (d & 31); }
__host__ __device__ __forceinline__ size_t q_off(int b, int h, int t, int d) { return (((size_t)(b * 8 + h) * T + t) * 64 + d); }
__host__ __device__ __forceinline__ size_t k_off(int b, int kvh, int pos, int d) { return ((size_t)((b * 2 + kvh) * NTILE + (pos >> 6)) * 4096 + (d >> 3) * 512 + (pos & 63) * 8 + (d & 7)); }
__host__ __device__ __forceinline__ size_t v_off(int b, int kvh, int pos, int d) { return ((size_t)((b * 2 + kvh) * NTILE + (pos >> 6)) * 4096 + (d >> 5) * 2048 + (pos & 63) * 32 + (d & 31)); }

struct P {
    const float *x, *c, *ctx, *c_ctx, *w_mod, *b_mod, *pre1, *post1, *w_in, *a_sink, *bqn, *bkn, *aon, *bon, *w_out, *pre2, *post2, *w_group, *b_group, *w_router, *b_router, *w_gate, *w_up, *w_down;
    float* out; unsigned char* ws;
};

#define GAS __attribute__((address_space(1)))
#define LAS __attribute__((address_space(3)))
typedef unsigned v4u __attribute__((ext_vector_type(4)));
typedef unsigned v2u __attribute__((ext_vector_type(2)));
typedef float f32x4 __attribute__((ext_vector_type(4)));
typedef float f32x16 __attribute__((ext_vector_type(16)));
typedef short bf16x8 __attribute__((ext_vector_type(8)));
typedef short s16x4 __attribute__((ext_vector_type(4)));
constexpr int NWAVES = 8, NTHR = 512;
constexpr int LDS_BYTES = 163840;
constexpr int RING_BYTES = 131072;
constexpr int MISC_OFF = 159 * 1024;
constexpr int CW_TMO = 0, CW_CODE = 1, CW_BAR = 4096;
static_assert((CW_BAR + 3456) * 4 <= 64 * 1024, "control words inside the per-call memset");
#define LDS_WAIT() asm volatile("s_waitcnt lgkmcnt(0)" ::: "memory")
#define VM_WAIT() asm volatile("s_waitcnt vmcnt(0)" ::: "memory")
__device__ __forceinline__ unsigned pk2(float lo, float hi) { return f2bf(lo) | (f2bf(hi) << 16); }
#ifndef WT_STORES
#define WT_STORES 0
#endif
__device__ __forceinline__ void st16(void* p, v4u v) {
#if WT_STORES
    asm volatile("global_store_dwordx4 %0, %1, off sc1\n\ts_nop 1" :: "v"(p), "v"(v) : "memory");
#else
    *(v4u*)p = v;
#endif
}
__device__ __forceinline__ void st16f(void* p, f32x4 v) { st16(p, __builtin_bit_cast(v4u, v)); }
__device__ __forceinline__ void st8(void* p, v2u v) {
#if WT_STORES
    asm volatile("global_store_dwordx2 %0, %1, off sc1\n\ts_nop 1" :: "v"(p), "v"(v) : "memory");
#else
    *(v2u*)p = v;
#endif
}

#define XB_TMO      128
#define XB_XCNT(j)  (256  + 64 * (j))
#define XB_XSUB(j)  (1280 + 64 * (j))
#define XB_XGEN(j)  (2304 + 64 * (j))
#define XB_TOP      3328
#define XB_TOPGEN   3392
#define XCD_BAR_WORDS 3456
#define XB_SPIN_CAP (1u << 18)
__device__ __forceinline__ unsigned xb_ld(unsigned* p)              { return __hip_atomic_load(p, __ATOMIC_RELAXED, __HIP_MEMORY_SCOPE_AGENT); }
__device__ __forceinline__ unsigned xb_add(unsigned* p, unsigned v) { return __hip_atomic_fetch_add(p, v, __ATOMIC_RELAXED, __HIP_MEMORY_SCOPE_AGENT); }
__device__ __forceinline__ unsigned xb_xcc_id() { return (unsigned)__builtin_amdgcn_s_getreg((3 << 11) | 20) & 0xFu; }
#define XB_SPIN(cond, bar) do { unsigned _sp = 0; while (cond) { __builtin_amdgcn_s_sleep(1); \
    if ((++_sp & 255u) == 0u) { if (xb_ld(&(bar)[XB_TMO])) break; if (_sp > XB_SPIN_CAP) { atomicAdd(&(bar)[XB_TMO], 1u); break; } } } } while (0)
struct XcdBarrier { unsigned* bar; unsigned x; volatile LAS unsigned* st; };
__device__ __forceinline__ XcdBarrier xcd_barrier_post(unsigned* bar, volatile LAS unsigned* st) {
    XcdBarrier b; b.bar = bar; b.x = xb_xcc_id(); b.st = st;
    if (threadIdx.x == 0) (void)xb_add(&bar[XB_XCNT(b.x)], 1u);
    return b;
}
__device__ __forceinline__ void xcd_barrier_complete(unsigned* bar, unsigned x, unsigned& nloc, unsigned& nx) {
    const unsigned G = gridDim.x * gridDim.y * gridDim.z;
    unsigned sum, cnt, mine, sp = 0u;
    for (;;) {
        sum = 0u; cnt = 0u; mine = 0u;
#pragma unroll
        for (unsigned j = 0; j < 16; ++j) { const unsigned c = xb_ld(&bar[XB_XCNT(j)]); sum += c; cnt += (c > 0u) ? 1u : 0u; mine = (j == x) ? c : mine; }
        if (sum == G) break;
        __builtin_amdgcn_s_sleep(1);
        if ((++sp & 255u) == 0u) { if (xb_ld(&bar[XB_TMO])) break; if (sp > XB_SPIN_CAP) { atomicAdd(&bar[XB_TMO], 1u); break; } }
    }
    nloc = mine > 0u ? mine : 1u; nx = cnt > 0u ? cnt : 1u;
}
__device__ __forceinline__ void xcd_barrier(const XcdBarrier& b) {
    asm volatile("s_waitcnt vmcnt(0)" ::: "memory");
    __syncthreads();
    if (threadIdx.x == 0) {
        unsigned* bar = b.bar;
        __builtin_amdgcn_s_waitcnt(0);
        unsigned nloc = b.st[0], nx = b.st[1];
        if (nloc == 0u) { xcd_barrier_complete(bar, b.x, nloc, nx); b.st[0] = nloc; b.st[1] = nx; }
        const unsigned old = xb_add(&bar[XB_XSUB(b.x)], 1u);
        const unsigned gen = old / nloc;
        if (old + 1u == (gen + 1u) * nloc) {
            __builtin_amdgcn_fence(__ATOMIC_RELEASE, "agent");
            asm volatile("s_waitcnt vmcnt(0)" ::: "memory");
            const unsigned og = xb_add(&bar[XB_TOP], 1u);
            const unsigned tg = og / nx;
            if (og + 1u == (tg + 1u) * nx) xb_add(&bar[XB_TOPGEN], 1u);
            else XB_SPIN(xb_ld(&bar[XB_TOPGEN]) == tg, bar);
            __builtin_amdgcn_fence(__ATOMIC_ACQUIRE, "agent");
            xb_add(&bar[XB_XGEN(b.x)], 1u);
            asm volatile("s_waitcnt vmcnt(0)" ::: "memory");
        } else {
            XB_SPIN(xb_ld(&bar[XB_XGEN(b.x)]) == gen, bar);
            __builtin_amdgcn_fence(__ATOMIC_ACQUIRE, "agent");
            asm volatile("s_waitcnt vmcnt(0)" ::: "memory");
        }
    }
    __syncthreads();
}

namespace pg8 {
#define PG8_LAS __attribute__((address_space(3)))
typedef unsigned short bf16_t;
typedef short bf16x8 __attribute__((ext_vector_type(8)));
typedef float f32x4 __attribute__((ext_vector_type(4)));
typedef unsigned u32x4 __attribute__((ext_vector_type(4)));
constexpr int BM = 256, BK = 64, HALF = 128, HTB = HALF * BK * 2  , STAGE_BYTES = 8 * HTB, NXCD = 8, WGM = 8;

__host__ __device__ __forceinline__ int lds_byte(int r, int c) { const int st = (r >> 4) * 2 + (c >> 5), rr = r & 15, cc = c & 31, ob = rr * 64 + cc * 2; return st * 1024 + (ob ^ (((ob >> 9) & 1) << 5)); }
__host__ __device__ __forceinline__ void stage_rc(int b, int& R, int& C) { const int st = b / 1024, sb = b % 1024, swz = sb ^ (((sb >> 9) & 1) << 5); R = (st >> 1) * 16 + swz / 64; C = (st & 1) * 32 + (swz % 64) / 2; }
__host__ __device__ __forceinline__ int perm32(int rho) { const int n = rho >> 4, i = rho & 15; return 8 * (i >> 2) + 4 * n + (i & 3); }

struct Unit { int pm, pn; };
struct Gemm { const bf16_t* A; const bf16_t* Bt; int M, N, K; };
__device__ __forceinline__ unsigned cvt_pk_bf16(float lo, float hi) { unsigned r; asm volatile("v_cvt_pk_bf16_f32 %0, %1, %2" : "=v"(r) : "v"(lo), "v"(hi)); return r; }
template <class Epi, class Sched, bool ALIGN_EPI = false, bool SP2 = false, bool GATHER = false>
__device__ __forceinline__ void gemm_phase(PG8_LAS unsigned char* lds, const Gemm g, const Sched& S, const Epi& E) {
    const int tid = threadIdx.x, wid = __builtin_amdgcn_readfirstlane(tid >> 6), lane = tid & 63, wr = wid >> 2, wc = wid & 3, fr = lane & 15, fq = lane >> 4;
    const int K = g.K, nt = K / BK;
    unsigned voffA[2], voffB[2]; int RA[2], CA[2];
#pragma unroll
    for (int i = 0; i < 2; ++i) { int R, C; stage_rc(tid * 16 + i * 8192, R, C); const int Rb = Epi::PERM ? ((R & ~31) + perm32(R & 31)) : R;
        voffA[i] = (unsigned)(R * K + C) * 2u; voffB[i] = (unsigned)(Rb * K + C) * 2u; RA[i] = R; CA[i] = C; }
    const size_t kstep = (size_t)(BK * 2);
    const size_t hstep = (size_t)HALF * K * 2;
    const size_t tstep = 2 * hstep;
    const unsigned ldsw = (unsigned)wid * 1024u;
    const int aoff = lds_byte(wr * 64 + fr, fq * 8), boff = lds_byte(wc * 32 + fr, fq * 8);
#define PG8_SA(b, h) (((b) * 2 + (h)) * HTB)
#define PG8_SB(b, h) ((4 + (b) * 2 + (h)) * HTB)
#define PG8_STAGE(bufoff, gbase, voff) do { _Pragma("unroll") for (int _i = 0; _i < 2; ++_i) \
        __builtin_amdgcn_global_load_lds((const unsigned*)((const char*)(gbase) + (voff)[_i]), (PG8_LAS unsigned*)(lds + (bufoff) + ldsw + _i * 8192), 16, 0, 0); } while (0)
#define PG8_STAGE_A(bufoff, gbase, h, VO) do { if constexpr (GATHER) { PG8_STAGE(bufoff, gbase, VO[h]); } else { PG8_STAGE(bufoff, (gbase) + (h) * hstep, voffA); } } while (0)
#define PG8_LDA(dst, b, h) do { _Pragma("unroll") for (int m = 0; m < 4; ++m) _Pragma("unroll") for (int k = 0; k < 2; ++k) dst[m][k] = *(const PG8_LAS bf16x8*)(lds + PG8_SA(b, h) + aoff + m * 2048 + k * 1024); } while (0)
#define PG8_LDB(dst, b, h) do { _Pragma("unroll") for (int n = 0; n < 2; ++n) _Pragma("unroll") for (int k = 0; k < 2; ++k) dst[n][k] = *(const PG8_LAS bf16x8*)(lds + PG8_SB(b, h) + boff + n * 2048 + k * 1024); } while (0)
#define PG8_MMA(ai, bj, At, Bt) do { __builtin_amdgcn_s_setprio(1); _Pragma("unroll") for (int m = 0; m < 4; ++m) _Pragma("unroll") for (int n = 0; n < 2; ++n) _Pragma("unroll") for (int k = 0; k < 2; ++k) \
        acc[ai][bj][m][n] = __builtin_amdgcn_mfma_f32_16x16x32_bf16(Bt[n][k], At[m][k], acc[ai][bj][m][n], 0, 0, 0); __builtin_amdgcn_s_setprio(0); } while (0)
#define PG8_WAIT_V(n) asm volatile("s_waitcnt vmcnt(" #n ")" ::: "memory")
#define PG8_WAIT_L(n) asm volatile("s_waitcnt lgkmcnt(" #n ")" ::: "memory")
#define PG8_BAR __builtin_amdgcn_s_barrier()
#define PG8_SCHED __builtin_amdgcn_sched_barrier(0)
    Unit cur, nxt; int ui = 0;
    if (!S.next(0, cur)) return;
    f32x4 acc[2][2][4][2];
#pragma unroll
    for (int a = 0; a < 2; ++a)
#pragma unroll
        for (int b = 0; b < 2; ++b)
#pragma unroll
            for (int m = 0; m < 4; ++m)
#pragma unroll
                for (int n = 0; n < 2; ++n) acc[a][b][m][n] = (f32x4){0.f, 0.f, 0.f, 0.f};
    bf16x8 At[4][2], B0[2][2], B1[2][2];
    const char* cA = (const char*)g.A + (GATHER ? (size_t)0 : (size_t)cur.pm * tstep); const char* cB = (const char*)g.Bt + (size_t)cur.pn * tstep;
    unsigned vcur[2][2], vnxt[2][2], vsel[2][2];
#pragma unroll
    for (int h = 0; h < 2; ++h)
#pragma unroll
        for (int i = 0; i < 2; ++i) { vcur[h][i] = 0u; vnxt[h][i] = 0u; vsel[h][i] = 0u; }
    if constexpr (GATHER) {
#pragma unroll
        for (int h = 0; h < 2; ++h)
#pragma unroll
            for (int i = 0; i < 2; ++i) vcur[h][i] = ((unsigned)S.rowidx[cur.pm * BM + h * HALF + RA[i]] * (unsigned)K + (unsigned)CA[i]) * 2u;
    }
    S.a_ready(cur);
    if constexpr (SP2) {
        PG8_STAGE(PG8_SB(0, 0), cB, voffB); PG8_STAGE(PG8_SB(0, 1), cB + hstep, voffB); PG8_STAGE_A(PG8_SA(0, 0), cA, 0, vcur); PG8_STAGE_A(PG8_SA(0, 1), cA, 1, vcur);
        if (wr == 1) PG8_BAR;
        PG8_WAIT_V(2); PG8_BAR;
        PG8_STAGE(PG8_SB(1, 0), cB + kstep, voffB); PG8_STAGE_A(PG8_SA(1, 0), cA + kstep, 0, vcur); PG8_STAGE(PG8_SB(1, 1), cB + hstep + kstep, voffB);
        PG8_WAIT_V(6); PG8_BAR;
    } else {
        PG8_STAGE(PG8_SB(0, 0), cB, voffB); PG8_STAGE_A(PG8_SA(0, 0), cA, 0, vcur); PG8_STAGE(PG8_SB(0, 1), cB + hstep, voffB); PG8_STAGE_A(PG8_SA(0, 1), cA, 1, vcur);
        if (wr == 1) PG8_BAR;
        PG8_WAIT_V(4); PG8_BAR;
        PG8_STAGE(PG8_SB(1, 0), cB + kstep, voffB); PG8_STAGE_A(PG8_SA(1, 0), cA + kstep, 0, vcur); PG8_STAGE(PG8_SB(1, 1), cB + hstep + kstep, voffB);
        PG8_WAIT_V(6); PG8_BAR;
    }
    for (;;) {
        const bool has_next = S.next(ui + 1, nxt);
        if constexpr (GATHER) {
#pragma unroll
            for (int h = 0; h < 2; ++h)
#pragma unroll
                for (int i = 0; i < 2; ++i) vnxt[h][i] = has_next ? ((unsigned)S.rowidx[nxt.pm * BM + h * HALF + RA[i]] * (unsigned)K + (unsigned)CA[i]) * 2u : vcur[h][i];
        }
        const char* nA = has_next ? (const char*)g.A + (GATHER ? (size_t)0 : (size_t)nxt.pm * tstep) : cA; const char* nB = has_next ? (const char*)g.Bt + (size_t)nxt.pn * tstep : cB;
        for (int t = 0; t < nt; t += 2) {
            const bool last = (t == nt - 2);
            if constexpr (GATHER) {
#pragma unroll
                for (int h = 0; h < 2; ++h)
#pragma unroll
                    for (int i = 0; i < 2; ++i) vsel[h][i] = last ? vnxt[h][i] : vcur[h][i];
            }
            if constexpr (Epi::HAS_MID) { if (t == nt / 2) E.mid(acc, cur, wr, wc, fr, fq); }
            const char* a1 = cA + (size_t)(t + 1) * kstep;
            const char* a2 = last ? nA : cA + (size_t)(t + 2) * kstep; const char* b2 = last ? nB : cB + (size_t)(t + 2) * kstep;
            const char* a3 = a2 + kstep; const char* b3 = b2 + kstep;
            if (last && has_next) S.a_ready(nxt);
            if constexpr (SP2) {
            PG8_LDB(B0, 0, 0); PG8_LDB(B1, 0, 1); PG8_SCHED; PG8_LDA(At, 0, 0); PG8_STAGE_A(PG8_SA(1, 1), a1, 1, vcur);
            PG8_WAIT_V(8); PG8_WAIT_L(0); PG8_BAR; PG8_MMA(0, 0, At, B0); PG8_MMA(0, 1, At, B1); PG8_BAR; PG8_SCHED;
            PG8_LDA(At, 0, 1); PG8_STAGE(PG8_SB(0, 0), b2, voffB); PG8_STAGE(PG8_SB(0, 1), b2 + hstep, voffB); PG8_STAGE_A(PG8_SA(0, 0), a2, 0, vsel);
            PG8_WAIT_V(8); PG8_WAIT_L(0); PG8_BAR; PG8_MMA(1, 0, At, B0); PG8_MMA(1, 1, At, B1); PG8_BAR; PG8_SCHED;
            PG8_LDB(B0, 1, 0); PG8_LDB(B1, 1, 1); PG8_SCHED; PG8_LDA(At, 1, 0); PG8_STAGE_A(PG8_SA(0, 1), a2, 1, vsel);
            PG8_WAIT_V(8); PG8_WAIT_L(0); PG8_BAR; PG8_MMA(0, 0, At, B0); PG8_MMA(0, 1, At, B1); PG8_BAR; PG8_SCHED;
            PG8_LDA(At, 1, 1); PG8_STAGE(PG8_SB(1, 0), b3, voffB); PG8_STAGE(PG8_SB(1, 1), b3 + hstep, voffB); PG8_STAGE_A(PG8_SA(1, 0), a3, 0, vsel);
            PG8_WAIT_V(8); PG8_WAIT_L(0); PG8_BAR; PG8_MMA(1, 0, At, B0); PG8_MMA(1, 1, At, B1); PG8_BAR; PG8_SCHED;
            } else {
            PG8_LDB(B0, 0, 0); PG8_SCHED; PG8_LDA(At, 0, 0); PG8_STAGE_A(PG8_SA(1, 1), a1, 1, vcur);
            PG8_WAIT_L(8); PG8_BAR; PG8_WAIT_L(0); PG8_MMA(0, 0, At, B0); PG8_BAR; PG8_SCHED;
            PG8_LDB(B1, 0, 1); PG8_STAGE(PG8_SB(0, 0), b2, voffB);
            PG8_BAR; PG8_WAIT_L(0); PG8_MMA(0, 1, At, B1); PG8_BAR;
            PG8_LDA(At, 0, 1); PG8_STAGE_A(PG8_SA(0, 0), a2, 0, vsel);
            PG8_BAR; PG8_WAIT_L(0); PG8_MMA(1, 0, At, B0); PG8_BAR; PG8_SCHED;
            PG8_STAGE(PG8_SB(0, 1), b2 + hstep, voffB);
            PG8_WAIT_V(6); PG8_BAR; PG8_MMA(1, 1, At, B1); PG8_BAR;
            PG8_LDB(B0, 1, 0); PG8_SCHED; PG8_LDA(At, 1, 0); PG8_STAGE_A(PG8_SA(0, 1), a2, 1, vsel);
            PG8_WAIT_L(8); PG8_BAR; PG8_WAIT_L(0); PG8_MMA(0, 0, At, B0); PG8_BAR; PG8_SCHED;
            PG8_LDB(B1, 1, 1); PG8_STAGE(PG8_SB(1, 0), b3, voffB);
            PG8_BAR; PG8_WAIT_L(0); PG8_MMA(0, 1, At, B1); PG8_BAR;
            PG8_LDA(At, 1, 1); PG8_STAGE_A(PG8_SA(1, 0), a3, 0, vsel);
            PG8_BAR; PG8_WAIT_L(0); PG8_MMA(1, 0, At, B0); PG8_BAR; PG8_SCHED;
            PG8_STAGE(PG8_SB(1, 1), b3 + hstep, voffB);
            PG8_WAIT_V(6); PG8_BAR; PG8_MMA(1, 1, At, B1); PG8_BAR;
            }
        }
        if constexpr (ALIGN_EPI) { if (wr == 0) PG8_BAR; }
        if constexpr (!Epi::AFTER_DRAIN) { E(acc, cur, wr, wc, fr, fq); S.done(cur); }
        if (!has_next) break;
#pragma unroll
        for (int a = 0; a < 2; ++a)
#pragma unroll
            for (int b = 0; b < 2; ++b)
#pragma unroll
                for (int m = 0; m < 4; ++m)
#pragma unroll
                    for (int n = 0; n < 2; ++n) acc[a][b][m][n] = (f32x4){0.f, 0.f, 0.f, 0.f};
        cur = nxt; cA = nA; cB = nB; ++ui;
        if constexpr (GATHER) {
#pragma unroll
            for (int h = 0; h < 2; ++h)
#pragma unroll
                for (int i = 0; i < 2; ++i) vcur[h][i] = vnxt[h][i];
        }
        if constexpr (ALIGN_EPI) { if (wr == 1) PG8_BAR; }
    }
    PG8_WAIT_V(0);
    if constexpr (!ALIGN_EPI) { if (wr == 0) PG8_BAR; }
    PG8_BAR;
    if constexpr (Epi::AFTER_DRAIN) { E.fused(acc, cur, wr, wc, fr, fq, lds, wid, lane); S.done(cur); }
#undef PG8_SA
#undef PG8_SB
#undef PG8_STAGE
#undef PG8_STAGE_A
#undef PG8_LDA
#undef PG8_LDB
#undef PG8_MMA
#undef PG8_WAIT_V
#undef PG8_WAIT_L
#undef PG8_BAR
#undef PG8_SCHED
}
}

namespace pg8 {
struct SchedQKV {
    int G, c;
    __device__ __forceinline__ bool next(int i, Unit& u) const {
        const int L = i * G + c; if (L >= 400) return false;
        if (L < 384) { const int xcd = L & 7, off = L >> 3, w = xcd * 48 + off; u.pm = (w / 48) * 8 + ((w % 48) & 7); u.pn = (w % 48) >> 3; }
        else { const int j = L - 384; u.pm = 64 + (j >> 1); u.pn = (j & 1) ? 5 : 2; }
        return true;
    }
    __device__ __forceinline__ void a_ready(const Unit&) const {}
    __device__ __forceinline__ void done(const Unit&) const {}
};
struct EpiQKV {
    static constexpr bool PERM = true, AFTER_DRAIN = false, HAS_MID = false;
    unsigned char* ws; const float* bqn; const float* bkn;
    __device__ __forceinline__ void operator()(const f32x4 (&acc)[2][2][4][2], const Unit& u, int wr, int wc, int fr, int fq) const {
        const int pn = u.pn; const bool isctx = u.pm >= 64;
        int kind, hh;
        if (pn < 2) { kind = 0; hh = pn * 4 + wc; } else if (pn == 2) { kind = wc < 2 ? 2 : 4; hh = wc & 1; } else if (pn < 5) { kind = 1; hh = (pn - 3) * 4 + wc; } else { kind = wc < 2 ? 3 : 5; hh = wc & 1; }
        const bool rms = kind == 1 || kind == 3, rope = !isctx && kind <= 3;
        const float* gp = kind == 1 ? bqn : bkn;
        f32x4 gain[2][2];
#pragma unroll
        for (int bj = 0; bj < 2; ++bj)
#pragma unroll
            for (int n = 0; n < 2; ++n) gain[bj][n] = rms ? *(const f32x4*)(gp + 32 * bj + 8 * fq + 4 * n) : (f32x4){1.f, 1.f, 1.f, 1.f};
        const float* tab = (const float*)(ws + WS_ROPE);
        bf16* base = (bf16*)(ws + (kind == 0 ? WS_QA : kind == 1 ? WS_QB : kind == 2 ? WS_KA : kind == 3 ? WS_KB : kind == 4 ? WS_VA : WS_VB));
        const float qs = kind <= 1 ? C2 : 1.f;
#pragma unroll
        for (int ai = 0; ai < 2; ++ai)
#pragma unroll
            for (int m = 0; m < 4; ++m) {
                const int row = u.pm * BM + ai * HALF + wr * 64 + m * 16 + fr;
                int b, t, pos;
                if (!isctx) { b = row >> 11; t = row & 2047; pos = t; } else { const int cr = row - ML; b = cr >> 8; t = 0; pos = T + (cr & 255); }
                f32x4 v[2][2];
#pragma unroll
                for (int bj = 0; bj < 2; ++bj)
#pragma unroll
                    for (int n = 0; n < 2; ++n) v[bj][n] = acc[ai][bj][m][n];
                if (rms) {
                    float ss = 0.f;
#pragma unroll
                    for (int bj = 0; bj < 2; ++bj)
#pragma unroll
                        for (int n = 0; n < 2; ++n) ss += (v[bj][n].x * v[bj][n].x + v[bj][n].y * v[bj][n].y) + (v[bj][n].z * v[bj][n].z + v[bj][n].w * v[bj][n].w);
                    ss += __shfl_xor(ss, 16); ss += __shfl_xor(ss, 32);
                    const float rn = rsqrtf(ss * (1.f / 64.f) + EPS);
#pragma unroll
                    for (int bj = 0; bj < 2; ++bj)
#pragma unroll
                        for (int n = 0; n < 2; ++n) v[bj][n] = v[bj][n] * rn * gain[bj][n];
                }
                if (rope) {
#pragma unroll
                    for (int bj = 0; bj < 2; ++bj)
#pragma unroll
                        for (int n = 0; n < 2; ++n) {
                            const int tp = bj == 0 ? (t >> 6) : 32 + (t & 63);
                            const f32x4 cs = *(const f32x4*)(tab + (tp * 16 + 4 * fq + 2 * n) * 2);
                            const f32x4 x = v[bj][n];
                            v[bj][n] = (f32x4){x.x * cs.x - x.y * cs.y, x.x * cs.y + x.y * cs.x, x.z * cs.z - x.w * cs.w, x.z * cs.w + x.w * cs.z};
                        }
                }
#pragma unroll
                for (int bj = 0; bj < 2; ++bj) {
                    const f32x4 v0 = v[bj][0] * qs, v1 = v[bj][1] * qs;
                    u32x4 w; w.x = pk2(v0.x, v0.y); w.y = pk2(v0.z, v0.w); w.z = pk2(v1.x, v1.y); w.w = pk2(v1.z, v1.w);
                    const int d0 = 32 * bj + 8 * fq;
                    bf16* dst = kind <= 1 ? base + q_off(b, hh, t, d0) : kind <= 3 ? base + k_off(b, hh, pos, d0) : base + v_off(b, hh, pos, d0);
                    st16(dst, w);
                }
            }
    }
};
}


namespace pg8 {
struct SchedOne { Unit u;
    __device__ __forceinline__ bool next(int i, Unit& o) const { if (i) return false; o = u; return true; }
    __device__ __forceinline__ void a_ready(const Unit&) const {}
    __device__ __forceinline__ void done(const Unit&) const {} };
struct EpiOut {
    static constexpr bool PERM = true, AFTER_DRAIN = false, HAS_MID = true;
    bf16* OX; const LAS float* tab;
    __device__ __forceinline__ void mid(f32x4 (&acc)[2][2][4][2], const Unit&, int wr, int, int fr, int) const {
#pragma unroll
        for (int ai = 0; ai < 2; ++ai)
#pragma unroll
            for (int m = 0; m < 4; ++m) { const float f = tab[2 * (ai * HALF + wr * 64 + m * 16 + fr)];
#pragma unroll
                for (int bj = 0; bj < 2; ++bj)
#pragma unroll
                    for (int n = 0; n < 2; ++n) acc[ai][bj][m][n] = acc[ai][bj][m][n] * f; }
    }
    __device__ __forceinline__ void operator()(const f32x4 (&acc)[2][2][4][2], const Unit& u, int wr, int wc, int fr, int fq) const {
#pragma unroll
        for (int ai = 0; ai < 2; ++ai)
#pragma unroll
            for (int m = 0; m < 4; ++m) { const int r = ai * HALF + wr * 64 + m * 16 + fr; const float f = tab[2 * r + 1];
                bf16* rowp = OX + (size_t)(u.pm * BM + r) * D + u.pn * BM + wc * 32 + 8 * fq;
#pragma unroll
                for (int bj = 0; bj < 2; ++bj) { const f32x4 v0 = acc[ai][bj][m][0] * f, v1 = acc[ai][bj][m][1] * f;
                    u32x4 w; w.x = pk2(v0.x, v0.y); w.y = pk2(v0.z, v0.w); w.z = pk2(v1.x, v1.y); w.w = pk2(v1.z, v1.w);
                    st16(rowp + bj * HALF, w); } }
    }
};
struct SchedMoE {
    int G, c, nwg; const LAS int* tile_e; const int* rowidx;
    __device__ __forceinline__ bool next(int i, Unit& u) const {
        const int L = i * G + c; if (L >= nwg) return false;
        const int q = nwg >> 3, r = nwg & 7, xcd = L & 7, off = L >> 3;
        const int w = (xcd < r ? xcd * (q + 1) : r * (q + 1) + (xcd - r) * q) + off;
        u.pm = w >> 2; u.pn = tile_e[w >> 2] * 4 + (w & 3); return true;
    }
    __device__ __forceinline__ void a_ready(const Unit&) const {}
    __device__ __forceinline__ void done(const Unit&) const {}
};
__device__ __forceinline__ float silu_fast(float g) { return g * __builtin_amdgcn_rcpf(1.f + __builtin_amdgcn_exp2f(-g * LOG2E)); }
struct EpiGU {
    static constexpr bool PERM = true, AFTER_DRAIN = false, HAS_MID = false;
    bf16* ACT; const float* roww;
    __device__ __forceinline__ void operator()(const f32x4 (&acc)[2][2][4][2], const Unit& u, int wr, int wc, int fr, int fq) const {
#pragma unroll
        for (int ai = 0; ai < 2; ++ai)
#pragma unroll
            for (int m = 0; m < 4; ++m) { const int pos = u.pm * BM + ai * HALF + wr * 64 + m * 16 + fr; const float w = roww[pos];
                const f32x4 g0 = acc[ai][0][m][0], g1 = acc[ai][0][m][1], u0 = acc[ai][1][m][0], u1 = acc[ai][1][m][1];
                u32x4 o;
                o.x = pk2(silu_fast(g0.x) * u0.x * w, silu_fast(g0.y) * u0.y * w); o.y = pk2(silu_fast(g0.z) * u0.z * w, silu_fast(g0.w) * u0.w * w);
                o.z = pk2(silu_fast(g1.x) * u1.x * w, silu_fast(g1.y) * u1.y * w); o.w = pk2(silu_fast(g1.z) * u1.z * w, silu_fast(g1.w) * u1.w * w);
                st16(ACT + (size_t)pos * EFF + (u.pn & 3) * 128 + wc * 32 + 8 * fq, o); }
    }
};
struct EpiY {
    static constexpr bool PERM = true, AFTER_DRAIN = false, HAS_MID = false;
    bf16* Y;
    __device__ __forceinline__ void operator()(const f32x4 (&acc)[2][2][4][2], const Unit& u, int wr, int wc, int fr, int fq) const {
#pragma unroll
        for (int ai = 0; ai < 2; ++ai)
#pragma unroll
            for (int m = 0; m < 4; ++m) { bf16* rowp = Y + (size_t)(u.pm * BM + ai * HALF + wr * 64 + m * 16 + fr) * D + (u.pn & 3) * BM + wc * 32 + 8 * fq;
#pragma unroll
                for (int bj = 0; bj < 2; ++bj) { const f32x4 v0 = acc[ai][bj][m][0], v1 = acc[ai][bj][m][1];
                    u32x4 w; w.x = pk2(v0.x, v0.y); w.y = pk2(v0.z, v0.w); w.z = pk2(v1.x, v1.y); w.w = pk2(v1.z, v1.w);
                    st16(rowp + bj * HALF, w); } }
    }
};
}

namespace att {
typedef __attribute__((address_space(3))) const char* lds_cptr;
typedef short v4i16_t __attribute__((ext_vector_type(4)));
constexpr int NSLOT = 4, SLOTB = 16384, OST_PITCH = 144, OST_WAVE = 32 * OST_PITCH;
static_assert(8 * OST_WAVE <= 3 * SLOTB && NSLOT * SLOTB <= 65536, "attention LDS");
__device__ __forceinline__ int crow(int r, int hi) { return (r & 3) + 8 * (r >> 2) + 4 * hi; }
__device__ __forceinline__ unsigned cvtpk(float lo, float hi) { typedef float f2 __attribute__((ext_vector_type(2))); typedef __bf16 b2 __attribute__((ext_vector_type(2))); f2 v = {lo, hi}; b2 b = __builtin_convertvector(v, b2); return __builtin_bit_cast(unsigned, b); }
__device__ __forceinline__ s16x4 vtr(lds_cptr p) { return __builtin_bit_cast(s16x4, __builtin_amdgcn_ds_read_tr16_b64_v4i16((__attribute__((address_space(3))) v4i16_t*)p)); }
__device__ __forceinline__ float swapmax(float m) { auto rr = __builtin_amdgcn_permlane32_swap(__float_as_uint(m), __float_as_uint(m), false, false); return fmaxf(__uint_as_float(rr[0]), __uint_as_float(rr[1])); }
__device__ __forceinline__ float swapsum(float m) { auto rr = __builtin_amdgcn_permlane32_swap(__float_as_uint(m), __float_as_uint(m), false, false); return __uint_as_float(rr[0]) + __uint_as_float(rr[1]); }

__device__ __forceinline__ void glds16(const void* gsrc, unsigned lds_dst) { unsigned keep;
    asm volatile("s_mov_b32 %0, m0\n\ts_mov_b32 m0, %2\n\ts_nop 0\n\tglobal_load_lds_dwordx4 %1, off\n\ts_mov_b32 m0, %0" : "=&s"(keep) : "v"(gsrc), "s"(lds_dst) : "memory"); }
__device__ __forceinline__ float max3f(float a, float b, float c) { float r; asm("v_max3_f32 %0, %1, %2, %3" : "=v"(r) : "v"(a), "v"(b), "v"(c)); return r; }
__device__ __forceinline__ float max2f(float a, float b) { float r; asm("v_max_f32_e32 %0, %1, %2" : "=v"(r) : "v"(a), "v"(b)); return r; }
constexpr int WC_PER_WAVE = 24, WC_LDS = 65536;
struct WConv { int next, j0, j1, gstep, cm1, cm2; };
struct WItem { const float* src; int N; bf16* dst; int dpitch; };
__device__ __forceinline__ WItem wc_decode(const P& p, int hidx, int& k0, int& n0, int& drow0) {
    const int item = hidx >> 1, kh = hidx & 1; WItem w;
    if (item < 16384) { const int up = item >= 8192, r = item & 8191, e = r >> 8, q = r & 255, kb = q >> 4, nb = q & 15; n0 = nb * 32;
        w.src = (up ? p.w_up : p.w_gate) + (size_t)e * 1024 * 512; w.N = 512; w.dst = (bf16*)(p.ws + WS_WGU) + (size_t)e * 1024 * 1024; w.dpitch = 1024;
        drow0 = (n0 >> 7) * 256 + up * 128 + (n0 & 127); k0 = kb * 64 + kh * 32; }
    else { const int r = item - 16384, e = r >> 8, q = r & 255, kb = q >> 5, nb = q & 31; n0 = nb * 32;
        w.src = p.w_down + (size_t)e * 512 * 1024; w.N = 1024; w.dst = (bf16*)(p.ws + WS_WD) + (size_t)e * 1024 * 512; w.dpitch = 512; drow0 = n0; k0 = kb * 64 + kh * 32; }
    return w;
}
__device__ __forceinline__ void glds16(const void* gsrc, unsigned lds_dst);
__device__ __forceinline__ void glds16_nt(const void* gsrc, unsigned lds_dst) { unsigned keep;
    asm volatile("s_mov_b32 %0, m0\n\ts_mov_b32 m0, %2\n\ts_nop 0\n\tglobal_load_lds_dwordx4 %1, off nt\n\ts_mov_b32 m0, %0" : "=&s"(keep) : "v"(gsrc), "s"(lds_dst) : "memory"); }
__device__ __forceinline__ void wc_issue(const P& p, int gw, int ord, unsigned ldsbuf, int lane) {
    int k0, n0, drow0; const WItem w = wc_decode(p, gw + 2048 * ord, k0, n0, drow0);
#pragma unroll
    for (int q = 0; q < 4; ++q) { const int kl = 8 * q + (lane >> 3), f4 = (lane & 7) ^ ((q >> 1) * 4);
        glds16_nt(w.src + (size_t)(k0 + kl) * w.N + n0 + f4 * 4, (unsigned)__builtin_amdgcn_readfirstlane(ldsbuf + q * 1024)); }
}
__device__ __forceinline__ void wc_consume(const P& p, int gw, int ord, LAS unsigned char* buf, int lane) {
    int k0, n0, drow0; const WItem w = wc_decode(p, gw + 2048 * ord, k0, n0, drow0);
    const int n = lane >> 1, kh = lane & 1;
    const LAS float* s = (const LAS float*)buf + (16 * kh) * 32 + 4 * ((n >> 2) ^ (4 * kh)) + (n & 3);
    float v[16];
#pragma unroll
    for (int i = 0; i < 16; ++i) v[i] = s[i * 32];
    v4u o0, o1;
    o0.x = cvtpk(v[0], v[1]); o0.y = cvtpk(v[2], v[3]); o0.z = cvtpk(v[4], v[5]); o0.w = cvtpk(v[6], v[7]);
    o1.x = cvtpk(v[8], v[9]); o1.y = cvtpk(v[10], v[11]); o1.z = cvtpk(v[12], v[13]); o1.w = cvtpk(v[14], v[15]);
    bf16* d = w.dst + (size_t)(drow0 + n) * w.dpitch + k0 + 16 * kh;
    __builtin_nontemporal_store(o0, (v4u*)d); __builtin_nontemporal_store(o1, (v4u*)(d + 8));
}
constexpr float THR = 8.f;
template <int GRP, int ABL = 0>
__device__ __forceinline__ void attn_unit(const P& p, LAS unsigned char* lds, int b, int kvh, int qb, WConv& wc, int gw) {
    const int tid = threadIdx.x, lane = tid & 63, r32 = lane & 31, hi = lane >> 5;
    const int wid = __builtin_amdgcn_readfirstlane(tid >> 6);
    const int h = kvh * 4 + (wid >> 1);
    const int q0w = qb * 64 + (wid & 1) * 32, qpos = q0w + r32;
    const bf16* Qp = (const bf16*)(p.ws + (GRP ? WS_QB : WS_QA)) + q_off(b, h, qpos, 0);
    bf16x8 qr[4];
#pragma unroll
    for (int d0 = 0; d0 < 4; ++d0) qr[d0] = *(const bf16x8*)(Qp + 16 * d0 + 8 * hi);
    asm volatile("" : "+v"(qr[0]), "+v"(qr[1]), "+v"(qr[2]), "+v"(qr[3]));
    const char* Kt = (const char*)(p.ws + (GRP ? WS_KB : WS_KA)) + (size_t)(b * 2 + kvh) * NTILE * 8192 + wid * 1024 + lane * 16;
    const char* Vt = (const char*)(p.ws + (GRP ? WS_VB : WS_VA)) + (size_t)(b * 2 + kvh) * NTILE * 8192 + wid * 1024 + lane * 16;
    const unsigned lds0 = (unsigned)(uintptr_t)lds;
    int jlo = 0, nband = NTILE, NT = NTILE;
    if (GRP == 0) { jlo = qb - 2 < 0 ? 0 : qb - 2; const int jhi = qb + 2 > 31 ? 31 : qb + 2; nband = jhi - jlo + 1; NT = nband + 4; }
#define ATT_TILE(i) ((i) < nband ? jlo + (i) : 32 + ((i) - nband))
#define ATT_ISSUE(i) do { if (ABL & 1) break; const int tl_ = ATT_TILE(i); const int sl_ = ((i) & 3) * SLOTB; \
        glds16(Kt + (size_t)tl_ * 8192, (unsigned)__builtin_amdgcn_readfirstlane(lds0 + sl_ + wid * 1024)); \
        glds16(Vt + (size_t)tl_ * 8192, (unsigned)__builtin_amdgcn_readfirstlane(lds0 + sl_ + 8192 + wid * 1024)); } while (0)
#define ATT_WAIT(n) do { if (ABL & 1) break; if ((n) >= 2) asm volatile("s_waitcnt vmcnt(4)" ::: "memory"); else if ((n) == 1) asm volatile("s_waitcnt vmcnt(2)" ::: "memory"); else asm volatile("s_waitcnt vmcnt(0)" ::: "memory"); } while (0)
#define ATT_WAITN(n) do { if (ABL & 1) break; switch (n) { case 0: asm volatile("s_waitcnt vmcnt(0)" ::: "memory"); break; case 2: asm volatile("s_waitcnt vmcnt(2)" ::: "memory"); break; \
        case 4: asm volatile("s_waitcnt vmcnt(4)" ::: "memory"); break; case 6: asm volatile("s_waitcnt vmcnt(6)" ::: "memory"); break; case 8: asm volatile("s_waitcnt vmcnt(8)" ::: "memory"); break; \
        case 10: asm volatile("s_waitcnt vmcnt(10)" ::: "memory"); break; case 12: asm volatile("s_waitcnt vmcnt(12)" ::: "memory"); break; default: asm volatile("s_waitcnt vmcnt(14)" ::: "memory"); break; } } while (0)
#define ATT_BAR() do { asm volatile("" ::: "memory"); __builtin_amdgcn_s_barrier(); asm volatile("" ::: "memory"); } while (0)
#define SBAR() __builtin_amdgcn_sched_barrier(0)
#define MF(a, b, c) __builtin_amdgcn_mfma_f32_32x32x16_bf16(a, b, c, 0, 0, 0)
#define KFRAG(dst, base, k) dst = *(const __attribute__((address_space(3))) bf16x8*)((base) + ((k) >> 1) * 2048 + ((k) & 1) * 512)
    float m, l;
    m = 0.f; l = 0.f;
    f32x16 o0, o1, sA0, sA1, sB0, sB1; const f32x16 zero16 = {0.f, 0.f, 0.f, 0.f, 0.f, 0.f, 0.f, 0.f, 0.f, 0.f, 0.f, 0.f, 0.f, 0.f, 0.f, 0.f};
#pragma unroll
    for (int r = 0; r < 16; ++r) { o0[r] = 0.f; o1[r] = 0.f; sB0[r] = 0.f; sB1[r] = 0.f; }
    const lds_cptr kp0 = (lds_cptr)lds + hi * 1024 + r32 * 16;
    const lds_cptr vp0 = (lds_cptr)lds + 8192 + ((lane >> 4) & 1) * 32 + (lane & 3) * 8 + (4 * hi + ((lane & 15) >> 2)) * 64;
#define ATT_MASK(S0, S1, t) do { if (GRP == 0) { const int tl = ATT_TILE(t); if (tl < 32 && (tl == qb - 2 || tl == qb + 2)) { const int kb = tl * 64; \
        _Pragma("unroll") for (int r = 0; r < 16; ++r) { const int dd = kb + crow(r, hi) - qpos; if (dd > 128 || dd < -128) S0[r] = -1e30f; if (dd + 32 > 128 || dd + 32 < -128) S1[r] = -1e30f; } } } } while (0)
#define ATT_DECIDE(S0, S1, mxv) do { float mx_ = swapmax(mxv); \
        if (__builtin_expect(__any(mx_ > THR), 0)) { const float dl = fmaxf(mx_, 0.f), alpha = __builtin_amdgcn_exp2f(-dl); m += dl; l *= alpha; \
            _Pragma("unroll") for (int r = 0; r < 16; ++r) { S0[r] -= dl; S1[r] -= dl; o0[r] *= alpha; o1[r] *= alpha; } } } while (0)
    if (wid >= 4) __builtin_amdgcn_s_setprio(1);
    wc.cm1 = 0; wc.cm2 = 0;
    ATT_ISSUE(0); ATT_ISSUE(1); ATT_ISSUE(2);
    ATT_WAIT(2); ATT_BAR();
    {
        bf16x8 kf[8];
#pragma unroll
        for (int k = 0; k < 8; ++k) KFRAG(kf[k], kp0, k);
        SBAR();
        sA0 = MF(kf[0], qr[0], zero16); sA1 = MF(kf[1], qr[0], zero16);
#pragma unroll
        for (int d0 = 1; d0 < 4; ++d0) { sA0 = MF(kf[2 * d0], qr[d0], sA0); sA1 = MF(kf[2 * d0 + 1], qr[d0], sA1); }
        ATT_MASK(sA0, sA1, 0);
        asm volatile("s_nop 15\n\ts_nop 7" : "+v"(sA0), "+v"(sA1));
        float a = max3f(sA0[0], sA0[1], sA1[0]), c = max3f(sA0[2], sA0[3], sA1[1]); a = max3f(a, sA1[2], sA1[3]);
#pragma unroll
        for (int r = 4; r < 16; r += 4) { a = max3f(a, sA0[r], sA0[r + 1]); c = max3f(c, sA0[r + 2], sA0[r + 3]); a = max3f(a, sA1[r], sA1[r + 1]); c = max3f(c, sA1[r + 2], sA1[r + 3]); }
        ATT_DECIDE(sA0, sA1, max2f(a, c));
    }
#define ATT_STEP(SC0, SC1, SN0, SN1, t, HN) do { \
        constexpr bool hn_ = HN;                                      \
        ATT_WAITN(wc.cm2 + wc.cm1 + ((t) + 2 < NT ? 2 : 0));         \
        ATT_BAR(); \
        if ((t) + 3 < NT) ATT_ISSUE((t) + 3); \
        if (WCONV_IN_ATTN) { int c_ = 0; const int r7_ = wc.gstep % 7, bs_ = r7_ == 0 ? 0 : r7_ == 3 ? 1 : 2;     \
            if (bs_ < 2) { LAS unsigned char* wb_ = lds + WC_LDS + wid * 8192 + bs_ * 4096; int jb_ = bs_ ? wc.j1 : wc.j0; \
                if (jb_ >= 0) { wc_consume(p, gw, jb_, wb_, lane); jb_ = -1; c_ += 2; } \
                if (wc.next < WC_PER_WAVE) { asm volatile("s_waitcnt lgkmcnt(0)" ::: "memory"); wc_issue(p, gw, wc.next, lds0 + WC_LDS + wid * 8192 + bs_ * 4096, lane); jb_ = wc.next++; c_ += 4; } \
                if (bs_) wc.j1 = jb_; else wc.j0 = jb_; } \
            wc.cm2 = wc.cm1; wc.cm1 = c_; wc.gstep++; } \
        const lds_cptr kp_ = kp0 + (((t) + 1) & 3) * SLOTB; const lds_cptr vp_ = vp0 + ((t) & 3) * SLOTB; \
        bf16x8 kf[8]; s16x4 vlo[8], vhi[8]; \
        if (hn_) { _Pragma("unroll") for (int k = 0; k < 8; ++k) KFRAG(kf[k], kp_, k); } \
        SBAR(); \
        float rs_ = 0.f; v4u pw[4]; _Pragma("unroll") for (int q_ = 0; q_ < 4; ++q_) pw[q_] = (v4u){0u, 0u, 0u, 0u}; \
        _Pragma("unroll") for (int g = 0; g < 8; ++g) {             \
            if (hn_) { if (g == 0) SN0 = MF(kf[0], qr[0], zero16); else if (g == 1) SN1 = MF(kf[1], qr[0], zero16); else if (g & 1) SN1 = MF(kf[g], qr[g >> 1], SN1); else SN0 = MF(kf[g], qr[g >> 1], SN0); } \
            if (g < 4) { _Pragma("unroll") for (int e = 0; e < 4; ++e) { SC0[4 * g + e] = __builtin_amdgcn_exp2f(SC0[4 * g + e]); rs_ += SC0[4 * g + e]; } \
                         pw[g >> 1][2 * (g & 1)] = cvtpk(SC0[4 * g], SC0[4 * g + 1]); pw[g >> 1][2 * (g & 1) + 1] = cvtpk(SC0[4 * g + 2], SC0[4 * g + 3]); \
                         asm volatile("" : "+v"(SC0), "+v"(pw[g >> 1]), "+v"(rs_)); } \
            else { const int g4 = g - 4;   \
                         vlo[g4] = vtr(vp_ + g4 * 1024); vhi[g4] = vtr(vp_ + g4 * 1024 + 512); vlo[4 + g4] = vtr(vp_ + 4096 + g4 * 1024); vhi[4 + g4] = vtr(vp_ + 4096 + g4 * 1024 + 512); \
                         _Pragma("unroll") for (int e = 0; e < 4; ++e) { SC1[4 * g4 + e] = __builtin_amdgcn_exp2f(SC1[4 * g4 + e]); rs_ += SC1[4 * g4 + e]; } \
                         pw[2 + (g4 >> 1)][2 * (g4 & 1)] = cvtpk(SC1[4 * g4], SC1[4 * g4 + 1]); pw[2 + (g4 >> 1)][2 * (g4 & 1) + 1] = cvtpk(SC1[4 * g4 + 2], SC1[4 * g4 + 3]); \
                         asm volatile("" : "+v"(SC1), "+v"(pw[2 + (g4 >> 1)]), "+v"(rs_)); } \
            SBAR(); } \
        l += rs_; \
        if (hn_) { ATT_MASK(SN0, SN1, (t) + 1); if (__builtin_expect(__any(m != 0.f), 0)) { _Pragma("unroll") for (int r = 0; r < 16; ++r) { SN0[r] -= m; SN1[r] -= m; } } \
                   asm volatile("s_nop 15\n\ts_nop 7" : "+v"(SN0), "+v"(SN1)); } \
        float ma_ = -3.0e38f, mc_ = -3.0e38f; \
        _Pragma("unroll") for (int g = 0; g < 8; ++g) {             \
            const int ks = g >> 1; const bf16x8 pf = __builtin_bit_cast(bf16x8, pw[ks]); \
            if (g & 1) { const bf16x8 v1 = (bf16x8){vlo[4 + ks][0], vlo[4 + ks][1], vlo[4 + ks][2], vlo[4 + ks][3], vhi[4 + ks][0], vhi[4 + ks][1], vhi[4 + ks][2], vhi[4 + ks][3]}; o1 = MF(v1, pf, o1); } \
            else { const bf16x8 v0 = (bf16x8){vlo[ks][0], vlo[ks][1], vlo[ks][2], vlo[ks][3], vhi[ks][0], vhi[ks][1], vhi[ks][2], vhi[ks][3]}; o0 = MF(v0, pf, o0); } \
            if (hn_) { if (g < 4) { ma_ = max3f(ma_, SN0[4 * g], SN0[4 * g + 1]); mc_ = max3f(mc_, SN0[4 * g + 2], SN0[4 * g + 3]); } \
                       else { ma_ = max3f(ma_, SN1[4 * (g - 4)], SN1[4 * (g - 4) + 1]); mc_ = max3f(mc_, SN1[4 * (g - 4) + 2], SN1[4 * (g - 4) + 3]); } \
                       asm volatile("" : "+v"(ma_), "+v"(mc_)); } \
            SBAR(); } \
        if (hn_) ATT_DECIDE(SN0, SN1, max2f(ma_, mc_)); \
    } while (0)
    {
        int t = 0;
        for (; t + 2 < NT; t += 2) { ATT_STEP(sA0, sA1, sB0, sB1, t, true); ATT_STEP(sB0, sB1, sA0, sA1, t + 1, true); }
        if (t + 2 == NT) { ATT_STEP(sA0, sA1, sB0, sB1, t, true); ATT_STEP(sB0, sB1, sA0, sA1, t + 1, false); }
        else { ATT_STEP(sA0, sA1, sB0, sB1, t, false); }
    }
#undef ATT_STEP
#undef ATT_DECIDE
#undef ATT_MASK
#undef KFRAG
#undef MF
#undef SBAR
#undef ATT_TILE
#undef ATT_ISSUE
#undef ATT_WAIT
    if (wid >= 4) __builtin_amdgcn_s_setprio(0);
    ATT_BAR();
    float ltot = swapsum(l); if (GRP == 0) ltot += __builtin_amdgcn_exp2f(p.a_sink[h] * LOG2E - m);
    const float inv = 1.f / ltot;
    int lane_e = lane; asm volatile("" : "+v"(lane_e));
    const int r32e = lane_e & 31, hie = lane_e >> 5;
    LAS unsigned char* ost = lds + wid * OST_WAVE;
#pragma unroll
    for (int g = 0; g < 4; ++g) {
        v2u w0, w1;
        w0.x = cvtpk(o0[4 * g] * inv, o0[4 * g + 1] * inv); w0.y = cvtpk(o0[4 * g + 2] * inv, o0[4 * g + 3] * inv);
        w1.x = cvtpk(o1[4 * g] * inv, o1[4 * g + 1] * inv); w1.y = cvtpk(o1[4 * g + 2] * inv, o1[4 * g + 3] * inv);
        *(LAS v2u*)(ost + r32e * OST_PITCH + (8 * g + 4 * hie) * 2) = w0;
        *(LAS v2u*)(ost + r32e * OST_PITCH + (32 + 8 * g + 4 * hie) * 2) = w1;
    }
    asm volatile("s_waitcnt lgkmcnt(0)" ::: "memory");
    bf16* Ob = (bf16*)(p.ws + (ABL ? WS_OX : WS_O)) + ((size_t)b * T + q0w) * D + GRP * 512 + h * 64;
    float* ssq = (float*)(p.ws + (ABL ? 256 * MiB : WS_SSQ)) + ((size_t)b * T + q0w) * 16 + GRP * 8 + h;
#pragma unroll
    for (int i = 0; i < 4; ++i) {
        const int row = i * 8 + (lane_e >> 3), ch = lane_e & 7;
        const v4u v = *(const LAS v4u*)(ost + row * OST_PITCH + ch * 16);
        st16(Ob + (size_t)row * D + ch * 8, v);
        float ss = 0.f;
#pragma unroll
        for (int q = 0; q < 4; ++q) { const float a = __uint_as_float(v[q] << 16), c = __uint_as_float(v[q] & 0xffff0000u); ss += a * a + c * c; }
        ss += __shfl_xor(ss, 1); ss += __shfl_xor(ss, 2); ss += __shfl_xor(ss, 4);
        if (ch == 0) ssq[(size_t)row * 16] = ss;
    }
    asm volatile("s_waitcnt vmcnt(0) lgkmcnt(0)" ::: "memory");
    ATT_BAR();
#undef ATT_BAR
}
template <int ABL = 0>
__device__ __forceinline__ void attn_phase(const P& p, LAS unsigned char* lds, int vcu, int G) {
    if (ABL & 64) return;
    const int wid = __builtin_amdgcn_readfirstlane(threadIdx.x >> 6), lane = threadIdx.x & 63, gw = vcu * 8 + wid;
    WConv wc; wc.next = (WCONV_IN_ATTN && G * 8 == 2048 && ABL == 0) ? 0 : WC_PER_WAVE; wc.j0 = -1; wc.j1 = -1; wc.gstep = 0; wc.cm1 = 0; wc.cm2 = 0;
    for (int u = vcu; u < 512; u += G) attn_unit<1, ABL>(p, lds, (u >> 5) >> 1, (u >> 5) & 1, u & 31, wc, gw);
    for (int u = vcu; u < 512; u += G) attn_unit<0, ABL>(p, lds, (u >> 5) >> 1, (u >> 5) & 1, u & 31, wc, gw);
    if (WCONV_IN_ATTN && ABL == 0) {
        if (G * 8 == 2048) {
            if (wc.j0 >= 0) wc_consume(p, gw, wc.j0, lds + WC_LDS + wid * 8192, lane);
            if (wc.j1 >= 0) wc_consume(p, gw, wc.j1, lds + WC_LDS + wid * 8192 + 4096, lane);
            for (; wc.next < WC_PER_WAVE; ++wc.next) { asm volatile("s_waitcnt lgkmcnt(0)" ::: "memory"); wc_issue(p, gw, wc.next, (unsigned)(uintptr_t)lds + WC_LDS + wid * 8192, lane);
                asm volatile("s_waitcnt vmcnt(0)" ::: "memory"); wc_consume(p, gw, wc.next, lds + WC_LDS + wid * 8192, lane); }
        } else {
            for (int hx = gw; hx < 49152; hx += G * 8) { asm volatile("s_waitcnt lgkmcnt(0)" ::: "memory"); wc_issue(p, hx & 2047, hx >> 11, (unsigned)(uintptr_t)lds + WC_LDS + wid * 8192, lane);
                asm volatile("s_waitcnt vmcnt(0)" ::: "memory"); wc_consume(p, hx & 2047, hx >> 11, lds + WC_LDS + wid * 8192, lane); }
        }
    }
}
}

struct Frame {
    LAS unsigned char* lds;
    volatile LAS unsigned* MISC;
    int tid, lane, wave, vcu, G;
};

__device__ __forceinline__ void p0_transpose_item(const float* W, int N, bf16* WT, int dpitch, int drow0, int k0, int n0, LAS float* scr, int lane, const float* gain) {
#pragma unroll
    for (int i = 0; i < 32; ++i) { const int kk = 2 * i + (lane >> 5); float v = W[(size_t)(k0 + kk) * N + n0 + (lane & 31)]; if (gain) v *= gain[kk]; scr[kk * 33 + (lane & 31)] = v; }
    LDS_WAIT(); asm volatile("" ::: "memory");
    const int c = lane & 7;
#pragma unroll
    for (int j = 0; j < 4; ++j) { const int n = (lane >> 3) + 8 * j; const LAS float* s = scr + (8 * c) * 33 + n;
        v4u o; o.x = pk2(s[0 * 33], s[1 * 33]); o.y = pk2(s[2 * 33], s[3 * 33]); o.z = pk2(s[4 * 33], s[5 * 33]); o.w = pk2(s[6 * 33], s[7 * 33]);
        *(GAS v4u*)(WT + (size_t)(drow0 + n) * dpitch + k0 + 8 * c) = o; }
    LDS_WAIT(); asm volatile("" ::: "memory");
}
__device__ __forceinline__ void p0_prologue(const P& p, Frame& F) {
    float* modx = (float*)(p.ws + WS_MODX);
    if (F.vcu < 96) {
        LAS float* s = (LAS float*)F.lds;
        LAS float* part = (LAS float*)(F.lds + 40960);
        for (int i = F.tid; i < 9 * D; i += NTHR) { const int r = i >> 10, k = i & 1023; const float v = r < 8 ? p.c[r * D + k] : p.c_ctx[k]; s[i] = silu_f(v); }
        __syncthreads();
        const int n = F.vcu * 64 + F.lane; float acc[9];
#pragma unroll
        for (int r = 0; r < 9; ++r) acc[r] = 0.f;
        const float* wp = p.w_mod + (size_t)(F.wave * 128) * 6144 + n;
#pragma unroll 4
        for (int k4 = 0; k4 < 128; k4 += 4) {
            float wv[4];
#pragma unroll
            for (int j = 0; j < 4; ++j) wv[j] = wp[(size_t)(k4 + j) * 6144];
#pragma unroll
            for (int r = 0; r < 9; ++r) { const f32x4 sv = *(const LAS f32x4*)(s + r * D + F.wave * 128 + k4); acc[r] += sv.x * wv[0]; acc[r] += sv.y * wv[1]; acc[r] += sv.z * wv[2]; acc[r] += sv.w * wv[3]; }
        }
#pragma unroll
        for (int r = 0; r < 9; ++r) part[(F.wave * 9 + r) * 64 + F.lane] = acc[r];
        __syncthreads();
        for (int i = F.tid; i < 9 * 64; i += NTHR) { const int r = i >> 6, l = i & 63; float sum = 0.f;
#pragma unroll
            for (int w = 0; w < 8; ++w) sum += part[(w * 9 + r) * 64 + l];
            modx[r * 6144 + F.vcu * 64 + l] = sum + p.b_mod[F.vcu * 64 + l]; }
        __syncthreads();
    }
    if (F.vcu == 96) {
        float2* tab = (float2*)(p.ws + WS_ROPE);
        for (int idx = F.tid; idx < 96 * 16; idx += NTHR) {
            const int pos = idx >> 4, i = idx & 15;
            const float invf = exp2f(-(float)i * (13.287712379549449f / 16.f));
            const float pv = (float)(pos < 32 ? pos : pos - 32);
            float rev = pv * invf * 0.15915494309189535f; rev -= rintf(rev);
            tab[idx] = make_float2(__builtin_amdgcn_cosf(rev), __builtin_amdgcn_sinf(rev));
        }
    }
    for (int nb = F.vcu - 97; nb >= 0 && nb < 48; nb += F.G) {
        bf16* wr = (bf16*)(p.ws + WS_WR);
        for (int i = nb * 1024 + F.tid; i < (nb + 1) * 1024; i += NTHR) {
            const int j = i & 7, ln = (i >> 3) & 63, q = i >> 9, nt = q % 3, ks = q / 3;
            const int k = 32 * ks + 8 * (ln >> 4) + j, n = 16 * nt + (ln & 15);
            const float w = n < 4 ? p.w_group[k * 4 + n] : n < 36 ? p.w_router[k * 32 + (n - 4)] : 0.f;
            const unsigned hi = f2bf(w); const unsigned lo = f2bf(w - bf2f((bf16)hi));
            wr[i] = (bf16)hi; wr[48 * D + i] = (bf16)lo; }
    }
    LAS float* scr = (LAS float*)(F.lds + F.wave * 16384);
    const int gw = F.vcu * NWAVES + F.wave, NGW = F.G * NWAVES;
    constexpr int I_IN = 16 * 48, I_OUT = 16 * 32, I_G = 32 * 256, I_D = 32 * 256, NITEMS = WCONV_IN_ATTN ? I_IN + I_OUT : I_IN + I_OUT + 2 * I_G + I_D;
    for (int it = gw; it < NITEMS; it += NGW) {
        int r = it;
        if (r < I_IN) { const int kb = r / 48, nb = r % 48; p0_transpose_item(p.w_in, NQKV, (bf16*)(p.ws + WS_WQKV), D, qkv_row(nb * 32), kb * 64, nb * 32, scr, F.lane, nullptr); continue; } r -= I_IN;
        if (r < I_OUT) { const int kb = r / 32, nb = r % 32; const float* g = kb < 8 ? p.aon + kb * 64 : p.bon + (kb - 8) * 64;
            p0_transpose_item(p.w_out, D, (bf16*)(p.ws + WS_WO), D, nb * 32, kb * 64, nb * 32, scr, F.lane, g); continue; } r -= I_OUT;
        if (r < 2 * I_G) { const int up = r >= I_G; if (up) r -= I_G; const int e = r >> 8, q = r & 255, kb = q >> 4, nb = q & 15; const int j0 = nb * 32;
            p0_transpose_item((up ? p.w_up : p.w_gate) + (size_t)e * 1024 * 512, 512, (bf16*)(p.ws + WS_WGU) + (size_t)e * 1024 * 1024, D, (j0 >> 7) * 256 + up * 128 + (j0 & 127), kb * 64, j0, scr, F.lane, nullptr); continue; } r -= 2 * I_G;
        { const int e = r >> 8, q = r & 255, kb = q >> 5, nb = q & 31;
            p0_transpose_item(p.w_down + (size_t)e * 512 * 1024, D, (bf16*)(p.ws + WS_WD) + (size_t)e * 1024 * 512, EFF, nb * 32, kb * 64, nb * 32, scr, F.lane, nullptr); }
    }
}
__device__ __forceinline__ void p1_norm(const P& p, Frame& F) {
    const int gw = F.vcu * NWAVES + F.wave, NGW = F.G * NWAVES;
    const float* modall = (const float*)(p.ws + WS_MODX);
    for (int r = gw; r < MT; r += NGW) {
        const float* src = r < ML ? p.x + (size_t)r * D : p.ctx + (size_t)(r - ML) * D;
        const float* modx = modall + (r < ML ? (r / T) : 8) * 6144;
        const GAS f32x4* xr = (const GAS f32x4*)src + F.lane;
        f32x4 v[4]; float s = 0.f;
#pragma unroll
        for (int j = 0; j < 4; ++j) { v[j] = xr[64 * j]; s += (v[j].x * v[j].x + v[j].y * v[j].y) + (v[j].z * v[j].z + v[j].w * v[j].w); }
        const float rn = rsqrtf(wave_sum(s) * (1.f / D) + EPS);
        GAS v2u* o8 = (GAS v2u*)((bf16*)(p.ws + WS_XN) + (size_t)r * D) + F.lane;
#pragma unroll
        for (int j = 0; j < 4; ++j) { const int k = 4 * (F.lane + 64 * j);
            const f32x4 g = *(const f32x4*)(p.pre1 + k), sc = *(const f32x4*)(modx + 1024 + k), sh = *(const f32x4*)(modx + k);
            const f32x4 h = v[j] * rn * g * (sc + 1.f) + sh;
            v2u w; w.x = pk2(h.x, h.y); w.y = pk2(h.z, h.w); st8((void*)(o8 + 64 * j), w); }
    }
}


constexpr int LDS_X = 147456;
__device__ __forceinline__ void p4_outproj(const P& p, Frame& F) {
    LAS float* tab = (LAS float*)(F.lds + LDS_X);
    for (int i = 0;; ++i) {
        const int L = i * F.G + (int)blockIdx.x; if (L >= 256) break;
        const int xcd = L & 7, off = L >> 3, w = xcd * 32 + off;
        pg8::Unit u; u.pm = (w >> 5) * 8 + (w & 7); u.pn = (w & 31) >> 3;
        if (F.tid < 256) {
            const f32x4* s4 = (const f32x4*)((const float*)(p.ws + WS_SSQ) + (size_t)(u.pm * 256 + F.tid) * 16);
            const f32x4 a0 = s4[0], a1 = s4[1], b0 = s4[2], b1 = s4[3];
            const float sa = ((a0.x + a0.y) + (a0.z + a0.w)) + ((a1.x + a1.y) + (a1.z + a1.w)), sb = ((b0.x + b0.y) + (b0.z + b0.w)) + ((b1.x + b1.y) + (b1.z + b1.w));
            const float ra = rsqrtf(sa * (1.f / 512.f) + EPS), rb = rsqrtf(sb * (1.f / 512.f) + EPS);
            tab[2 * F.tid] = ra / rb; tab[2 * F.tid + 1] = rb;
        }
        __syncthreads();
        pg8::Gemm g{(const pg8::bf16_t*)(p.ws + WS_O), (const pg8::bf16_t*)(p.ws + WS_WO), ML, D, D};
        pg8::SchedOne S{u};
        pg8::EpiOut E{(bf16*)(p.ws + WS_OX), tab};
        pg8::gemm_phase<pg8::EpiOut, pg8::SchedOne, false, true, false>((PG8_LAS unsigned char*)F.lds, g, S, E);
    }
}
constexpr int P5_PITCH = 2064;
constexpr int P5_PART = 64 * P5_PITCH, P5_LG = 0;
static_assert(P5_PART + 8 * 16 * 48 * 4 <= MISC_OFF && 64 * 48 * 4 <= P5_PART, "P5 LDS map");
__device__ __forceinline__ void p5_rowpass(const P& p, Frame& F, int abl = 0) {
    LAS unsigned char* LO = F.lds;
    LAS float* PART = (LAS float*)(F.lds + P5_PART); LAS float* LG = (LAS float*)(F.lds + P5_LG);
    LAS int* hist = (LAS int*)(F.lds + MISC_OFF) + 64;
    const bf16* WRh = (const bf16*)(p.ws + WS_WR); const bf16* WRl = WRh + 48 * D;
    for (int rb = F.vcu; rb < ML / 64; rb += F.G) {
        if (F.tid < 32) hist[F.tid] = 0;
        const int b = (rb * 64) / T;
        const float* modx = (const float*)(p.ws + WS_MODX) + b * 6144;
        if (!(abl & 2)) {
            f32x4 gp[4], mp[4], ap[4];
#pragma unroll
            for (int j = 0; j < 4; ++j) { const int k = 256 * j + 4 * F.lane;
                gp[j] = *(const f32x4*)(modx + 2048 + k) * *(const f32x4*)(p.post1 + k);
                mp[j] = *(const f32x4*)(p.pre2 + k) * (*(const f32x4*)(modx + 4096 + k) + 1.f);
                ap[j] = *(const f32x4*)(modx + 3072 + k); }
            f32x4 xn[4]; v2u on[4];
#define P5_LOAD(rw) do { _Pragma("unroll") for (int j = 0; j < 4; ++j) { xn[j] = *(const f32x4*)(p.x + (size_t)(rw) * D + 256 * j + 4 * F.lane); \
                on[j] = *(const v2u*)((const bf16*)(p.ws + WS_OX) + (size_t)(rw) * D + 256 * j + 4 * F.lane); } } while (0)
            P5_LOAD(rb * 64 + F.wave * 8);
            for (int rr = 0; rr < 8; ++rr) {
                const int rl = F.wave * 8 + rr, row = rb * 64 + rl;
                f32x4 xv[4], ox[4]; v2u oc[4]; float ss = 0.f;
#pragma unroll
                for (int j = 0; j < 4; ++j) { xv[j] = xn[j]; oc[j] = on[j]; }
                if (rr + 1 < 8) P5_LOAD(row + 1);
#pragma unroll
                for (int j = 0; j < 4; ++j) { const v2u o2 = oc[j];
                    ox[j] = (f32x4){__uint_as_float(o2.x << 16), __uint_as_float(o2.x & 0xffff0000u), __uint_as_float(o2.y << 16), __uint_as_float(o2.y & 0xffff0000u)};
                    ss += (ox[j].x * ox[j].x + ox[j].y * ox[j].y) + (ox[j].z * ox[j].z + ox[j].w * ox[j].w); }
                const float r1 = rsqrtf(wave_sum(ss) * (1.f / D) + EPS);
                float ss2 = 0.f;
#pragma unroll
                for (int j = 0; j < 4; ++j) { xv[j] = xv[j] + gp[j] * (ox[j] * r1);
                    ss2 += (xv[j].x * xv[j].x + xv[j].y * xv[j].y) + (xv[j].z * xv[j].z + xv[j].w * xv[j].w); }
                const float r2 = rsqrtf(wave_sum(ss2) * (1.f / D) + EPS);
                if (F.lane == 0) ((float*)(p.ws + WS_R1))[row] = r1;
#pragma unroll
                for (int j = 0; j < 4; ++j) {
                    const f32x4 h = xv[j] * r2 * mp[j] + ap[j];
                    v2u wh; wh.x = att::cvtpk(h.x, h.y); wh.y = att::cvtpk(h.z, h.w);
                    const f32x4 hb = (f32x4){__uint_as_float(wh.x << 16), __uint_as_float(wh.x & 0xffff0000u), __uint_as_float(wh.y << 16), __uint_as_float(wh.y & 0xffff0000u)};
                    const f32x4 dl = h - hb;
                    v2u wl; wl.x = att::cvtpk(dl.x, dl.y); wl.y = att::cvtpk(dl.z, dl.w);
                    st8((bf16*)(p.ws + WS_XN) + (size_t)row * D + 256 * j + 4 * F.lane, wh);
                    *(LAS v2u*)(LO + rl * P5_PITCH + (256 * j + 4 * F.lane) * 2) = wl;
                }
            }
#undef P5_LOAD
        }
        asm volatile("s_waitcnt vmcnt(0)" ::: "memory");
        __syncthreads();
        if (F.tid == 0) { __builtin_amdgcn_fence(__ATOMIC_ACQUIRE, "agent"); asm volatile("s_waitcnt vmcnt(0)" ::: "memory"); }
        __syncthreads();
        if (abl & 1) continue;
        {
            const int gI = F.wave >> 1, kq = F.wave & 1, r16 = F.lane & 15, g4 = F.lane >> 4;
            f32x4 acc[3];
#pragma unroll
            for (int nt = 0; nt < 3; ++nt) acc[nt] = (f32x4){0.f, 0.f, 0.f, 0.f};
            const bf16* ah = (const bf16*)(p.ws + WS_XN) + (size_t)(rb * 64 + 16 * gI + r16) * D + 512 * kq + 8 * g4;
            const LAS unsigned char* al = LO + (16 * gI + r16) * P5_PITCH + (512 * kq + 8 * g4) * 2;
            const bf16* bh = WRh + (size_t)(16 * kq) * 3 * 512 + F.lane * 8; const bf16* bl = WRl + (size_t)(16 * kq) * 3 * 512 + F.lane * 8;
#pragma unroll 8
            for (int ks = 0; ks < 16; ++ks) {
                const bf16x8 a_hi = *(const bf16x8*)(ah + ks * 32), a_lo = *(const LAS bf16x8*)(al + ks * 64);
#pragma unroll
                for (int nt = 0; nt < 3; ++nt) {
                    const bf16x8 b_hi = *(const bf16x8*)(bh + (ks * 3 + nt) * 512), b_lo = *(const bf16x8*)(bl + (ks * 3 + nt) * 512);
                    acc[nt] = __builtin_amdgcn_mfma_f32_16x16x32_bf16(a_hi, b_hi, acc[nt], 0, 0, 0);
                    acc[nt] = __builtin_amdgcn_mfma_f32_16x16x32_bf16(a_hi, b_lo, acc[nt], 0, 0, 0);
                    acc[nt] = __builtin_amdgcn_mfma_f32_16x16x32_bf16(a_lo, b_hi, acc[nt], 0, 0, 0);
                }
            }
#pragma unroll
            for (int nt = 0; nt < 3; ++nt)
#pragma unroll
                for (int q = 0; q < 4; ++q) PART[(F.wave * 16 + 4 * g4 + q) * 48 + 16 * nt + r16] = acc[nt][q];
        }
        __syncthreads();
        for (int i = F.tid; i < 64 * 48; i += NTHR) { const int row = i / 48, n = i - row * 48, gI = row >> 4, r16 = row & 15;
            LG[i] = (PART[((gI * 2 + 0) * 16 + r16) * 48 + n] + PART[((gI * 2 + 1) * 16 + r16) * 48 + n]) + (n < 4 ? p.b_group[n] : n < 36 ? p.b_router[n - 4] : 0.f); }
        __syncthreads();
        if (F.tid < 64) {
            float lg[36];
#pragma unroll
            for (int c = 0; c < 36; ++c) lg[c] = LG[F.tid * 48 + c];
            int e1, e2; float w1, w2;
            {
                int g = 0; float gm = lg[0];
#pragma unroll
                for (int q = 1; q < 4; ++q) if (lg[q] > gm) { gm = lg[q]; g = q; }
                float gs = 0.f;
#pragma unroll
                for (int q = 0; q < 4; ++q) gs += __expf(lg[q] - gm);
                const float gw = 1.f / gs;
                float el[8];
#pragma unroll
                for (int q = 0; q < 8; ++q) el[q] = g == 0 ? lg[4 + q] : g == 1 ? lg[12 + q] : g == 2 ? lg[20 + q] : lg[28 + q];
                int i1 = 0; float m1 = el[0];
#pragma unroll
                for (int q = 1; q < 8; ++q) if (el[q] > m1) { m1 = el[q]; i1 = q; }
                int i2 = -1; float m2 = -3.0e38f;
#pragma unroll
                for (int q = 0; q < 8; ++q) if (q != i1 && el[q] > m2) { m2 = el[q]; i2 = q; }
                const float ex = __expf(m2 - m1);
                w1 = gw / (1.f + ex); w2 = gw * ex / (1.f + ex); e1 = g * 8 + i1; e2 = g * 8 + i2;
            }
            const int row = rb * 64 + F.tid;
            if (!(abl & 2)) { int* te = (int*)(p.ws + WS_TOKE) + row * 2; float* tw = (float*)(p.ws + WS_TOKW) + row * 2; te[0] = e1; te[1] = e2; tw[0] = w1; tw[1] = w2; }
            atomicAdd((int*)&hist[e1 & 31], 1); atomicAdd((int*)&hist[e2 & 31], 1);
        }
        __syncthreads();
        if (F.tid < 32 && !(abl & 2)) ((int*)(p.ws + WS_BLKCNT))[rb * 32 + F.tid] = hist[F.tid];
        __syncthreads();
    }
}
__device__ __forceinline__ void p6_lists(const P& p, Frame& F) {
    LAS int* ps = (LAS int*)F.lds;
    LAS int* pp = ps + 512;
    LAS int* tot = pp + 512; LAS int* pre = tot + 32; LAS int* ebase = pre + 32;
    LAS int* es = ebase + 40;
    const int* blk = (const int*)(p.ws + WS_BLKCNT);
    int* meta = (int*)(p.ws + WS_META);
    for (int rb = F.vcu; rb < ML / 64; rb += F.G) {
        { const int e = F.tid & 31, part = F.tid >> 5; int s = 0, q = 0;
#pragma unroll 4
          for (int j = 0; j < 16; ++j) { const int bb = part * 16 + j; const int v = blk[bb * 32 + e]; s += v; q += bb < rb ? v : 0; }
          ps[part * 32 + e] = s; pp[part * 32 + e] = q; }
        __syncthreads();
        if (F.tid < 32) { int s = 0, q = 0;
#pragma unroll
            for (int part = 0; part < 16; ++part) { s += ps[part * 32 + F.tid]; q += pp[part * 32 + F.tid]; }
            tot[F.tid] = s; pre[F.tid] = q; }
        __syncthreads();
        if (F.tid == 0) { int tb = 0; for (int e = 0; e < 32; ++e) { ebase[e] = tb; tb += (tot[e] + 255) >> 8; } ebase[32] = tb; }
        if (F.tid < 128) es[F.tid] = ((const int*)(p.ws + WS_TOKE))[rb * 128 + F.tid];
        __syncthreads();
        if (F.tid < 128) {
            const int e = es[F.tid]; int rank = 0;
            for (int a = 0; a < F.tid; ++a) rank += es[a] == e ? 1 : 0;
            const int pos = ebase[e] * 256 + pre[e] + rank;
            ((int*)(p.ws + WS_ROWIDX))[pos] = rb * 64 + (F.tid >> 1);
            ((float*)(p.ws + WS_ROWW))[pos] = ((const float*)(p.ws + WS_TOKW))[rb * 128 + F.tid];
            ((int*)(p.ws + WS_TOKPOS))[rb * 128 + F.tid] = pos;
        }
        if (rb < 32) {
            const int e = rb, lo = ebase[e] * 256 + tot[e], hi = ebase[e + 1] * 256;
            for (int pos = lo + F.tid; pos < hi; pos += NTHR) { ((int*)(p.ws + WS_ROWIDX))[pos] = 0; ((float*)(p.ws + WS_ROWW))[pos] = 0.f; }
            for (int t = ebase[e] + F.tid; t < ebase[e + 1]; t += NTHR) meta[128 + t] = e;
            if (F.tid == 0) { meta[e] = tot[e]; meta[64 + e] = ebase[e]; if (e == 31) { meta[64 + 32] = ebase[32]; meta[320] = ebase[32]; } }
        }
        __syncthreads();
    }
}
__device__ __forceinline__ void p78_moe(const P& p, Frame& F, bool down) {
    LAS int* tile_e = (LAS int*)(F.lds + LDS_X);
    const int* meta = (const int*)(p.ws + WS_META);
    for (int t = F.tid; t < MAXTILES; t += NTHR) tile_e[t] = meta[128 + t] & 31;
    __syncthreads();
    const int ntiles = meta[320];
    pg8::SchedMoE S{F.G, (int)blockIdx.x, ntiles * 4, tile_e, (const int*)(p.ws + WS_ROWIDX)};
    if (!down) {
        pg8::Gemm g{(const pg8::bf16_t*)(p.ws + WS_XN), (const pg8::bf16_t*)(p.ws + WS_WGU), MAXPOS, NE * 1024, D};
        pg8::EpiGU E{(bf16*)(p.ws + WS_ACT), (const float*)(p.ws + WS_ROWW)};
        pg8::gemm_phase<pg8::EpiGU, pg8::SchedMoE, true, true, true>((PG8_LAS unsigned char*)F.lds, g, S, E);
    } else {
        pg8::Gemm g{(const pg8::bf16_t*)(p.ws + WS_ACT), (const pg8::bf16_t*)(p.ws + WS_WD), MAXPOS, NE * 1024, EFF};
        pg8::EpiY E{(bf16*)(p.ws + WS_Y)};
        pg8::gemm_phase<pg8::EpiY, pg8::SchedMoE, true, true, false>((PG8_LAS unsigned char*)F.lds, g, S, E);
    }
}
__device__ __forceinline__ void p9_final(const P& p, Frame& F, float* dst) {
    const bf16* Y = (const bf16*)(p.ws + WS_Y); const bf16* OX = (const bf16*)(p.ws + WS_OX); const float* R1 = (const float*)(p.ws + WS_R1);
    for (int rb = F.vcu; rb < ML / 64; rb += F.G) {
        const int b = (rb * 64) / T;
        const float* modx = (const float*)(p.ws + WS_MODX) + b * 6144;
        const int row0 = rb * 64 + F.wave * 8;
        f32x4 gp[4], g1p[4];
#pragma unroll
        for (int j = 0; j < 4; ++j) { const int k = 256 * j + 4 * F.lane; gp[j] = *(const f32x4*)(modx + 5120 + k) * *(const f32x4*)(p.post2 + k); g1p[j] = *(const f32x4*)(modx + 2048 + k) * *(const f32x4*)(p.post1 + k); }
        v2u ya[2][4], yc[2][4], oo[2][4]; f32x4 xo[2][4]; float r1v[2];
        const int* tpp = (const int*)(p.ws + WS_TOKPOS) + row0 * 2;
#define P9_LOAD(buf, rw, t2) do { r1v[buf] = R1[rw]; _Pragma("unroll") for (int j = 0; j < 4; ++j) { \
            ya[buf][j] = *(const v2u*)(Y + (size_t)(t2).x * D + 256 * j + 4 * F.lane); yc[buf][j] = *(const v2u*)(Y + (size_t)(t2).y * D + 256 * j + 4 * F.lane); \
            oo[buf][j] = *(const v2u*)(OX + (size_t)(rw) * D + 256 * j + 4 * F.lane); xo[buf][j] = *(const f32x4*)(p.x + (size_t)(rw) * D + 256 * j + 4 * F.lane); } } while (0)
#define P9_COMP(buf, rw) do { f32x4 y[4]; float ss = 0.f; \
            _Pragma("unroll") for (int j = 0; j < 4; ++j) { const v2u a = ya[buf][j], c = yc[buf][j]; \
                y[j] = (f32x4){__uint_as_float(a.x << 16) + __uint_as_float(c.x << 16), __uint_as_float(a.x & 0xffff0000u) + __uint_as_float(c.x & 0xffff0000u), \
                               __uint_as_float(a.y << 16) + __uint_as_float(c.y << 16), __uint_as_float(a.y & 0xffff0000u) + __uint_as_float(c.y & 0xffff0000u)}; \
                ss += (y[j].x * y[j].x + y[j].y * y[j].y) + (y[j].z * y[j].z + y[j].w * y[j].w); } \
            const float rn = rsqrtf(wave_sum(ss) * (1.f / D) + EPS); \
            _Pragma("unroll") for (int j = 0; j < 4; ++j) { const v2u o2 = oo[buf][j]; \
                const f32x4 oxv = (f32x4){__uint_as_float(o2.x << 16), __uint_as_float(o2.x & 0xffff0000u), __uint_as_float(o2.y << 16), __uint_as_float(o2.y & 0xffff0000u)}; \
                const f32x4 x1 = xo[buf][j] + g1p[j] * (oxv * r1v[buf]);                   \
                *(f32x4*)(dst + (size_t)(rw) * D + 256 * j + 4 * F.lane) = x1 + gp[j] * (y[j] * rn); } } while (0)
        int2 tpA = *(const int2*)(tpp), tpB = *(const int2*)(tpp + 2);
        P9_LOAD(0, row0, tpA);
#pragma unroll 1
        for (int rp = 0; rp < 4; ++rp) {
            const int ra = row0 + 2 * rp;
            P9_LOAD(1, ra + 1, tpB);
            int2 tpA2 = tpA, tpB2 = tpB;
            if (rp < 3) { tpA2 = *(const int2*)(tpp + 4 * rp + 4); tpB2 = *(const int2*)(tpp + 4 * rp + 6); }
            P9_COMP(0, ra);
            if (rp < 3) P9_LOAD(0, ra + 2, tpA2);
            P9_COMP(1, ra + 1);
            tpA = tpA2; tpB = tpB2;
        }
#undef P9_COMP
#undef P9_LOAD
    }
}

struct Args { P p; int ph_lo, ph_hi, li, pad; };
__global__ void __launch_bounds__(NTHR, 2) mega(Args args) {
    extern __shared__ __attribute__((aligned(16))) unsigned char lds_raw[];
    Frame F;
    F.lds = (LAS unsigned char*)lds_raw;
    F.MISC = (volatile LAS unsigned*)(F.lds + MISC_OFF);
    F.tid = threadIdx.x; F.lane = F.tid & 63; F.wave = __builtin_amdgcn_readfirstlane(F.tid >> 6);
    F.G = gridDim.x; { const int bx = blockIdx.x; F.vcu = (F.G % 8 == 0) ? (bx % 8) * (F.G / 8) + bx / 8 : bx; }
    const P& p = args.p;
    unsigned* ctl = (unsigned*)(p.ws + WS_CTL);
    for (int u = F.tid; u < (LDS_BYTES - MISC_OFF) / 4; u += NTHR) ((LAS unsigned*)(F.lds + MISC_OFF))[u] = 0u;
    __syncthreads();
    const int lo = args.ph_lo, hi = args.ph_hi;
    XcdBarrier bar; bar.bar = ctl + CW_BAR + args.li * XCD_BAR_WORDS; bar.x = 0; bar.st = nullptr;
    if (hi - lo > 1) bar = xcd_barrier_post(ctl + CW_BAR + args.li * XCD_BAR_WORDS, F.MISC + 8);
#define IN(k) (lo <= (k) && (k) < hi)
#define SEAM(k) do { if (IN(k) && IN((k) + 1)) xcd_barrier(bar); } while (0)
    if (IN(0)) { p0_prologue(p, F); SEAM(0); }
    if (IN(1)) { p1_norm(p, F); SEAM(1); }
    if (IN(2)) {
        pg8::Gemm g{(const pg8::bf16_t*)(p.ws + WS_XN), (const pg8::bf16_t*)(p.ws + WS_WQKV), MT, NQKV, D};
        pg8::SchedQKV S{F.G, (int)blockIdx.x};
        pg8::EpiQKV E{p.ws, p.bqn, p.bkn};
        pg8::gemm_phase<pg8::EpiQKV, pg8::SchedQKV, true, true, false>((PG8_LAS unsigned char*)F.lds, g, S, E);
        SEAM(2);
    }
#ifdef PROBE_ABL
    if (IN(3) && args.pad) { att::attn_phase<PROBE_ABL>(p, F.lds, F.vcu, F.G); } else
#endif
    if (IN(3)) { att::attn_phase<0>(p, F.lds, F.vcu, F.G); SEAM(3); }
    if (IN(4)) { p4_outproj(p, F); SEAM(4); }
#ifdef PROBE_ABL5
    if (IN(5) && args.pad) { p5_rowpass(p, F, PROBE_ABL5); } else
#endif
    if (IN(5)) { p5_rowpass(p, F); SEAM(5); }
    if (IN(6)) { p6_lists(p, F); SEAM(6); }
    if (IN(7)) { p78_moe(p, F, false); SEAM(7); }
    if (IN(8)) { p78_moe(p, F, true); SEAM(8); }
    if (IN(9)) { p9_final(p, F, args.pad ? (float*)(p.ws + WS_WGU) : p.out); }
#undef IN
#undef SEAM
}

#ifndef ONE_LAUNCH
#define ONE_LAUNCH 1
#endif
#ifndef FAST_MASK
#define FAST_MASK 0x3ff
#endif
static void launch_mega(const P& p, int lo, int hi, int li, int grid, hipStream_t stream) {
    Args a{}; a.p = p; a.ph_lo = lo; a.ph_hi = hi; a.li = li; a.pad = 0;
    hipLaunchKernelGGL(mega, dim3(grid), dim3(NTHR), LDS_BYTES, stream, a);
}
extern "C" void kernel_launch(void* const* d_in, const int* in_sizes, int n_in, void* d_out, int out_size, void* d_ws, size_t ws_size, hipStream_t stream) {
    static int grid = 0;
    if (grid == 0) {
        if (n_in != 24 || out_size != ML * D || ws_size < WS_END) { fprintf(stderr, "kernel_launch: unexpected shapes (n_in %d out %d ws %zu)\n", n_in, out_size, ws_size); grid = -1; return; }
        int dev = 0, cus = 0, per_cu = 0;
        if (hipGetDevice(&dev) != hipSuccess || hipDeviceGetAttribute(&cus, hipDeviceAttributeMultiprocessorCount, dev) != hipSuccess) { grid = -1; return; }
        if (hipFuncSetAttribute((const void*)mega, hipFuncAttributeMaxDynamicSharedMemorySize, LDS_BYTES) != hipSuccess) { fprintf(stderr, "kernel_launch: hipFuncSetAttribute failed\n"); grid = -1; return; }
        if (hipOccupancyMaxActiveBlocksPerMultiprocessor(&per_cu, (const void*)mega, NTHR, LDS_BYTES) != hipSuccess || per_cu < 1) { fprintf(stderr, "kernel_launch: occupancy query says %d blocks/CU\n", per_cu); (void)hipGetLastError(); grid = -1; return; }
        grid = cus;
    }
    if (grid < 0) return;
    P p{};
    const float** f = (const float**)&p;
    for (int i = 0; i < 24; ++i) f[i] = (const float*)d_in[i];
    p.out = (float*)d_out; p.ws = (unsigned char*)d_ws;
    (void)hipMemsetAsync((char*)d_ws + WS_CTL, 0, 64 * 1024, stream);
#if ONE_LAUNCH
    launch_mega(p, 0, 10, 0, grid, stream);
#else
    for (int k = 0; k < 10; ++k) {
        launch_mega(p, k, k + 1, 0, grid, stream);
#ifdef PROBE_DUP
        if (k == PROBE_DUP) for (int r_ = 0; r_ < 3; ++r_) { Args a{}; a.p = p; a.ph_lo = k; a.ph_hi = k + 1; a.li = 0; a.pad = 1; hipLaunchKernelGGL(mega, dim3(grid), dim3(NTHR), LDS_BYTES, stream, a); }
#endif
    }
#endif
}
```

```cpp
#include <hip/hip_runtime.h>
#include <cstdio>
#include <cstdint>
#ifndef WCONV_IN_ATTN
#define WCONV_IN_ATTN 1
#endif

constexpr int NB = 8, T = 2048, D = 1024, CL = 256;
constexpr int ML = NB * T;
constexpr int MC = NB * CL;
constexpr int MT = ML + MC;
constexpr int NKEY = T + CL;
constexpr int NTILE = NKEY / 64;
constexpr int NQKV = 1536;
constexpr int NE = 32, EFF = 512;
constexpr int MAXPOS = 40960;
constexpr int MAXTILES = MAXPOS / 256;
constexpr float EPS = 1e-6f;
constexpr float LOG2E = 1.4426950408889634f;
constexpr float C2 = 0.125f * LOG2E;

typedef unsigned short bf16;

constexpr size_t MiB = 1u << 20;
constexpr size_t WS_CTL = 0;
constexpr size_t WS_MODX = 1 * MiB;
constexpr size_t WS_ROPE = 1 * MiB + 512 * 1024;
constexpr size_t WS_WR = 1 * MiB + 768 * 1024;
constexpr size_t WS_TOKE = 2 * MiB;
constexpr size_t WS_TOKW = WS_TOKE + 128 * 1024;
constexpr size_t WS_TOKPOS = WS_TOKW + 128 * 1024;
constexpr size_t WS_ROWIDX = WS_TOKPOS + 128 * 1024;
constexpr size_t WS_ROWW = WS_ROWIDX + 160 * 1024;
constexpr size_t WS_BLKCNT = WS_ROWW + 160 * 1024;
constexpr size_t WS_META = WS_BLKCNT + 32 * 1024;
constexpr size_t WS_WQKV = 4 * MiB;
constexpr size_t WS_WO = 7 * MiB;
constexpr size_t WS_WGU = 9 * MiB;
constexpr size_t WS_WD = 73 * MiB;
constexpr size_t WS_XN = 105 * MiB;
constexpr size_t WS_QA = 141 * MiB;
constexpr size_t WS_QB = 157 * MiB;
constexpr size_t WS_KA = 173 * MiB;
constexpr size_t WS_VA = WS_KA + 4608 * 1024;
constexpr size_t WS_KB = WS_VA + 4608 * 1024;
constexpr size_t WS_VB = WS_KB + 4608 * 1024;
constexpr size_t WS_O = 191 * MiB;
constexpr size_t WS_SSQ = 223 * MiB;
constexpr size_t WS_OX = 261 * MiB;
constexpr size_t WS_R1 = 293 * MiB;
constexpr size_t WS_ACT = 141 * MiB;
constexpr size_t WS_Y = 181 * MiB;
constexpr size_t WS_END = 294 * MiB;

__device__ __forceinline__ unsigned f2bf(float f) { unsigned u = __builtin_bit_cast(unsigned, f); return (u + 0x7fffu + ((u >> 16) & 1u)) >> 16; }
__device__ __forceinline__ float bf2f(bf16 h) { return __builtin_bit_cast(float, (unsigned)h << 16); }
__device__ __forceinline__ float dpp_add(float v, const int ctrl_sel) {
    const int x = __builtin_bit_cast(int, v); int y;
    switch (ctrl_sel) { case 0: y = __builtin_amdgcn_update_dpp(x, x, 0xB1, 0xF, 0xF, false); break;
                        case 1: y = __builtin_amdgcn_update_dpp(x, x, 0x4E, 0xF, 0xF, false); break;
                        case 2: y = __builtin_amdgcn_update_dpp(x, x, 0x141, 0xF, 0xF, false); break;
                        default: y = __builtin_amdgcn_update_dpp(x, x, 0x140, 0xF, 0xF, false); break; }
    return v + __builtin_bit_cast(float, y);
}
__device__ __forceinline__ float wave_sum(float v) {
    v = dpp_add(v, 0); v = dpp_add(v, 1); v = dpp_add(v, 2); v = dpp_add(v, 3);
    const int x = __builtin_bit_cast(int, v);
    const float r0 = __builtin_bit_cast(float, __builtin_amdgcn_readlane(x, 0)), r1 = __builtin_bit_cast(float, __builtin_amdgcn_readlane(x, 16));
    const float r2 = __builtin_bit_cast(float, __builtin_amdgcn_readlane(x, 32)), r3 = __builtin_bit_cast(float, __builtin_amdgcn_readlane(x, 48));
    return (r0 + r1) + (r2 + r3);
}
__device__ __forceinline__ float wave_max(float v) {
#pragma unroll
    for (int o = 1; o < 64; o <<= 1) v = fmaxf(v, __shfl_xor(v, o));
    return v;
}
__device__ __forceinline__ float silu_f(float v) { return v / (1.f + __expf(-v)); }

__host__ __device__ __forceinline__ int qkv_row(int n) { const int pn = n >> 8, j = n & 255, hh = j >> 6, d = j & 63; return pn * 256 + (d >> 5) * 128 + hh * 32 + (d & 31); }
__host__ __device__ __forceinline__ size_t q_off(int b, int h, int t, int d) { return (((size_t)(b * 8 + h) * T + t) * 64 + d); }
__host__ __device__ __forceinline__ size_t k_off(int b, int kvh, int pos, int d) { return ((size_t)((b * 2 + kvh) * NTILE + (pos >> 6)) * 4096 + (d >> 3) * 512 + (pos & 63) * 8 + (d & 7)); }
__host__ __device__ __forceinline__ size_t v_off(int b, int kvh, int pos, int d) { return ((size_t)((b * 2 + kvh) * NTILE + (pos >> 6)) * 4096 + (d >> 5) * 2048 + (pos & 63) * 32 + (d & 31)); }

struct P {
    const float *x, *c, *ctx, *c_ctx, *w_mod, *b_mod, *pre1, *post1, *w_in, *a_sink, *bqn, *bkn, *aon, *bon, *w_out, *pre2, *post2, *w_group, *b_group, *w_router, *b_router, *w_gate, *w_up, *w_down;
    float* out; unsigned char* ws;
};

#define GAS __attribute__((address_space(1)))
#define LAS __attribute__((address_space(3)))
typedef unsigned v4u __attribute__((ext_vector_type(4)));
typedef unsigned v2u __attribute__((ext_vector_type(2)));
typedef float f32x4 __attribute__((ext_vector_type(4)));
typedef float f32x16 __attribute__((ext_vector_type(16)));
typedef short bf16x8 __attribute__((ext_vector_type(8)));
typedef short s16x4 __attribute__((ext_vector_type(4)));
constexpr int NWAVES = 8, NTHR = 512;
constexpr int LDS_BYTES = 163840;
constexpr int RING_BYTES = 131072;
constexpr int MISC_OFF = 159 * 1024;
constexpr int CW_TMO = 0, CW_CODE = 1, CW_BAR = 4096;
static_assert((CW_BAR + 3456) * 4 <= 64 * 1024, "control words inside the per-call memset");
#define LDS_WAIT() asm volatile("s_waitcnt lgkmcnt(0)" ::: "memory")
#define VM_WAIT() asm volatile("s_waitcnt vmcnt(0)" ::: "memory")
__device__ __forceinline__ unsigned pk2(float lo, float hi) { return f2bf(lo) | (f2bf(hi) << 16); }
#ifndef WT_STORES
#define WT_STORES 0
#endif
__device__ __forceinline__ void st16(void* p, v4u v) {
#if WT_STORES
    asm volatile("global_store_dwordx4 %0, %1, off sc1\n\ts_nop 1" :: "v"(p), "v"(v) : "memory");
#else
    *(v4u*)p = v;
#endif
}
__device__ __forceinline__ void st16f(void* p, f32x4 v) { st16(p, __builtin_bit_cast(v4u, v)); }
__device__ __forceinline__ void st8(void* p, v2u v) {
#if WT_STORES
    asm volatile("global_store_dwordx2 %0, %1, off sc1\n\ts_nop 1" :: "v"(p), "v"(v) : "memory");
#else
    *(v2u*)p = v;
#endif
}

#define XB_TMO      128
#define XB_XCNT(j)  (256  + 64 * (j))
#define XB_XSUB(j)  (1280 + 64 * (j))
#define XB_XGEN(j)  (2304 + 64 * (j))
#define XB_TOP      3328
#define XB_TOPGEN   3392
#define XCD_BAR_WORDS 3456
#define XB_SPIN_CAP (1u << 18)
__device__ __forceinline__ unsigned xb_ld(unsigned* p)              { return __hip_atomic_load(p, __ATOMIC_RELAXED, __HIP_MEMORY_SCOPE_AGENT); }
__device__ __forceinline__ unsigned xb_add(unsigned* p, unsigned v) { return __hip_atomic_fetch_add(p, v, __ATOMIC_RELAXED, __HIP_MEMORY_SCOPE_AGENT); }
__device__ __forceinline__ unsigned xb_xcc_id() { return (unsigned)__builtin_amdgcn_s_getreg((3 << 11) | 20) & 0xFu; }
#define XB_SPIN(cond, bar) do { unsigned _sp = 0; while (cond) { __builtin_amdgcn_s_sleep(1); \
    if ((++_sp & 255u) == 0u) { if (xb_ld(&(bar)[XB_TMO])) break; if (_sp > XB_SPIN_CAP) { atomicAdd(&(bar)[XB_TMO], 1u); break; } } } } while (0)
struct XcdBarrier { unsigned* bar; unsigned x; volatile LAS unsigned* st; };
__device__ __forceinline__ XcdBarrier xcd_barrier_post(unsigned* bar, volatile LAS unsigned* st) {
    XcdBarrier b; b.bar = bar; b.x = xb_xcc_id(); b.st = st;
    if (threadIdx.x == 0) (void)xb_add(&bar[XB_XCNT(b.x)], 1u);
    return b;
}
__device__ __forceinline__ void xcd_barrier_complete(unsigned* bar, unsigned x, unsigned& nloc, unsigned& nx) {
    const unsigned G = gridDim.x * gridDim.y * gridDim.z;
    unsigned sum, cnt, mine, sp = 0u;
    for (;;) {
        sum = 0u; cnt = 0u; mine = 0u;
#pragma unroll
        for (unsigned j = 0; j < 16; ++j) { const unsigned c = xb_ld(&bar[XB_XCNT(j)]); sum += c; cnt += (c > 0u) ? 1u : 0u; mine = (j == x) ? c : mine; }
        if (sum == G) break;
        __builtin_amdgcn_s_sleep(1);
        if ((++sp & 255u) == 0u) { if (xb_ld(&bar[XB_TMO])) break; if (sp > XB_SPIN_CAP) { atomicAdd(&bar[XB_TMO], 1u); break; } }
    }
    nloc = mine > 0u ? mine : 1u; nx = cnt > 0u ? cnt : 1u;
}
__device__ __forceinline__ void xcd_barrier(const XcdBarrier& b) {
    asm volatile("s_waitcnt vmcnt(0)" ::: "memory");
    __syncthreads();
    if (threadIdx.x == 0) {
        unsigned* bar = b.bar;
        __builtin_amdgcn_s_waitcnt(0);
        unsigned nloc = b.st[0], nx = b.st[1];
        if (nloc == 0u) { xcd_barrier_complete(bar, b.x, nloc, nx); b.st[0] = nloc; b.st[1] = nx; }
        const unsigned old = xb_add(&bar[XB_XSUB(b.x)], 1u);
        const unsigned gen = old / nloc;
        if (old + 1u == (gen + 1u) * nloc) {
            __builtin_amdgcn_fence(__ATOMIC_RELEASE, "agent");
            asm volatile("s_waitcnt vmcnt(0)" ::: "memory");
            const unsigned og = xb_add(&bar[XB_TOP], 1u);
            const unsigned tg = og / nx;
            if (og + 1u == (tg + 1u) * nx) xb_add(&bar[XB_TOPGEN], 1u);
            else XB_SPIN(xb_ld(&bar[XB_TOPGEN]) == tg, bar);
            __builtin_amdgcn_fence(__ATOMIC_ACQUIRE, "agent");
            xb_add(&bar[XB_XGEN(b.x)], 1u);
            asm volatile("s_waitcnt vmcnt(0)" ::: "memory");
        } else {
            XB_SPIN(xb_ld(&bar[XB_XGEN(b.x)]) == gen, bar);
            __builtin_amdgcn_fence(__ATOMIC_ACQUIRE, "agent");
            asm volatile("s_waitcnt vmcnt(0)" ::: "memory");
        }
    }
    __syncthreads();
}

namespace pg8 {
#define PG8_LAS __attribute__((address_space(3)))
typedef unsigned short bf16_t;
typedef short bf16x8 __attribute__((ext_vector_type(8)));
typedef float f32x4 __attribute__((ext_vector_type(4)));
typedef unsigned u32x4 __attribute__((ext_vector_type(4)));
constexpr int BM = 256, BK = 64, HALF = 128, HTB = HALF * BK * 2  , STAGE_BYTES = 8 * HTB, NXCD = 8, WGM = 8;

__host__ __device__ __forceinline__ int lds_byte(int r, int c) { const int st = (r >> 4) * 2 + (c >> 5), rr = r & 15, cc = c & 31, ob = rr * 64 + cc * 2; return st * 1024 + (ob ^ (((ob >> 9) & 1) << 5)); }
__host__ __device__ __forceinline__ void stage_rc(int b, int& R, int& C) { const int st = b / 1024, sb = b % 1024, swz = sb ^ (((sb >> 9) & 1) << 5); R = (st >> 1) * 16 + swz / 64; C = (st & 1) * 32 + (swz % 64) / 2; }
__host__ __device__ __forceinline__ int perm32(int rho) { const int n = rho >> 4, i = rho & 15; return 8 * (i >> 2) + 4 * n + (i & 3); }

struct Unit { int pm, pn; };
struct Gemm { const bf16_t* A; const bf16_t* Bt; int M, N, K; };
__device__ __forceinline__ unsigned cvt_pk_bf16(float lo, float hi) { unsigned r; asm volatile("v_cvt_pk_bf16_f32 %0, %1, %2" : "=v"(r) : "v"(lo), "v"(hi)); return r; }
template <class Epi, class Sched, bool ALIGN_EPI = false, bool SP2 = false, bool GATHER = false>
__device__ __forceinline__ void gemm_phase(PG8_LAS unsigned char* lds, const Gemm g, const Sched& S, const Epi& E) {
    const int tid = threadIdx.x, wid = __builtin_amdgcn_readfirstlane(tid >> 6), lane = tid & 63, wr = wid >> 2, wc = wid & 3, fr = lane & 15, fq = lane >> 4;
    const int K = g.K, nt = K / BK;
    unsigned voffA[2], voffB[2]; int RA[2], CA[2];
#pragma unroll
    for (int i = 0; i < 2; ++i) { int R, C; stage_rc(tid * 16 + i * 8192, R, C); const int Rb = Epi::PERM ? ((R & ~31) + perm32(R & 31)) : R;
        voffA[i] = (unsigned)(R * K + C) * 2u; voffB[i] = (unsigned)(Rb * K + C) * 2u; RA[i] = R; CA[i] = C; }
    const size_t kstep = (size_t)(BK * 2);
    const size_t hstep = (size_t)HALF * K * 2;
    const size_t tstep = 2 * hstep;
    const unsigned ldsw = (unsigned)wid * 1024u;
    const int aoff = lds_byte(wr * 64 + fr, fq * 8), boff = lds_byte(wc * 32 + fr, fq * 8);
#define PG8_SA(b, h) (((b) * 2 + (h)) * HTB)
#define PG8_SB(b, h) ((4 + (b) * 2 + (h)) * HTB)
#define PG8_STAGE(bufoff, gbase, voff) do { _Pragma("unroll") for (int _i = 0; _i < 2; ++_i) \
        __builtin_amdgcn_global_load_lds((const unsigned*)((const char*)(gbase) + (voff)[_i]), (PG8_LAS unsigned*)(lds + (bufoff) + ldsw + _i * 8192), 16, 0, 0); } while (0)
#define PG8_STAGE_A(bufoff, gbase, h, VO) do { if constexpr (GATHER) { PG8_STAGE(bufoff, gbase, VO[h]); } else { PG8_STAGE(bufoff, (gbase) + (h) * hstep, voffA); } } while (0)
#define PG8_LDA(dst, b, h) do { _Pragma("unroll") for (int m = 0; m < 4; ++m) _Pragma("unroll") for (int k = 0; k < 2; ++k) dst[m][k] = *(const PG8_LAS bf16x8*)(lds + PG8_SA(b, h) + aoff + m * 2048 + k * 1024); } while (0)
#define PG8_LDB(dst, b, h) do { _Pragma("unroll") for (int n = 0; n < 2; ++n) _Pragma("unroll") for (int k = 0; k < 2; ++k) dst[n][k] = *(const PG8_LAS bf16x8*)(lds + PG8_SB(b, h) + boff + n * 2048 + k * 1024); } while (0)
#define PG8_MMA(ai, bj, At, Bt) do { __builtin_amdgcn_s_setprio(1); _Pragma("unroll") for (int m = 0; m < 4; ++m) _Pragma("unroll") for (int n = 0; n < 2; ++n) _Pragma("unroll") for (int k = 0; k < 2; ++k) \
        acc[ai][bj][m][n] = __builtin_amdgcn_mfma_f32_16x16x32_bf16(Bt[n][k], At[m][k], acc[ai][bj][m][n], 0, 0, 0); __builtin_amdgcn_s_setprio(0); } while (0)
#define PG8_WAIT_V(n) asm volatile("s_waitcnt vmcnt(" #n ")" ::: "memory")
#define PG8_WAIT_L(n) asm volatile("s_waitcnt lgkmcnt(" #n ")" ::: "memory")
#define PG8_BAR __builtin_amdgcn_s_barrier()
#define PG8_SCHED __builtin_amdgcn_sched_barrier(0)
    Unit cur, nxt; int ui = 0;
    if (!S.next(0, cur)) return;
    f32x4 acc[2][2][4][2];
#pragma unroll
    for (int a = 0; a < 2; ++a)
#pragma unroll
        for (int b = 0; b < 2; ++b)
#pragma unroll
            for (int m = 0; m < 4; ++m)
#pragma unroll
                for (int n = 0; n < 2; ++n) acc[a][b][m][n] = (f32x4){0.f, 0.f, 0.f, 0.f};
    bf16x8 At[4][2], B0[2][2], B1[2][2];
    const char* cA = (const char*)g.A + (GATHER ? (size_t)0 : (size_t)cur.pm * tstep); const char* cB = (const char*)g.Bt + (size_t)cur.pn * tstep;
    unsigned vcur[2][2], vnxt[2][2], vsel[2][2];
#pragma unroll
    for (int h = 0; h < 2; ++h)
#pragma unroll
        for (int i = 0; i < 2; ++i) { vcur[h][i] = 0u; vnxt[h][i] = 0u; vsel[h][i] = 0u; }
    if constexpr (GATHER) {
#pragma unroll
        for (int h = 0; h < 2; ++h)
#pragma unroll
            for (int i = 0; i < 2; ++i) vcur[h][i] = ((unsigned)S.rowidx[cur.pm * BM + h * HALF + RA[i]] * (unsigned)K + (unsigned)CA[i]) * 2u;
    }
    S.a_ready(cur);
    if constexpr (SP2) {
        PG8_STAGE(PG8_SB(0, 0), cB, voffB); PG8_STAGE(PG8_SB(0, 1), cB + hstep, voffB); PG8_STAGE_A(PG8_SA(0, 0), cA, 0, vcur); PG8_STAGE_A(PG8_SA(0, 1), cA, 1, vcur);
        if (wr == 1) PG8_BAR;
        PG8_WAIT_V(2); PG8_BAR;
        PG8_STAGE(PG8_SB(1, 0), cB + kstep, voffB); PG8_STAGE_A(PG8_SA(1, 0), cA + kstep, 0, vcur); PG8_STAGE(PG8_SB(1, 1), cB + hstep + kstep, voffB);
        PG8_WAIT_V(6); PG8_BAR;
    } else {
        PG8_STAGE(PG8_SB(0, 0), cB, voffB); PG8_STAGE_A(PG8_SA(0, 0), cA, 0, vcur); PG8_STAGE(PG8_SB(0, 1), cB + hstep, voffB); PG8_STAGE_A(PG8_SA(0, 1), cA, 1, vcur);
        if (wr == 1) PG8_BAR;
        PG8_WAIT_V(4); PG8_BAR;
        PG8_STAGE(PG8_SB(1, 0), cB + kstep, voffB); PG8_STAGE_A(PG8_SA(1, 0), cA + kstep, 0, vcur); PG8_STAGE(PG8_SB(1, 1), cB + hstep + kstep, voffB);
        PG8_WAIT_V(6); PG8_BAR;
    }
    for (;;) {
        const bool has_next = S.next(ui + 1, nxt);
        if constexpr (GATHER) {
#pragma unroll
            for (int h = 0; h < 2; ++h)
#pragma unroll
                for (int i = 0; i < 2; ++i) vnxt[h][i] = has_next ? ((unsigned)S.rowidx[nxt.pm * BM + h * HALF + RA[i]] * (unsigned)K + (unsigned)CA[i]) * 2u : vcur[h][i];
        }
        const char* nA = has_next ? (const char*)g.A + (GATHER ? (size_t)0 : (size_t)nxt.pm * tstep) : cA; const char* nB = has_next ? (const char*)g.Bt + (size_t)nxt.pn * tstep : cB;
        for (int t = 0; t < nt; t += 2) {
            const bool last = (t == nt - 2);
            if constexpr (GATHER) {
#pragma unroll
                for (int h = 0; h < 2; ++h)
#pragma unroll
                    for (int i = 0; i < 2; ++i) vsel[h][i] = last ? vnxt[h][i] : vcur[h][i];
            }
            if constexpr (Epi::HAS_MID) { if (t == nt / 2) E.mid(acc, cur, wr, wc, fr, fq); }
            const char* a1 = cA + (size_t)(t + 1) * kstep;
            const char* a2 = last ? nA : cA + (size_t)(t + 2) * kstep; const char* b2 = last ? nB : cB + (size_t)(t + 2) * kstep;
            const char* a3 = a2 + kstep; const char* b3 = b2 + kstep;
            if (last && has_next) S.a_ready(nxt);
            if constexpr (SP2) {
            PG8_LDB(B0, 0, 0); PG8_LDB(B1, 0, 1); PG8_SCHED; PG8_LDA(At, 0, 0); PG8_STAGE_A(PG8_SA(1, 1), a1, 1, vcur);
            PG8_WAIT_V(8); PG8_WAIT_L(0); PG8_BAR; PG8_MMA(0, 0, At, B0); PG8_MMA(0, 1, At, B1); PG8_BAR; PG8_SCHED;
            PG8_LDA(At, 0, 1); PG8_STAGE(PG8_SB(0, 0), b2, voffB); PG8_STAGE(PG8_SB(0, 1), b2 + hstep, voffB); PG8_STAGE_A(PG8_SA(0, 0), a2, 0, vsel);
            PG8_WAIT_V(8); PG8_WAIT_L(0); PG8_BAR; PG8_MMA(1, 0, At, B0); PG8_MMA(1, 1, At, B1); PG8_BAR; PG8_SCHED;
            PG8_LDB(B0, 1, 0); PG8_LDB(B1, 1, 1); PG8_SCHED; PG8_LDA(At, 1, 0); PG8_STAGE_A(PG8_SA(0, 1), a2, 1, vsel);
            PG8_WAIT_V(8); PG8_WAIT_L(0); PG8_BAR; PG8_MMA(0, 0, At, B0); PG8_MMA(0, 1, At, B1); PG8_BAR; PG8_SCHED;
            PG8_LDA(At, 1, 1); PG8_STAGE(PG8_SB(1, 0), b3, voffB); PG8_STAGE(PG8_SB(1, 1), b3 + hstep, voffB); PG8_STAGE_A(PG8_SA(1, 0), a3, 0, vsel);
            PG8_WAIT_V(8); PG8_WAIT_L(0); PG8_BAR; PG8_MMA(1, 0, At, B0); PG8_MMA(1, 1, At, B1); PG8_BAR; PG8_SCHED;
            } else {
            PG8_LDB(B0, 0, 0); PG8_SCHED; PG8_LDA(At, 0, 0); PG8_STAGE_A(PG8_SA(1, 1), a1, 1, vcur);
            PG8_WAIT_L(8); PG8_BAR; PG8_WAIT_L(0); PG8_MMA(0, 0, At, B0); PG8_BAR; PG8_SCHED;
            PG8_LDB(B1, 0, 1); PG8_STAGE(PG8_SB(0, 0), b2, voffB);
            PG8_BAR; PG8_WAIT_L(0); PG8_MMA(0, 1, At, B1); PG8_BAR;
            PG8_LDA(At, 0, 1); PG8_STAGE_A(PG8_SA(0, 0), a2, 0, vsel);
            PG8_BAR; PG8_WAIT_L(0); PG8_MMA(1, 0, At, B0); PG8_BAR; PG8_SCHED;
            PG8_STAGE(PG8_SB(0, 1), b2 + hstep, voffB);
            PG8_WAIT_V(6); PG8_BAR; PG8_MMA(1, 1, At, B1); PG8_BAR;
            PG8_LDB(B0, 1, 0); PG8_SCHED; PG8_LDA(At, 1, 0); PG8_STAGE_A(PG8_SA(0, 1), a2, 1, vsel);
            PG8_WAIT_L(8); PG8_BAR; PG8_WAIT_L(0); PG8_MMA(0, 0, At, B0); PG8_BAR; PG8_SCHED;
            PG8_LDB(B1, 1, 1); PG8_STAGE(PG8_SB(1, 0), b3, voffB);
            PG8_BAR; PG8_WAIT_L(0); PG8_MMA(0, 1, At, B1); PG8_BAR;
            PG8_LDA(At, 1, 1); PG8_STAGE_A(PG8_SA(1, 0), a3, 0, vsel);
            PG8_BAR; PG8_WAIT_L(0); PG8_MMA(1, 0, At, B0); PG8_BAR; PG8_SCHED;
            PG8_STAGE(PG8_SB(1, 1), b3 + hstep, voffB);
            PG8_WAIT_V(6); PG8_BAR; PG8_MMA(1, 1, At, B1); PG8_BAR;
            }
        }
        if constexpr (ALIGN_EPI) { if (wr == 0) PG8_BAR; }
        if constexpr (!Epi::AFTER_DRAIN) { E(acc, cur, wr, wc, fr, fq); S.done(cur); }
        if (!has_next) break;
#pragma unroll
        for (int a = 0; a < 2; ++a)
#pragma unroll
            for (int b = 0; b < 2; ++b)
#pragma unroll
                for (int m = 0; m < 4; ++m)
#pragma unroll
                    for (int n = 0; n < 2; ++n) acc[a][b][m][n] = (f32x4){0.f, 0.f, 0.f, 0.f};
        cur = nxt; cA = nA; cB = nB; ++ui;
        if constexpr (GATHER) {
#pragma unroll
            for (int h = 0; h < 2; ++h)
#pragma unroll
                for (int i = 0; i < 2; ++i) vcur[h][i] = vnxt[h][i];
        }
        if constexpr (ALIGN_EPI) { if (wr == 1) PG8_BAR; }
    }
    PG8_WAIT_V(0);
    if constexpr (!ALIGN_EPI) { if (wr == 0) PG8_BAR; }
    PG8_BAR;
    if constexpr (Epi::AFTER_DRAIN) { E.fused(acc, cur, wr, wc, fr, fq, lds, wid, lane); S.done(cur); }
#undef PG8_SA
#undef PG8_SB
#undef PG8_STAGE
#undef PG8_STAGE_A
#undef PG8_LDA
#undef PG8_LDB
#undef PG8_MMA
#undef PG8_WAIT_V
#undef PG8_WAIT_L
#undef PG8_BAR
#undef PG8_SCHED
}
}

namespace pg8 {
struct SchedQKV {
    int G, c;
    __device__ __forceinline__ bool next(int i, Unit& u) const {
        const int L = i * G + c; if (L >= 400) return false;
        if (L < 384) { const int xcd = L & 7, off = L >> 3, w = xcd * 48 + off; u.pm = (w / 48) * 8 + ((w % 48) & 7); u.pn = (w % 48) >> 3; }
        else { const int j = L - 384; u.pm = 64 + (j >> 1); u.pn = (j & 1) ? 5 : 2; }
        return true;
    }
    __device__ __forceinline__ void a_ready(const Unit&) const {}
    __device__ __forceinline__ void done(const Unit&) const {}
};
struct EpiQKV {
    static constexpr bool PERM = true, AFTER_DRAIN = false, HAS_MID = false;
    unsigned char* ws; const float* bqn; const float* bkn;
    __device__ __forceinline__ void operator()(const f32x4 (&acc)[2][2][4][2], const Unit& u, int wr, int wc, int fr, int fq) const {
        const int pn = u.pn; const bool isctx = u.pm >= 64;
        int kind, hh;
        if (pn < 2) { kind = 0; hh = pn * 4 + wc; } else if (pn == 2) { kind = wc < 2 ? 2 : 4; hh = wc & 1; } else if (pn < 5) { kind = 1; hh = (pn - 3) * 4 + wc; } else { kind = wc < 2 ? 3 : 5; hh = wc & 1; }
        const bool rms = kind == 1 || kind == 3, rope = !isctx && kind <= 3;
        const float* gp = kind == 1 ? bqn : bkn;
        f32x4 gain[2][2];
#pragma unroll
        for (int bj = 0; bj < 2; ++bj)
#pragma unroll
            for (int n = 0; n < 2; ++n) gain[bj][n] = rms ? *(const f32x4*)(gp + 32 * bj + 8 * fq + 4 * n) : (f32x4){1.f, 1.f, 1.f, 1.f};
        const float* tab = (const float*)(ws + WS_ROPE);
        bf16* base = (bf16*)(ws + (kind == 0 ? WS_QA : kind == 1 ? WS_QB : kind == 2 ? WS_KA : kind == 3 ? WS_KB : kind == 4 ? WS_VA : WS_VB));
        const float qs = kind <= 1 ? C2 : 1.f;
#pragma unroll
        for (int ai = 0; ai < 2; ++ai)
#pragma unroll
            for (int m = 0; m < 4; ++m) {
                const int row = u.pm * BM + ai * HALF + wr * 64 + m * 16 + fr;
                int b, t, pos;
                if (!isctx) { b = row >> 11; t = row & 2047; pos = t; } else { const int cr = row - ML; b = cr >> 8; t = 0; pos = T + (cr & 255); }
                f32x4 v[2][2];
#pragma unroll
                for (int bj = 0; bj < 2; ++bj)
#pragma unroll
                    for (int n = 0; n < 2; ++n) v[bj][n] = acc[ai][bj][m][n];
                if (rms) {
                    float ss = 0.f;
#pragma unroll
                    for (int bj = 0; bj < 2; ++bj)
#pragma unroll
                        for (int n = 0; n < 2; ++n) ss += (v[bj][n].x * v[bj][n].x + v[bj][n].y * v[bj][n].y) + (v[bj][n].z * v[bj][n].z + v[bj][n].w * v[bj][n].w);
                    ss += __shfl_xor(ss, 16); ss += __shfl_xor(ss, 32);
                    const float rn = rsqrtf(ss * (1.f / 64.f) + EPS);
#pragma unroll
                    for (int bj = 0; bj < 2; ++bj)
#pragma unroll
                        for (int n = 0; n < 2; ++n) v[bj][n] = v[bj][n] * rn * gain[bj][n];
                }
                if (rope) {
#pragma unroll
                    for (int bj = 0; bj < 2; ++bj)
#pragma unroll
                        for (int n = 0; n < 2; ++n) {
                            const int tp = bj == 0 ? (t >> 6) : 32 + (t & 63);
                            const f32x4 cs = *(const f32x4*)(tab + (tp * 16 + 4 * fq + 2 * n) * 2);
                            const f32x4 x = v[bj][n];
                            v[bj][n] = (f32x4){x.x * cs.x - x.y * cs.y, x.x * cs.y + x.y * cs.x, x.z * cs.z - x.w * cs.w, x.z * cs.w + x.w * cs.z};
                        }
                }
#pragma unroll
                for (int bj = 0; bj < 2; ++bj) {
                    const f32x4 v0 = v[bj][0] * qs, v1 = v[bj][1] * qs;
                    u32x4 w; w.x = pk2(v0.x, v0.y); w.y = pk2(v0.z, v0.w); w.z = pk2(v1.x, v1.y); w.w = pk2(v1.z, v1.w);
                    const int d0 = 32 * bj + 8 * fq;
                    bf16* dst = kind <= 1 ? base + q_off(b, hh, t, d0) : kind <= 3 ? base + k_off(b, hh, pos, d0) : base + v_off(b, hh, pos, d0);
                    st16(dst, w);
                }
            }
    }
};
}


namespace pg8 {
struct SchedOne { Unit u;
    __device__ __forceinline__ bool next(int i, Unit& o) const { if (i) return false; o = u; return true; }
    __device__ __forceinline__ void a_ready(const Unit&) const {}
    __device__ __forceinline__ void done(const Unit&) const {} };
struct EpiOut {
    static constexpr bool PERM = true, AFTER_DRAIN = false, HAS_MID = true;
    bf16* OX; const LAS float* tab;
    __device__ __forceinline__ void mid(f32x4 (&acc)[2][2][4][2], const Unit&, int wr, int, int fr, int) const {
#pragma unroll
        for (int ai = 0; ai < 2; ++ai)
#pragma unroll
            for (int m = 0; m < 4; ++m) { const float f = tab[2 * (ai * HALF + wr * 64 + m * 16 + fr)];
#pragma unroll
                for (int bj = 0; bj < 2; ++bj)
#pragma unroll
                    for (int n = 0; n < 2; ++n) acc[ai][bj][m][n] = acc[ai][bj][m][n] * f; }
    }
    __device__ __forceinline__ void operator()(const f32x4 (&acc)[2][2][4][2], const Unit& u, int wr, int wc, int fr, int fq) const {
#pragma unroll
        for (int ai = 0; ai < 2; ++ai)
#pragma unroll
            for (int m = 0; m < 4; ++m) { const int r = ai * HALF + wr * 64 + m * 16 + fr; const float f = tab[2 * r + 1];
                bf16* rowp = OX + (size_t)(u.pm * BM + r) * D + u.pn * BM + wc * 32 + 8 * fq;
#pragma unroll
                for (int bj = 0; bj < 2; ++bj) { const f32x4 v0 = acc[ai][bj][m][0] * f, v1 = acc[ai][bj][m][1] * f;
                    u32x4 w; w.x = pk2(v0.x, v0.y); w.y = pk2(v0.z, v0.w); w.z = pk2(v1.x, v1.y); w.w = pk2(v1.z, v1.w);
                    st16(rowp + bj * HALF, w); } }
    }
};
struct SchedMoE {
    int G, c, nwg; const LAS int* tile_e; const int* rowidx;
    __device__ __forceinline__ bool next(int i, Unit& u) const {
        const int L = i * G + c; if (L >= nwg) return false;
        const int q = nwg >> 3, r = nwg & 7, xcd = L & 7, off = L >> 3;
        const int w = (xcd < r ? xcd * (q + 1) : r * (q + 1) + (xcd - r) * q) + off;
        u.pm = w >> 2; u.pn = tile_e[w >> 2] * 4 + (w & 3); return true;
    }
    __device__ __forceinline__ void a_ready(const Unit&) const {}
    __device__ __forceinline__ void done(const Unit&) const {}
};
__device__ __forceinline__ float silu_fast(float g) { return g * __builtin_amdgcn_rcpf(1.f + __builtin_amdgcn_exp2f(-g * LOG2E)); }
struct EpiGU {
    static constexpr bool PERM = true, AFTER_DRAIN = false, HAS_MID = false;
    bf16* ACT; const float* roww;
    __device__ __forceinline__ void operator()(const f32x4 (&acc)[2][2][4][2], const Unit& u, int wr, int wc, int fr, int fq) const {
#pragma unroll
        for (int ai = 0; ai < 2; ++ai)
#pragma unroll
            for (int m = 0; m < 4; ++m) { const int pos = u.pm * BM + ai * HALF + wr * 64 + m * 16 + fr; const float w = roww[pos];
                const f32x4 g0 = acc[ai][0][m][0], g1 = acc[ai][0][m][1], u0 = acc[ai][1][m][0], u1 = acc[ai][1][m][1];
                u32x4 o;
                o.x = pk2(silu_fast(g0.x) * u0.x * w, silu_fast(g0.y) * u0.y * w); o.y = pk2(silu_fast(g0.z) * u0.z * w, silu_fast(g0.w) * u0.w * w);
                o.z = pk2(silu_fast(g1.x) * u1.x * w, silu_fast(g1.y) * u1.y * w); o.w = pk2(silu_fast(g1.z) * u1.z * w, silu_fast(g1.w) * u1.w * w);
                st16(ACT + (size_t)pos * EFF + (u.pn & 3) * 128 + wc * 32 + 8 * fq, o); }
    }
};
struct EpiY {
    static constexpr bool PERM = true, AFTER_DRAIN = false, HAS_MID = false;
    bf16* Y;
    __device__ __forceinline__ void operator()(const f32x4 (&acc)[2][2][4][2], const Unit& u, int wr, int wc, int fr, int fq) const {
#pragma unroll
        for (int ai = 0; ai < 2; ++ai)
#pragma unroll
            for (int m = 0; m < 4; ++m) { bf16* rowp = Y + (size_t)(u.pm * BM + ai * HALF + wr * 64 + m * 16 + fr) * D + (u.pn & 3) * BM + wc * 32 + 8 * fq;
#pragma unroll
                for (int bj = 0; bj < 2; ++bj) { const f32x4 v0 = acc[ai][bj][m][0], v1 = acc[ai][bj][m][1];
                    u32x4 w; w.x = pk2(v0.x, v0.y); w.y = pk2(v0.z, v0.w); w.z = pk2(v1.x, v1.y); w.w = pk2(v1.z, v1.w);
                    st16(rowp + bj * HALF, w); } }
    }
};
}

namespace att {
typedef __attribute__((address_space(3))) const char* lds_cptr;
typedef short v4i16_t __attribute__((ext_vector_type(4)));
constexpr int NSLOT = 4, SLOTB = 16384, OST_PITCH = 144, OST_WAVE = 32 * OST_PITCH;
static_assert(8 * OST_WAVE <= 3 * SLOTB && NSLOT * SLOTB <= 65536, "attention LDS");
__device__ __forceinline__ int crow(int r, int hi) { return (r & 3) + 8 * (r >> 2) + 4 * hi; }
__device__ __forceinline__ unsigned cvtpk(float lo, float hi) { typedef float f2 __attribute__((ext_vector_type(2))); typedef __bf16 b2 __attribute__((ext_vector_type(2))); f2 v = {lo, hi}; b2 b = __builtin_convertvector(v, b2); return __builtin_bit_cast(unsigned, b); }
__device__ __forceinline__ s16x4 vtr(lds_cptr p) { return __builtin_bit_cast(s16x4, __builtin_amdgcn_ds_read_tr16_b64_v4i16((__attribute__((address_space(3))) v4i16_t*)p)); }
__device__ __forceinline__ float swapmax(float m) { auto rr = __builtin_amdgcn_permlane32_swap(__float_as_uint(m), __float_as_uint(m), false, false); return fmaxf(__uint_as_float(rr[0]), __uint_as_float(rr[1])); }
__device__ __forceinline__ float swapsum(float m) { auto rr = __builtin_amdgcn_permlane32_swap(__float_as_uint(m), __float_as_uint(m), false, false); return __uint_as_float(rr[0]) + __uint_as_float(rr[1]); }

__device__ __forceinline__ void glds16(const void* gsrc, unsigned lds_dst) { unsigned keep;
    asm volatile("s_mov_b32 %0, m0\n\ts_mov_b32 m0, %2\n\ts_nop 0\n\tglobal_load_lds_dwordx4 %1, off\n\ts_mov_b32 m0, %0" : "=&s"(keep) : "v"(gsrc), "s"(lds_dst) : "memory"); }
__device__ __forceinline__ float max3f(float a, float b, float c) { float r; asm("v_max3_f32 %0, %1, %2, %3" : "=v"(r) : "v"(a), "v"(b), "v"(c)); return r; }
__device__ __forceinline__ float max2f(float a, float b) { float r; asm("v_max_f32_e32 %0, %1, %2" : "=v"(r) : "v"(a), "v"(b)); return r; }
constexpr int WC_PER_WAVE = 24, WC_LDS = 65536;
struct WConv { int next, j0, j1, gstep, cm1, cm2; };
struct WItem { const float* src; int N; bf16* dst; int dpitch; };
__device__ __forceinline__ WItem wc_decode(const P& p, int hidx, int& k0, int& n0, int& drow0) {
    const int item = hidx >> 1, kh = hidx & 1; WItem w;
    if (item < 16384) { const int up = item >= 8192, r = item & 8191, e = r >> 8, q = r & 255, kb = q >> 4, nb = q & 15; n0 = nb * 32;
        w.src = (up ? p.w_up : p.w_gate) + (size_t)e * 1024 * 512; w.N = 512; w.dst = (bf16*)(p.ws + WS_WGU) + (size_t)e * 1024 * 1024; w.dpitch = 1024;
        drow0 = (n0 >> 7) * 256 + up * 128 + (n0 & 127); k0 = kb * 64 + kh * 32; }
    else { const int r = item - 16384, e = r >> 8, q = r & 255, kb = q >> 5, nb = q & 31; n0 = nb * 32;
        w.src = p.w_down + (size_t)e * 512 * 1024; w.N = 1024; w.dst = (bf16*)(p.ws + WS_WD) + (size_t)e * 1024 * 512; w.dpitch = 512; drow0 = n0; k0 = kb * 64 + kh * 32; }
    return w;
}
__device__ __forceinline__ void glds16(const void* gsrc, unsigned lds_dst);
__device__ __forceinline__ void glds16_nt(const void* gsrc, unsigned lds_dst) { unsigned keep;
    asm volatile("s_mov_b32 %0, m0\n\ts_mov_b32 m0, %2\n\ts_nop 0\n\tglobal_load_lds_dwordx4 %1, off nt\n\ts_mov_b32 m0, %0" : "=&s"(keep) : "v"(gsrc), "s"(lds_dst) : "memory"); }
__device__ __forceinline__ void wc_issue(const P& p, int gw, int ord, unsigned ldsbuf, int lane) {
    int k0, n0, drow0; const WItem w = wc_decode(p, gw + 2048 * ord, k0, n0, drow0);
#pragma unroll
    for (int q = 0; q < 4; ++q) { const int kl = 8 * q + (lane >> 3), f4 = (lane & 7) ^ ((q >> 1) * 4);
        glds16_nt(w.src + (size_t)(k0 + kl) * w.N + n0 + f4 * 4, (unsigned)__builtin_amdgcn_readfirstlane(ldsbuf + q * 1024)); }
}
__device__ __forceinline__ void wc_consume(const P& p, int gw, int ord, LAS unsigned char* buf, int lane) {
    int k0, n0, drow0; const WItem w = wc_decode(p, gw + 2048 * ord, k0, n0, drow0);
    const int n = lane >> 1, kh = lane & 1;
    const LAS float* s = (const LAS float*)buf + (16 * kh) * 32 + 4 * ((n >> 2) ^ (4 * kh)) + (n & 3);
    float v[16];
#pragma unroll
    for (int i = 0; i < 16; ++i) v[i] = s[i * 32];
    v4u o0, o1;
    o0.x = cvtpk(v[0], v[1]); o0.y = cvtpk(v[2], v[3]); o0.z = cvtpk(v[4], v[5]); o0.w = cvtpk(v[6], v[7]);
    o1.x = cvtpk(v[8], v[9]); o1.y = cvtpk(v[10], v[11]); o1.z = cvtpk(v[12], v[13]); o1.w = cvtpk(v[14], v[15]);
    bf16* d = w.dst + (size_t)(drow0 + n) * w.dpitch + k0 + 16 * kh;
    __builtin_nontemporal_store(o0, (v4u*)d); __builtin_nontemporal_store(o1, (v4u*)(d + 8));
}
constexpr float THR = 8.f;
template <int GRP, int ABL = 0>
__device__ __forceinline__ void attn_unit(const P& p, LAS unsigned char* lds, int b, int kvh, int qb, WConv& wc, int gw) {
    const int tid = threadIdx.x, lane = tid & 63, r32 = lane & 31, hi = lane >> 5;
    const int wid = __builtin_amdgcn_readfirstlane(tid >> 6);
    const int h = kvh * 4 + (wid >> 1);
    const int q0w = qb * 64 + (wid & 1) * 32, qpos = q0w + r32;
    const bf16* Qp = (const bf16*)(p.ws + (GRP ? WS_QB : WS_QA)) + q_off(b, h, qpos, 0);
    bf16x8 qr[4];
#pragma unroll
    for (int d0 = 0; d0 < 4; ++d0) qr[d0] = *(const bf16x8*)(Qp + 16 * d0 + 8 * hi);
    asm volatile("" : "+v"(qr[0]), "+v"(qr[1]), "+v"(qr[2]), "+v"(qr[3]));
    const char* Kt = (const char*)(p.ws + (GRP ? WS_KB : WS_KA)) + (size_t)(b * 2 + kvh) * NTILE * 8192 + wid * 1024 + lane * 16;
    const char* Vt = (const char*)(p.ws + (GRP ? WS_VB : WS_VA)) + (size_t)(b * 2 + kvh) * NTILE * 8192 + wid * 1024 + lane * 16;
    const unsigned lds0 = (unsigned)(uintptr_t)lds;
    int jlo = 0, nband = NTILE, NT = NTILE;
    if (GRP == 0) { jlo = qb - 2 < 0 ? 0 : qb - 2; const int jhi = qb + 2 > 31 ? 31 : qb + 2; nband = jhi - jlo + 1; NT = nband + 4; }
#define ATT_TILE(i) ((i) < nband ? jlo + (i) : 32 + ((i) - nband))
#define ATT_ISSUE(i) do { if (ABL & 1) break; const int tl_ = ATT_TILE(i); const int sl_ = ((i) & 3) * SLOTB; \
        glds16(Kt + (size_t)tl_ * 8192, (unsigned)__builtin_amdgcn_readfirstlane(lds0 + sl_ + wid * 1024)); \
        glds16(Vt + (size_t)tl_ * 8192, (unsigned)__builtin_amdgcn_readfirstlane(lds0 + sl_ + 8192 + wid * 1024)); } while (0)
#define ATT_WAIT(n) do { if (ABL & 1) break; if ((n) >= 2) asm volatile("s_waitcnt vmcnt(4)" ::: "memory"); else if ((n) == 1) asm volatile("s_waitcnt vmcnt(2)" ::: "memory"); else asm volatile("s_waitcnt vmcnt(0)" ::: "memory"); } while (0)
#define ATT_WAITN(n) do { if (ABL & 1) break; switch (n) { case 0: asm volatile("s_waitcnt vmcnt(0)" ::: "memory"); break; case 2: asm volatile("s_waitcnt vmcnt(2)" ::: "memory"); break; \
        case 4: asm volatile("s_waitcnt vmcnt(4)" ::: "memory"); break; case 6: asm volatile("s_waitcnt vmcnt(6)" ::: "memory"); break; case 8: asm volatile("s_waitcnt vmcnt(8)" ::: "memory"); break; \
        case 10: asm volatile("s_waitcnt vmcnt(10)" ::: "memory"); break; case 12: asm volatile("s_waitcnt vmcnt(12)" ::: "memory"); break; default: asm volatile("s_waitcnt vmcnt(14)" ::: "memory"); break; } } while (0)
#define ATT_BAR() do { asm volatile("" ::: "memory"); __builtin_amdgcn_s_barrier(); asm volatile("" ::: "memory"); } while (0)
#define SBAR() __builtin_amdgcn_sched_barrier(0)
#define MF(a, b, c) __builtin_amdgcn_mfma_f32_32x32x16_bf16(a, b, c, 0, 0, 0)
#define KFRAG(dst, base, k) dst = *(const __attribute__((address_space(3))) bf16x8*)((base) + ((k) >> 1) * 2048 + ((k) & 1) * 512)
    float m, l;
    m = 0.f; l = 0.f;
    f32x16 o0, o1, sA0, sA1, sB0, sB1; const f32x16 zero16 = {0.f, 0.f, 0.f, 0.f, 0.f, 0.f, 0.f, 0.f, 0.f, 0.f, 0.f, 0.f, 0.f, 0.f, 0.f, 0.f};
#pragma unroll
    for (int r = 0; r < 16; ++r) { o0[r] = 0.f; o1[r] = 0.f; sB0[r] = 0.f; sB1[r] = 0.f; }
    const lds_cptr kp0 = (lds_cptr)lds + hi * 1024 + r32 * 16;
    const lds_cptr vp0 = (lds_cptr)lds + 8192 + ((lane >> 4) & 1) * 32 + (lane & 3) * 8 + (4 * hi + ((lane & 15) >> 2)) * 64;
#define ATT_MASK(S0, S1, t) do { if (GRP == 0) { const int tl = ATT_TILE(t); if (tl < 32 && (tl == qb - 2 || tl == qb + 2)) { const int kb = tl * 64; \
        _Pragma("unroll") for (int r = 0; r < 16; ++r) { const int dd = kb + crow(r, hi) - qpos; if (dd > 128 || dd < -128) S0[r] = -1e30f; if (dd + 32 > 128 || dd + 32 < -128) S1[r] = -1e30f; } } } } while (0)
#define ATT_DECIDE(S0, S1, mxv) do { float mx_ = swapmax(mxv); \
        if (__builtin_expect(__any(mx_ > THR), 0)) { const float dl = fmaxf(mx_, 0.f), alpha = __builtin_amdgcn_exp2f(-dl); m += dl; l *= alpha; \
            _Pragma("unroll") for (int r = 0; r < 16; ++r) { S0[r] -= dl; S1[r] -= dl; o0[r] *= alpha; o1[r] *= alpha; } } } while (0)
    if (wid >= 4) __builtin_amdgcn_s_setprio(1);
    wc.cm1 = 0; wc.cm2 = 0;
    ATT_ISSUE(0); ATT_ISSUE(1); ATT_ISSUE(2);
    ATT_WAIT(2); ATT_BAR();
    {
        bf16x8 kf[8];
#pragma unroll
        for (int k = 0; k < 8; ++k) KFRAG(kf[k], kp0, k);
        SBAR();
        sA0 = MF(kf[0], qr[0], zero16); sA1 = MF(kf[1], qr[0], zero16);
#pragma unroll
        for (int d0 = 1; d0 < 4; ++d0) { sA0 = MF(kf[2 * d0], qr[d0], sA0); sA1 = MF(kf[2 * d0 + 1], qr[d0], sA1); }
        ATT_MASK(sA0, sA1, 0);
        asm volatile("s_nop 15\n\ts_nop 7" : "+v"(sA0), "+v"(sA1));
        float a = max3f(sA0[0], sA0[1], sA1[0]), c = max3f(sA0[2], sA0[3], sA1[1]); a = max3f(a, sA1[2], sA1[3]);
#pragma unroll
        for (int r = 4; r < 16; r += 4) { a = max3f(a, sA0[r], sA0[r + 1]); c = max3f(c, sA0[r + 2], sA0[r + 3]); a = max3f(a, sA1[r], sA1[r + 1]); c = max3f(c, sA1[r + 2], sA1[r + 3]); }
        ATT_DECIDE(sA0, sA1, max2f(a, c));
    }
#define ATT_STEP(SC0, SC1, SN0, SN1, t, HN) do { \
        constexpr bool hn_ = HN;                                      \
        ATT_WAITN(wc.cm2 + wc.cm1 + ((t) + 2 < NT ? 2 : 0));         \
        ATT_BAR(); \
        if ((t) + 3 < NT) ATT_ISSUE((t) + 3); \
        if (WCONV_IN_ATTN) { int c_ = 0; const int r7_ = wc.gstep % 7, bs_ = r7_ == 0 ? 0 : r7_ == 3 ? 1 : 2;     \
            if (bs_ < 2) { LAS unsigned char* wb_ = lds + WC_LDS + wid * 8192 + bs_ * 4096; int jb_ = bs_ ? wc.j1 : wc.j0; \
                if (jb_ >= 0) { wc_consume(p, gw, jb_, wb_, lane); jb_ = -1; c_ += 2; } \
                if (wc.next < WC_PER_WAVE) { asm volatile("s_waitcnt lgkmcnt(0)" ::: "memory"); wc_issue(p, gw, wc.next, lds0 + WC_LDS + wid * 8192 + bs_ * 4096, lane); jb_ = wc.next++; c_ += 4; } \
                if (bs_) wc.j1 = jb_; else wc.j0 = jb_; } \
            wc.cm2 = wc.cm1; wc.cm1 = c_; wc.gstep++; } \
        const lds_cptr kp_ = kp0 + (((t) + 1) & 3) * SLOTB; const lds_cptr vp_ = vp0 + ((t) & 3) * SLOTB; \
        bf16x8 kf[8]; s16x4 vlo[8], vhi[8]; \
        if (hn_) { _Pragma("unroll") for (int k = 0; k < 8; ++k) KFRAG(kf[k], kp_, k); } \
        SBAR(); \
        float rs_ = 0.f; v4u pw[4]; _Pragma("unroll") for (int q_ = 0; q_ < 4; ++q_) pw[q_] = (v4u){0u, 0u, 0u, 0u}; \
        _Pragma("unroll") for (int g = 0; g < 8; ++g) {             \
            if (hn_) { if (g == 0) SN0 = MF(kf[0], qr[0], zero16); else if (g == 1) SN1 = MF(kf[1], qr[0], zero16); else if (g & 1) SN1 = MF(kf[g], qr[g >> 1], SN1); else SN0 = MF(kf[g], qr[g >> 1], SN0); } \
            if (g < 4) { _Pragma("unroll") for (int e = 0; e < 4; ++e) { SC0[4 * g + e] = __builtin_amdgcn_exp2f(SC0[4 * g + e]); rs_ += SC0[4 * g + e]; } \
                         pw[g >> 1][2 * (g & 1)] = cvtpk(SC0[4 * g], SC0[4 * g + 1]); pw[g >> 1][2 * (g & 1) + 1] = cvtpk(SC0[4 * g + 2], SC0[4 * g + 3]); \
                         asm volatile("" : "+v"(SC0), "+v"(pw[g >> 1]), "+v"(rs_)); } \
            else { const int g4 = g - 4;   \
                         vlo[g4] = vtr(vp_ + g4 * 1024); vhi[g4] = vtr(vp_ + g4 * 1024 + 512); vlo[4 + g4] = vtr(vp_ + 4096 + g4 * 1024); vhi[4 + g4] = vtr(vp_ + 4096 + g4 * 1024 + 512); \
                         _Pragma("unroll") for (int e = 0; e < 4; ++e) { SC1[4 * g4 + e] = __builtin_amdgcn_exp2f(SC1[4 * g4 + e]); rs_ += SC1[4 * g4 + e]; } \
                         pw[2 + (g4 >> 1)][2 * (g4 & 1)] = cvtpk(SC1[4 * g4], SC1[4 * g4 + 1]); pw[2 + (g4 >> 1)][2 * (g4 & 1) + 1] = cvtpk(SC1[4 * g4 + 2], SC1[4 * g4 + 3]); \
                         asm volatile("" : "+v"(SC1), "+v"(pw[2 + (g4 >> 1)]), "+v"(rs_)); } \
            SBAR(); } \
        l += rs_; \
        if (hn_) { ATT_MASK(SN0, SN1, (t) + 1); if (__builtin_expect(__any(m != 0.f), 0)) { _Pragma("unroll") for (int r = 0; r < 16; ++r) { SN0[r] -= m; SN1[r] -= m; } } \
                   asm volatile("s_nop 15\n\ts_nop 7" : "+v"(SN0), "+v"(SN1)); } \
        float ma_ = -3.0e38f, mc_ = -3.0e38f; \
        _Pragma("unroll") for (int g = 0; g < 8; ++g) {             \
            const int ks = g >> 1; const bf16x8 pf = __builtin_bit_cast(bf16x8, pw[ks]); \
            if (g & 1) { const bf16x8 v1 = (bf16x8){vlo[4 + ks][0], vlo[4 + ks][1], vlo[4 + ks][2], vlo[4 + ks][3], vhi[4 + ks][0], vhi[4 + ks][1], vhi[4 + ks][2], vhi[4 + ks][3]}; o1 = MF(v1, pf, o1); } \
            else { const bf16x8 v0 = (bf16x8){vlo[ks][0], vlo[ks][1], vlo[ks][2], vlo[ks][3], vhi[ks][0], vhi[ks][1], vhi[ks][2], vhi[ks][3]}; o0 = MF(v0, pf, o0); } \
            if (hn_) { if (g < 4) { ma_ = max3f(ma_, SN0[4 * g], SN0[4 * g + 1]); mc_ = max3f(mc_, SN0[4 * g + 2], SN0[4 * g + 3]); } \
                       else { ma_ = max3f(ma_, SN1[4 * (g - 4)], SN1[4 * (g - 4) + 1]); mc_ = max3f(mc_, SN1[4 * (g - 4) + 2], SN1[4 * (g - 4) + 3]); } \
                       asm volatile("" : "+v"(ma_), "+v"(mc_)); } \
            SBAR(); } \
        if (hn_) ATT_DECIDE(SN0, SN1, max2f(ma_, mc_)); \
    } while (0)
    {
        int t = 0;
        for (; t + 2 < NT; t += 2) { ATT_STEP(sA0, sA1, sB0, sB1, t, true); ATT_STEP(sB0, sB1, sA0, sA1, t + 1, true); }
        if (t + 2 == NT) { ATT_STEP(sA0, sA1, sB0, sB1, t, true); ATT_STEP(sB0, sB1, sA0, sA1, t + 1, false); }
        else { ATT_STEP(sA0, sA1, sB0, sB1, t, false); }
    }
#undef ATT_STEP
#undef ATT_DECIDE
#undef ATT_MASK
#undef KFRAG
#undef MF
#undef SBAR
#undef ATT_TILE
#undef ATT_ISSUE
#undef ATT_WAIT
    if (wid >= 4) __builtin_amdgcn_s_setprio(0);
    ATT_BAR();
    float ltot = swapsum(l); if (GRP == 0) ltot += __builtin_amdgcn_exp2f(p.a_sink[h] * LOG2E - m);
    const float inv = 1.f / ltot;
    int lane_e = lane; asm volatile("" : "+v"(lane_e));
    const int r32e = lane_e & 31, hie = lane_e >> 5;
    LAS unsigned char* ost = lds + wid * OST_WAVE;
#pragma unroll
    for (int g = 0; g < 4; ++g) {
        v2u w0, w1;
        w0.x = cvtpk(o0[4 * g] * inv, o0[4 * g + 1] * inv); w0.y = cvtpk(o0[4 * g + 2] * inv, o0[4 * g + 3] * inv);
        w1.x = cvtpk(o1[4 * g] * inv, o1[4 * g + 1] * inv); w1.y = cvtpk(o1[4 * g + 2] * inv, o1[4 * g + 3] * inv);
        *(LAS v2u*)(ost + r32e * OST_PITCH + (8 * g + 4 * hie) * 2) = w0;
        *(LAS v2u*)(ost + r32e * OST_PITCH + (32 + 8 * g + 4 * hie) * 2) = w1;
    }
    asm volatile("s_waitcnt lgkmcnt(0)" ::: "memory");
    bf16* Ob = (bf16*)(p.ws + (ABL ? WS_OX : WS_O)) + ((size_t)b * T + q0w) * D + GRP * 512 + h * 64;
    float* ssq = (float*)(p.ws + (ABL ? 256 * MiB : WS_SSQ)) + ((size_t)b * T + q0w) * 16 + GRP * 8 + h;
#pragma unroll
    for (int i = 0; i < 4; ++i) {
        const int row = i * 8 + (lane_e >> 3), ch = lane_e & 7;
        const v4u v = *(const LAS v4u*)(ost + row * OST_PITCH + ch * 16);
        st16(Ob + (size_t)row * D + ch * 8, v);
        float ss = 0.f;
#pragma unroll
        for (int q = 0; q < 4; ++q) { const float a = __uint_as_float(v[q] << 16), c = __uint_as_float(v[q] & 0xffff0000u); ss += a * a + c * c; }
        ss += __shfl_xor(ss, 1); ss += __shfl_xor(ss, 2); ss += __shfl_xor(ss, 4);
        if (ch == 0) ssq[(size_t)row * 16] = ss;
    }
    asm volatile("s_waitcnt vmcnt(0) lgkmcnt(0)" ::: "memory");
    ATT_BAR();
#undef ATT_BAR
}
template <int ABL = 0>
__device__ __forceinline__ void attn_phase(const P& p, LAS unsigned char* lds, int vcu, int G) {
    if (ABL & 64) return;
    const int wid = __builtin_amdgcn_readfirstlane(threadIdx.x >> 6), lane = threadIdx.x & 63, gw = vcu * 8 + wid;
    WConv wc; wc.next = (WCONV_IN_ATTN && G * 8 == 2048 && ABL == 0) ? 0 : WC_PER_WAVE; wc.j0 = -1; wc.j1 = -1; wc.gstep = 0; wc.cm1 = 0; wc.cm2 = 0;
    for (int u = vcu; u < 512; u += G) attn_unit<1, ABL>(p, lds, (u >> 5) >> 1, (u >> 5) & 1, u & 31, wc, gw);
    for (int u = vcu; u < 512; u += G) attn_unit<0, ABL>(p, lds, (u >> 5) >> 1, (u >> 5) & 1, u & 31, wc, gw);
    if (WCONV_IN_ATTN && ABL == 0) {
        if (G * 8 == 2048) {
            if (wc.j0 >= 0) wc_consume(p, gw, wc.j0, lds + WC_LDS + wid * 8192, lane);
            if (wc.j1 >= 0) wc_consume(p, gw, wc.j1, lds + WC_LDS + wid * 8192 + 4096, lane);
            for (; wc.next < WC_PER_WAVE; ++wc.next) { asm volatile("s_waitcnt lgkmcnt(0)" ::: "memory"); wc_issue(p, gw, wc.next, (unsigned)(uintptr_t)lds + WC_LDS + wid * 8192, lane);
                asm volatile("s_waitcnt vmcnt(0)" ::: "memory"); wc_consume(p, gw, wc.next, lds + WC_LDS + wid * 8192, lane); }
        } else {
            for (int hx = gw; hx < 49152; hx += G * 8) { asm volatile("s_waitcnt lgkmcnt(0)" ::: "memory"); wc_issue(p, hx & 2047, hx >> 11, (unsigned)(uintptr_t)lds + WC_LDS + wid * 8192, lane);
                asm volatile("s_waitcnt vmcnt(0)" ::: "memory"); wc_consume(p, hx & 2047, hx >> 11, lds + WC_LDS + wid * 8192, lane); }
        }
    }
}
}

struct Frame {
    LAS unsigned char* lds;
    volatile LAS unsigned* MISC;
    int tid, lane, wave, vcu, G;
};

__device__ __forceinline__ void p0_transpose_item(const float* W, int N, bf16* WT, int dpitch, int drow0, int k0, int n0, LAS float* scr, int lane, const float* gain) {
#pragma unroll
    for (int i = 0; i < 32; ++i) { const int kk = 2 * i + (lane >> 5); float v = W[(size_t)(k0 + kk) * N + n0 + (lane & 31)]; if (gain) v *= gain[kk]; scr[kk * 33 + (lane & 31)] = v; }
    LDS_WAIT(); asm volatile("" ::: "memory");
    const int c = lane & 7;
#pragma unroll
    for (int j = 0; j < 4; ++j) { const int n = (lane >> 3) + 8 * j; const LAS float* s = scr + (8 * c) * 33 + n;
        v4u o; o.x = pk2(s[0 * 33], s[1 * 33]); o.y = pk2(s[2 * 33], s[3 * 33]); o.z = pk2(s[4 * 33], s[5 * 33]); o.w = pk2(s[6 * 33], s[7 * 33]);
        *(GAS v4u*)(WT + (size_t)(drow0 + n) * dpitch + k0 + 8 * c) = o; }
    LDS_WAIT(); asm volatile("" ::: "memory");
}
__device__ __forceinline__ void p0_prologue(const P& p, Frame& F) {
    float* modx = (float*)(p.ws + WS_MODX);
    if (F.vcu < 96) {
        LAS float* s = (LAS float*)F.lds;
        LAS float* part = (LAS float*)(F.lds + 40960);
        for (int i = F.tid; i < 9 * D; i += NTHR) { const int r = i >> 10, k = i & 1023; const float v = r < 8 ? p.c[r * D + k] : p.c_ctx[k]; s[i] = silu_f(v); }
        __syncthreads();
        const int n = F.vcu * 64 + F.lane; float acc[9];
#pragma unroll
        for (int r = 0; r < 9; ++r) acc[r] = 0.f;
        const float* wp = p.w_mod + (size_t)(F.wave * 128) * 6144 + n;
#pragma unroll 4
        for (int k4 = 0; k4 < 128; k4 += 4) {
            float wv[4];
#pragma unroll
            for (int j = 0; j < 4; ++j) wv[j] = wp[(size_t)(k4 + j) * 6144];
#pragma unroll
            for (int r = 0; r < 9; ++r) { const f32x4 sv = *(const LAS f32x4*)(s + r * D + F.wave * 128 + k4); acc[r] += sv.x * wv[0]; acc[r] += sv.y * wv[1]; acc[r] += sv.z * wv[2]; acc[r] += sv.w * wv[3]; }
        }
#pragma unroll
        for (int r = 0; r < 9; ++r) part[(F.wave * 9 + r) * 64 + F.lane] = acc[r];
        __syncthreads();
        for (int i = F.tid; i < 9 * 64; i += NTHR) { const int r = i >> 6, l = i & 63; float sum = 0.f;
#pragma unroll
            for (int w = 0; w < 8; ++w) sum += part[(w * 9 + r) * 64 + l];
            modx[r * 6144 + F.vcu * 64 + l] = sum + p.b_mod[F.vcu * 64 + l]; }
        __syncthreads();
    }
    if (F.vcu == 96) {
        float2* tab = (float2*)(p.ws + WS_ROPE);
        for (int idx = F.tid; idx < 96 * 16; idx += NTHR) {
            const int pos = idx >> 4, i = idx & 15;
            const float invf = exp2f(-(float)i * (13.287712379549449f / 16.f));
            const float pv = (float)(pos < 32 ? pos : pos - 32);
            float rev = pv * invf * 0.15915494309189535f; rev -= rintf(rev);
            tab[idx] = make_float2(__builtin_amdgcn_cosf(rev), __builtin_amdgcn_sinf(rev));
        }
    }
    for (int nb = F.vcu - 97; nb >= 0 && nb < 48; nb += F.G) {
        bf16* wr = (bf16*)(p.ws + WS_WR);
        for (int i = nb * 1024 + F.tid; i < (nb + 1) * 1024; i += NTHR) {
            const int j = i & 7, ln = (i >> 3) & 63, q = i >> 9, nt = q % 3, ks = q / 3;
            const int k = 32 * ks + 8 * (ln >> 4) + j, n = 16 * nt + (ln & 15);
            const float w = n < 4 ? p.w_group[k * 4 + n] : n < 36 ? p.w_router[k * 32 + (n - 4)] : 0.f;
            const unsigned hi = f2bf(w); const unsigned lo = f2bf(w - bf2f((bf16)hi));
            wr[i] = (bf16)hi; wr[48 * D + i] = (bf16)lo; }
    }
    LAS float* scr = (LAS float*)(F.lds + F.wave * 16384);
    const int gw = F.vcu * NWAVES + F.wave, NGW = F.G * NWAVES;
    constexpr int I_IN = 16 * 48, I_OUT = 16 * 32, I_G = 32 * 256, I_D = 32 * 256, NITEMS = WCONV_IN_ATTN ? I_IN + I_OUT : I_IN + I_OUT + 2 * I_G + I_D;
    for (int it = gw; it < NITEMS; it += NGW) {
        int r = it;
        if (r < I_IN) { const int kb = r / 48, nb = r % 48; p0_transpose_item(p.w_in, NQKV, (bf16*)(p.ws + WS_WQKV), D, qkv_row(nb * 32), kb * 64, nb * 32, scr, F.lane, nullptr); continue; } r -= I_IN;
        if (r < I_OUT) { const int kb = r / 32, nb = r % 32; const float* g = kb < 8 ? p.aon + kb * 64 : p.bon + (kb - 8) * 64;
            p0_transpose_item(p.w_out, D, (bf16*)(p.ws + WS_WO), D, nb * 32, kb * 64, nb * 32, scr, F.lane, g); continue; } r -= I_OUT;
        if (r < 2 * I_G) { const int up = r >= I_G; if (up) r -= I_G; const int e = r >> 8, q = r & 255, kb = q >> 4, nb = q & 15; const int j0 = nb * 32;
            p0_transpose_item((up ? p.w_up : p.w_gate) + (size_t)e * 1024 * 512, 512, (bf16*)(p.ws + WS_WGU) + (size_t)e * 1024 * 1024, D, (j0 >> 7) * 256 + up * 128 + (j0 & 127), kb * 64, j0, scr, F.lane, nullptr); continue; } r -= 2 * I_G;
        { const int e = r >> 8, q = r & 255, kb = q >> 5, nb = q & 31;
            p0_transpose_item(p.w_down + (size_t)e * 512 * 1024, D, (bf16*)(p.ws + WS_WD) + (size_t)e * 1024 * 512, EFF, nb * 32, kb * 64, nb * 32, scr, F.lane, nullptr); }
    }
}
__device__ __forceinline__ void p1_norm(const P& p, Frame& F) {
    const int gw = F.vcu * NWAVES + F.wave, NGW = F.G * NWAVES;
    const float* modall = (const float*)(p.ws + WS_MODX);
    for (int r = gw; r < MT; r += NGW) {
        const float* src = r < ML ? p.x + (size_t)r * D : p.ctx + (size_t)(r - ML) * D;
        const float* modx = modall + (r < ML ? (r / T) : 8) * 6144;
        const GAS f32x4* xr = (const GAS f32x4*)src + F.lane;
        f32x4 v[4]; float s = 0.f;
#pragma unroll
        for (int j = 0; j < 4; ++j) { v[j] = xr[64 * j]; s += (v[j].x * v[j].x + v[j].y * v[j].y) + (v[j].z * v[j].z + v[j].w * v[j].w); }
        const float rn = rsqrtf(wave_sum(s) * (1.f / D) + EPS);
        GAS v2u* o8 = (GAS v2u*)((bf16*)(p.ws + WS_XN) + (size_t)r * D) + F.lane;
#pragma unroll
        for (int j = 0; j < 4; ++j) { const int k = 4 * (F.lane + 64 * j);
            const f32x4 g = *(const f32x4*)(p.pre1 + k), sc = *(const f32x4*)(modx + 1024 + k), sh = *(const f32x4*)(modx + k);
            const f32x4 h = v[j] * rn * g * (sc + 1.f) + sh;
            v2u w; w.x = pk2(h.x, h.y); w.y = pk2(h.z, h.w); st8((void*)(o8 + 64 * j), w); }
    }
}


constexpr int LDS_X = 147456;
__device__ __forceinline__ void p4_outproj(const P& p, Frame& F) {
    LAS float* tab = (LAS float*)(F.lds + LDS_X);
    for (int i = 0;; ++i) {
        const int L = i * F.G + (int)blockIdx.x; if (L >= 256) break;
        const int xcd = L & 7, off = L >> 3, w = xcd * 32 + off;
        pg8::Unit u; u.pm = (w >> 5) * 8 + (w & 7); u.pn = (w & 31) >> 3;
        if (F.tid < 256) {
            const f32x4* s4 = (const f32x4*)((const float*)(p.ws + WS_SSQ) + (size_t)(u.pm * 256 + F.tid) * 16);
            const f32x4 a0 = s4[0], a1 = s4[1], b0 = s4[2], b1 = s4[3];
            const float sa = ((a0.x + a0.y) + (a0.z + a0.w)) + ((a1.x + a1.y) + (a1.z + a1.w)), sb = ((b0.x + b0.y) + (b0.z + b0.w)) + ((b1.x + b1.y) + (b1.z + b1.w));
            const float ra = rsqrtf(sa * (1.f / 512.f) + EPS), rb = rsqrtf(sb * (1.f / 512.f) + EPS);
            tab[2 * F.tid] = ra / rb; tab[2 * F.tid + 1] = rb;
        }
        __syncthreads();
        pg8::Gemm g{(const pg8::bf16_t*)(p.ws + WS_O), (const pg8::bf16_t*)(p.ws + WS_WO), ML, D, D};
        pg8::SchedOne S{u};
        pg8::EpiOut E{(bf16*)(p.ws + WS_OX), tab};
        pg8::gemm_phase<pg8::EpiOut, pg8::SchedOne, false, true, false>((PG8_LAS unsigned char*)F.lds, g, S, E);
    }
}
constexpr int P5_PITCH = 2064;
constexpr int P5_PART = 64 * P5_PITCH, P5_LG = 0;
static_assert(P5_PART + 8 * 16 * 48 * 4 <= MISC_OFF && 64 * 48 * 4 <= P5_PART, "P5 LDS map");
__device__ __forceinline__ void p5_rowpass(const P& p, Frame& F, int abl = 0) {
    LAS unsigned char* LO = F.lds;
    LAS float* PART = (LAS float*)(F.lds + P5_PART); LAS float* LG = (LAS float*)(F.lds + P5_LG);
    LAS int* hist = (LAS int*)(F.lds + MISC_OFF) + 64;
    const bf16* WRh = (const bf16*)(p.ws + WS_WR); const bf16* WRl = WRh + 48 * D;
    for (int rb = F.vcu; rb < ML / 64; rb += F.G) {
        if (F.tid < 32) hist[F.tid] = 0;
        const int b = (rb * 64) / T;
        const float* modx = (const float*)(p.ws + WS_MODX) + b * 6144;
        if (!(abl & 2)) {
            f32x4 gp[4], mp[4], ap[4];
#pragma unroll
            for (int j = 0; j < 4; ++j) { const int k = 256 * j + 4 * F.lane;
                gp[j] = *(const f32x4*)(modx + 2048 + k) * *(const f32x4*)(p.post1 + k);
                mp[j] = *(const f32x4*)(p.pre2 + k) * (*(const f32x4*)(modx + 4096 + k) + 1.f);
                ap[j] = *(const f32x4*)(modx + 3072 + k); }
            f32x4 xn[4]; v2u on[4];
#define P5_LOAD(rw) do { _Pragma("unroll") for (int j = 0; j < 4; ++j) { xn[j] = *(const f32x4*)(p.x + (size_t)(rw) * D + 256 * j + 4 * F.lane); \
                on[j] = *(const v2u*)((const bf16*)(p.ws + WS_OX) + (size_t)(rw) * D + 256 * j + 4 * F.lane); } } while (0)
            P5_LOAD(rb * 64 + F.wave * 8);
            for (int rr = 0; rr < 8; ++rr) {
                const int rl = F.wave * 8 + rr, row = rb * 64 + rl;
                f32x4 xv[4], ox[4]; v2u oc[4]; float ss = 0.f;
#pragma unroll
                for (int j = 0; j < 4; ++j) { xv[j] = xn[j]; oc[j] = on[j]; }
                if (rr + 1 < 8) P5_LOAD(row + 1);
#pragma unroll
                for (int j = 0; j < 4; ++j) { const v2u o2 = oc[j];
                    ox[j] = (f32x4){__uint_as_float(o2.x << 16), __uint_as_float(o2.x & 0xffff0000u), __uint_as_float(o2.y << 16), __uint_as_float(o2.y & 0xffff0000u)};
                    ss += (ox[j].x * ox[j].x + ox[j].y * ox[j].y) + (ox[j].z * ox[j].z + ox[j].w * ox[j].w); }
                const float r1 = rsqrtf(wave_sum(ss) * (1.f / D) + EPS);
                float ss2 = 0.f;
#pragma unroll
                for (int j = 0; j < 4; ++j) { xv[j] = xv[j] + gp[j] * (ox[j] * r1);
                    ss2 += (xv[j].x * xv[j].x + xv[j].y * xv[j].y) + (xv[j].z * xv[j].z + xv[j].w * xv[j].w); }
                const float r2 = rsqrtf(wave_sum(ss2) * (1.f / D) + EPS);
                if (F.lane == 0) ((float*)(p.ws + WS_R1))[row] = r1;
#pragma unroll
                for (int j = 0; j < 4; ++j) {
                    const f32x4 h = xv[j] * r2 * mp[j] + ap[j];
                    v2u wh; wh.x = att::cvtpk(h.x, h.y); wh.y = att::cvtpk(h.z, h.w);
                    const f32x4 hb = (f32x4){__uint_as_float(wh.x << 16), __uint_as_float(wh.x & 0xffff0000u), __uint_as_float(wh.y << 16), __uint_as_float(wh.y & 0xffff0000u)};
                    const f32x4 dl = h - hb;
                    v2u wl; wl.x = att::cvtpk(dl.x, dl.y); wl.y = att::cvtpk(dl.z, dl.w);
                    st8((bf16*)(p.ws + WS_XN) + (size_t)row * D + 256 * j + 4 * F.lane, wh);
                    *(LAS v2u*)(LO + rl * P5_PITCH + (256 * j + 4 * F.lane) * 2) = wl;
                }
            }
#undef P5_LOAD
        }
        asm volatile("s_waitcnt vmcnt(0)" ::: "memory");
        __syncthreads();
        if (F.tid == 0) { __builtin_amdgcn_fence(__ATOMIC_ACQUIRE, "agent"); asm volatile("s_waitcnt vmcnt(0)" ::: "memory"); }
        __syncthreads();
        if (abl & 1) continue;
        {
            const int gI = F.wave >> 1, kq = F.wave & 1, r16 = F.lane & 15, g4 = F.lane >> 4;
            f32x4 acc[3];
#pragma unroll
            for (int nt = 0; nt < 3; ++nt) acc[nt] = (f32x4){0.f, 0.f, 0.f, 0.f};
            const bf16* ah = (const bf16*)(p.ws + WS_XN) + (size_t)(rb * 64 + 16 * gI + r16) * D + 512 * kq + 8 * g4;
            const LAS unsigned char* al = LO + (16 * gI + r16) * P5_PITCH + (512 * kq + 8 * g4) * 2;
            const bf16* bh = WRh + (size_t)(16 * kq) * 3 * 512 + F.lane * 8; const bf16* bl = WRl + (size_t)(16 * kq) * 3 * 512 + F.lane * 8;
#pragma unroll 8
            for (int ks = 0; ks < 16; ++ks) {
                const bf16x8 a_hi = *(const bf16x8*)(ah + ks * 32), a_lo = *(const LAS bf16x8*)(al + ks * 64);
#pragma unroll
                for (int nt = 0; nt < 3; ++nt) {
                    const bf16x8 b_hi = *(const bf16x8*)(bh + (ks * 3 + nt) * 512), b_lo = *(const bf16x8*)(bl + (ks * 3 + nt) * 512);
                    acc[nt] = __builtin_amdgcn_mfma_f32_16x16x32_bf16(a_hi, b_hi, acc[nt], 0, 0, 0);
                    acc[nt] = __builtin_amdgcn_mfma_f32_16x16x32_bf16(a_hi, b_lo, acc[nt], 0, 0, 0);
                    acc[nt] = __builtin_amdgcn_mfma_f32_16x16x32_bf16(a_lo, b_hi, acc[nt], 0, 0, 0);
                }
            }
#pragma unroll
            for (int nt = 0; nt < 3; ++nt)
#pragma unroll
                for (int q = 0; q < 4; ++q) PART[(F.wave * 16 + 4 * g4 + q) * 48 + 16 * nt + r16] = acc[nt][q];
        }
        __syncthreads();
        for (int i = F.tid; i < 64 * 48; i += NTHR) { const int row = i / 48, n = i - row * 48, gI = row >> 4, r16 = row & 15;
            LG[i] = (PART[((gI * 2 + 0) * 16 + r16) * 48 + n] + PART[((gI * 2 + 1) * 16 + r16) * 48 + n]) + (n < 4 ? p.b_group[n] : n < 36 ? p.b_router[n - 4] : 0.f); }
        __syncthreads();
        if (F.tid < 64) {
            float lg[36];
#pragma unroll
            for (int c = 0; c < 36; ++c) lg[c] = LG[F.tid * 48 + c];
            int e1, e2; float w1, w2;
            {
                int g = 0; float gm = lg[0];
#pragma unroll
                for (int q = 1; q < 4; ++q) if (lg[q] > gm) { gm = lg[q]; g = q; }
                float gs = 0.f;
#pragma unroll
                for (int q = 0; q < 4; ++q) gs += __expf(lg[q] - gm);
                const float gw = 1.f / gs;
                float el[8];
#pragma unroll
                for (int q = 0; q < 8; ++q) el[q] = g == 0 ? lg[4 + q] : g == 1 ? lg[12 + q] : g == 2 ? lg[20 + q] : lg[28 + q];
                int i1 = 0; float m1 = el[0];
#pragma unroll
                for (int q = 1; q < 8; ++q) if (el[q] > m1) { m1 = el[q]; i1 = q; }
                int i2 = -1; float m2 = -3.0e38f;
#pragma unroll
                for (int q = 0; q < 8; ++q) if (q != i1 && el[q] > m2) { m2 = el[q]; i2 = q; }
                const float ex = __expf(m2 - m1);
                w1 = gw / (1.f + ex); w2 = gw * ex / (1.f + ex); e1 = g * 8 + i1; e2 = g * 8 + i2;
            }
            const int row = rb * 64 + F.tid;
            if (!(abl & 2)) { int* te = (int*)(p.ws + WS_TOKE) + row * 2; float* tw = (float*)(p.ws + WS_TOKW) + row * 2; te[0] = e1; te[1] = e2; tw[0] = w1; tw[1] = w2; }
            atomicAdd((int*)&hist[e1 & 31], 1); atomicAdd((int*)&hist[e2 & 31], 1);
        }
        __syncthreads();
        if (F.tid < 32 && !(abl & 2)) ((int*)(p.ws + WS_BLKCNT))[rb * 32 + F.tid] = hist[F.tid];
        __syncthreads();
    }
}
__device__ __forceinline__ void p6_lists(const P& p, Frame& F) {
    LAS int* ps = (LAS int*)F.lds;
    LAS int* pp = ps + 512;
    LAS int* tot = pp + 512; LAS int* pre = tot + 32; LAS int* ebase = pre + 32;
    LAS int* es = ebase + 40;
    const int* blk = (const int*)(p.ws + WS_BLKCNT);
    int* meta = (int*)(p.ws + WS_META);
    for (int rb = F.vcu; rb < ML / 64; rb += F.G) {
        { const int e = F.tid & 31, part = F.tid >> 5; int s = 0, q = 0;
#pragma unroll 4
          for (int j = 0; j < 16; ++j) { const int bb = part * 16 + j; const int v = blk[bb * 32 + e]; s += v; q += bb < rb ? v : 0; }
          ps[part * 32 + e] = s; pp[part * 32 + e] = q; }
        __syncthreads();
        if (F.tid < 32) { int s = 0, q = 0;
#pragma unroll
            for (int part = 0; part < 16; ++part) { s += ps[part * 32 + F.tid]; q += pp[part * 32 + F.tid]; }
            tot[F.tid] = s; pre[F.tid] = q; }
        __syncthreads();
        if (F.tid == 0) { int tb = 0; for (int e = 0; e < 32; ++e) { ebase[e] = tb; tb += (tot[e] + 255) >> 8; } ebase[32] = tb; }
        if (F.tid < 128) es[F.tid] = ((const int*)(p.ws + WS_TOKE))[rb * 128 + F.tid];
        __syncthreads();
        if (F.tid < 128) {
            const int e = es[F.tid]; int rank = 0;
            for (int a = 0; a < F.tid; ++a) rank += es[a] == e ? 1 : 0;
            const int pos = ebase[e] * 256 + pre[e] + rank;
            ((int*)(p.ws + WS_ROWIDX))[pos] = rb * 64 + (F.tid >> 1);
            ((float*)(p.ws + WS_ROWW))[pos] = ((const float*)(p.ws + WS_TOKW))[rb * 128 + F.tid];
            ((int*)(p.ws + WS_TOKPOS))[rb * 128 + F.tid] = pos;
        }
        if (rb < 32) {
            const int e = rb, lo = ebase[e] * 256 + tot[e], hi = ebase[e + 1] * 256;
            for (int pos = lo + F.tid; pos < hi; pos += NTHR) { ((int*)(p.ws + WS_ROWIDX))[pos] = 0; ((float*)(p.ws + WS_ROWW))[pos] = 0.f; }
            for (int t = ebase[e] + F.tid; t < ebase[e + 1]; t += NTHR) meta[128 + t] = e;
            if (F.tid == 0) { meta[e] = tot[e]; meta[64 + e] = ebase[e]; if (e == 31) { meta[64 + 32] = ebase[32]; meta[320] = ebase[32]; } }
        }
        __syncthreads();
    }
}
__device__ __forceinline__ void p78_moe(const P& p, Frame& F, bool down) {
    LAS int* tile_e = (LAS int*)(F.lds + LDS_X);
    const int* meta = (const int*)(p.ws + WS_META);
    for (int t = F.tid; t < MAXTILES; t += NTHR) tile_e[t] = meta[128 + t] & 31;
    __syncthreads();
    const int ntiles = meta[320];
    pg8::SchedMoE S{F.G, (int)blockIdx.x, ntiles * 4, tile_e, (const int*)(p.ws + WS_ROWIDX)};
    if (!down) {
        pg8::Gemm g{(const pg8::bf16_t*)(p.ws + WS_XN), (const pg8::bf16_t*)(p.ws + WS_WGU), MAXPOS, NE * 1024, D};
        pg8::EpiGU E{(bf16*)(p.ws + WS_ACT), (const float*)(p.ws + WS_ROWW)};
        pg8::gemm_phase<pg8::EpiGU, pg8::SchedMoE, true, true, true>((PG8_LAS unsigned char*)F.lds, g, S, E);
    } else {
        pg8::Gemm g{(const pg8::bf16_t*)(p.ws + WS_ACT), (const pg8::bf16_t*)(p.ws + WS_WD), MAXPOS, NE * 1024, EFF};
        pg8::EpiY E{(bf16*)(p.ws + WS_Y)};
        pg8::gemm_phase<pg8::EpiY, pg8::SchedMoE, true, true, false>((PG8_LAS unsigned char*)F.lds, g, S, E);
    }
}
__device__ __forceinline__ void p9_final(const P& p, Frame& F, float* dst) {
    const bf16* Y = (const bf16*)(p.ws + WS_Y); const bf16* OX = (const bf16*)(p.ws + WS_OX); const float* R1 = (const float*)(p.ws + WS_R1);
    for (int rb = F.vcu; rb < ML / 64; rb += F.G) {
        const int b = (rb * 64) / T;
        const float* modx = (const float*)(p.ws + WS_MODX) + b * 6144;
        const int row0 = rb * 64 + F.wave * 8;
        f32x4 gp[4], g1p[4];
#pragma unroll
        for (int j = 0; j < 4; ++j) { const int k = 256 * j + 4 * F.lane; gp[j] = *(const f32x4*)(modx + 5120 + k) * *(const f32x4*)(p.post2 + k); g1p[j] = *(const f32x4*)(modx + 2048 + k) * *(const f32x4*)(p.post1 + k); }
        v2u ya[2][4], yc[2][4], oo[2][4]; f32x4 xo[2][4]; float r1v[2];
        const int* tpp = (const int*)(p.ws + WS_TOKPOS) + row0 * 2;
#define P9_LOAD(buf, rw, t2) do { r1v[buf] = R1[rw]; _Pragma("unroll") for (int j = 0; j < 4; ++j) { \
            ya[buf][j] = *(const v2u*)(Y + (size_t)(t2).x * D + 256 * j + 4 * F.lane); yc[buf][j] = *(const v2u*)(Y + (size_t)(t2).y * D + 256 * j + 4 * F.lane); \
            oo[buf][j] = *(const v2u*)(OX + (size_t)(rw) * D + 256 * j + 4 * F.lane); xo[buf][j] = *(const f32x4*)(p.x + (size_t)(rw) * D + 256 * j + 4 * F.lane); } } while (0)
#define P9_COMP(buf, rw) do { f32x4 y[4]; float ss = 0.f; \
            _Pragma("unroll") for (int j = 0; j < 4; ++j) { const v2u a = ya[buf][j], c = yc[buf][j]; \
                y[j] = (f32x4){__uint_as_float(a.x << 16) + __uint_as_float(c.x << 16), __uint_as_float(a.x & 0xffff0000u) + __uint_as_float(c.x & 0xffff0000u), \
                               __uint_as_float(a.y << 16) + __uint_as_float(c.y << 16), __uint_as_float(a.y & 0xffff0000u) + __uint_as_float(c.y & 0xffff0000u)}; \
                ss += (y[j].x * y[j].x + y[j].y * y[j].y) + (y[j].z * y[j].z + y[j].w * y[j].w); } \
            const float rn = rsqrtf(wave_sum(ss) * (1.f / D) + EPS); \
            _Pragma("unroll") for (int j = 0; j < 4; ++j) { const v2u o2 = oo[buf][j]; \
                const f32x4 oxv = (f32x4){__uint_as_float(o2.x << 16), __uint_as_float(o2.x & 0xffff0000u), __uint_as_float(o2.y << 16), __uint_as_float(o2.y & 0xffff0000u)}; \
                const f32x4 x1 = xo[buf][j] + g1p[j] * (oxv * r1v[buf]);                   \
                *(f32x4*)(dst + (size_t)(rw) * D + 256 * j + 4 * F.lane) = x1 + gp[j] * (y[j] * rn); } } while (0)
        int2 tpA = *(const int2*)(tpp), tpB = *(const int2*)(tpp + 2);
        P9_LOAD(0, row0, tpA);
#pragma unroll 1
        for (int rp = 0; rp < 4; ++rp) {
            const int ra = row0 + 2 * rp;
            P9_LOAD(1, ra + 1, tpB);
            int2 tpA2 = tpA, tpB2 = tpB;
            if (rp < 3) { tpA2 = *(const int2*)(tpp + 4 * rp + 4); tpB2 = *(const int2*)(tpp + 4 * rp + 6); }
            P9_COMP(0, ra);
            if (rp < 3) P9_LOAD(0, ra + 2, tpA2);
            P9_COMP(1, ra + 1);
            tpA = tpA2; tpB = tpB2;
        }
#undef P9_COMP
#undef P9_LOAD
    }
}

struct Args { P p; int ph_lo, ph_hi, li, pad; };
__global__ void __launch_bounds__(NTHR, 2) mega(Args args) {
    extern __shared__ __attribute__((aligned(16))) unsigned char lds_raw[];
    Frame F;
    F.lds = (LAS unsigned char*)lds_raw;
    F.MISC = (volatile LAS unsigned*)(F.lds + MISC_OFF);
    F.tid = threadIdx.x; F.lane = F.tid & 63; F.wave = __builtin_amdgcn_readfirstlane(F.tid >> 6);
    F.G = gridDim.x; { const int bx = blockIdx.x; F.vcu = (F.G % 8 == 0) ? (bx % 8) * (F.G / 8) + bx / 8 : bx; }
    const P& p = args.p;
    unsigned* ctl = (unsigned*)(p.ws + WS_CTL);
    for (int u = F.tid; u < (LDS_BYTES - MISC_OFF) / 4; u += NTHR) ((LAS unsigned*)(F.lds + MISC_OFF))[u] = 0u;
    __syncthreads();
    const int lo = args.ph_lo, hi = args.ph_hi;
    XcdBarrier bar; bar.bar = ctl + CW_BAR + args.li * XCD_BAR_WORDS; bar.x = 0; bar.st = nullptr;
    if (hi - lo > 1) bar = xcd_barrier_post(ctl + CW_BAR + args.li * XCD_BAR_WORDS, F.MISC + 8);
#define IN(k) (lo <= (k) && (k) < hi)
#define SEAM(k) do { if (IN(k) && IN((k) + 1)) xcd_barrier(bar); } while (0)
    if (IN(0)) { p0_prologue(p, F); SEAM(0); }
    if (IN(1)) { p1_norm(p, F); SEAM(1); }
    if (IN(2)) {
        pg8::Gemm g{(const pg8::bf16_t*)(p.ws + WS_XN), (const pg8::bf16_t*)(p.ws + WS_WQKV), MT, NQKV, D};
        pg8::SchedQKV S{F.G, (int)blockIdx.x};
        pg8::EpiQKV E{p.ws, p.bqn, p.bkn};
        pg8::gemm_phase<pg8::EpiQKV, pg8::SchedQKV, true, true, false>((PG8_LAS unsigned char*)F.lds, g, S, E);
        SEAM(2);
    }
#ifdef PROBE_ABL
    if (IN(3) && args.pad) { att::attn_phase<PROBE_ABL>(p, F.lds, F.vcu, F.G); } else
#endif
    if (IN(3)) { att::attn_phase<0>(p, F.lds, F.vcu, F.G); SEAM(3); }
    if (IN(4)) { p4_outproj(p, F); SEAM(4); }
#ifdef PROBE_ABL5
    if (IN(5) && args.pad) { p5_rowpass(p, F, PROBE_ABL5); } else
#endif
    if (IN(5)) { p5_rowpass(p, F); SEAM(5); }
    if (IN(6)) { p6_lists(p, F); SEAM(6); }
    if (IN(7)) { p78_moe(p, F, false); SEAM(7); }
    if (IN(8)) { p78_moe(p, F, true); SEAM(8); }
    if (IN(9)) { p9_final(p, F, args.pad ? (float*)(p.ws + WS_WGU) : p.out); }
#undef IN
#undef SEAM
}

#ifndef ONE_LAUNCH
#define ONE_LAUNCH 1
#endif
#ifndef FAST_MASK
#define FAST_MASK 0x3ff
#endif
static void launch_mega(const P& p, int lo, int hi, int li, int grid, hipStream_t stream) {
    Args a{}; a.p = p; a.ph_lo = lo; a.ph_hi = hi; a.li = li; a.pad = 0;
    hipLaunchKernelGGL(mega, dim3(grid), dim3(NTHR), LDS_BYTES, stream, a);
}
extern "C" void kernel_launch(void* const* d_in, const int* in_sizes, int n_in, void* d_out, int out_size, void* d_ws, size_t ws_size, hipStream_t stream) {
    static int grid = 0;
    if (grid == 0) {
        if (n_in != 24 || out_size != ML * D || ws_size < WS_END) { fprintf(stderr, "kernel_launch: unexpected shapes (n_in %d out %d ws %zu)\n", n_in, out_size, ws_size); grid = -1; return; }
        int dev = 0, cus = 0, per_cu = 0;
        if (hipGetDevice(&dev) != hipSuccess || hipDeviceGetAttribute(&cus, hipDeviceAttributeMultiprocessorCount, dev) != hipSuccess) { grid = -1; return; }
        if (hipFuncSetAttribute((const void*)mega, hipFuncAttributeMaxDynamicSharedMemorySize, LDS_BYTES) != hipSuccess) { fprintf(stderr, "kernel_launch: hipFuncSetAttribute failed\n"); grid = -1; return; }
        if (hipOccupancyMaxActiveBlocksPerMultiprocessor(&per_cu, (const void*)mega, NTHR, LDS_BYTES) != hipSuccess || per_cu < 1) { fprintf(stderr, "kernel_launch: occupancy query says %d blocks/CU\n", per_cu); (void)hipGetLastError(); grid = -1; return; }
        grid = cus;
    }
    if (grid < 0) return;
    P p{};
    const float** f = (const float**)&p;
    for (int i = 0; i < 24; ++i) f[i] = (const float*)d_in[i];
    p.out = (float*)d_out; p.ws = (unsigned char*)d_ws;
    (void)hipMemsetAsync((char*)d_ws + WS_CTL, 0, 64 * 1024, stream);
#if ONE_LAUNCH
    launch_mega(p, 0, 10, 0, grid, stream);
#else
    for (int k = 0; k < 10; ++k) {
        launch_mega(p, k, k + 1, 0, grid, stream);
#ifdef PROBE_DUP
        if (k == PROBE_DUP) for (int r_ = 0; r_ < 3; ++r_) { Args a{}; a.p = p; a.ph_lo = k; a.ph_hi = k + 1; a.li = 0; a.pad = 1; hipLaunchKernelGGL(mega, dim3(grid), dim3(NTHR), LDS_BYTES, stream, a); }
#endif
    }
#endif
}
```

```cpp
#include <hip/hip_runtime.h>
#include <cstdio>
#include <cstdint>
#ifndef WCONV_IN_ATTN
#define WCONV_IN_ATTN 1
#endif

constexpr int NB = 8, T = 2048, D = 1024, CL = 256;
constexpr int ML = NB * T;
constexpr int MC = NB * CL;
constexpr int MT = ML + MC;
constexpr int NKEY = T + CL;
constexpr int NTILE = NKEY / 64;
constexpr int NQKV = 1536;
constexpr int NE = 32, EFF = 512;
constexpr int MAXPOS = 40960;
constexpr int MAXTILES = MAXPOS / 256;
constexpr float EPS = 1e-6f;
constexpr float LOG2E = 1.4426950408889634f;
constexpr float C2 = 0.125f * LOG2E;

typedef unsigned short bf16;

constexpr size_t MiB = 1u << 20;
constexpr size_t WS_CTL = 0;
constexpr size_t WS_MODX = 1 * MiB;
constexpr size_t WS_ROPE = 1 * MiB + 512 * 1024;
constexpr size_t WS_WR = 1 * MiB + 768 * 1024;
constexpr size_t WS_TOKE = 2 * MiB;
constexpr size_t WS_TOKW = WS_TOKE + 128 * 1024;
constexpr size_t WS_TOKPOS = WS_TOKW + 128 * 1024;
constexpr size_t WS_ROWIDX = WS_TOKPOS + 128 * 1024;
constexpr size_t WS_ROWW = WS_ROWIDX + 160 * 1024;
constexpr size_t WS_BLKCNT = WS_ROWW + 160 * 1024;
constexpr size_t WS_META = WS_BLKCNT + 32 * 1024;
constexpr size_t WS_WQKV = 4 * MiB;
constexpr size_t WS_WO = 7 * MiB;
constexpr size_t WS_WGU = 9 * MiB;
constexpr size_t WS_WD = 73 * MiB;
constexpr size_t WS_XN = 105 * MiB;
constexpr size_t WS_QA = 141 * MiB;
constexpr size_t WS_QB = 157 * MiB;
constexpr size_t WS_KA = 173 * MiB;
constexpr size_t WS_VA = WS_KA + 4608 * 1024;
constexpr size_t WS_KB = WS_VA + 4608 * 1024;
constexpr size_t WS_VB = WS_KB + 4608 * 1024;
constexpr size_t WS_O = 191 * MiB;
constexpr size_t WS_SSQ = 223 * MiB;
constexpr size_t WS_OX = 261 * MiB;
constexpr size_t WS_R1 = 293 * MiB;
constexpr size_t WS_ACT = 141 * MiB;
constexpr size_t WS_Y = 181 * MiB;
constexpr size_t WS_END = 294 * MiB;

__device__ __forceinline__ unsigned f2bf(float f) { unsigned u = __builtin_bit_cast(unsigned, f); return (u + 0x7fffu + ((u >> 16) & 1u)) >> 16; }
__device__ __forceinline__ float bf2f(bf16 h) { return __builtin_bit_cast(float, (unsigned)h << 16); }
__device__ __forceinline__ float dpp_add(float v, const int ctrl_sel) {
    const int x = __builtin_bit_cast(int, v); int y;
    switch (ctrl_sel) { case 0: y = __builtin_amdgcn_update_dpp(x, x, 0xB1, 0xF, 0xF, false); break;
                        case 1: y = __builtin_amdgcn_update_dpp(x, x, 0x4E, 0xF, 0xF, false); break;
                        case 2: y = __builtin_amdgcn_update_dpp(x, x, 0x141, 0xF, 0xF, false); break;
                        default: y = __builtin_amdgcn_update_dpp(x, x, 0x140, 0xF, 0xF, false); break; }
    return v + __builtin_bit_cast(float, y);
}
__device__ __forceinline__ float wave_sum(float v) {
    v = dpp_add(v, 0); v = dpp_add(v, 1); v = dpp_add(v, 2); v = dpp_add(v, 3);
    const int x = __builtin_bit_cast(int, v);
    const float r0 = __builtin_bit_cast(float, __builtin_amdgcn_readlane(x, 0)), r1 = __builtin_bit_cast(float, __builtin_amdgcn_readlane(x, 16));
    const float r2 = __builtin_bit_cast(float, __builtin_amdgcn_readlane(x, 32)), r3 = __builtin_bit_cast(float, __builtin_amdgcn_readlane(x, 48));
    return (r0 + r1) + (r2 + r3);
}
__device__ __forceinline__ float wave_max(float v) {
#pragma unroll
    for (int o = 1; o < 64; o <<= 1) v = fmaxf(v, __shfl_xor(v, o));
    return v;
}
__device__ __forceinline__ float silu_f(float v) { return v / (1.f + __expf(-v)); }

__host__ __device__ __forceinline__ int qkv_row(int n) { const int pn = n >> 8, j = n & 255, hh = j >> 6, d = j & 63; return pn * 256 + (d >> 5) * 128 + hh * 32 + (d & 31); }
__host__ __device__ __forceinline__ size_t q_off(int b, int h, int t, int d) { return (((size_t)(b * 8 + h) * T + t) * 64 + d); }
__host__ __device__ __forceinline__ size_t k_off(int b, int kvh, int pos, int d) { return ((size_t)((b * 2 + kvh) * NTILE + (pos >> 6)) * 4096 + (d >> 3) * 512 + (pos & 63) * 8 + (d & 7)); }
__host__ __device__ __forceinline__ size_t v_off(int b, int kvh, int pos, int d) { return ((size_t)((b * 2 + kvh) * NTILE + (pos >> 6)) * 4096 + (d >> 5) * 2048 + (pos & 63) * 32 + (d & 31)); }

struct P {
    const float *x, *c, *ctx, *c_ctx, *w_mod, *b_mod, *pre1, *post1, *w_in, *a_sink, *bqn, *bkn, *aon, *bon, *w_out, *pre2, *post2, *w_group, *b_group, *w_router, *b_router, *w_gate, *w_up, *w_down;
    float* out; unsigned char* ws;
};

#define GAS __attribute__((address_space(1)))
#define LAS __attribute__((address_space(3)))
typedef unsigned v4u __attribute__((ext_vector_type(4)));
typedef unsigned v2u __attribute__((ext_vector_type(2)));
typedef float f32x4 __attribute__((ext_vector_type(4)));
typedef float f32x16 __attribute__((ext_vector_type(16)));
typedef short bf16x8 __attribute__((ext_vector_type(8)));
typedef short s16x4 __attribute__((ext_vector_type(4)));
constexpr int NWAVES = 8, NTHR = 512;
constexpr int LDS_BYTES = 163840;
constexpr int RING_BYTES = 131072;
constexpr int MISC_OFF = 159 * 1024;
constexpr int CW_TMO = 0, CW_CODE = 1, CW_BAR = 4096;
static_assert((CW_BAR + 3456) * 4 <= 64 * 1024, "control words inside the per-call memset");
#define LDS_WAIT() asm volatile("s_waitcnt lgkmcnt(0)" ::: "memory")
#define VM_WAIT() asm volatile("s_waitcnt vmcnt(0)" ::: "memory")
__device__ __forceinline__ unsigned pk2(float lo, float hi) { return f2bf(lo) | (f2bf(hi) << 16); }
#ifndef WT_STORES
#define WT_STORES 0
#endif
__device__ __forceinline__ void st16(void* p, v4u v) {
#if WT_STORES
    asm volatile("global_store_dwordx4 %0, %1, off sc1\n\ts_nop 1" :: "v"(p), "v"(v) : "memory");
#else
    *(v4u*)p = v;
#endif
}
__device__ __forceinline__ void st16f(void* p, f32x4 v) { st16(p, __builtin_bit_cast(v4u, v)); }
__device__ __forceinline__ void st8(void* p, v2u v) {
#if WT_STORES
    asm volatile("global_store_dwordx2 %0, %1, off sc1\n\ts_nop 1" :: "v"(p), "v"(v) : "memory");
#else
    *(v2u*)p = v;
#endif
}

#define XB_TMO      128
#define XB_XCNT(j)  (256  + 64 * (j))
#define XB_XSUB(j)  (1280 + 64 * (j))
#define XB_XGEN(j)  (2304 + 64 * (j))
#define XB_TOP      3328
#define XB_TOPGEN   3392
#define XCD_BAR_WORDS 3456
#define XB_SPIN_CAP (1u << 18)
__device__ __forceinline__ unsigned xb_ld(unsigned* p)              { return __hip_atomic_load(p, __ATOMIC_RELAXED, __HIP_MEMORY_SCOPE_AGENT); }
__device__ __forceinline__ unsigned xb_add(unsigned* p, unsigned v) { return __hip_atomic_fetch_add(p, v, __ATOMIC_RELAXED, __HIP_MEMORY_SCOPE_AGENT); }
__device__ __forceinline__ unsigned xb_xcc_id() { return (unsigned)__builtin_amdgcn_s_getreg((3 << 11) | 20) & 0xFu; }
#define XB_SPIN(cond, bar) do { unsigned _sp = 0; while (cond) { __builtin_amdgcn_s_sleep(1); \
    if ((++_sp & 255u) == 0u) { if (xb_ld(&(bar)[XB_TMO])) break; if (_sp > XB_SPIN_CAP) { atomicAdd(&(bar)[XB_TMO], 1u); break; } } } } while (0)
struct XcdBarrier { unsigned* bar; unsigned x; volatile LAS unsigned* st; };
__device__ __forceinline__ XcdBarrier xcd_barrier_post(unsigned* bar, volatile LAS unsigned* st) {
    XcdBarrier b; b.bar = bar; b.x = xb_xcc_id(); b.st = st;
    if (threadIdx.x == 0) (void)xb_add(&bar[XB_XCNT(b.x)], 1u);
    return b;
}
__device__ __forceinline__ void xcd_barrier_complete(unsigned* bar, unsigned x, unsigned& nloc, unsigned& nx) {
    const unsigned G = gridDim.x * gridDim.y * gridDim.z;
    unsigned sum, cnt, mine, sp = 0u;
    for (;;) {
        sum = 0u; cnt = 0u; mine = 0u;
#pragma unroll
        for (unsigned j = 0; j < 16; ++j) { const unsigned c = xb_ld(&bar[XB_XCNT(j)]); sum += c; cnt += (c > 0u) ? 1u : 0u; mine = (j == x) ? c : mine; }
        if (sum == G) break;
        __builtin_amdgcn_s_sleep(1);
        if ((++sp & 255u) == 0u) { if (xb_ld(&bar[XB_TMO])) break; if (sp > XB_SPIN_CAP) { atomicAdd(&bar[XB_TMO], 1u); break; } }
    }
    nloc = mine > 0u ? mine : 1u; nx = cnt > 0u ? cnt : 1u;
}
__device__ __forceinline__ void xcd_barrier(const XcdBarrier& b) {
    asm volatile("s_waitcnt vmcnt(0)" ::: "memory");
    __syncthreads();
    if (threadIdx.x == 0) {
        unsigned* bar = b.bar;
        __builtin_amdgcn_s_waitcnt(0);
        unsigned nloc = b.st[0], nx = b.st[1];
        if (nloc == 0u) { xcd_barrier_complete(bar, b.x, nloc, nx); b.st[0] = nloc; b.st[1] = nx; }
        const unsigned old = xb_add(&bar[XB_XSUB(b.x)], 1u);
        const unsigned gen = old / nloc;
        if (old + 1u == (gen + 1u) * nloc) {
            __builtin_amdgcn_fence(__ATOMIC_RELEASE, "agent");
            asm volatile("s_waitcnt vmcnt(0)" ::: "memory");
            const unsigned og = xb_add(&bar[XB_TOP], 1u);
            const unsigned tg = og / nx;
            if (og + 1u == (tg + 1u) * nx) xb_add(&bar[XB_TOPGEN], 1u);
            else XB_SPIN(xb_ld(&bar[XB_TOPGEN]) == tg, bar);
            __builtin_amdgcn_fence(__ATOMIC_ACQUIRE, "agent");
            xb_add(&bar[XB_XGEN(b.x)], 1u);
            asm volatile("s_waitcnt vmcnt(0)" ::: "memory");
        } else {
            XB_SPIN(xb_ld(&bar[XB_XGEN(b.x)]) == gen, bar);
            __builtin_amdgcn_fence(__ATOMIC_ACQUIRE, "agent");
            asm volatile("s_waitcnt vmcnt(0)" ::: "memory");
        }
    }
    __syncthreads();
}

namespace pg8 {
#define PG8_LAS __attribute__((address_space(3)))
typedef unsigned short bf16_t;
typedef short bf16x8 __attribute__((ext_vector_type(8)));
typedef float f32x4 __attribute__((ext_vector_type(4)));
typedef unsigned u32x4 __attribute__((ext_vector_type(4)));
constexpr int BM = 256, BK = 64, HALF = 128, HTB = HALF * BK * 2  , STAGE_BYTES = 8 * HTB, NXCD = 8, WGM = 8;

__host__ __device__ __forceinline__ int lds_byte(int r, int c) { const int st = (r >> 4) * 2 + (c >> 5), rr = r & 15, cc = c & 31, ob = rr * 64 + cc * 2; return st * 1024 + (ob ^ (((ob >> 9) & 1) << 5)); }
__host__ __device__ __forceinline__ void stage_rc(int b, int& R, int& C) { const int st = b / 1024, sb = b % 1024, swz = sb ^ (((sb >> 9) & 1) << 5); R = (st >> 1) * 16 + swz / 64; C = (st & 1) * 32 + (swz % 64) / 2; }
__host__ __device__ __forceinline__ int perm32(int rho) { const int n = rho >> 4, i = rho & 15; return 8 * (i >> 2) + 4 * n + (i & 3); }

struct Unit { int pm, pn; };
struct Gemm { const bf16_t* A; const bf16_t* Bt; int M, N, K; };
__device__ __forceinline__ unsigned cvt_pk_bf16(float lo, float hi) { unsigned r; asm volatile("v_cvt_pk_bf16_f32 %0, %1, %2" : "=v"(r) : "v"(lo), "v"(hi)); return r; }
template <class Epi, class Sched, bool ALIGN_EPI = false, bool SP2 = false, bool GATHER = false>
__device__ __forceinline__ void gemm_phase(PG8_LAS unsigned char* lds, const Gemm g, const Sched& S, const Epi& E) {
    const int tid = threadIdx.x, wid = __builtin_amdgcn_readfirstlane(tid >> 6), lane = tid & 63, wr = wid >> 2, wc = wid & 3, fr = lane & 15, fq = lane >> 4;
    const int K = g.K, nt = K / BK;
    unsigned voffA[2], voffB[2]; int RA[2], CA[2];
#pragma unroll
    for (int i = 0; i < 2; ++i) { int R, C; stage_rc(tid * 16 + i * 8192, R, C); const int Rb = Epi::PERM ? ((R & ~31) + perm32(R & 31)) : R;
        voffA[i] = (unsigned)(R * K + C) * 2u; voffB[i] = (unsigned)(Rb * K + C) * 2u; RA[i] = R; CA[i] = C; }
    const size_t kstep = (size_t)(BK * 2);
    const size_t hstep = (size_t)HALF * K * 2;
    const size_t tstep = 2 * hstep;
    const unsigned ldsw = (unsigned)wid * 1024u;
    const int aoff = lds_byte(wr * 64 + fr, fq * 8), boff = lds_byte(wc * 32 + fr, fq * 8);
#define PG8_SA(b, h) (((b) * 2 + (h)) * HTB)
#define PG8_SB(b, h) ((4 + (b) * 2 + (h)) * HTB)
#define PG8_STAGE(bufoff, gbase, voff) do { _Pragma("unroll") for (int _i = 0; _i < 2; ++_i) \
        __builtin_amdgcn_global_load_lds((const unsigned*)((const char*)(gbase) + (voff)[_i]), (PG8_LAS unsigned*)(lds + (bufoff) + ldsw + _i * 8192), 16, 0, 0); } while (0)
#define PG8_STAGE_A(bufoff, gbase, h, VO) do { if constexpr (GATHER) { PG8_STAGE(bufoff, gbase, VO[h]); } else { PG8_STAGE(bufoff, (gbase) + (h) * hstep, voffA); } } while (0)
#define PG8_LDA(dst, b, h) do { _Pragma("unroll") for (int m = 0; m < 4; ++m) _Pragma("unroll") for (int k = 0; k < 2; ++k) dst[m][k] = *(const PG8_LAS bf16x8*)(lds + PG8_SA(b, h) + aoff + m * 2048 + k * 1024); } while (0)
#define PG8_LDB(dst, b, h) do { _Pragma("unroll") for (int n = 0; n < 2; ++n) _Pragma("unroll") for (int k = 0; k < 2; ++k) dst[n][k] = *(const PG8_LAS bf16x8*)(lds + PG8_SB(b, h) + boff + n * 2048 + k * 1024); } while (0)
#define PG8_MMA(ai, bj, At, Bt) do { __builtin_amdgcn_s_setprio(1); _Pragma("unroll") for (int m = 0; m < 4; ++m) _Pragma("unroll") for (int n = 0; n < 2; ++n) _Pragma("unroll") for (int k = 0; k < 2; ++k) \
        acc[ai][bj][m][n] = __builtin_amdgcn_mfma_f32_16x16x32_bf16(Bt[n][k], At[m][k], acc[ai][bj][m][n], 0, 0, 0); __builtin_amdgcn_s_setprio(0); } while (0)
#define PG8_WAIT_V(n) asm volatile("s_waitcnt vmcnt(" #n ")" ::: "memory")
#define PG8_WAIT_L(n) asm volatile("s_waitcnt lgkmcnt(" #n ")" ::: "memory")
#define PG8_BAR __builtin_amdgcn_s_barrier()
#define PG8_SCHED __builtin_amdgcn_sched_barrier(0)
    Unit cur, nxt; int ui = 0;
    if (!S.next(0, cur)) return;
    f32x4 acc[2][2][4][2];
#pragma unroll
    for (int a = 0; a < 2; ++a)
#pragma unroll
        for (int b = 0; b < 2; ++b)
#pragma unroll
            for (int m = 0; m < 4; ++m)
#pragma unroll
                for (int n = 0; n < 2; ++n) acc[a][b][m][n] = (f32x4){0.f, 0.f, 0.f, 0.f};
    bf16x8 At[4][2], B0[2][2], B1[2][2];
    const char* cA = (const char*)g.A + (GATHER ? (size_t)0 : (size_t)cur.pm * tstep); const char* cB = (const char*)g.Bt + (size_t)cur.pn * tstep;
    unsigned vcur[2][2], vnxt[2][2], vsel[2][2];
#pragma unroll
    for (int h = 0; h < 2; ++h)
#pragma unroll
        for (int i = 0; i < 2; ++i) { vcur[h][i] = 0u; vnxt[h][i] = 0u; vsel[h][i] = 0u; }
    if constexpr (GATHER) {
#pragma unroll
        for (int h = 0; h < 2; ++h)
#pragma unroll
            for (int i = 0; i < 2; ++i) vcur[h][i] = ((unsigned)S.rowidx[cur.pm * BM + h * HALF + RA[i]] * (unsigned)K + (unsigned)CA[i]) * 2u;
    }
    S.a_ready(cur);
    if constexpr (SP2) {
        PG8_STAGE(PG8_SB(0, 0), cB, voffB); PG8_STAGE(PG8_SB(0, 1), cB + hstep, voffB); PG8_STAGE_A(PG8_SA(0, 0), cA, 0, vcur); PG8_STAGE_A(PG8_SA(0, 1), cA, 1, vcur);
        if (wr == 1) PG8_BAR;
        PG8_WAIT_V(2); PG8_BAR;
        PG8_STAGE(PG8_SB(1, 0), cB + kstep, voffB); PG8_STAGE_A(PG8_SA(1, 0), cA + kstep, 0, vcur); PG8_STAGE(PG8_SB(1, 1), cB + hstep + kstep, voffB);
        PG8_WAIT_V(6); PG8_BAR;
    } else {
        PG8_STAGE(PG8_SB(0, 0), cB, voffB); PG8_STAGE_A(PG8_SA(0, 0), cA, 0, vcur); PG8_STAGE(PG8_SB(0, 1), cB + hstep, voffB); PG8_STAGE_A(PG8_SA(0, 1), cA, 1, vcur);
        if (wr == 1) PG8_BAR;
        PG8_WAIT_V(4); PG8_BAR;
        PG8_STAGE(PG8_SB(1, 0), cB + kstep, voffB); PG8_STAGE_A(PG8_SA(1, 0), cA + kstep, 0, vcur); PG8_STAGE(PG8_SB(1, 1), cB + hstep + kstep, voffB);
        PG8_WAIT_V(6); PG8_BAR;
    }
    for (;;) {
        const bool has_next = S.next(ui + 1, nxt);
        if constexpr (GATHER) {
#pragma unroll
            for (int h = 0; h < 2; ++h)
#pragma unroll
                for (int i = 0; i < 2; ++i) vnxt[h][i] = has_next ? ((unsigned)S.rowidx[nxt.pm * BM + h * HALF + RA[i]] * (unsigned)K + (unsigned)CA[i]) * 2u : vcur[h][i];
        }
        const char* nA = has_next ? (const char*)g.A + (GATHER ? (size_t)0 : (size_t)nxt.pm * tstep) : cA; const char* nB = has_next ? (const char*)g.Bt + (size_t)nxt.pn * tstep : cB;
        for (int t = 0; t < nt; t += 2) {
            const bool last = (t == nt - 2);
            if constexpr (GATHER) {
#pragma unroll
                for (int h = 0; h < 2; ++h)
#pragma unroll
                    for (int i = 0; i < 2; ++i) vsel[h][i] = last ? vnxt[h][i] : vcur[h][i];
            }
            if constexpr (Epi::HAS_MID) { if (t == nt / 2) E.mid(acc, cur, wr, wc, fr, fq); }
            const char* a1 = cA + (size_t)(t + 1) * kstep;
            const char* a2 = last ? nA : cA + (size_t)(t + 2) * kstep; const char* b2 = last ? nB : cB + (size_t)(t + 2) * kstep;
            const char* a3 = a2 + kstep; const char* b3 = b2 + kstep;
            if (last && has_next) S.a_ready(nxt);
            if constexpr (SP2) {
            PG8_LDB(B0, 0, 0); PG8_LDB(B1, 0, 1); PG8_SCHED; PG8_LDA(At, 0, 0); PG8_STAGE_A(PG8_SA(1, 1), a1, 1, vcur);
            PG8_WAIT_V(8); PG8_WAIT_L(0); PG8_BAR; PG8_MMA(0, 0, At, B0); PG8_MMA(0, 1, At, B1); PG8_BAR; PG8_SCHED;
            PG8_LDA(At, 0, 1); PG8_STAGE(PG8_SB(0, 0), b2, voffB); PG8_STAGE(PG8_SB(0, 1), b2 + hstep, voffB); PG8_STAGE_A(PG8_SA(0, 0), a2, 0, vsel);
            PG8_WAIT_V(8); PG8_WAIT_L(0); PG8_BAR; PG8_MMA(1, 0, At, B0); PG8_MMA(1, 1, At, B1); PG8_BAR; PG8_SCHED;
            PG8_LDB(B0, 1, 0); PG8_LDB(B1, 1, 1); PG8_SCHED; PG8_LDA(At, 1, 0); PG8_STAGE_A(PG8_SA(0, 1), a2, 1, vsel);
            PG8_WAIT_V(8); PG8_WAIT_L(0); PG8_BAR; PG8_MMA(0, 0, At, B0); PG8_MMA(0, 1, At, B1); PG8_BAR; PG8_SCHED;
            PG8_LDA(At, 1, 1); PG8_STAGE(PG8_SB(1, 0), b3, voffB); PG8_STAGE(PG8_SB(1, 1), b3 + hstep, voffB); PG8_STAGE_A(PG8_SA(1, 0), a3, 0, vsel);
            PG8_WAIT_V(8); PG8_WAIT_L(0); PG8_BAR; PG8_MMA(1, 0, At, B0); PG8_MMA(1, 1, At, B1); PG8_BAR; PG8_SCHED;
            } else {
            PG8_LDB(B0, 0, 0); PG8_SCHED; PG8_LDA(At, 0, 0); PG8_STAGE_A(PG8_SA(1, 1), a1, 1, vcur);
            PG8_WAIT_L(8); PG8_BAR; PG8_WAIT_L(0); PG8_MMA(0, 0, At, B0); PG8_BAR; PG8_SCHED;
            PG8_LDB(B1, 0, 1); PG8_STAGE(PG8_SB(0, 0), b2, voffB);
            PG8_BAR; PG8_WAIT_L(0); PG8_MMA(0, 1, At, B1); PG8_BAR;
            PG8_LDA(At, 0, 1); PG8_STAGE_A(PG8_SA(0, 0), a2, 0, vsel);
            PG8_BAR; PG8_WAIT_L(0); PG8_MMA(1, 0, At, B0); PG8_BAR; PG8_SCHED;
            PG8_STAGE(PG8_SB(0, 1), b2 + hstep, voffB);
            PG8_WAIT_V(6); PG8_BAR; PG8_MMA(1, 1, At, B1); PG8_BAR;
            PG8_LDB(B0, 1, 0); PG8_SCHED; PG8_LDA(At, 1, 0); PG8_STAGE_A(PG8_SA(0, 1), a2, 1, vsel);
            PG8_WAIT_L(8); PG8_BAR; PG8_WAIT_L(0); PG8_MMA(0, 0, At, B0); PG8_BAR; PG8_SCHED;
            PG8_LDB(B1, 1, 1); PG8_STAGE(PG8_SB(1, 0), b3, voffB);
            PG8_BAR; PG8_WAIT_L(0); PG8_MMA(0, 1, At, B1); PG8_BAR;
            PG8_LDA(At, 1, 1); PG8_STAGE_A(PG8_SA(1, 0), a3, 0, vsel);
            PG8_BAR; PG8_WAIT_L(0); PG8_MMA(1, 0, At, B0); PG8_BAR; PG8_SCHED;
            PG8_STAGE(PG8_SB(1, 1), b3 + hstep, voffB);
            PG8_WAIT_V(6); PG8_BAR; PG8_MMA(1, 1, At, B1); PG8_BAR;
            }
        }
        if constexpr (ALIGN_EPI) { if (wr == 0) PG8_BAR; }
        if constexpr (!Epi::AFTER_DRAIN) { E(acc, cur, wr, wc, fr, fq); S.done(cur); }
        if (!has_next) break;
#pragma unroll
        for (int a = 0; a < 2; ++a)
#pragma unroll
            for (int b = 0; b < 2; ++b)
#pragma unroll
                for (int m = 0; m < 4; ++m)
#pragma unroll
                    for (int n = 0; n < 2; ++n) acc[a][b][m][n] = (f32x4){0.f, 0.f, 0.f, 0.f};
        cur = nxt; cA = nA; cB = nB; ++ui;
        if constexpr (GATHER) {
#pragma unroll
            for (int h = 0; h < 2; ++h)
#pragma unroll
                for (int i = 0; i < 2; ++i) vcur[h][i] = vnxt[h][i];
        }
        if constexpr (ALIGN_EPI) { if (wr == 1) PG8_BAR; }
    }
    PG8_WAIT_V(0);
    if constexpr (!ALIGN_EPI) { if (wr == 0) PG8_BAR; }
    PG8_BAR;
    if constexpr (Epi::AFTER_DRAIN) { E.fused(acc, cur, wr, wc, fr, fq, lds, wid, lane); S.done(cur); }
#undef PG8_SA
#undef PG8_SB
#undef PG8_STAGE
#undef PG8_STAGE_A
#undef PG8_LDA
#undef PG8_LDB
#undef PG8_MMA
#undef PG8_WAIT_V
#undef PG8_WAIT_L
#undef PG8_BAR
#undef PG8_SCHED
}
}

namespace pg8 {
struct SchedQKV {
    int G, c;
    __device__ __forceinline__ bool next(int i, Unit& u) const {
        const int L = i * G + c; if (L >= 400) return false;
        if (L < 384) { const int xcd = L & 7, off = L >> 3, w = xcd * 48 + off; u.pm = (w / 48) * 8 + ((w % 48) & 7); u.pn = (w % 48) >> 3; }
        else { const int j = L - 384; u.pm = 64 + (j >> 1); u.pn = (j & 1) ? 5 : 2; }
        return true;
    }
    __device__ __forceinline__ void a_ready(const Unit&) const {}
    __device__ __forceinline__ void done(const Unit&) const {}
};
struct EpiQKV {
    static constexpr bool PERM = true, AFTER_DRAIN = false, HAS_MID = false;
    unsigned char* ws; const float* bqn; const float* bkn;
    __device__ __forceinline__ void operator()(const f32x4 (&acc)[2][2][4][2], const Unit& u, int wr, int wc, int fr, int fq) const {
        const int pn = u.pn; const bool isctx = u.pm >= 64;
        int kind, hh;
        if (pn < 2) { kind = 0; hh = pn * 4 + wc; } else if (pn == 2) { kind = wc < 2 ? 2 : 4; hh = wc & 1; } else if (pn < 5) { kind = 1; hh = (pn - 3) * 4 + wc; } else { kind = wc < 2 ? 3 : 5; hh = wc & 1; }
        const bool rms = kind == 1 || kind == 3, rope = !isctx && kind <= 3;
        const float* gp = kind == 1 ? bqn : bkn;
        f32x4 gain[2][2];
#pragma unroll
        for (int bj = 0; bj < 2; ++bj)
#pragma unroll
            for (int n = 0; n < 2; ++n) gain[bj][n] = rms ? *(const f32x4*)(gp + 32 * bj + 8 * fq + 4 * n) : (f32x4){1.f, 1.f, 1.f, 1.f};
        const float* tab = (const float*)(ws + WS_ROPE);
        bf16* base = (bf16*)(ws + (kind == 0 ? WS_QA : kind == 1 ? WS_QB : kind == 2 ? WS_KA : kind == 3 ? WS_KB : kind == 4 ? WS_VA : WS_VB));
        const float qs = kind <= 1 ? C2 : 1.f;
#pragma unroll
        for (int ai = 0; ai < 2; ++ai)
#pragma unroll
            for (int m = 0; m < 4; ++m) {
                const int row = u.pm * BM + ai * HALF + wr * 64 + m * 16 + fr;
                int b, t, pos;
                if (!isctx) { b = row >> 11; t = row & 2047; pos = t; } else { const int cr = row - ML; b = cr >> 8; t = 0; pos = T + (cr & 255); }
                f32x4 v[2][2];
#pragma unroll
                for (int bj = 0; bj < 2; ++bj)
#pragma unroll
                    for (int n = 0; n < 2; ++n) v[bj][n] = acc[ai][bj][m][n];
                if (rms) {
                    float ss = 0.f;
#pragma unroll
                    for (int bj = 0; bj < 2; ++bj)
#pragma unroll
                        for (int n = 0; n < 2; ++n) ss += (v[bj][n].x * v[bj][n].x + v[bj][n].y * v[bj][n].y) + (v[bj][n].z * v[bj][n].z + v[bj][n].w * v[bj][n].w);
                    ss += __shfl_xor(ss, 16); ss += __shfl_xor(ss, 32);
                    const float rn = rsqrtf(ss * (1.f / 64.f) + EPS);
#pragma unroll
                    for (int bj = 0; bj < 2; ++bj)
#pragma unroll
                        for (int n = 0; n < 2; ++n) v[bj][n] = v[bj][n] * rn * gain[bj][n];
                }
                if (rope) {
#pragma unroll
                    for (int bj = 0; bj < 2; ++bj)
#pragma unroll
                        for (int n = 0; n < 2; ++n) {
                            const int tp = bj == 0 ? (t >> 6) : 32 + (t & 63);
                            const f32x4 cs = *(const f32x4*)(tab + (tp * 16 + 4 * fq + 2 * n) * 2);
                            const f32x4 x = v[bj][n];
                            v[bj][n] = (f32x4){x.x * cs.x - x.y * cs.y, x.x * cs.y + x.y * cs.x, x.z * cs.z - x.w * cs.w, x.z * cs.w + x.w * cs.z};
                        }
                }
#pragma unroll
                for (int bj = 0; bj < 2; ++bj) {
                    const f32x4 v0 = v[bj][0] * qs, v1 = v[bj][1] * qs;
                    u32x4 w; w.x = pk2(v0.x, v0.y); w.y = pk2(v0.z, v0.w); w.z = pk2(v1.x, v1.y); w.w = pk2(v1.z, v1.w);
                    const int d0 = 32 * bj + 8 * fq;
                    bf16* dst = kind <= 1 ? base + q_off(b, hh, t, d0) : kind <= 3 ? base + k_off(b, hh, pos, d0) : base + v_off(b, hh, pos, d0);
                    st16(dst, w);
                }
            }
    }
};
}


namespace pg8 {
struct SchedOne { Unit u;
    __device__ __forceinline__ bool next(int i, Unit& o) const { if (i) return false; o = u; return true; }
    __device__ __forceinline__ void a_ready(const Unit&) const {}
    __device__ __forceinline__ void done(const Unit&) const {} };
struct EpiOut {
    static constexpr bool PERM = true, AFTER_DRAIN = false, HAS_MID = true;
    bf16* OX; const LAS float* tab;
    __device__ __forceinline__ void mid(f32x4 (&acc)[2][2][4][2], const Unit&, int wr, int, int fr, int) const {
#pragma unroll
        for (int ai = 0; ai < 2; ++ai)
#pragma unroll
            for (int m = 0; m < 4; ++m) { const float f = tab[2 * (ai * HALF + wr * 64 + m * 16 + fr)];
#pragma unroll
                for (int bj = 0; bj < 2; ++bj)
#pragma unroll
                    for (int n = 0; n < 2; ++n) acc[ai][bj][m][n] = acc[ai][bj][m][n] * f; }
    }
    __device__ __forceinline__ void operator()(const f32x4 (&acc)[2][2][4][2], const Unit& u, int wr, int wc, int fr, int fq) const {
#pragma unroll
        for (int ai = 0; ai < 2; ++ai)
#pragma unroll
            for (int m = 0; m < 4; ++m) { const int r = ai * HALF + wr * 64 + m * 16 + fr; const float f = tab[2 * r + 1];
                bf16* rowp = OX + (size_t)(u.pm * BM + r) * D + u.pn * BM + wc * 32 + 8 * fq;
#pragma unroll
                for (int bj = 0; bj < 2; ++bj) { const f32x4 v0 = acc[ai][bj][m][0] * f, v1 = acc[ai][bj][m][1] * f;
                    u32x4 w; w.x = pk2(v0.x, v0.y); w.y = pk2(v0.z, v0.w); w.z = pk2(v1.x, v1.y); w.w = pk2(v1.z, v1.w);
                    st16(rowp + bj * HALF, w); } }
    }
};
struct SchedMoE {
    int G, c, nwg; const LAS int* tile_e; const int* rowidx;
    __device__ __forceinline__ bool next(int i, Unit& u) const {
        const int L = i * G + c; if (L >= nwg) return false;
        const int q = nwg >> 3, r = nwg & 7, xcd = L & 7, off = L >> 3;
        const int w = (xcd < r ? xcd * (q + 1) : r * (q + 1) + (xcd - r) * q) + off;
        u.pm = w >> 2; u.pn = tile_e[w >> 2] * 4 + (w & 3); return true;
    }
    __device__ __forceinline__ void a_ready(const Unit&) const {}
    __device__ __forceinline__ void done(const Unit&) const {}
};
__device__ __forceinline__ float silu_fast(float g) { return g * __builtin_amdgcn_rcpf(1.f + __builtin_amdgcn_exp2f(-g * LOG2E)); }
struct EpiGU {
    static constexpr bool PERM = true, AFTER_DRAIN = false, HAS_MID = false;
    bf16* ACT; const float* roww;
    __device__ __forceinline__ void operator()(const f32x4 (&acc)[2][2][4][2], const Unit& u, int wr, int wc, int fr, int fq) const {
#pragma unroll
        for (int ai = 0; ai < 2; ++ai)
#pragma unroll
            for (int m = 0; m < 4; ++m) { const int pos = u.pm * BM + ai * HALF + wr * 64 + m * 16 + fr; const float w = roww[pos];
                const f32x4 g0 = acc[ai][0][m][0], g1 = acc[ai][0][m][1], u0 = acc[ai][1][m][0], u1 = acc[ai][1][m][1];
                u32x4 o;
                o.x = pk2(silu_fast(g0.x) * u0.x * w, silu_fast(g0.y) * u0.y * w); o.y = pk2(silu_fast(g0.z) * u0.z * w, silu_fast(g0.w) * u0.w * w);
                o.z = pk2(silu_fast(g1.x) * u1.x * w, silu_fast(g1.y) * u1.y * w); o.w = pk2(silu_fast(g1.z) * u1.z * w, silu_fast(g1.w) * u1.w * w);
                st16(ACT + (size_t)pos * EFF + (u.pn & 3) * 128 + wc * 32 + 8 * fq, o); }
    }
};
struct EpiY {
    static constexpr bool PERM = true, AFTER_DRAIN = false, HAS_MID = false;
    bf16* Y;
    __device__ __forceinline__ void operator()(const f32x4 (&acc)[2][2][4][2], const Unit& u, int wr, int wc, int fr, int fq) const {
#pragma unroll
        for (int ai = 0; ai < 2; ++ai)
#pragma unroll
            for (int m = 0; m < 4; ++m) { bf16* rowp = Y + (size_t)(u.pm * BM + ai * HALF + wr * 64 + m * 16 + fr) * D + (u.pn & 3) * BM + wc * 32 + 8 * fq;
#pragma unroll
                for (int bj = 0; bj < 2; ++bj) { const f32x4 v0 = acc[ai][bj][m][0], v1 = acc[ai][bj][m][1];
                    u32x4 w; w.x = pk2(v0.x, v0.y); w.y = pk2(v0.z, v0.w); w.z = pk2(v1.x, v1.y); w.w = pk2(v1.z, v1.w);
                    st16(rowp + bj * HALF, w); } }
    }
};
}

namespace att {
typedef __attribute__((address_space(3))) const char* lds_cptr;
typedef short v4i16_t __attribute__((ext_vector_type(4)));
constexpr int NSLOT = 4, SLOTB = 16384, OST_PITCH = 144, OST_WAVE = 32 * OST_PITCH;
static_assert(8 * OST_WAVE <= 3 * SLOTB && NSLOT * SLOTB <= 65536, "attention LDS");
__device__ __forceinline__ int crow(int r, int hi) { return (r & 3) + 8 * (r >> 2) + 4 * hi; }
__device__ __forceinline__ unsigned cvtpk(float lo, float hi) { typedef float f2 __attribute__((ext_vector_type(2))); typedef __bf16 b2 __attribute__((ext_vector_type(2))); f2 v = {lo, hi}; b2 b = __builtin_convertvector(v, b2); return __builtin_bit_cast(unsigned, b); }
__device__ __forceinline__ s16x4 vtr(lds_cptr p) { return __builtin_bit_cast(s16x4, __builtin_amdgcn_ds_read_tr16_b64_v4i16((__attribute__((address_space(3))) v4i16_t*)p)); }
__device__ __forceinline__ float swapmax(float m) { auto rr = __builtin_amdgcn_permlane32_swap(__float_as_uint(m), __float_as_uint(m), false, false); return fmaxf(__uint_as_float(rr[0]), __uint_as_float(rr[1])); }
__device__ __forceinline__ float swapsum(float m) { auto rr = __builtin_amdgcn_permlane32_swap(__float_as_uint(m), __float_as_uint(m), false, false); return __uint_as_float(rr[0]) + __uint_as_float(rr[1]); }

__device__ __forceinline__ void glds16(const void* gsrc, unsigned lds_dst) { unsigned keep;
    asm volatile("s_mov_b32 %0, m0\n\ts_mov_b32 m0, %2\n\ts_nop 0\n\tglobal_load_lds_dwordx4 %1, off\n\ts_mov_b32 m0, %0" : "=&s"(keep) : "v"(gsrc), "s"(lds_dst) : "memory"); }
__device__ __forceinline__ float max3f(float a, float b, float c) { float r; asm("v_max3_f32 %0, %1, %2, %3" : "=v"(r) : "v"(a), "v"(b), "v"(c)); return r; }
__device__ __forceinline__ float max2f(float a, float b) { float r; asm("v_max_f32_e32 %0, %1, %2" : "=v"(r) : "v"(a), "v"(b)); return r; }
constexpr int WC_PER_WAVE = 24, WC_LDS = 65536;
struct WConv { int next, j0, j1, gstep, cm1, cm2; };
struct WItem { const float* src; int N; bf16* dst; int dpitch; };
__device__ __forceinline__ WItem wc_decode(const P& p, int hidx, int& k0, int& n0, int& drow0) {
    const int item = hidx >> 1, kh = hidx & 1; WItem w;
    if (item < 16384) { const int up = item >= 8192, r = item & 8191, e = r >> 8, q = r & 255, kb = q >> 4, nb = q & 15; n0 = nb * 32;
        w.src = (up ? p.w_up : p.w_gate) + (size_t)e * 1024 * 512; w.N = 512; w.dst = (bf16*)(p.ws + WS_WGU) + (size_t)e * 1024 * 1024; w.dpitch = 1024;
        drow0 = (n0 >> 7) * 256 + up * 128 + (n0 & 127); k0 = kb * 64 + kh * 32; }
    else { const int r = item - 16384, e = r >> 8, q = r & 255, kb = q >> 5, nb = q & 31; n0 = nb * 32;
        w.src = p.w_down + (size_t)e * 512 * 1024; w.N = 1024; w.dst = (bf16*)(p.ws + WS_WD) + (size_t)e * 1024 * 512; w.dpitch = 512; drow0 = n0; k0 = kb * 64 + kh * 32; }
    return w;
}
__device__ __forceinline__ void glds16(const void* gsrc, unsigned lds_dst);
__device__ __forceinline__ void glds16_nt(const void* gsrc, unsigned lds_dst) { unsigned keep;
    asm volatile("s_mov_b32 %0, m0\n\ts_mov_b32 m0, %2\n\ts_nop 0\n\tglobal_load_lds_dwordx4 %1, off nt\n\ts_mov_b32 m0, %0" : "=&s"(keep) : "v"(gsrc), "s"(lds_dst) : "memory"); }
__device__ __forceinline__ void wc_issue(const P& p, int gw, int ord, unsigned ldsbuf, int lane) {
    int k0, n0, drow0; const WItem w = wc_decode(p, gw + 2048 * ord, k0, n0, drow0);
#pragma unroll
    for (int q = 0; q < 4; ++q) { const int kl = 8 * q + (lane >> 3), f4 = (lane & 7) ^ ((q >> 1) * 4);
        glds16_nt(w.src + (size_t)(k0 + kl) * w.N + n0 + f4 * 4, (unsigned)__builtin_amdgcn_readfirstlane(ldsbuf + q * 1024)); }
}
__device__ __forceinline__ void wc_consume(const P& p, int gw, int ord, LAS unsigned char* buf, int lane) {
    int k0, n0, drow0; const WItem w = wc_decode(p, gw + 2048 * ord, k0, n0, drow0);
    const int n = lane >> 1, kh = lane & 1;
    const LAS float* s = (const LAS float*)buf + (16 * kh) * 32 + 4 * ((n >> 2) ^ (4 * kh)) + (n & 3);
    float v[16];
#pragma unroll
    for (int i = 0; i < 16; ++i) v[i] = s[i * 32];
    v4u o0, o1;
    o0.x = cvtpk(v[0], v[1]); o0.y = cvtpk(v[2], v[3]); o0.z = cvtpk(v[4], v[5]); o0.w = cvtpk(v[6], v[7]);
    o1.x = cvtpk(v[8], v[9]); o1.y = cvtpk(v[10], v[11]); o1.z = cvtpk(v[12], v[13]); o1.w = cvtpk(v[14], v[15]);
    bf16* d = w.dst + (size_t)(drow0 + n) * w.dpitch + k0 + 16 * kh;
    __builtin_nontemporal_store(o0, (v4u*)d); __builtin_nontemporal_store(o1, (v4u*)(d + 8));
}
constexpr float THR = 8.f;
template <int GRP, int ABL = 0>
__device__ __forceinline__ void attn_unit(const P& p, LAS unsigned char* lds, int b, int kvh, int qb, WConv& wc, int gw) {
    const int tid = threadIdx.x, lane = tid & 63, r32 = lane & 31, hi = lane >> 5;
    const int wid = __builtin_amdgcn_readfirstlane(tid >> 6);
    const int h = kvh * 4 + (wid >> 1);
    const int q0w = qb * 64 + (wid & 1) * 32, qpos = q0w + r32;
    const bf16* Qp = (const bf16*)(p.ws + (GRP ? WS_QB : WS_QA)) + q_off(b, h, qpos, 0);
    bf16x8 qr[4];
#pragma unroll
    for (int d0 = 0; d0 < 4; ++d0) qr[d0] = *(const bf16x8*)(Qp + 16 * d0 + 8 * hi);
    asm volatile("" : "+v"(qr[0]), "+v"(qr[1]), "+v"(qr[2]), "+v"(qr[3]));
    const char* Kt = (const char*)(p.ws + (GRP ? WS_KB : WS_KA)) + (size_t)(b * 2 + kvh) * NTILE * 8192 + wid * 1024 + lane * 16;
    const char* Vt = (const char*)(p.ws + (GRP ? WS_VB : WS_VA)) + (size_t)(b * 2 + kvh) * NTILE * 8192 + wid * 1024 + lane * 16;
    const unsigned lds0 = (unsigned)(uintptr_t)lds;
    int jlo = 0, nband = NTILE, NT = NTILE;
    if (GRP == 0) { jlo = qb - 2 < 0 ? 0 : qb - 2; const int jhi = qb + 2 > 31 ? 31 : qb + 2; nband = jhi - jlo + 1; NT = nband + 4; }
#define ATT_TILE(i) ((i) < nband ? jlo + (i) : 32 + ((i) - nband))
#define ATT_ISSUE(i) do { if (ABL & 1) break; const int tl_ = ATT_TILE(i); const int sl_ = ((i) & 3) * SLOTB; \
        glds16(Kt + (size_t)tl_ * 8192, (unsigned)__builtin_amdgcn_readfirstlane(lds0 + sl_ + wid * 1024)); \
        glds16(Vt + (size_t)tl_ * 8192, (unsigned)__builtin_amdgcn_readfirstlane(lds0 + sl_ + 8192 + wid * 1024)); } while (0)
#define ATT_WAIT(n) do { if (ABL & 1) break; if ((n) >= 2) asm volatile("s_waitcnt vmcnt(4)" ::: "memory"); else if ((n) == 1) asm volatile("s_waitcnt vmcnt(2)" ::: "memory"); else asm volatile("s_waitcnt vmcnt(0)" ::: "memory"); } while (0)
#define ATT_WAITN(n) do { if (ABL & 1) break; switch (n) { case 0: asm volatile("s_waitcnt vmcnt(0)" ::: "memory"); break; case 2: asm volatile("s_waitcnt vmcnt(2)" ::: "memory"); break; \
        case 4: asm volatile("s_waitcnt vmcnt(4)" ::: "memory"); break; case 6: asm volatile("s_waitcnt vmcnt(6)" ::: "memory"); break; case 8: asm volatile("s_waitcnt vmcnt(8)" ::: "memory"); break; \
        case 10: asm volatile("s_waitcnt vmcnt(10)" ::: "memory"); break; case 12: asm volatile("s_waitcnt vmcnt(12)" ::: "memory"); break; default: asm volatile("s_waitcnt vmcnt(14)" ::: "memory"); break; } } while (0)
#define ATT_BAR() do { asm volatile("" ::: "memory"); __builtin_amdgcn_s_barrier(); asm volatile("" ::: "memory"); } while (0)
#define SBAR() __builtin_amdgcn_sched_barrier(0)
#define MF(a, b, c) __builtin_amdgcn_mfma_f32_32x32x16_bf16(a, b, c, 0, 0, 0)
#define KFRAG(dst, base, k) dst = *(const __attribute__((address_space(3))) bf16x8*)((base) + ((k) >> 1) * 2048 + ((k) & 1) * 512)
    float m, l;
    m = 0.f; l = 0.f;
    f32x16 o0, o1, sA0, sA1, sB0, sB1; const f32x16 zero16 = {0.f, 0.f, 0.f, 0.f, 0.f, 0.f, 0.f, 0.f, 0.f, 0.f, 0.f, 0.f, 0.f, 0.f, 0.f, 0.f};
#pragma unroll
    for (int r = 0; r < 16; ++r) { o0[r] = 0.f; o1[r] = 0.f; sB0[r] = 0.f; sB1[r] = 0.f; }
    const lds_cptr kp0 = (lds_cptr)lds + hi * 1024 + r32 * 16;
    const lds_cptr vp0 = (lds_cptr)lds + 8192 + ((lane >> 4) & 1) * 32 + (lane & 3) * 8 + (4 * hi + ((lane & 15) >> 2)) * 64;
#define ATT_MASK(S0, S1, t) do { if (GRP == 0) { const int tl = ATT_TILE(t); if (tl < 32 && (tl == qb - 2 || tl == qb + 2)) { const int kb = tl * 64; \
        _Pragma("unroll") for (int r = 0; r < 16; ++r) { const int dd = kb + crow(r, hi) - qpos; if (dd > 128 || dd < -128) S0[r] = -1e30f; if (dd + 32 > 128 || dd + 32 < -128) S1[r] = -1e30f; } } } } while (0)
#define ATT_DECIDE(S0, S1, mxv) do { float mx_ = swapmax(mxv); \
        if (__builtin_expect(__any(mx_ > THR), 0)) { const float dl = fmaxf(mx_, 0.f), alpha = __builtin_amdgcn_exp2f(-dl); m += dl; l *= alpha; \
            _Pragma("unroll") for (int r = 0; r < 16; ++r) { S0[r] -= dl; S1[r] -= dl; o0[r] *= alpha; o1[r] *= alpha; } } } while (0)
    if (wid >= 4) __builtin_amdgcn_s_setprio(1);
    wc.cm1 = 0; wc.cm2 = 0;
    ATT_ISSUE(0); ATT_ISSUE(1); ATT_ISSUE(2);
    ATT_WAIT(2); ATT_BAR();
    {
        bf16x8 kf[8];
#pragma unroll
        for (int k = 0; k < 8; ++k) KFRAG(kf[k], kp0, k);
        SBAR();
        sA0 = MF(kf[0], qr[0], zero16); sA1 = MF(kf[1], qr[0], zero16);
#pragma unroll
        for (int d0 = 1; d0 < 4; ++d0) { sA0 = MF(kf[2 * d0], qr[d0], sA0); sA1 = MF(kf[2 * d0 + 1], qr[d0], sA1); }
        ATT_MASK(sA0, sA1, 0);
        asm volatile("s_nop 15\n\ts_nop 7" : "+v"(sA0), "+v"(sA1));
        float a = max3f(sA0[0], sA0[1], sA1[0]), c = max3f(sA0[2], sA0[3], sA1[1]); a = max3f(a, sA1[2], sA1[3]);
#pragma unroll
        for (int r = 4; r < 16; r += 4) { a = max3f(a, sA0[r], sA0[r + 1]); c = max3f(c, sA0[r + 2], sA0[r + 3]); a = max3f(a, sA1[r], sA1[r + 1]); c = max3f(c, sA1[r + 2], sA1[r + 3]); }
        ATT_DECIDE(sA0, sA1, max2f(a, c));
    }
#define ATT_STEP(SC0, SC1, SN0, SN1, t, HN) do { \
        constexpr bool hn_ = HN;                                      \
        ATT_WAITN(wc.cm2 + wc.cm1 + ((t) + 2 < NT ? 2 : 0));         \
        ATT_BAR(); \
        if ((t) + 3 < NT) ATT_ISSUE((t) + 3); \
        if (WCONV_IN_ATTN) { int c_ = 0; const int r7_ = wc.gstep % 7, bs_ = r7_ == 0 ? 0 : r7_ == 3 ? 1 : 2;     \
            if (bs_ < 2) { LAS unsigned char* wb_ = lds + WC_LDS + wid * 8192 + bs_ * 4096; int jb_ = bs_ ? wc.j1 : wc.j0; \
                if (jb_ >= 0) { wc_consume(p, gw, jb_, wb_, lane); jb_ = -1; c_ += 2; } \
                if (wc.next < WC_PER_WAVE) { asm volatile("s_waitcnt lgkmcnt(0)" ::: "memory"); wc_issue(p, gw, wc.next, lds0 + WC_LDS + wid * 8192 + bs_ * 4096, lane); jb_ = wc.next++; c_ += 4; } \
                if (bs_) wc.j1 = jb_; else wc.j0 = jb_; } \
            wc.cm2 = wc.cm1; wc.cm1 = c_; wc.gstep++; } \
        const lds_cptr kp_ = kp0 + (((t) + 1) & 3) * SLOTB; const lds_cptr vp_ = vp0 + ((t) & 3) * SLOTB; \
        bf16x8 kf[8]; s16x4 vlo[8], vhi[8]; \
        if (hn_) { _Pragma("unroll") for (int k = 0; k < 8; ++k) KFRAG(kf[k], kp_, k); } \
        SBAR(); \
        float rs_ = 0.f; v4u pw[4]; _Pragma("unroll") for (int q_ = 0; q_ < 4; ++q_) pw[q_] = (v4u){0u, 0u, 0u, 0u}; \
        _Pragma("unroll") for (int g = 0; g < 8; ++g) {             \
            if (hn_) { if (g == 0) SN0 = MF(kf[0], qr[0], zero16); else if (g == 1) SN1 = MF(kf[1], qr[0], zero16); else if (g & 1) SN1 = MF(kf[g], qr[g >> 1], SN1); else SN0 = MF(kf[g], qr[g >> 1], SN0); } \
            if (g < 4) { _Pragma("unroll") for (int e = 0; e < 4; ++e) { SC0[4 * g + e] = __builtin_amdgcn_exp2f(SC0[4 * g + e]); rs_ += SC0[4 * g + e]; } \
                         pw[g >> 1][2 * (g & 1)] = cvtpk(SC0[4 * g], SC0[4 * g + 1]); pw[g >> 1][2 * (g & 1) + 1] = cvtpk(SC0[4 * g + 2], SC0[4 * g + 3]); \
                         asm volatile("" : "+v"(SC0), "+v"(pw[g >> 1]), "+v"(rs_)); } \
            else { const int g4 = g - 4;   \
                         vlo[g4] = vtr(vp_ + g4 * 1024); vhi[g4] = vtr(vp_ + g4 * 1024 + 512); vlo[4 + g4] = vtr(vp_ + 4096 + g4 * 1024); vhi[4 + g4] = vtr(vp_ + 4096 + g4 * 1024 + 512); \
                         _Pragma("unroll") for (int e = 0; e < 4; ++e) { SC1[4 * g4 + e] = __builtin_amdgcn_exp2f(SC1[4 * g4 + e]); rs_ += SC1[4 * g4 + e]; } \
                         pw[2 + (g4 >> 1)][2 * (g4 & 1)] = cvtpk(SC1[4 * g4], SC1[4 * g4 + 1]); pw[2 + (g4 >> 1)][2 * (g4 & 1) + 1] = cvtpk(SC1[4 * g4 + 2], SC1[4 * g4 + 3]); \
                         asm volatile("" : "+v"(SC1), "+v"(pw[2 + (g4 >> 1)]), "+v"(rs_)); } \
            SBAR(); } \
        l += rs_; \
        if (hn_) { ATT_MASK(SN0, SN1, (t) + 1); if (__builtin_expect(__any(m != 0.f), 0)) { _Pragma("unroll") for (int r = 0; r < 16; ++r) { SN0[r] -= m; SN1[r] -= m; } } \
                   asm volatile("s_nop 15\n\ts_nop 7" : "+v"(SN0), "+v"(SN1)); } \
        float ma_ = -3.0e38f, mc_ = -3.0e38f; \
        _Pragma("unroll") for (int g = 0; g < 8; ++g) {             \
            const int ks = g >> 1; const bf16x8 pf = __builtin_bit_cast(bf16x8, pw[ks]); \
            if (g & 1) { const bf16x8 v1 = (bf16x8){vlo[4 + ks][0], vlo[4 + ks][1], vlo[4 + ks][2], vlo[4 + ks][3], vhi[4 + ks][0], vhi[4 + ks][1], vhi[4 + ks][2], vhi[4 + ks][3]}; o1 = MF(v1, pf, o1); } \
            else { const bf16x8 v0 = (bf16x8){vlo[ks][0], vlo[ks][1], vlo[ks][2], vlo[ks][3], vhi[ks][0], vhi[ks][1], vhi[ks][2], vhi[ks][3]}; o0 = MF(v0, pf, o0); } \
            if (hn_) { if (g < 4) { ma_ = max3f(ma_, SN0[4 * g], SN0[4 * g + 1]); mc_ = max3f(mc_, SN0[4 * g + 2], SN0[4 * g + 3]); } \
                       else { ma_ = max3f(ma_, SN1[4 * (g - 4)], SN1[4 * (g - 4) + 1]); mc_ = max3f(mc_, SN1[4 * (g - 4) + 2], SN1[4 * (g - 4) + 3]); } \
                       asm volatile("" : "+v"(ma_), "+v"(mc_)); } \
            SBAR(); } \
        if (hn_) ATT_DECIDE(SN0, SN1, max2f(ma_, mc_)); \
    } while (0)
    {
        int t = 0;
        for (; t + 2 < NT; t += 2) { ATT_STEP(sA0, sA1, sB0, sB1, t, true); ATT_STEP(sB0, sB1, sA0, sA1, t + 1, true); }
        if (t + 2 == NT) { ATT_STEP(sA0, sA1, sB0, sB1, t, true); ATT_STEP(sB0, sB1, sA0, sA1, t + 1, false); }
        else { ATT_STEP(sA0, sA1, sB0, sB1, t, false); }
    }
#undef ATT_STEP
#undef ATT_DECIDE
#undef ATT_MASK
#undef KFRAG
#undef MF
#undef SBAR
#undef ATT_TILE
#undef ATT_ISSUE
#undef ATT_WAIT
    if (wid >= 4) __builtin_amdgcn_s_setprio(0);
    ATT_BAR();
    float ltot = swapsum(l); if (GRP == 0) ltot += __builtin_amdgcn_exp2f(p.a_sink[h] * LOG2E - m);
    const float inv = 1.f / ltot;
    int lane_e = lane; asm volatile("" : "+v"(lane_e));
    const int r32e = lane_e & 31, hie = lane_e >> 5;
    LAS unsigned char* ost = lds + wid * OST_WAVE;
#pragma unroll
    for (int g = 0; g < 4; ++g) {
        v2u w0, w1;
        w0.x = cvtpk(o0[4 * g] * inv, o0[4 * g + 1] * inv); w0.y = cvtpk(o0[4 * g + 2] * inv, o0[4 * g + 3] * inv);
        w1.x = cvtpk(o1[4 * g] * inv, o1[4 * g + 1] * inv); w1.y = cvtpk(o1[4 * g + 2] * inv, o1[4 * g + 3] * inv);
        *(LAS v2u*)(ost + r32e * OST_PITCH + (8 * g + 4 * hie) * 2) = w0;
        *(LAS v2u*)(ost + r32e * OST_PITCH + (32 + 8 * g + 4 * hie) * 2) = w1;
    }
    asm volatile("s_waitcnt lgkmcnt(0)" ::: "memory");
    bf16* Ob = (bf16*)(p.ws + (ABL ? WS_OX : WS_O)) + ((size_t)b * T + q0w) * D + GRP * 512 + h * 64;
    float* ssq = (float*)(p.ws + (ABL ? 256 * MiB : WS_SSQ)) + ((size_t)b * T + q0w) * 16 + GRP * 8 + h;
#pragma unroll
    for (int i = 0; i < 4; ++i) {
        const int row = i * 8 + (lane_e >> 3), ch = lane_e & 7;
        const v4u v = *(const LAS v4u*)(ost + row * OST_PITCH + ch * 16);
        st16(Ob + (size_t)row * D + ch * 8, v);
        float ss = 0.f;
#pragma unroll
        for (int q = 0; q < 4; ++q) { const float a = __uint_as_float(v[q] << 16), c = __uint_as_float(v[q] & 0xffff0000u); ss += a * a + c * c; }
        ss += __shfl_xor(ss, 1); ss += __shfl_xor(ss, 2); ss += __shfl_xor(ss, 4);
        if (ch == 0) ssq[(size_t)row * 16] = ss;
    }
    asm volatile("s_waitcnt vmcnt(0) lgkmcnt(0)" ::: "memory");
    ATT_BAR();
#undef ATT_BAR
}
template <int ABL = 0>
__device__ __forceinline__ void attn_phase(const P& p, LAS unsigned char* lds, int vcu, int G) {
    if (ABL & 64) return;
    const int wid = __builtin_amdgcn_readfirstlane(threadIdx.x >> 6), lane = threadIdx.x & 63, gw = vcu * 8 + wid;
    WConv wc; wc.next = (WCONV_IN_ATTN && G * 8 == 2048 && ABL == 0) ? 0 : WC_PER_WAVE; wc.j0 = -1; wc.j1 = -1; wc.gstep = 0; wc.cm1 = 0; wc.cm2 = 0;
    for (int u = vcu; u < 512; u += G) attn_unit<1, ABL>(p, lds, (u >> 5) >> 1, (u >> 5) & 1, u & 31, wc, gw);
    for (int u = vcu; u < 512; u += G) attn_unit<0, ABL>(p, lds, (u >> 5) >> 1, (u >> 5) & 1, u & 31, wc, gw);
    if (WCONV_IN_ATTN && ABL == 0) {
        if (G * 8 == 2048) {
            if (wc.j0 >= 0) wc_consume(p, gw, wc.j0, lds + WC_LDS + wid * 8192, lane);
            if (wc.j1 >= 0) wc_consume(p, gw, wc.j1, lds + WC_LDS + wid * 8192 + 4096, lane);
            for (; wc.next < WC_PER_WAVE; ++wc.next) { asm volatile("s_waitcnt lgkmcnt(0)" ::: "memory"); wc_issue(p, gw, wc.next, (unsigned)(uintptr_t)lds + WC_LDS + wid * 8192, lane);
                asm volatile("s_waitcnt vmcnt(0)" ::: "memory"); wc_consume(p, gw, wc.next, lds + WC_LDS + wid * 8192, lane); }
        } else {
            for (int hx = gw; hx < 49152; hx += G * 8) { asm volatile("s_waitcnt lgkmcnt(0)" ::: "memory"); wc_issue(p, hx & 2047, hx >> 11, (unsigned)(uintptr_t)lds + WC_LDS + wid * 8192, lane);
                asm volatile("s_waitcnt vmcnt(0)" ::: "memory"); wc_consume(p, hx & 2047, hx >> 11, lds + WC_LDS + wid * 8192, lane); }
        }
    }
}
}

struct Frame {
    LAS unsigned char* lds;
    volatile LAS unsigned* MISC;
    int tid, lane, wave, vcu, G;
};

__device__ __forceinline__ void p0_transpose_item(const float* W, int N, bf16* WT, int dpitch, int drow0, int k0, int n0, LAS float* scr, int lane, const float* gain) {
#pragma unroll
    for (int i = 0; i < 32; ++i) { const int kk = 2 * i + (lane >> 5); float v = W[(size_t)(k0 + kk) * N + n0 + (lane & 31)]; if (gain) v *= gain[kk]; scr[kk * 33 + (lane & 31)] = v; }
    LDS_WAIT(); asm volatile("" ::: "memory");
    const int c = lane & 7;
#pragma unroll
    for (int j = 0; j < 4; ++j) { const int n = (lane >> 3) + 8 * j; const LAS float* s = scr + (8 * c) * 33 + n;
        v4u o; o.x = pk2(s[0 * 33], s[1 * 33]); o.y = pk2(s[2 * 33], s[3 * 33]); o.z = pk2(s[4 * 33], s[5 * 33]); o.w = pk2(s[6 * 33], s[7 * 33]);
        *(GAS v4u*)(WT + (size_t)(drow0 + n) * dpitch + k0 + 8 * c) = o; }
    LDS_WAIT(); asm volatile("" ::: "memory");
}
__device__ __forceinline__ void p0_prologue(const P& p, Frame& F) {
    float* modx = (float*)(p.ws + WS_MODX);
    if (F.vcu < 96) {
        LAS float* s = (LAS float*)F.lds;
        LAS float* part = (LAS float*)(F.lds + 40960);
        for (int i = F.tid; i < 9 * D; i += NTHR) { const int r = i >> 10, k = i & 1023; const float v = r < 8 ? p.c[r * D + k] : p.c_ctx[k]; s[i] = silu_f(v); }
        __syncthreads();
        const int n = F.vcu * 64 + F.lane; float acc[9];
#pragma unroll
        for (int r = 0; r < 9; ++r) acc[r] = 0.f;
        const float* wp = p.w_mod + (size_t)(F.wave * 128) * 6144 + n;
#pragma unroll 4
        for (int k4 = 0; k4 < 128; k4 += 4) {
            float wv[4];
#pragma unroll
            for (int j = 0; j < 4; ++j) wv[j] = wp[(size_t)(k4 + j) * 6144];
#pragma unroll
            for (int r = 0; r < 9; ++r) { const f32x4 sv = *(const LAS f32x4*)(s + r * D + F.wave * 128 + k4); acc[r] += sv.x * wv[0]; acc[r] += sv.y * wv[1]; acc[r] += sv.z * wv[2]; acc[r] += sv.w * wv[3]; }
        }
#pragma unroll
        for (int r = 0; r < 9; ++r) part[(F.wave * 9 + r) * 64 + F.lane] = acc[r];
        __syncthreads();
        for (int i = F.tid; i < 9 * 64; i += NTHR) { const int r = i >> 6, l = i & 63; float sum = 0.f;
#pragma unroll
            for (int w = 0; w < 8; ++w) sum += part[(w * 9 + r) * 64 + l];
            modx[r * 6144 + F.vcu * 64 + l] = sum + p.b_mod[F.vcu * 64 + l]; }
        __syncthreads();
    }
    if (F.vcu == 96) {
        float2* tab = (float2*)(p.ws + WS_ROPE);
        for (int idx = F.tid; idx < 96 * 16; idx += NTHR) {
            const int pos = idx >> 4, i = idx & 15;
            const float invf = exp2f(-(float)i * (13.287712379549449f / 16.f));
            const float pv = (float)(pos < 32 ? pos : pos - 32);
            float rev = pv * invf * 0.15915494309189535f; rev -= rintf(rev);
            tab[idx] = make_float2(__builtin_amdgcn_cosf(rev), __builtin_amdgcn_sinf(rev));
        }
    }
    for (int nb = F.vcu - 97; nb >= 0 && nb < 48; nb += F.G) {
        bf16* wr = (bf16*)(p.ws + WS_WR);
        for (int i = nb * 1024 + F.tid; i < (nb + 1) * 1024; i += NTHR) {
            const int j = i & 7, ln = (i >> 3) & 63, q = i >> 9, nt = q % 3, ks = q / 3;
            const int k = 32 * ks + 8 * (ln >> 4) + j, n = 16 * nt + (ln & 15);
            const float w = n < 4 ? p.w_group[k * 4 + n] : n < 36 ? p.w_router[k * 32 + (n - 4)] : 0.f;
            const unsigned hi = f2bf(w); const unsigned lo = f2bf(w - bf2f((bf16)hi));
            wr[i] = (bf16)hi; wr[48 * D + i] = (bf16)lo; }
    }
    LAS float* scr = (LAS float*)(F.lds + F.wave * 16384);
    const int gw = F.vcu * NWAVES + F.wave, NGW = F.G * NWAVES;
    constexpr int I_IN = 16 * 48, I_OUT = 16 * 32, I_G = 32 * 256, I_D = 32 * 256, NITEMS = WCONV_IN_ATTN ? I_IN + I_OUT : I_IN + I_OUT + 2 * I_G + I_D;
    for (int it = gw; it < NITEMS; it += NGW) {
        int r = it;
        if (r < I_IN) { const int kb = r / 48, nb = r % 48; p0_transpose_item(p.w_in, NQKV, (bf16*)(p.ws + WS_WQKV), D, qkv_row(nb * 32), kb * 64, nb * 32, scr, F.lane, nullptr); continue; } r -= I_IN;
        if (r < I_OUT) { const int kb = r / 32, nb = r % 32; const float* g = kb < 8 ? p.aon + kb * 64 : p.bon + (kb - 8) * 64;
            p0_transpose_item(p.w_out, D, (bf16*)(p.ws + WS_WO), D, nb * 32, kb * 64, nb * 32, scr, F.lane, g); continue; } r -= I_OUT;
        if (r < 2 * I_G) { const int up = r >= I_G; if (up) r -= I_G; const int e = r >> 8, q = r & 255, kb = q >> 4, nb = q & 15; const int j0 = nb * 32;
            p0_transpose_item((up ? p.w_up : p.w_gate) + (size_t)e * 1024 * 512, 512, (bf16*)(p.ws + WS_WGU) + (size_t)e * 1024 * 1024, D, (j0 >> 7) * 256 + up * 128 + (j0 & 127), kb * 64, j0, scr, F.lane, nullptr); continue; } r -= 2 * I_G;
        { const int e = r >> 8, q = r & 255, kb = q >> 5, nb = q & 31;
            p0_transpose_item(p.w_down + (size_t)e * 512 * 1024, D, (bf16*)(p.ws + WS_WD) + (size_t)e * 1024 * 512, EFF, nb * 32, kb * 64, nb * 32, scr, F.lane, nullptr); }
    }
}
__device__ __forceinline__ void p1_norm(const P& p, Frame& F) {
    const int gw = F.vcu * NWAVES + F.wave, NGW = F.G * NWAVES;
    const float* modall = (const float*)(p.ws + WS_MODX);
    for (int r = gw; r < MT; r += NGW) {
        const float* src = r < ML ? p.x + (size_t)r * D : p.ctx + (size_t)(r - ML) * D;
        const float* modx = modall + (r < ML ? (r / T) : 8) * 6144;
        const GAS f32x4* xr = (const GAS f32x4*)src + F.lane;
        f32x4 v[4]; float s = 0.f;
#pragma unroll
        for (int j = 0; j < 4; ++j) { v[j] = __builtin_nontemporal_load((const f32x4*)((const float*)src + 4 * (F.lane + 64 * j))); s += (v[j].x * v[j].x + v[j].y * v[j].y) + (v[j].z * v[j].z + v[j].w * v[j].w); }
        const float rn = rsqrtf(wave_sum(s) * (1.f / D) + EPS);
        GAS v2u* o8 = (GAS v2u*)((bf16*)(p.ws + WS_XN) + (size_t)r * D) + F.lane;
#pragma unroll
        for (int j = 0; j < 4; ++j) { const int k = 4 * (F.lane + 64 * j);
            const f32x4 g = *(const f32x4*)(p.pre1 + k), sc = *(const f32x4*)(modx + 1024 + k), sh = *(const f32x4*)(modx + k);
            const f32x4 h = v[j] * rn * g * (sc + 1.f) + sh;
            v2u w; w.x = pk2(h.x, h.y); w.y = pk2(h.z, h.w); st8((void*)(o8 + 64 * j), w); }
    }
}


constexpr int LDS_X = 147456;
__device__ __forceinline__ void p4_outproj(const P& p, Frame& F) {
    LAS float* tab = (LAS float*)(F.lds + LDS_X);
    for (int i = 0;; ++i) {
        const int L = i * F.G + (int)blockIdx.x; if (L >= 256) break;
        const int xcd = L & 7, off = L >> 3, w = xcd * 32 + off;
        pg8::Unit u; u.pm = (w >> 5) * 8 + (w & 7); u.pn = (w & 31) >> 3;
        if (F.tid < 256) {
            const f32x4* s4 = (const f32x4*)((const float*)(p.ws + WS_SSQ) + (size_t)(u.pm * 256 + F.tid) * 16);
            const f32x4 a0 = s4[0], a1 = s4[1], b0 = s4[2], b1 = s4[3];
            const float sa = ((a0.x + a0.y) + (a0.z + a0.w)) + ((a1.x + a1.y) + (a1.z + a1.w)), sb = ((b0.x + b0.y) + (b0.z + b0.w)) + ((b1.x + b1.y) + (b1.z + b1.w));
            const float ra = rsqrtf(sa * (1.f / 512.f) + EPS), rb = rsqrtf(sb * (1.f / 512.f) + EPS);
            tab[2 * F.tid] = ra / rb; tab[2 * F.tid + 1] = rb;
        }
        __syncthreads();
        pg8::Gemm g{(const pg8::bf16_t*)(p.ws + WS_O), (const pg8::bf16_t*)(p.ws + WS_WO), ML, D, D};
        pg8::SchedOne S{u};
        pg8::EpiOut E{(bf16*)(p.ws + WS_OX), tab};
        pg8::gemm_phase<pg8::EpiOut, pg8::SchedOne, false, true, false>((PG8_LAS unsigned char*)F.lds, g, S, E);
    }
}
constexpr int P5_PITCH = 2064;
constexpr int P5_PART = 64 * P5_PITCH, P5_LG = 0;
static_assert(P5_PART + 8 * 16 * 48 * 4 <= MISC_OFF && 64 * 48 * 4 <= P5_PART, "P5 LDS map");
__device__ __forceinline__ void p5_rowpass(const P& p, Frame& F, int abl = 0) {
    LAS unsigned char* LO = F.lds;
    LAS float* PART = (LAS float*)(F.lds + P5_PART); LAS float* LG = (LAS float*)(F.lds + P5_LG);
    LAS int* hist = (LAS int*)(F.lds + MISC_OFF) + 64;
    const bf16* WRh = (const bf16*)(p.ws + WS_WR); const bf16* WRl = WRh + 48 * D;
    for (int rb = F.vcu; rb < ML / 64; rb += F.G) {
        if (F.tid < 32) hist[F.tid] = 0;
        const int b = (rb * 64) / T;
        const float* modx = (const float*)(p.ws + WS_MODX) + b * 6144;
        if (!(abl & 2)) {
            f32x4 gp[4], mp[4], ap[4];
#pragma unroll
            for (int j = 0; j < 4; ++j) { const int k = 256 * j + 4 * F.lane;
                gp[j] = *(const f32x4*)(modx + 2048 + k) * *(const f32x4*)(p.post1 + k);
                mp[j] = *(const f32x4*)(p.pre2 + k) * (*(const f32x4*)(modx + 4096 + k) + 1.f);
                ap[j] = *(const f32x4*)(modx + 3072 + k); }
            f32x4 xn[4]; v2u on[4];
#define P5_LOAD(rw) do { _Pragma("unroll") for (int j = 0; j < 4; ++j) { xn[j] = *(const f32x4*)(p.x + (size_t)(rw) * D + 256 * j + 4 * F.lane); \
                on[j] = *(const v2u*)((const bf16*)(p.ws + WS_OX) + (size_t)(rw) * D + 256 * j + 4 * F.lane); } } while (0)
            P5_LOAD(rb * 64 + F.wave * 8);
            for (int rr = 0; rr < 8; ++rr) {
                const int rl = F.wave * 8 + rr, row = rb * 64 + rl;
                f32x4 xv[4], ox[4]; v2u oc[4]; float ss = 0.f;
#pragma unroll
                for (int j = 0; j < 4; ++j) { xv[j] = xn[j]; oc[j] = on[j]; }
                if (rr + 1 < 8) P5_LOAD(row + 1);
#pragma unroll
                for (int j = 0; j < 4; ++j) { const v2u o2 = oc[j];
                    ox[j] = (f32x4){__uint_as_float(o2.x << 16), __uint_as_float(o2.x & 0xffff0000u), __uint_as_float(o2.y << 16), __uint_as_float(o2.y & 0xffff0000u)};
                    ss += (ox[j].x * ox[j].x + ox[j].y * ox[j].y) + (ox[j].z * ox[j].z + ox[j].w * ox[j].w); }
                const float r1 = rsqrtf(wave_sum(ss) * (1.f / D) + EPS);
                float ss2 = 0.f;
#pragma unroll
                for (int j = 0; j < 4; ++j) { xv[j] = xv[j] + gp[j] * (ox[j] * r1);
                    ss2 += (xv[j].x * xv[j].x + xv[j].y * xv[j].y) + (xv[j].z * xv[j].z + xv[j].w * xv[j].w); }
                const float r2 = rsqrtf(wave_sum(ss2) * (1.f / D) + EPS);
                if (F.lane == 0) ((float*)(p.ws + WS_R1))[row] = r1;
#pragma unroll
                for (int j = 0; j < 4; ++j) {
                    const f32x4 h = xv[j] * r2 * mp[j] + ap[j];
                    v2u wh; wh.x = att::cvtpk(h.x, h.y); wh.y = att::cvtpk(h.z, h.w);
                    const f32x4 hb = (f32x4){__uint_as_float(wh.x << 16), __uint_as_float(wh.x & 0xffff0000u), __uint_as_float(wh.y << 16), __uint_as_float(wh.y & 0xffff0000u)};
                    const f32x4 dl = h - hb;
                    v2u wl; wl.x = att::cvtpk(dl.x, dl.y); wl.y = att::cvtpk(dl.z, dl.w);
                    st8((bf16*)(p.ws + WS_XN) + (size_t)row * D + 256 * j + 4 * F.lane, wh);
                    *(LAS v2u*)(LO + rl * P5_PITCH + (256 * j + 4 * F.lane) * 2) = wl;
                }
            }
#undef P5_LOAD
        }
        asm volatile("s_waitcnt vmcnt(0)" ::: "memory");
        __syncthreads();
        if (F.tid == 0) { __builtin_amdgcn_fence(__ATOMIC_ACQUIRE, "agent"); asm volatile("s_waitcnt vmcnt(0)" ::: "memory"); }
        __syncthreads();
        if (abl & 1) continue;
        {
            const int gI = F.wave >> 1, kq = F.wave & 1, r16 = F.lane & 15, g4 = F.lane >> 4;
            f32x4 acc[3];
#pragma unroll
            for (int nt = 0; nt < 3; ++nt) acc[nt] = (f32x4){0.f, 0.f, 0.f, 0.f};
            const bf16* ah = (const bf16*)(p.ws + WS_XN) + (size_t)(rb * 64 + 16 * gI + r16) * D + 512 * kq + 8 * g4;
            const LAS unsigned char* al = LO + (16 * gI + r16) * P5_PITCH + (512 * kq + 8 * g4) * 2;
            const bf16* bh = WRh + (size_t)(16 * kq) * 3 * 512 + F.lane * 8; const bf16* bl = WRl + (size_t)(16 * kq) * 3 * 512 + F.lane * 8;
#pragma unroll 8
            for (int ks = 0; ks < 16; ++ks) {
                const bf16x8 a_hi = *(const bf16x8*)(ah + ks * 32), a_lo = *(const LAS bf16x8*)(al + ks * 64);
#pragma unroll
                for (int nt = 0; nt < 3; ++nt) {
                    const bf16x8 b_hi = *(const bf16x8*)(bh + (ks * 3 + nt) * 512), b_lo = *(const bf16x8*)(bl + (ks * 3 + nt) * 512);
                    acc[nt] = __builtin_amdgcn_mfma_f32_16x16x32_bf16(a_hi, b_hi, acc[nt], 0, 0, 0);
                    acc[nt] = __builtin_amdgcn_mfma_f32_16x16x32_bf16(a_hi, b_lo, acc[nt], 0, 0, 0);
                    acc[nt] = __builtin_amdgcn_mfma_f32_16x16x32_bf16(a_lo, b_hi, acc[nt], 0, 0, 0);
                }
            }
#pragma unroll
            for (int nt = 0; nt < 3; ++nt)
#pragma unroll
                for (int q = 0; q < 4; ++q) PART[(F.wave * 16 + 4 * g4 + q) * 48 + 16 * nt + r16] = acc[nt][q];
        }
        __syncthreads();
        for (int i = F.tid; i < 64 * 48; i += NTHR) { const int row = i / 48, n = i - row * 48, gI = row >> 4, r16 = row & 15;
            LG[i] = (PART[((gI * 2 + 0) * 16 + r16) * 48 + n] + PART[((gI * 2 + 1) * 16 + r16) * 48 + n]) + (n < 4 ? p.b_group[n] : n < 36 ? p.b_router[n - 4] : 0.f); }
        __syncthreads();
        if (F.tid < 64) {
            float lg[36];
#pragma unroll
            for (int c = 0; c < 36; ++c) lg[c] = LG[F.tid * 48 + c];
            int e1, e2; float w1, w2;
            {
                int g = 0; float gm = lg[0];
#pragma unroll
                for (int q = 1; q < 4; ++q) if (lg[q] > gm) { gm = lg[q]; g = q; }
                float gs = 0.f;
#pragma unroll
                for (int q = 0; q < 4; ++q) gs += __expf(lg[q] - gm);
                const float gw = 1.f / gs;
                float el[8];
#pragma unroll
                for (int q = 0; q < 8; ++q) el[q] = g == 0 ? lg[4 + q] : g == 1 ? lg[12 + q] : g == 2 ? lg[20 + q] : lg[28 + q];
                int i1 = 0; float m1 = el[0];
#pragma unroll
                for (int q = 1; q < 8; ++q) if (el[q] > m1) { m1 = el[q]; i1 = q; }
                int i2 = -1; float m2 = -3.0e38f;
#pragma unroll
                for (int q = 0; q < 8; ++q) if (q != i1 && el[q] > m2) { m2 = el[q]; i2 = q; }
                const float ex = __expf(m2 - m1);
                w1 = gw / (1.f + ex); w2 = gw * ex / (1.f + ex); e1 = g * 8 + i1; e2 = g * 8 + i2;
            }
            const int row = rb * 64 + F.tid;
            if (!(abl & 2)) { int* te = (int*)(p.ws + WS_TOKE) + row * 2; float* tw = (float*)(p.ws + WS_TOKW) + row * 2; te[0] = e1; te[1] = e2; tw[0] = w1; tw[1] = w2; }
            atomicAdd((int*)&hist[e1 & 31], 1); atomicAdd((int*)&hist[e2 & 31], 1);
        }
        __syncthreads();
        if (F.tid < 32 && !(abl & 2)) ((int*)(p.ws + WS_BLKCNT))[rb * 32 + F.tid] = hist[F.tid];
        __syncthreads();
    }
}
__device__ __forceinline__ void p6_lists(const P& p, Frame& F) {
    LAS int* ps = (LAS int*)F.lds;
    LAS int* pp = ps + 512;
    LAS int* tot = pp + 512; LAS int* pre = tot + 32; LAS int* ebase = pre + 32;
    LAS int* es = ebase + 40;
    const int* blk = (const int*)(p.ws + WS_BLKCNT);
    int* meta = (int*)(p.ws + WS_META);
    for (int rb = F.vcu; rb < ML / 64; rb += F.G) {
        { const int e = F.tid & 31, part = F.tid >> 5; int s = 0, q = 0;
#pragma unroll 4
          for (int j = 0; j < 16; ++j) { const int bb = part * 16 + j; const int v = blk[bb * 32 + e]; s += v; q += bb < rb ? v : 0; }
          ps[part * 32 + e] = s; pp[part * 32 + e] = q; }
        __syncthreads();
        if (F.tid < 32) { int s = 0, q = 0;
#pragma unroll
            for (int part = 0; part < 16; ++part) { s += ps[part * 32 + F.tid]; q += pp[part * 32 + F.tid]; }
            tot[F.tid] = s; pre[F.tid] = q; }
        __syncthreads();
        if (F.tid == 0) { int tb = 0; for (int e = 0; e < 32; ++e) { ebase[e] = tb; tb += (tot[e] + 255) >> 8; } ebase[32] = tb; }
        if (F.tid < 128) es[F.tid] = ((const int*)(p.ws + WS_TOKE))[rb * 128 + F.tid];
        __syncthreads();
        if (F.tid < 128) {
            const int e = es[F.tid]; int rank = 0;
            for (int a = 0; a < F.tid; ++a) rank += es[a] == e ? 1 : 0;
            const int pos = ebase[e] * 256 + pre[e] + rank;
            ((int*)(p.ws + WS_ROWIDX))[pos] = rb * 64 + (F.tid >> 1);
            ((float*)(p.ws + WS_ROWW))[pos] = ((const float*)(p.ws + WS_TOKW))[rb * 128 + F.tid];
            ((int*)(p.ws + WS_TOKPOS))[rb * 128 + F.tid] = pos;
        }
        if (rb < 32) {
            const int e = rb, lo = ebase[e] * 256 + tot[e], hi = ebase[e + 1] * 256;
            for (int pos = lo + F.tid; pos < hi; pos += NTHR) { ((int*)(p.ws + WS_ROWIDX))[pos] = 0; ((float*)(p.ws + WS_ROWW))[pos] = 0.f; }
            for (int t = ebase[e] + F.tid; t < ebase[e + 1]; t += NTHR) meta[128 + t] = e;
            if (F.tid == 0) { meta[e] = tot[e]; meta[64 + e] = ebase[e]; if (e == 31) { meta[64 + 32] = ebase[32]; meta[320] = ebase[32]; } }
        }
        __syncthreads();
    }
}
__device__ __forceinline__ void p78_moe(const P& p, Frame& F, bool down) {
    LAS int* tile_e = (LAS int*)(F.lds + LDS_X);
    const int* meta = (const int*)(p.ws + WS_META);
    for (int t = F.tid; t < MAXTILES; t += NTHR) tile_e[t] = meta[128 + t] & 31;
    __syncthreads();
    const int ntiles = meta[320];
    pg8::SchedMoE S{F.G, (int)blockIdx.x, ntiles * 4, tile_e, (const int*)(p.ws + WS_ROWIDX)};
    if (!down) {
        pg8::Gemm g{(const pg8::bf16_t*)(p.ws + WS_XN), (const pg8::bf16_t*)(p.ws + WS_WGU), MAXPOS, NE * 1024, D};
        pg8::EpiGU E{(bf16*)(p.ws + WS_ACT), (const float*)(p.ws + WS_ROWW)};
        pg8::gemm_phase<pg8::EpiGU, pg8::SchedMoE, true, true, true>((PG8_LAS unsigned char*)F.lds, g, S, E);
    } else {
        pg8::Gemm g{(const pg8::bf16_t*)(p.ws + WS_ACT), (const pg8::bf16_t*)(p.ws + WS_WD), MAXPOS, NE * 1024, EFF};
        pg8::EpiY E{(bf16*)(p.ws + WS_Y)};
        pg8::gemm_phase<pg8::EpiY, pg8::SchedMoE, true, true, false>((PG8_LAS unsigned char*)F.lds, g, S, E);
    }
}
__device__ __forceinline__ void p9_final(const P& p, Frame& F, float* dst) {
    const bf16* Y = (const bf16*)(p.ws + WS_Y); const bf16* OX = (const bf16*)(p.ws + WS_OX); const float* R1 = (const float*)(p.ws + WS_R1);
    for (int rb = F.vcu; rb < ML / 64; rb += F.G) {
        const int b = (rb * 64) / T;
        const float* modx = (const float*)(p.ws + WS_MODX) + b * 6144;
        const int row0 = rb * 64 + F.wave * 8;
        f32x4 gp[4], g1p[4];
#pragma unroll
        for (int j = 0; j < 4; ++j) { const int k = 256 * j + 4 * F.lane; gp[j] = *(const f32x4*)(modx + 5120 + k) * *(const f32x4*)(p.post2 + k); g1p[j] = *(const f32x4*)(modx + 2048 + k) * *(const f32x4*)(p.post1 + k); }
        v2u ya[2][4], yc[2][4], oo[2][4]; f32x4 xo[2][4]; float r1v[2];
        const int* tpp = (const int*)(p.ws + WS_TOKPOS) + row0 * 2;
#define P9_LOAD(buf, rw, t2) do { r1v[buf] = R1[rw]; _Pragma("unroll") for (int j = 0; j < 4; ++j) { \
            ya[buf][j] = __builtin_nontemporal_load((const v2u*)(Y + (size_t)(t2).x * D + 256 * j + 4 * F.lane)); yc[buf][j] = __builtin_nontemporal_load((const v2u*)(Y + (size_t)(t2).y * D + 256 * j + 4 * F.lane)); \
            oo[buf][j] = __builtin_nontemporal_load((const v2u*)(OX + (size_t)(rw) * D + 256 * j + 4 * F.lane)); xo[buf][j] = __builtin_nontemporal_load((const f32x4*)(p.x + (size_t)(rw) * D + 256 * j + 4 * F.lane)); } } while (0)
#define P9_COMP(buf, rw) do { f32x4 y[4]; float ss = 0.f; \
            _Pragma("unroll") for (int j = 0; j < 4; ++j) { const v2u a = ya[buf][j], c = yc[buf][j]; \
                y[j] = (f32x4){__uint_as_float(a.x << 16) + __uint_as_float(c.x << 16), __uint_as_float(a.x & 0xffff0000u) + __uint_as_float(c.x & 0xffff0000u), \
                               __uint_as_float(a.y << 16) + __uint_as_float(c.y << 16), __uint_as_float(a.y & 0xffff0000u) + __uint_as_float(c.y & 0xffff0000u)}; \
                ss += (y[j].x * y[j].x + y[j].y * y[j].y) + (y[j].z * y[j].z + y[j].w * y[j].w); } \
            const float rn = rsqrtf(wave_sum(ss) * (1.f / D) + EPS); \
            _Pragma("unroll") for (int j = 0; j < 4; ++j) { const v2u o2 = oo[buf][j]; \
                const f32x4 oxv = (f32x4){__uint_as_float(o2.x << 16), __uint_as_float(o2.x & 0xffff0000u), __uint_as_float(o2.y << 16), __uint_as_float(o2.y & 0xffff0000u)}; \
                const f32x4 x1 = xo[buf][j] + g1p[j] * (oxv * r1v[buf]);                   \
                __builtin_nontemporal_store(x1 + gp[j] * (y[j] * rn), (f32x4*)(dst + (size_t)(rw) * D + 256 * j + 4 * F.lane)); } } while (0)
        int2 tpA = *(const int2*)(tpp), tpB = *(const int2*)(tpp + 2);
        P9_LOAD(0, row0, tpA);
#pragma unroll 1
        for (int rp = 0; rp < 4; ++rp) {
            const int ra = row0 + 2 * rp;
            P9_LOAD(1, ra + 1, tpB);
            int2 tpA2 = tpA, tpB2 = tpB;
            if (rp < 3) { tpA2 = *(const int2*)(tpp + 4 * rp + 4); tpB2 = *(const int2*)(tpp + 4 * rp + 6); }
            P9_COMP(0, ra);
            if (rp < 3) P9_LOAD(0, ra + 2, tpA2);
            P9_COMP(1, ra + 1);
            tpA = tpA2; tpB = tpB2;
        }
#undef P9_COMP
#undef P9_LOAD
    }
}

struct Args { P p; int ph_lo, ph_hi, li, pad; };
__global__ void __launch_bounds__(NTHR, 2) mega(Args args) {
    extern __shared__ __attribute__((aligned(16))) unsigned char lds_raw[];
    Frame F;
    F.lds = (LAS unsigned char*)lds_raw;
    F.MISC = (volatile LAS unsigned*)(F.lds + MISC_OFF);
    F.tid = threadIdx.x; F.lane = F.tid & 63; F.wave = __builtin_amdgcn_readfirstlane(F.tid >> 6);
    F.G = gridDim.x; { const int bx = blockIdx.x; F.vcu = (F.G % 8 == 0) ? (bx % 8) * (F.G / 8) + bx / 8 : bx; }
    const P& p = args.p;
    unsigned* ctl = (unsigned*)(p.ws + WS_CTL);
    for (int u = F.tid; u < (LDS_BYTES - MISC_OFF) / 4; u += NTHR) ((LAS unsigned*)(F.lds + MISC_OFF))[u] = 0u;
    __syncthreads();
    const int lo = args.ph_lo, hi = args.ph_hi;
    XcdBarrier bar; bar.bar = ctl + CW_BAR + args.li * XCD_BAR_WORDS; bar.x = 0; bar.st = nullptr;
    if (hi - lo > 1) bar = xcd_barrier_post(ctl + CW_BAR + args.li * XCD_BAR_WORDS, F.MISC + 8);
#define IN(k) (lo <= (k) && (k) < hi)
#define SEAM(k) do { if (IN(k) && IN((k) + 1)) xcd_barrier(bar); } while (0)
    if (IN(0)) { p0_prologue(p, F); SEAM(0); }
    if (IN(1)) { p1_norm(p, F); SEAM(1); }
    if (IN(2)) {
        pg8::Gemm g{(const pg8::bf16_t*)(p.ws + WS_XN), (const pg8::bf16_t*)(p.ws + WS_WQKV), MT, NQKV, D};
        pg8::SchedQKV S{F.G, (int)blockIdx.x};
        pg8::EpiQKV E{p.ws, p.bqn, p.bkn};
        pg8::gemm_phase<pg8::EpiQKV, pg8::SchedQKV, true, true, false>((PG8_LAS unsigned char*)F.lds, g, S, E);
        SEAM(2);
    }
#ifdef PROBE_ABL
    if (IN(3) && args.pad) { att::attn_phase<PROBE_ABL>(p, F.lds, F.vcu, F.G); } else
#endif
    if (IN(3)) { att::attn_phase<0>(p, F.lds, F.vcu, F.G); SEAM(3); }
    if (IN(4)) { p4_outproj(p, F); SEAM(4); }
#ifdef PROBE_ABL5
    if (IN(5) && args.pad) { p5_rowpass(p, F, PROBE_ABL5); } else
#endif
    if (IN(5)) { p5_rowpass(p, F); SEAM(5); }
    if (IN(6)) { p6_lists(p, F); SEAM(6); }
    if (IN(7)) { p78_moe(p, F, false); SEAM(7); }
    if (IN(8)) { p78_moe(p, F, true); SEAM(8); }
    if (IN(9)) { p9_final(p, F, args.pad ? (float*)(p.ws + WS_WGU) : p.out); }
#undef IN
#undef SEAM
}

#ifndef ONE_LAUNCH
#define ONE_LAUNCH 1
#endif
#ifndef FAST_MASK
#define FAST_MASK 0x3ff
#endif
static void launch_mega(const P& p, int lo, int hi, int li, int grid, hipStream_t stream) {
    Args a{}; a.p = p; a.ph_lo = lo; a.ph_hi = hi; a.li = li; a.pad = 0;
    hipLaunchKernelGGL(mega, dim3(grid), dim3(NTHR), LDS_BYTES, stream, a);
}
extern "C" void kernel_launch(void* const* d_in, const int* in_sizes, int n_in, void* d_out, int out_size, void* d_ws, size_t ws_size, hipStream_t stream) {
    static int grid = 0;
    if (grid == 0) {
        if (n_in != 24 || out_size != ML * D || ws_size < WS_END) { fprintf(stderr, "kernel_launch: unexpected shapes (n_in %d out %d ws %zu)\n", n_in, out_size, ws_size); grid = -1; return; }
        int dev = 0, cus = 0, per_cu = 0;
        if (hipGetDevice(&dev) != hipSuccess || hipDeviceGetAttribute(&cus, hipDeviceAttributeMultiprocessorCount, dev) != hipSuccess) { grid = -1; return; }
        if (hipFuncSetAttribute((const void*)mega, hipFuncAttributeMaxDynamicSharedMemorySize, LDS_BYTES) != hipSuccess) { fprintf(stderr, "kernel_launch: hipFuncSetAttribute failed\n"); grid = -1; return; }
        if (hipOccupancyMaxActiveBlocksPerMultiprocessor(&per_cu, (const void*)mega, NTHR, LDS_BYTES) != hipSuccess || per_cu < 1) { fprintf(stderr, "kernel_launch: occupancy query says %d blocks/CU\n", per_cu); (void)hipGetLastError(); grid = -1; return; }
        grid = cus;
    }
    if (grid < 0) return;
    P p{};
    const float** f = (const float**)&p;
    for (int i = 0; i < 24; ++i) f[i] = (const float*)d_in[i];
    p.out = (float*)d_out; p.ws = (unsigned char*)d_ws;
    (void)hipMemsetAsync((char*)d_ws + WS_CTL, 0, 64 * 1024, stream);
#if ONE_LAUNCH
    launch_mega(p, 0, 10, 0, grid, stream);
#else
    for (int k = 0; k < 10; ++k) {
        launch_mega(p, k, k + 1, 0, grid, stream);
#ifdef PROBE_DUP
        if (k == PROBE_DUP) for (int r_ = 0; r_ < 3; ++r_) { Args a{}; a.p = p; a.ph_lo = k; a.ph_hi = k + 1; a.li = 0; a.pad = 1; hipLaunchKernelGGL(mega, dim3(grid), dim3(NTHR), LDS_BYTES, stream, a); }
#endif
    }
#endif
}
```

```cpp
#include <hip/hip_runtime.h>
#include <cstdio>
#include <cstdint>
#ifndef WCONV_IN_ATTN
#define WCONV_IN_ATTN 1
#endif

constexpr int NB = 8, T = 2048, D = 1024, CL = 256;
constexpr int ML = NB * T;
constexpr int MC = NB * CL;
constexpr int MT = ML + MC;
constexpr int NKEY = T + CL;
constexpr int NTILE = NKEY / 64;
constexpr int NQKV = 1536;
constexpr int NE = 32, EFF = 512;
constexpr int MAXPOS = 40960;
constexpr int MAXTILES = MAXPOS / 256;
constexpr float EPS = 1e-6f;
constexpr float LOG2E = 1.4426950408889634f;
constexpr float C2 = 0.125f * LOG2E;

typedef unsigned short bf16;

constexpr size_t MiB = 1u << 20;
constexpr size_t WS_CTL = 0;
constexpr size_t WS_MODX = 1 * MiB;
constexpr size_t WS_ROPE = 1 * MiB + 512 * 1024;
constexpr size_t WS_WR = 1 * MiB + 768 * 1024;
constexpr size_t WS_TOKE = 2 * MiB;
constexpr size_t WS_TOKW = WS_TOKE + 128 * 1024;
constexpr size_t WS_TOKPOS = WS_TOKW + 128 * 1024;
constexpr size_t WS_ROWIDX = WS_TOKPOS + 128 * 1024;
constexpr size_t WS_ROWW = WS_ROWIDX + 160 * 1024;
constexpr size_t WS_BLKCNT = WS_ROWW + 160 * 1024;
constexpr size_t WS_META = WS_BLKCNT + 32 * 1024;
constexpr size_t WS_WQKV = 4 * MiB;
constexpr size_t WS_WO = 7 * MiB;
constexpr size_t WS_WGU = 9 * MiB;
constexpr size_t WS_WD = 73 * MiB;
constexpr size_t WS_XN = 105 * MiB;
constexpr size_t WS_QA = 141 * MiB;
constexpr size_t WS_QB = 157 * MiB;
constexpr size_t WS_KA = 173 * MiB;
constexpr size_t WS_VA = WS_KA + 4608 * 1024;
constexpr size_t WS_KB = WS_VA + 4608 * 1024;
constexpr size_t WS_VB = WS_KB + 4608 * 1024;
constexpr size_t WS_O = 191 * MiB;
constexpr size_t WS_SSQ = 223 * MiB;
constexpr size_t WS_OX = 261 * MiB;
constexpr size_t WS_R1 = 293 * MiB;
constexpr size_t WS_ACT = 141 * MiB;
constexpr size_t WS_Y = 181 * MiB;
constexpr size_t WS_END = 294 * MiB;

__device__ __forceinline__ unsigned f2bf(float f) { unsigned u = __builtin_bit_cast(unsigned, f); return (u + 0x7fffu + ((u >> 16) & 1u)) >> 16; }
__device__ __forceinline__ float bf2f(bf16 h) { return __builtin_bit_cast(float, (unsigned)h << 16); }
__device__ __forceinline__ float dpp_add(float v, const int ctrl_sel) {
    const int x = __builtin_bit_cast(int, v); int y;
    switch (ctrl_sel) { case 0: y = __builtin_amdgcn_update_dpp(x, x, 0xB1, 0xF, 0xF, false); break;
                        case 1: y = __builtin_amdgcn_update_dpp(x, x, 0x4E, 0xF, 0xF, false); break;
                        case 2: y = __builtin_amdgcn_update_dpp(x, x, 0x141, 0xF, 0xF, false); break;
                        default: y = __builtin_amdgcn_update_dpp(x, x, 0x140, 0xF, 0xF, false); break; }
    return v + __builtin_bit_cast(float, y);
}
__device__ __forceinline__ float wave_sum(float v) {
    v = dpp_add(v, 0); v = dpp_add(v, 1); v = dpp_add(v, 2); v = dpp_add(v, 3);
    const int x = __builtin_bit_cast(int, v);
    const float r0 = __builtin_bit_cast(float, __builtin_amdgcn_readlane(x, 0)), r1 = __builtin_bit_cast(float, __builtin_amdgcn_readlane(x, 16));
    const float r2 = __builtin_bit_cast(float, __builtin_amdgcn_readlane(x, 32)), r3 = __builtin_bit_cast(float, __builtin_amdgcn_readlane(x, 48));
    return (r0 + r1) + (r2 + r3);
}
__device__ __forceinline__ float wave_max(float v) {
#pragma unroll
    for (int o = 1; o < 64; o <<= 1) v = fmaxf(v, __shfl_xor(v, o));
    return v;
}
__device__ __forceinline__ float silu_f(float v) { return v / (1.f + __expf(-v)); }

__host__ __device__ __forceinline__ int qkv_row(int n) { const int pn = n >> 8, j = n & 255, hh = j >> 6, d = j & 63; return pn * 256 + (d >> 5) * 128 + hh * 32 + (d & 31); }
__host__ __device__ __forceinline__ size_t q_off(int b, int h, int t, int d) { return (((size_t)(b * 8 + h) * T + t) * 64 + d); }
__host__ __device__ __forceinline__ size_t k_off(int b, int kvh, int pos, int d) { return ((size_t)((b * 2 + kvh) * NTILE + (pos >> 6)) * 4096 + (d >> 3) * 512 + (pos & 63) * 8 + (d & 7)); }
__host__ __device__ __forceinline__ size_t v_off(int b, int kvh, int pos, int d) { return ((size_t)((b * 2 + kvh) * NTILE + (pos >> 6)) * 4096 + (d >> 5) * 2048 + (pos & 63) * 32 + (d & 31)); }

struct P {
    const float *x, *c, *ctx, *c_ctx, *w_mod, *b_mod, *pre1, *post1, *w_in, *a_sink, *bqn, *bkn, *aon, *bon, *w_out, *pre2, *post2, *w_group, *b_group, *w_router, *b_router, *w_gate, *w_up, *w_down;
    float* out; unsigned char* ws;
};

#define GAS __attribute__((address_space(1)))
#define LAS __attribute__((address_space(3)))
typedef unsigned v4u __attribute__((ext_vector_type(4)));
typedef unsigned v2u __attribute__((ext_vector_type(2)));
typedef float f32x4 __attribute__((ext_vector_type(4)));
typedef float f32x16 __attribute__((ext_vector_type(16)));
typedef short bf16x8 __attribute__((ext_vector_type(8)));
typedef short s16x4 __attribute__((ext_vector_type(4)));
constexpr int NWAVES = 8, NTHR = 512;
constexpr int LDS_BYTES = 163840;
constexpr int RING_BYTES = 131072;
constexpr int MISC_OFF = 159 * 1024;
constexpr int CW_TMO = 0, CW_CODE = 1, CW_BAR = 4096;
static_assert((CW_BAR + 3456) * 4 <= 64 * 1024, "control words inside the per-call memset");
#define LDS_WAIT() asm volatile("s_waitcnt lgkmcnt(0)" ::: "memory")
#define VM_WAIT() asm volatile("s_waitcnt vmcnt(0)" ::: "memory")
__device__ __forceinline__ unsigned pk2(float lo, float hi) { return f2bf(lo) | (f2bf(hi) << 16); }
#ifndef WT_STORES
#define WT_STORES 0
#endif
__device__ __forceinline__ void st16(void* p, v4u v) {
#if WT_STORES
    asm volatile("global_store_dwordx4 %0, %1, off sc1\n\ts_nop 1" :: "v"(p), "v"(v) : "memory");
#else
    *(v4u*)p = v;
#endif
}
__device__ __forceinline__ void st16f(void* p, f32x4 v) { st16(p, __builtin_bit_cast(v4u, v)); }
__device__ __forceinline__ void st8(void* p, v2u v) {
#if WT_STORES
    asm volatile("global_store_dwordx2 %0, %1, off sc1\n\ts_nop 1" :: "v"(p), "v"(v) : "memory");
#else
    *(v2u*)p = v;
#endif
}

#define XB_TMO      128
#define XB_XCNT(j)  (256  + 64 * (j))
#define XB_XSUB(j)  (1280 + 64 * (j))
#define XB_XGEN(j)  (2304 + 64 * (j))
#define XB_TOP      3328
#define XB_TOPGEN   3392
#define XCD_BAR_WORDS 3456
#define XB_SPIN_CAP (1u << 18)
__device__ __forceinline__ unsigned xb_ld(unsigned* p)              { return __hip_atomic_load(p, __ATOMIC_RELAXED, __HIP_MEMORY_SCOPE_AGENT); }
__device__ __forceinline__ unsigned xb_add(unsigned* p, unsigned v) { return __hip_atomic_fetch_add(p, v, __ATOMIC_RELAXED, __HIP_MEMORY_SCOPE_AGENT); }
__device__ __forceinline__ unsigned xb_xcc_id() { return (unsigned)__builtin_amdgcn_s_getreg((3 << 11) | 20) & 0xFu; }
#define XB_SPIN(cond, bar) do { unsigned _sp = 0; while (cond) { __builtin_amdgcn_s_sleep(1); \
    if ((++_sp & 255u) == 0u) { if (xb_ld(&(bar)[XB_TMO])) break; if (_sp > XB_SPIN_CAP) { atomicAdd(&(bar)[XB_TMO], 1u); break; } } } } while (0)
struct XcdBarrier { unsigned* bar; unsigned x; volatile LAS unsigned* st; };
__device__ __forceinline__ XcdBarrier xcd_barrier_post(unsigned* bar, volatile LAS unsigned* st) {
    XcdBarrier b; b.bar = bar; b.x = xb_xcc_id(); b.st = st;
    if (threadIdx.x == 0) (void)xb_add(&bar[XB_XCNT(b.x)], 1u);
    return b;
}
__device__ __forceinline__ void xcd_barrier_complete(unsigned* bar, unsigned x, unsigned& nloc, unsigned& nx) {
    const unsigned G = gridDim.x * gridDim.y * gridDim.z;
    unsigned sum, cnt, mine, sp = 0u;
    for (;;) {
        sum = 0u; cnt = 0u; mine = 0u;
#pragma unroll
        for (unsigned j = 0; j < 16; ++j) { const unsigned c = xb_ld(&bar[XB_XCNT(j)]); sum += c; cnt += (c > 0u) ? 1u : 0u; mine = (j == x) ? c : mine; }
        if (sum == G) break;
        __builtin_amdgcn_s_sleep(1);
        if ((++sp & 255u) == 0u) { if (xb_ld(&bar[XB_TMO])) break; if (sp > XB_SPIN_CAP) { atomicAdd(&bar[XB_TMO], 1u); break; } }
    }
    nloc = mine > 0u ? mine : 1u; nx = cnt > 0u ? cnt : 1u;
}
__device__ __forceinline__ void xcd_barrier(const XcdBarrier& b) {
    asm volatile("s_waitcnt vmcnt(0)" ::: "memory");
    __syncthreads();
    if (threadIdx.x == 0) {
        unsigned* bar = b.bar;
        __builtin_amdgcn_s_waitcnt(0);
        unsigned nloc = b.st[0], nx = b.st[1];
        if (nloc == 0u) { xcd_barrier_complete(bar, b.x, nloc, nx); b.st[0] = nloc; b.st[1] = nx; }
        const unsigned old = xb_add(&bar[XB_XSUB(b.x)], 1u);
        const unsigned gen = old / nloc;
        if (old + 1u == (gen + 1u) * nloc) {
            __builtin_amdgcn_fence(__ATOMIC_RELEASE, "agent");
            asm volatile("s_waitcnt vmcnt(0)" ::: "memory");
            const unsigned og = xb_add(&bar[XB_TOP], 1u);
            const unsigned tg = og / nx;
            if (og + 1u == (tg + 1u) * nx) xb_add(&bar[XB_TOPGEN], 1u);
            else XB_SPIN(xb_ld(&bar[XB_TOPGEN]) == tg, bar);
            __builtin_amdgcn_fence(__ATOMIC_ACQUIRE, "agent");
            xb_add(&bar[XB_XGEN(b.x)], 1u);
            asm volatile("s_waitcnt vmcnt(0)" ::: "memory");
        } else {
            XB_SPIN(xb_ld(&bar[XB_XGEN(b.x)]) == gen, bar);
            __builtin_amdgcn_fence(__ATOMIC_ACQUIRE, "agent");
            asm volatile("s_waitcnt vmcnt(0)" ::: "memory");
        }
    }
    __syncthreads();
}

namespace pg8 {
#define PG8_LAS __attribute__((address_space(3)))
typedef unsigned short bf16_t;
typedef short bf16x8 __attribute__((ext_vector_type(8)));
typedef float f32x4 __attribute__((ext_vector_type(4)));
typedef unsigned u32x4 __attribute__((ext_vector_type(4)));
constexpr int BM = 256, BK = 64, HALF = 128, HTB = HALF * BK * 2  , STAGE_BYTES = 8 * HTB, NXCD = 8, WGM = 8;

__host__ __device__ __forceinline__ int lds_byte(int r, int c) { const int st = (r >> 4) * 2 + (c >> 5), rr = r & 15, cc = c & 31, ob = rr * 64 + cc * 2; return st * 1024 + (ob ^ (((ob >> 9) & 1) << 5)); }
__host__ __device__ __forceinline__ void stage_rc(int b, int& R, int& C) { const int st = b / 1024, sb = b % 1024, swz = sb ^ (((sb >> 9) & 1) << 5); R = (st >> 1) * 16 + swz / 64; C = (st & 1) * 32 + (swz % 64) / 2; }
__host__ __device__ __forceinline__ int perm32(int rho) { const int n = rho >> 4, i = rho & 15; return 8 * (i >> 2) + 4 * n + (i & 3); }

struct Unit { int pm, pn; };
struct Gemm { const bf16_t* A; const bf16_t* Bt; int M, N, K; };
__device__ __forceinline__ unsigned cvt_pk_bf16(float lo, float hi) { unsigned r; asm volatile("v_cvt_pk_bf16_f32 %0, %1, %2" : "=v"(r) : "v"(lo), "v"(hi)); return r; }
template <class Epi, class Sched, bool ALIGN_EPI = false, bool SP2 = false, bool GATHER = false>
__device__ __forceinline__ void gemm_phase(PG8_LAS unsigned char* lds, const Gemm g, const Sched& S, const Epi& E) {
    const int tid = threadIdx.x, wid = __builtin_amdgcn_readfirstlane(tid >> 6), lane = tid & 63, wr = wid >> 2, wc = wid & 3, fr = lane & 15, fq = lane >> 4;
    const int K = g.K, nt = K / BK;
    unsigned voffA[2], voffB[2]; int RA[2], CA[2];
#pragma unroll
    for (int i = 0; i < 2; ++i) { int R, C; stage_rc(tid * 16 + i * 8192, R, C); const int Rb = Epi::PERM ? ((R & ~31) + perm32(R & 31)) : R;
        voffA[i] = (unsigned)(R * K + C) * 2u; voffB[i] = (unsigned)(Rb * K + C) * 2u; RA[i] = R; CA[i] = C; }
    const size_t kstep = (size_t)(BK * 2);
    const size_t hstep = (size_t)HALF * K * 2;
    const size_t tstep = 2 * hstep;
    const unsigned ldsw = (unsigned)wid * 1024u;
    const int aoff = lds_byte(wr * 64 + fr, fq * 8), boff = lds_byte(wc * 32 + fr, fq * 8);
#define PG8_SA(b, h) (((b) * 2 + (h)) * HTB)
#define PG8_SB(b, h) ((4 + (b) * 2 + (h)) * HTB)
#define PG8_STAGE(bufoff, gbase, voff) do { _Pragma("unroll") for (int _i = 0; _i < 2; ++_i) \
        __builtin_amdgcn_global_load_lds((const unsigned*)((const char*)(gbase) + (voff)[_i]), (PG8_LAS unsigned*)(lds + (bufoff) + ldsw + _i * 8192), 16, 0, 0); } while (0)
#define PG8_STAGE_A(bufoff, gbase, h, VO) do { if constexpr (GATHER) { PG8_STAGE(bufoff, gbase, VO[h]); } else { PG8_STAGE(bufoff, (gbase) + (h) * hstep, voffA); } } while (0)
#define PG8_LDA(dst, b, h) do { _Pragma("unroll") for (int m = 0; m < 4; ++m) _Pragma("unroll") for (int k = 0; k < 2; ++k) dst[m][k] = *(const PG8_LAS bf16x8*)(lds + PG8_SA(b, h) + aoff + m * 2048 + k * 1024); } while (0)
#define PG8_LDB(dst, b, h) do { _Pragma("unroll") for (int n = 0; n < 2; ++n) _Pragma("unroll") for (int k = 0; k < 2; ++k) dst[n][k] = *(const PG8_LAS bf16x8*)(lds + PG8_SB(b, h) + boff + n * 2048 + k * 1024); } while (0)
#define PG8_MMA(ai, bj, At, Bt) do { __builtin_amdgcn_s_setprio(1); _Pragma("unroll") for (int m = 0; m < 4; ++m) _Pragma("unroll") for (int n = 0; n < 2; ++n) _Pragma("unroll") for (int k = 0; k < 2; ++k) \
        acc[ai][bj][m][n] = __builtin_amdgcn_mfma_f32_16x16x32_bf16(Bt[n][k], At[m][k], acc[ai][bj][m][n], 0, 0, 0); __builtin_amdgcn_s_setprio(0); } while (0)
#define PG8_WAIT_V(n) asm volatile("s_waitcnt vmcnt(" #n ")" ::: "memory")
#define PG8_WAIT_L(n) asm volatile("s_waitcnt lgkmcnt(" #n ")" ::: "memory")
#define PG8_BAR __builtin_amdgcn_s_barrier()
#define PG8_SCHED __builtin_amdgcn_sched_barrier(0)
    Unit cur, nxt; int ui = 0;
    if (!S.next(0, cur)) return;
    f32x4 acc[2][2][4][2];
#pragma unroll
    for (int a = 0; a < 2; ++a)
#pragma unroll
        for (int b = 0; b < 2; ++b)
#pragma unroll
            for (int m = 0; m < 4; ++m)
#pragma unroll
                for (int n = 0; n < 2; ++n) acc[a][b][m][n] = (f32x4){0.f, 0.f, 0.f, 0.f};
    bf16x8 At[4][2], B0[2][2], B1[2][2];
    const char* cA = (const char*)g.A + (GATHER ? (size_t)0 : (size_t)cur.pm * tstep); const char* cB = (const char*)g.Bt + (size_t)cur.pn * tstep;
    unsigned vcur[2][2], vnxt[2][2], vsel[2][2];
#pragma unroll
    for (int h = 0; h < 2; ++h)
#pragma unroll
        for (int i = 0; i < 2; ++i) { vcur[h][i] = 0u; vnxt[h][i] = 0u; vsel[h][i] = 0u; }
    if constexpr (GATHER) {
#pragma unroll
        for (int h = 0; h < 2; ++h)
#pragma unroll
            for (int i = 0; i < 2; ++i) vcur[h][i] = ((unsigned)S.rowidx[cur.pm * BM + h * HALF + RA[i]] * (unsigned)K + (unsigned)CA[i]) * 2u;
    }
    S.a_ready(cur);
    if constexpr (SP2) {
        PG8_STAGE(PG8_SB(0, 0), cB, voffB); PG8_STAGE(PG8_SB(0, 1), cB + hstep, voffB); PG8_STAGE_A(PG8_SA(0, 0), cA, 0, vcur); PG8_STAGE_A(PG8_SA(0, 1), cA, 1, vcur);
        if (wr == 1) PG8_BAR;
        PG8_WAIT_V(2); PG8_BAR;
        PG8_STAGE(PG8_SB(1, 0), cB + kstep, voffB); PG8_STAGE_A(PG8_SA(1, 0), cA + kstep, 0, vcur); PG8_STAGE(PG8_SB(1, 1), cB + hstep + kstep, voffB);
        PG8_WAIT_V(6); PG8_BAR;
    } else {
        PG8_STAGE(PG8_SB(0, 0), cB, voffB); PG8_STAGE_A(PG8_SA(0, 0), cA, 0, vcur); PG8_STAGE(PG8_SB(0, 1), cB + hstep, voffB); PG8_STAGE_A(PG8_SA(0, 1), cA, 1, vcur);
        if (wr == 1) PG8_BAR;
        PG8_WAIT_V(4); PG8_BAR;
        PG8_STAGE(PG8_SB(1, 0), cB + kstep, voffB); PG8_STAGE_A(PG8_SA(1, 0), cA + kstep, 0, vcur); PG8_STAGE(PG8_SB(1, 1), cB + hstep + kstep, voffB);
        PG8_WAIT_V(6); PG8_BAR;
    }
    for (;;) {
        const bool has_next = S.next(ui + 1, nxt);
        if constexpr (GATHER) {
#pragma unroll
            for (int h = 0; h < 2; ++h)
#pragma unroll
                for (int i = 0; i < 2; ++i) vnxt[h][i] = has_next ? ((unsigned)S.rowidx[nxt.pm * BM + h * HALF + RA[i]] * (unsigned)K + (unsigned)CA[i]) * 2u : vcur[h][i];
        }
        const char* nA = has_next ? (const char*)g.A + (GATHER ? (size_t)0 : (size_t)nxt.pm * tstep) : cA; const char* nB = has_next ? (const char*)g.Bt + (size_t)nxt.pn * tstep : cB;
        for (int t = 0; t < nt; t += 2) {
            const bool last = (t == nt - 2);
            if constexpr (GATHER) {
#pragma unroll
                for (int h = 0; h < 2; ++h)
#pragma unroll
                    for (int i = 0; i < 2; ++i) vsel[h][i] = last ? vnxt[h][i] : vcur[h][i];
            }
            if constexpr (Epi::HAS_MID) { if (t == nt / 2) E.mid(acc, cur, wr, wc, fr, fq); }
            const char* a1 = cA + (size_t)(t + 1) * kstep;
            const char* a2 = last ? nA : cA + (size_t)(t + 2) * kstep; const char* b2 = last ? nB : cB + (size_t)(t + 2) * kstep;
            const char* a3 = a2 + kstep; const char* b3 = b2 + kstep;
            if (last && has_next) S.a_ready(nxt);
            if constexpr (SP2) {
            PG8_LDB(B0, 0, 0); PG8_LDB(B1, 0, 1); PG8_SCHED; PG8_LDA(At, 0, 0); PG8_STAGE_A(PG8_SA(1, 1), a1, 1, vcur);
            PG8_WAIT_V(8); PG8_WAIT_L(0); PG8_BAR; PG8_MMA(0, 0, At, B0); PG8_MMA(0, 1, At, B1); PG8_BAR; PG8_SCHED;
            PG8_LDA(At, 0, 1); PG8_STAGE(PG8_SB(0, 0), b2, voffB); PG8_STAGE(PG8_SB(0, 1), b2 + hstep, voffB); PG8_STAGE_A(PG8_SA(0, 0), a2, 0, vsel);
            PG8_WAIT_V(8); PG8_WAIT_L(0); PG8_BAR; PG8_MMA(1, 0, At, B0); PG8_MMA(1, 1, At, B1); PG8_BAR; PG8_SCHED;
            PG8_LDB(B0, 1, 0); PG8_LDB(B1, 1, 1); PG8_SCHED; PG8_LDA(At, 1, 0); PG8_STAGE_A(PG8_SA(0, 1), a2, 1, vsel);
            PG8_WAIT_V(8); PG8_WAIT_L(0); PG8_BAR; PG8_MMA(0, 0, At, B0); PG8_MMA(0, 1, At, B1); PG8_BAR; PG8_SCHED;
            PG8_LDA(At, 1, 1); PG8_STAGE(PG8_SB(1, 0), b3, voffB); PG8_STAGE(PG8_SB(1, 1), b3 + hstep, voffB); PG8_STAGE_A(PG8_SA(1, 0), a3, 0, vsel);
            PG8_WAIT_V(8); PG8_WAIT_L(0); PG8_BAR; PG8_MMA(1, 0, At, B0); PG8_MMA(1, 1, At, B1); PG8_BAR; PG8_SCHED;
            } else {
            PG8_LDB(B0, 0, 0); PG8_SCHED; PG8_LDA(At, 0, 0); PG8_STAGE_A(PG8_SA(1, 1), a1, 1, vcur);
            PG8_WAIT_L(8); PG8_BAR; PG8_WAIT_L(0); PG8_MMA(0, 0, At, B0); PG8_BAR; PG8_SCHED;
            PG8_LDB(B1, 0, 1); PG8_STAGE(PG8_SB(0, 0), b2, voffB);
            PG8_BAR; PG8_WAIT_L(0); PG8_MMA(0, 1, At, B1); PG8_BAR;
            PG8_LDA(At, 0, 1); PG8_STAGE_A(PG8_SA(0, 0), a2, 0, vsel);
            PG8_BAR; PG8_WAIT_L(0); PG8_MMA(1, 0, At, B0); PG8_BAR; PG8_SCHED;
            PG8_STAGE(PG8_SB(0, 1), b2 + hstep, voffB);
            PG8_WAIT_V(6); PG8_BAR; PG8_MMA(1, 1, At, B1); PG8_BAR;
            PG8_LDB(B0, 1, 0); PG8_SCHED; PG8_LDA(At, 1, 0); PG8_STAGE_A(PG8_SA(0, 1), a2, 1, vsel);
            PG8_WAIT_L(8); PG8_BAR; PG8_WAIT_L(0); PG8_MMA(0, 0, At, B0); PG8_BAR; PG8_SCHED;
            PG8_LDB(B1, 1, 1); PG8_STAGE(PG8_SB(1, 0), b3, voffB);
            PG8_BAR; PG8_WAIT_L(0); PG8_MMA(0, 1, At, B1); PG8_BAR;
            PG8_LDA(At, 1, 1); PG8_STAGE_A(PG8_SA(1, 0), a3, 0, vsel);
            PG8_BAR; PG8_WAIT_L(0); PG8_MMA(1, 0, At, B0); PG8_BAR; PG8_SCHED;
            PG8_STAGE(PG8_SB(1, 1), b3 + hstep, voffB);
            PG8_WAIT_V(6); PG8_BAR; PG8_MMA(1, 1, At, B1); PG8_BAR;
            }
        }
        if constexpr (ALIGN_EPI) { if (wr == 0) PG8_BAR; }
        if constexpr (!Epi::AFTER_DRAIN) { E(acc, cur, wr, wc, fr, fq); S.done(cur); }
        if (!has_next) break;
#pragma unroll
        for (int a = 0; a < 2; ++a)
#pragma unroll
            for (int b = 0; b < 2; ++b)
#pragma unroll
                for (int m = 0; m < 4; ++m)
#pragma unroll
                    for (int n = 0; n < 2; ++n) acc[a][b][m][n] = (f32x4){0.f, 0.f, 0.f, 0.f};
        cur = nxt; cA = nA; cB = nB; ++ui;
        if constexpr (GATHER) {
#pragma unroll
            for (int h = 0; h < 2; ++h)
#pragma unroll
                for (int i = 0; i < 2; ++i) vcur[h][i] = vnxt[h][i];
        }
        if constexpr (ALIGN_EPI) { if (wr == 1) PG8_BAR; }
    }
    PG8_WAIT_V(0);
    if constexpr (!ALIGN_EPI) { if (wr == 0) PG8_BAR; }
    PG8_BAR;
    if constexpr (Epi::AFTER_DRAIN) { E.fused(acc, cur, wr, wc, fr, fq, lds, wid, lane); S.done(cur); }
#undef PG8_SA
#undef PG8_SB
#undef PG8_STAGE
#undef PG8_STAGE_A
#undef PG8_LDA
#undef PG8_LDB
#undef PG8_MMA
#undef PG8_WAIT_V
#undef PG8_WAIT_L
#undef PG8_BAR
#undef PG8_SCHED
}
}

namespace pg8 {
struct SchedQKV {
    int G, c;
    __device__ __forceinline__ bool next(int i, Unit& u) const {
        const int L = i * G + c; if (L >= 400) return false;
        if (L < 384) { const int xcd = L & 7, off = L >> 3, w = xcd * 48 + off; u.pm = (w / 48) * 8 + ((w % 48) & 7); u.pn = (w % 48) >> 3; }
        else { const int j = L - 384; u.pm = 64 + (j >> 1); u.pn = (j & 1) ? 5 : 2; }
        return true;
    }
    __device__ __forceinline__ void a_ready(const Unit&) const {}
    __device__ __forceinline__ void done(const Unit&) const {}
};
struct EpiQKV {
    static constexpr bool PERM = true, AFTER_DRAIN = false, HAS_MID = false;
    unsigned char* ws; const float* bqn; const float* bkn;
    __device__ __forceinline__ void operator()(const f32x4 (&acc)[2][2][4][2], const Unit& u, int wr, int wc, int fr, int fq) const {
        const int pn = u.pn; const bool isctx = u.pm >= 64;
        int kind, hh;
        if (pn < 2) { kind = 0; hh = pn * 4 + wc; } else if (pn == 2) { kind = wc < 2 ? 2 : 4; hh = wc & 1; } else if (pn < 5) { kind = 1; hh = (pn - 3) * 4 + wc; } else { kind = wc < 2 ? 3 : 5; hh = wc & 1; }
        const bool rms = kind == 1 || kind == 3, rope = !isctx && kind <= 3;
        const float* gp = kind == 1 ? bqn : bkn;
        f32x4 gain[2][2];
#pragma unroll
        for (int bj = 0; bj < 2; ++bj)
#pragma unroll
            for (int n = 0; n < 2; ++n) gain[bj][n] = rms ? *(const f32x4*)(gp + 32 * bj + 8 * fq + 4 * n) : (f32x4){1.f, 1.f, 1.f, 1.f};
        const float* tab = (const float*)(ws + WS_ROPE);
        bf16* base = (bf16*)(ws + (kind == 0 ? WS_QA : kind == 1 ? WS_QB : kind == 2 ? WS_KA : kind == 3 ? WS_KB : kind == 4 ? WS_VA : WS_VB));
        const float qs = kind <= 1 ? C2 : 1.f;
#pragma unroll
        for (int ai = 0; ai < 2; ++ai)
#pragma unroll
            for (int m = 0; m < 4; ++m) {
                const int row = u.pm * BM + ai * HALF + wr * 64 + m * 16 + fr;
                int b, t, pos;
                if (!isctx) { b = row >> 11; t = row & 2047; pos = t; } else { const int cr = row - ML; b = cr >> 8; t = 0; pos = T + (cr & 255); }
                f32x4 v[2][2];
#pragma unroll
                for (int bj = 0; bj < 2; ++bj)
#pragma unroll
                    for (int n = 0; n < 2; ++n) v[bj][n] = acc[ai][bj][m][n];
                if (rms) {
                    float ss = 0.f;
#pragma unroll
                    for (int bj = 0; bj < 2; ++bj)
#pragma unroll
                        for (int n = 0; n < 2; ++n) ss += (v[bj][n].x * v[bj][n].x + v[bj][n].y * v[bj][n].y) + (v[bj][n].z * v[bj][n].z + v[bj][n].w * v[bj][n].w);
                    ss += __shfl_xor(ss, 16); ss += __shfl_xor(ss, 32);
                    const float rn = rsqrtf(ss * (1.f / 64.f) + EPS);
#pragma unroll
                    for (int bj = 0; bj < 2; ++bj)
#pragma unroll
                        for (int n = 0; n < 2; ++n) v[bj][n] = v[bj][n] * rn * gain[bj][n];
                }
                if (rope) {
#pragma unroll
                    for (int bj = 0; bj < 2; ++bj)
#pragma unroll
                        for (int n = 0; n < 2; ++n) {
                            const int tp = bj == 0 ? (t >> 6) : 32 + (t & 63);
                            const f32x4 cs = *(const f32x4*)(tab + (tp * 16 + 4 * fq + 2 * n) * 2);
                            const f32x4 x = v[bj][n];
                            v[bj][n] = (f32x4){x.x * cs.x - x.y * cs.y, x.x * cs.y + x.y * cs.x, x.z * cs.z - x.w * cs.w, x.z * cs.w + x.w * cs.z};
                        }
                }
#pragma unroll
                for (int bj = 0; bj < 2; ++bj) {
                    const f32x4 v0 = v[bj][0] * qs, v1 = v[bj][1] * qs;
                    u32x4 w; w.x = pk2(v0.x, v0.y); w.y = pk2(v0.z, v0.w); w.z = pk2(v1.x, v1.y); w.w = pk2(v1.z, v1.w);
                    const int d0 = 32 * bj + 8 * fq;
                    bf16* dst = kind <= 1 ? base + q_off(b, hh, t, d0) : kind <= 3 ? base + k_off(b, hh, pos, d0) : base + v_off(b, hh, pos, d0);
                    st16(dst, w);
                }
            }
    }
};
}


namespace pg8 {
struct SchedOne { Unit u;
    __device__ __forceinline__ bool next(int i, Unit& o) const { if (i) return false; o = u; return true; }
    __device__ __forceinline__ void a_ready(const Unit&) const {}
    __device__ __forceinline__ void done(const Unit&) const {} };
struct EpiOut {
    static constexpr bool PERM = true, AFTER_DRAIN = false, HAS_MID = true;
    bf16* OX; const LAS float* tab;
    __device__ __forceinline__ void mid(f32x4 (&acc)[2][2][4][2], const Unit&, int wr, int, int fr, int) const {
#pragma unroll
        for (int ai = 0; ai < 2; ++ai)
#pragma unroll
            for (int m = 0; m < 4; ++m) { const float f = tab[2 * (ai * HALF + wr * 64 + m * 16 + fr)];
#pragma unroll
                for (int bj = 0; bj < 2; ++bj)
#pragma unroll
                    for (int n = 0; n < 2; ++n) acc[ai][bj][m][n] = acc[ai][bj][m][n] * f; }
    }
    __device__ __forceinline__ void operator()(const f32x4 (&acc)[2][2][4][2], const Unit& u, int wr, int wc, int fr, int fq) const {
#pragma unroll
        for (int ai = 0; ai < 2; ++ai)
#pragma unroll
            for (int m = 0; m < 4; ++m) { const int r = ai * HALF + wr * 64 + m * 16 + fr; const float f = tab[2 * r + 1];
                bf16* rowp = OX + (size_t)(u.pm * BM + r) * D + u.pn * BM + wc * 32 + 8 * fq;
#pragma unroll
                for (int bj = 0; bj < 2; ++bj) { const f32x4 v0 = acc[ai][bj][m][0] * f, v1 = acc[ai][bj][m][1] * f;
                    u32x4 w; w.x = pk2(v0.x, v0.y); w.y = pk2(v0.z, v0.w); w.z = pk2(v1.x, v1.y); w.w = pk2(v1.z, v1.w);
                    st16(rowp + bj * HALF, w); } }
    }
};
struct SchedMoE {
    int G, c, nwg; const LAS int* tile_e; const int* rowidx;
    __device__ __forceinline__ bool next(int i, Unit& u) const {
        const int L = i * G + c; if (L >= nwg) return false;
        const int q = nwg >> 3, r = nwg & 7, xcd = L & 7, off = L >> 3;
        const int w = (xcd < r ? xcd * (q + 1) : r * (q + 1) + (xcd - r) * q) + off;
        u.pm = w >> 2; u.pn = tile_e[w >> 2] * 4 + (w & 3); return true;
    }
    __device__ __forceinline__ void a_ready(const Unit&) const {}
    __device__ __forceinline__ void done(const Unit&) const {}
};
__device__ __forceinline__ float silu_fast(float g) { return g * __builtin_amdgcn_rcpf(1.f + __builtin_amdgcn_exp2f(-g * LOG2E)); }
struct EpiGU {
    static constexpr bool PERM = true, AFTER_DRAIN = false, HAS_MID = false;
    bf16* ACT; const float* roww;
    __device__ __forceinline__ void operator()(const f32x4 (&acc)[2][2][4][2], const Unit& u, int wr, int wc, int fr, int fq) const {
#pragma unroll
        for (int ai = 0; ai < 2; ++ai)
#pragma unroll
            for (int m = 0; m < 4; ++m) { const int pos = u.pm * BM + ai * HALF + wr * 64 + m * 16 + fr; const float w = roww[pos];
                const f32x4 g0 = acc[ai][0][m][0], g1 = acc[ai][0][m][1], u0 = acc[ai][1][m][0], u1 = acc[ai][1][m][1];
                u32x4 o;
                o.x = pk2(silu_fast(g0.x) * u0.x * w, silu_fast(g0.y) * u0.y * w); o.y = pk2(silu_fast(g0.z) * u0.z * w, silu_fast(g0.w) * u0.w * w);
                o.z = pk2(silu_fast(g1.x) * u1.x * w, silu_fast(g1.y) * u1.y * w); o.w = pk2(silu_fast(g1.z) * u1.z * w, silu_fast(g1.w) * u1.w * w);
                st16(ACT + (size_t)pos * EFF + (u.pn & 3) * 128 + wc * 32 + 8 * fq, o); }
    }
};
struct EpiY {
    static constexpr bool PERM = true, AFTER_DRAIN = false, HAS_MID = false;
    bf16* Y;
    __device__ __forceinline__ void operator()(const f32x4 (&acc)[2][2][4][2], const Unit& u, int wr, int wc, int fr, int fq) const {
#pragma unroll
        for (int ai = 0; ai < 2; ++ai)
#pragma unroll
            for (int m = 0; m < 4; ++m) { bf16* rowp = Y + (size_t)(u.pm * BM + ai * HALF + wr * 64 + m * 16 + fr) * D + (u.pn & 3) * BM + wc * 32 + 8 * fq;
#pragma unroll
                for (int bj = 0; bj < 2; ++bj) { const f32x4 v0 = acc[ai][bj][m][0], v1 = acc[ai][bj][m][1];
                    u32x4 w; w.x = pk2(v0.x, v0.y); w.y = pk2(v0.z, v0.w); w.z = pk2(v1.x, v1.y); w.w = pk2(v1.z, v1.w);
                    st16(rowp + bj * HALF, w); } }
    }
};
}

namespace att {
typedef __attribute__((address_space(3))) const char* lds_cptr;
typedef short v4i16_t __attribute__((ext_vector_type(4)));
constexpr int NSLOT = 4, SLOTB = 16384, OST_PITCH = 144, OST_WAVE = 32 * OST_PITCH;
static_assert(8 * OST_WAVE <= 3 * SLOTB && NSLOT * SLOTB <= 65536, "attention LDS");
__device__ __forceinline__ int crow(int r, int hi) { return (r & 3) + 8 * (r >> 2) + 4 * hi; }
__device__ __forceinline__ unsigned cvtpk(float lo, float hi) { typedef float f2 __attribute__((ext_vector_type(2))); typedef __bf16 b2 __attribute__((ext_vector_type(2))); f2 v = {lo, hi}; b2 b = __builtin_convertvector(v, b2); return __builtin_bit_cast(unsigned, b); }
__device__ __forceinline__ s16x4 vtr(lds_cptr p) { return __builtin_bit_cast(s16x4, __builtin_amdgcn_ds_read_tr16_b64_v4i16((__attribute__((address_space(3))) v4i16_t*)p)); }
__device__ __forceinline__ float swapmax(float m) { auto rr = __builtin_amdgcn_permlane32_swap(__float_as_uint(m), __float_as_uint(m), false, false); return fmaxf(__uint_as_float(rr[0]), __uint_as_float(rr[1])); }
__device__ __forceinline__ float swapsum(float m) { auto rr = __builtin_amdgcn_permlane32_swap(__float_as_uint(m), __float_as_uint(m), false, false); return __uint_as_float(rr[0]) + __uint_as_float(rr[1]); }

__device__ __forceinline__ void glds16(const void* gsrc, unsigned lds_dst) { unsigned keep;
    asm volatile("s_mov_b32 %0, m0\n\ts_mov_b32 m0, %2\n\ts_nop 0\n\tglobal_load_lds_dwordx4 %1, off\n\ts_mov_b32 m0, %0" : "=&s"(keep) : "v"(gsrc), "s"(lds_dst) : "memory"); }
__device__ __forceinline__ float max3f(float a, float b, float c) { float r; asm("v_max3_f32 %0, %1, %2, %3" : "=v"(r) : "v"(a), "v"(b), "v"(c)); return r; }
__device__ __forceinline__ float max2f(float a, float b) { float r; asm("v_max_f32_e32 %0, %1, %2" : "=v"(r) : "v"(a), "v"(b)); return r; }
constexpr int WC_PER_WAVE = 24, WC_LDS = 65536;
struct WConv { int next, j0, j1, gstep, cm1, cm2; };
struct WItem { const float* src; int N; bf16* dst; int dpitch; };
__device__ __forceinline__ WItem wc_decode(const P& p, int hidx, int& k0, int& n0, int& drow0) {
    const int item = hidx >> 1, kh = hidx & 1; WItem w;
    if (item < 16384) { const int up = item >= 8192, r = item & 8191, e = r >> 8, q = r & 255, kb = q >> 4, nb = q & 15; n0 = nb * 32;
        w.src = (up ? p.w_up : p.w_gate) + (size_t)e * 1024 * 512; w.N = 512; w.dst = (bf16*)(p.ws + WS_WGU) + (size_t)e * 1024 * 1024; w.dpitch = 1024;
        drow0 = (n0 >> 7) * 256 + up * 128 + (n0 & 127); k0 = kb * 64 + kh * 32; }
    else { const int r = item - 16384, e = r >> 8, q = r & 255, kb = q >> 5, nb = q & 31; n0 = nb * 32;
        w.src = p.w_down + (size_t)e * 512 * 1024; w.N = 1024; w.dst = (bf16*)(p.ws + WS_WD) + (size_t)e * 1024 * 512; w.dpitch = 512; drow0 = n0; k0 = kb * 64 + kh * 32; }
    return w;
}
__device__ __forceinline__ void glds16(const void* gsrc, unsigned lds_dst);
__device__ __forceinline__ void glds16_nt(const void* gsrc, unsigned lds_dst) { unsigned keep;
    asm volatile("s_mov_b32 %0, m0\n\ts_mov_b32 m0, %2\n\ts_nop 0\n\tglobal_load_lds_dwordx4 %1, off nt\n\ts_mov_b32 m0, %0" : "=&s"(keep) : "v"(gsrc), "s"(lds_dst) : "memory"); }
__device__ __forceinline__ void wc_issue(const P& p, int gw, int ord, unsigned ldsbuf, int lane) {
    int k0, n0, drow0; const WItem w = wc_decode(p, gw + 2048 * ord, k0, n0, drow0);
#pragma unroll
    for (int q = 0; q < 4; ++q) { const int kl = 8 * q + (lane >> 3), f4 = (lane & 7) ^ ((q >> 1) * 4);
        glds16_nt(w.src + (size_t)(k0 + kl) * w.N + n0 + f4 * 4, (unsigned)__builtin_amdgcn_readfirstlane(ldsbuf + q * 1024)); }
}
__device__ __forceinline__ void wc_consume(const P& p, int gw, int ord, LAS unsigned char* buf, int lane) {
    int k0, n0, drow0; const WItem w = wc_decode(p, gw + 2048 * ord, k0, n0, drow0);
    const int n = lane >> 1, kh = lane & 1;
    const LAS float* s = (const LAS float*)buf + (16 * kh) * 32 + 4 * ((n >> 2) ^ (4 * kh)) + (n & 3);
    float v[16];
#pragma unroll
    for (int i = 0; i < 16; ++i) v[i] = s[i * 32];
    v4u o0, o1;
    o0.x = cvtpk(v[0], v[1]); o0.y = cvtpk(v[2], v[3]); o0.z = cvtpk(v[4], v[5]); o0.w = cvtpk(v[6], v[7]);
    o1.x = cvtpk(v[8], v[9]); o1.y = cvtpk(v[10], v[11]); o1.z = cvtpk(v[12], v[13]); o1.w = cvtpk(v[14], v[15]);
    bf16* d = w.dst + (size_t)(drow0 + n) * w.dpitch + k0 + 16 * kh;
    __builtin_nontemporal_store(o0, (v4u*)d); __builtin_nontemporal_store(o1, (v4u*)(d + 8));
}
constexpr float THR = 8.f;
template <int GRP, int ABL = 0>
__device__ __forceinline__ void attn_unit(const P& p, LAS unsigned char* lds, int b, int kvh, int qb, WConv& wc, int gw) {
    const int tid = threadIdx.x, lane = tid & 63, r32 = lane & 31, hi = lane >> 5;
    const int wid = __builtin_amdgcn_readfirstlane(tid >> 6);
    const int h = kvh * 4 + (wid >> 1);
    const int q0w = qb * 64 + (wid & 1) * 32, qpos = q0w + r32;
    const bf16* Qp = (const bf16*)(p.ws + (GRP ? WS_QB : WS_QA)) + q_off(b, h, qpos, 0);
    bf16x8 qr[4];
#pragma unroll
    for (int d0 = 0; d0 < 4; ++d0) qr[d0] = *(const bf16x8*)(Qp + 16 * d0 + 8 * hi);
    asm volatile("" : "+v"(qr[0]), "+v"(qr[1]), "+v"(qr[2]), "+v"(qr[3]));
    const char* Kt = (const char*)(p.ws + (GRP ? WS_KB : WS_KA)) + (size_t)(b * 2 + kvh) * NTILE * 8192 + wid * 1024 + lane * 16;
    const char* Vt = (const char*)(p.ws + (GRP ? WS_VB : WS_VA)) + (size_t)(b * 2 + kvh) * NTILE * 8192 + wid * 1024 + lane * 16;
    const unsigned lds0 = (unsigned)(uintptr_t)lds;
    int jlo = 0, nband = NTILE, NT = NTILE;
    if (GRP == 0) { jlo = qb - 2 < 0 ? 0 : qb - 2; const int jhi = qb + 2 > 31 ? 31 : qb + 2; nband = jhi - jlo + 1; NT = nband + 4; }
#define ATT_TILE(i) ((i) < nband ? jlo + (i) : 32 + ((i) - nband))
#define ATT_ISSUE(i) do { if (ABL & 1) break; const int tl_ = ATT_TILE(i); const int sl_ = ((i) & 3) * SLOTB; \
        glds16(Kt + (size_t)tl_ * 8192, (unsigned)__builtin_amdgcn_readfirstlane(lds0 + sl_ + wid * 1024)); \
        glds16(Vt + (size_t)tl_ * 8192, (unsigned)__builtin_amdgcn_readfirstlane(lds0 + sl_ + 8192 + wid * 1024)); } while (0)
#define ATT_WAIT(n) do { if (ABL & 1) break; if ((n) >= 2) asm volatile("s_waitcnt vmcnt(4)" ::: "memory"); else if ((n) == 1) asm volatile("s_waitcnt vmcnt(2)" ::: "memory"); else asm volatile("s_waitcnt vmcnt(0)" ::: "memory"); } while (0)
#define ATT_WAITN(n) do { if (ABL & 1) break; switch (n) { case 0: asm volatile("s_waitcnt vmcnt(0)" ::: "memory"); break; case 2: asm volatile("s_waitcnt vmcnt(2)" ::: "memory"); break; \
        case 4: asm volatile("s_waitcnt vmcnt(4)" ::: "memory"); break; case 6: asm volatile("s_waitcnt vmcnt(6)" ::: "memory"); break; case 8: asm volatile("s_waitcnt vmcnt(8)" ::: "memory"); break; \
        case 10: asm volatile("s_waitcnt vmcnt(10)" ::: "memory"); break; case 12: asm volatile("s_waitcnt vmcnt(12)" ::: "memory"); break; default: asm volatile("s_waitcnt vmcnt(14)" ::: "memory"); break; } } while (0)
#define ATT_BAR() do { asm volatile("" ::: "memory"); __builtin_amdgcn_s_barrier(); asm volatile("" ::: "memory"); } while (0)
#define SBAR() __builtin_amdgcn_sched_barrier(0)
#define MF(a, b, c) __builtin_amdgcn_mfma_f32_32x32x16_bf16(a, b, c, 0, 0, 0)
#define KFRAG(dst, base, k) dst = *(const __attribute__((address_space(3))) bf16x8*)((base) + ((k) >> 1) * 2048 + ((k) & 1) * 512)
    float m, l;
    m = 0.f; l = 0.f;
    f32x16 o0, o1, sA0, sA1, sB0, sB1; const f32x16 zero16 = {0.f, 0.f, 0.f, 0.f, 0.f, 0.f, 0.f, 0.f, 0.f, 0.f, 0.f, 0.f, 0.f, 0.f, 0.f, 0.f};
#pragma unroll
    for (int r = 0; r < 16; ++r) { o0[r] = 0.f; o1[r] = 0.f; sB0[r] = 0.f; sB1[r] = 0.f; }
    const lds_cptr kp0 = (lds_cptr)lds + hi * 1024 + r32 * 16;
    const lds_cptr vp0 = (lds_cptr)lds + 8192 + ((lane >> 4) & 1) * 32 + (lane & 3) * 8 + (4 * hi + ((lane & 15) >> 2)) * 64;
#define ATT_MASK(S0, S1, t) do { if (GRP == 0) { const int tl = ATT_TILE(t); if (tl < 32 && (tl == qb - 2 || tl == qb + 2)) { const int kb = tl * 64; \
        _Pragma("unroll") for (int r = 0; r < 16; ++r) { const int dd = kb + crow(r, hi) - qpos; if (dd > 128 || dd < -128) S0[r] = -1e30f; if (dd + 32 > 128 || dd + 32 < -128) S1[r] = -1e30f; } } } } while (0)
#define ATT_DECIDE(S0, S1, mxv) do { float mx_ = swapmax(mxv); \
        if (__builtin_expect(__any(mx_ > THR), 0)) { const float dl = fmaxf(mx_, 0.f), alpha = __builtin_amdgcn_exp2f(-dl); m += dl; l *= alpha; \
            _Pragma("unroll") for (int r = 0; r < 16; ++r) { S0[r] -= dl; S1[r] -= dl; o0[r] *= alpha; o1[r] *= alpha; } } } while (0)
    if (wid >= 4) __builtin_amdgcn_s_setprio(1);
    wc.cm1 = 0; wc.cm2 = 0;
    ATT_ISSUE(0); ATT_ISSUE(1); ATT_ISSUE(2);
    ATT_WAIT(2); ATT_BAR();
    {
        bf16x8 kf[8];
#pragma unroll
        for (int k = 0; k < 8; ++k) KFRAG(kf[k], kp0, k);
        SBAR();
        sA0 = MF(kf[0], qr[0], zero16); sA1 = MF(kf[1], qr[0], zero16);
#pragma unroll
        for (int d0 = 1; d0 < 4; ++d0) { sA0 = MF(kf[2 * d0], qr[d0], sA0); sA1 = MF(kf[2 * d0 + 1], qr[d0], sA1); }
        ATT_MASK(sA0, sA1, 0);
        asm volatile("s_nop 15\n\ts_nop 7" : "+v"(sA0), "+v"(sA1));
        float a = max3f(sA0[0], sA0[1], sA1[0]), c = max3f(sA0[2], sA0[3], sA1[1]); a = max3f(a, sA1[2], sA1[3]);
#pragma unroll
        for (int r = 4; r < 16; r += 4) { a = max3f(a, sA0[r], sA0[r + 1]); c = max3f(c, sA0[r + 2], sA0[r + 3]); a = max3f(a, sA1[r], sA1[r + 1]); c = max3f(c, sA1[r + 2], sA1[r + 3]); }
        ATT_DECIDE(sA0, sA1, max2f(a, c));
    }
#define ATT_STEP(SC0, SC1, SN0, SN1, t, HN) do { \
        constexpr bool hn_ = HN;                                      \
        ATT_WAITN(wc.cm2 + wc.cm1 + ((t) + 2 < NT ? 2 : 0));         \
        ATT_BAR(); \
        if ((t) + 3 < NT) ATT_ISSUE((t) + 3); \
        if (WCONV_IN_ATTN) { int c_ = 0; const int r7_ = wc.gstep % 7, bs_ = r7_ == 0 ? 0 : r7_ == 3 ? 1 : 2;     \
            if (bs_ < 2) { LAS unsigned char* wb_ = lds + WC_LDS + wid * 8192 + bs_ * 4096; int jb_ = bs_ ? wc.j1 : wc.j0; \
                if (jb_ >= 0) { wc_consume(p, gw, jb_, wb_, lane); jb_ = -1; c_ += 2; } \
                if (wc.next < WC_PER_WAVE) { asm volatile("s_waitcnt lgkmcnt(0)" ::: "memory"); wc_issue(p, gw, wc.next, lds0 + WC_LDS + wid * 8192 + bs_ * 4096, lane); jb_ = wc.next++; c_ += 4; } \
                if (bs_) wc.j1 = jb_; else wc.j0 = jb_; } \
            wc.cm2 = wc.cm1; wc.cm1 = c_; wc.gstep++; } \
        const lds_cptr kp_ = kp0 + (((t) + 1) & 3) * SLOTB; const lds_cptr vp_ = vp0 + ((t) & 3) * SLOTB; \
        bf16x8 kf[8]; s16x4 vlo[8], vhi[8]; \
        if (hn_) { _Pragma("unroll") for (int k = 0; k < 8; ++k) KFRAG(kf[k], kp_, k); } \
        SBAR(); \
        float rs_ = 0.f; v4u pw[4]; _Pragma("unroll") for (int q_ = 0; q_ < 4; ++q_) pw[q_] = (v4u){0u, 0u, 0u, 0u}; \
        _Pragma("unroll") for (int g = 0; g < 8; ++g) {             \
            if (hn_) { if (g == 0) SN0 = MF(kf[0], qr[0], zero16); else if (g == 1) SN1 = MF(kf[1], qr[0], zero16); else if (g & 1) SN1 = MF(kf[g], qr[g >> 1], SN1); else SN0 = MF(kf[g], qr[g >> 1], SN0); } \
            if (g < 4) { _Pragma("unroll") for (int e = 0; e < 4; ++e) { SC0[4 * g + e] = __builtin_amdgcn_exp2f(SC0[4 * g + e]); rs_ += SC0[4 * g + e]; } \
                         pw[g >> 1][2 * (g & 1)] = cvtpk(SC0[4 * g], SC0[4 * g + 1]); pw[g >> 1][2 * (g & 1) + 1] = cvtpk(SC0[4 * g + 2], SC0[4 * g + 3]); \
                         asm volatile("" : "+v"(SC0), "+v"(pw[g >> 1]), "+v"(rs_)); } \
            else { const int g4 = g - 4;   \
                         vlo[g4] = vtr(vp_ + g4 * 1024); vhi[g4] = vtr(vp_ + g4 * 1024 + 512); vlo[4 + g4] = vtr(vp_ + 4096 + g4 * 1024); vhi[4 + g4] = vtr(vp_ + 4096 + g4 * 1024 + 512); \
                         _Pragma("unroll") for (int e = 0; e < 4; ++e) { SC1[4 * g4 + e] = __builtin_amdgcn_exp2f(SC1[4 * g4 + e]); rs_ += SC1[4 * g4 + e]; } \
                         pw[2 + (g4 >> 1)][2 * (g4 & 1)] = cvtpk(SC1[4 * g4], SC1[4 * g4 + 1]); pw[2 + (g4 >> 1)][2 * (g4 & 1) + 1] = cvtpk(SC1[4 * g4 + 2], SC1[4 * g4 + 3]); \
                         asm volatile("" : "+v"(SC1), "+v"(pw[2 + (g4 >> 1)]), "+v"(rs_)); } \
            SBAR(); } \
        l += rs_; \
        if (hn_) { ATT_MASK(SN0, SN1, (t) + 1); if (__builtin_expect(__any(m != 0.f), 0)) { _Pragma("unroll") for (int r = 0; r < 16; ++r) { SN0[r] -= m; SN1[r] -= m; } } \
                   asm volatile("s_nop 15\n\ts_nop 7" : "+v"(SN0), "+v"(SN1)); } \
        float ma_ = -3.0e38f, mc_ = -3.0e38f; \
        _Pragma("unroll") for (int g = 0; g < 8; ++g) {             \
            const int ks = g >> 1; const bf16x8 pf = __builtin_bit_cast(bf16x8, pw[ks]); \
            if (g & 1) { const bf16x8 v1 = (bf16x8){vlo[4 + ks][0], vlo[4 + ks][1], vlo[4 + ks][2], vlo[4 + ks][3], vhi[4 + ks][0], vhi[4 + ks][1], vhi[4 + ks][2], vhi[4 + ks][3]}; o1 = MF(v1, pf, o1); } \
            else { const bf16x8 v0 = (bf16x8){vlo[ks][0], vlo[ks][1], vlo[ks][2], vlo[ks][3], vhi[ks][0], vhi[ks][1], vhi[ks][2], vhi[ks][3]}; o0 = MF(v0, pf, o0); } \
            if (hn_) { if (g < 4) { ma_ = max3f(ma_, SN0[4 * g], SN0[4 * g + 1]); mc_ = max3f(mc_, SN0[4 * g + 2], SN0[4 * g + 3]); } \
                       else { ma_ = max3f(ma_, SN1[4 * (g - 4)], SN1[4 * (g - 4) + 1]); mc_ = max3f(mc_, SN1[4 * (g - 4) + 2], SN1[4 * (g - 4) + 3]); } \
                       asm volatile("" : "+v"(ma_), "+v"(mc_)); } \
            SBAR(); } \
        if (hn_) ATT_DECIDE(SN0, SN1, max2f(ma_, mc_)); \
    } while (0)
    {
        int t = 0;
        for (; t + 2 < NT; t += 2) { ATT_STEP(sA0, sA1, sB0, sB1, t, true); ATT_STEP(sB0, sB1, sA0, sA1, t + 1, true); }
        if (t + 2 == NT) { ATT_STEP(sA0, sA1, sB0, sB1, t, true); ATT_STEP(sB0, sB1, sA0, sA1, t + 1, false); }
        else { ATT_STEP(sA0, sA1, sB0, sB1, t, false); }
    }
#undef ATT_STEP
#undef ATT_DECIDE
#undef ATT_MASK
#undef KFRAG
#undef MF
#undef SBAR
#undef ATT_TILE
#undef ATT_ISSUE
#undef ATT_WAIT
    if (wid >= 4) __builtin_amdgcn_s_setprio(0);
    ATT_BAR();
    float ltot = swapsum(l); if (GRP == 0) ltot += __builtin_amdgcn_exp2f(p.a_sink[h] * LOG2E - m);
    const float inv = 1.f / ltot;
    int lane_e = lane; asm volatile("" : "+v"(lane_e));
    const int r32e = lane_e & 31, hie = lane_e >> 5;
    LAS unsigned char* ost = lds + wid * OST_WAVE;
#pragma unroll
    for (int g = 0; g < 4; ++g) {
        v2u w0, w1;
        w0.x = cvtpk(o0[4 * g] * inv, o0[4 * g + 1] * inv); w0.y = cvtpk(o0[4 * g + 2] * inv, o0[4 * g + 3] * inv);
        w1.x = cvtpk(o1[4 * g] * inv, o1[4 * g + 1] * inv); w1.y = cvtpk(o1[4 * g + 2] * inv, o1[4 * g + 3] * inv);
        *(LAS v2u*)(ost + r32e * OST_PITCH + (8 * g + 4 * hie) * 2) = w0;
        *(LAS v2u*)(ost + r32e * OST_PITCH + (32 + 8 * g + 4 * hie) * 2) = w1;
    }
    asm volatile("s_waitcnt lgkmcnt(0)" ::: "memory");
    bf16* Ob = (bf16*)(p.ws + (ABL ? WS_OX : WS_O)) + ((size_t)b * T + q0w) * D + GRP * 512 + h * 64;
    float* ssq = (float*)(p.ws + (ABL ? 256 * MiB : WS_SSQ)) + ((size_t)b * T + q0w) * 16 + GRP * 8 + h;
#pragma unroll
    for (int i = 0; i < 4; ++i) {
        const int row = i * 8 + (lane_e >> 3), ch = lane_e & 7;
        const v4u v = *(const LAS v4u*)(ost + row * OST_PITCH + ch * 16);
        st16(Ob + (size_t)row * D + ch * 8, v);
        float ss = 0.f;
#pragma unroll
        for (int q = 0; q < 4; ++q) { const float a = __uint_as_float(v[q] << 16), c = __uint_as_float(v[q] & 0xffff0000u); ss += a * a + c * c; }
        ss += __shfl_xor(ss, 1); ss += __shfl_xor(ss, 2); ss += __shfl_xor(ss, 4);
        if (ch == 0) ssq[(size_t)row * 16] = ss;
    }
    asm volatile("s_waitcnt vmcnt(0) lgkmcnt(0)" ::: "memory");
    ATT_BAR();
#undef ATT_BAR
}
template <int ABL = 0>
__device__ __forceinline__ void attn_phase(const P& p, LAS unsigned char* lds, int vcu, int G) {
    if (ABL & 64) return;
    const int wid = __builtin_amdgcn_readfirstlane(threadIdx.x >> 6), lane = threadIdx.x & 63, gw = vcu * 8 + wid;
    WConv wc; wc.next = (WCONV_IN_ATTN && G * 8 == 2048 && ABL == 0) ? 0 : WC_PER_WAVE; wc.j0 = -1; wc.j1 = -1; wc.gstep = 0; wc.cm1 = 0; wc.cm2 = 0;
    for (int u = vcu; u < 512; u += G) attn_unit<1, ABL>(p, lds, (u >> 5) >> 1, (u >> 5) & 1, u & 31, wc, gw);
    for (int u = vcu; u < 512; u += G) attn_unit<0, ABL>(p, lds, (u >> 5) >> 1, (u >> 5) & 1, u & 31, wc, gw);
    if (WCONV_IN_ATTN && ABL == 0) {
        if (G * 8 == 2048) {
            if (wc.j0 >= 0) wc_consume(p, gw, wc.j0, lds + WC_LDS + wid * 8192, lane);
            if (wc.j1 >= 0) wc_consume(p, gw, wc.j1, lds + WC_LDS + wid * 8192 + 4096, lane);
            for (; wc.next < WC_PER_WAVE; ++wc.next) { asm volatile("s_waitcnt lgkmcnt(0)" ::: "memory"); wc_issue(p, gw, wc.next, (unsigned)(uintptr_t)lds + WC_LDS + wid * 8192, lane);
                asm volatile("s_waitcnt vmcnt(0)" ::: "memory"); wc_consume(p, gw, wc.next, lds + WC_LDS + wid * 8192, lane); }
        } else {
            for (int hx = gw; hx < 49152; hx += G * 8) { asm volatile("s_waitcnt lgkmcnt(0)" ::: "memory"); wc_issue(p, hx & 2047, hx >> 11, (unsigned)(uintptr_t)lds + WC_LDS + wid * 8192, lane);
                asm volatile("s_waitcnt vmcnt(0)" ::: "memory"); wc_consume(p, hx & 2047, hx >> 11, lds + WC_LDS + wid * 8192, lane); }
        }
    }
}
}

struct Frame {
    LAS unsigned char* lds;
    volatile LAS unsigned* MISC;
    int tid, lane, wave, vcu, G;
};

__device__ __forceinline__ void p0_transpose_item(const float* W, int N, bf16* WT, int dpitch, int drow0, int k0, int n0, LAS float* scr, int lane, const float* gain) {
#pragma unroll
    for (int i = 0; i < 32; ++i) { const int kk = 2 * i + (lane >> 5); float v = __builtin_nontemporal_load(W + (size_t)(k0 + kk) * N + n0 + (lane & 31)); if (gain) v *= gain[kk]; scr[kk * 33 + (lane & 31)] = v; }
    LDS_WAIT(); asm volatile("" ::: "memory");
    const int c = lane & 7;
#pragma unroll
    for (int j = 0; j < 4; ++j) { const int n = (lane >> 3) + 8 * j; const LAS float* s = scr + (8 * c) * 33 + n;
        v4u o; o.x = pk2(s[0 * 33], s[1 * 33]); o.y = pk2(s[2 * 33], s[3 * 33]); o.z = pk2(s[4 * 33], s[5 * 33]); o.w = pk2(s[6 * 33], s[7 * 33]);
        *(GAS v4u*)(WT + (size_t)(drow0 + n) * dpitch + k0 + 8 * c) = o; }
    LDS_WAIT(); asm volatile("" ::: "memory");
}
__device__ __forceinline__ void p0_prologue(const P& p, Frame& F) {
    float* modx = (float*)(p.ws + WS_MODX);
    if (F.vcu < 96) {
        LAS float* s = (LAS float*)F.lds;
        LAS float* part = (LAS float*)(F.lds + 40960);
        for (int i = F.tid; i < 9 * D; i += NTHR) { const int r = i >> 10, k = i & 1023; const float v = r < 8 ? p.c[r * D + k] : p.c_ctx[k]; s[i] = silu_f(v); }
        __syncthreads();
        const int n = F.vcu * 64 + F.lane; float acc[9];
#pragma unroll
        for (int r = 0; r < 9; ++r) acc[r] = 0.f;
        const float* wp = p.w_mod + (size_t)(F.wave * 128) * 6144 + n;
#pragma unroll 4
        for (int k4 = 0; k4 < 128; k4 += 4) {
            float wv[4];
#pragma unroll
            for (int j = 0; j < 4; ++j) wv[j] = __builtin_nontemporal_load(wp + (size_t)(k4 + j) * 6144);
#pragma unroll
            for (int r = 0; r < 9; ++r) { const f32x4 sv = *(const LAS f32x4*)(s + r * D + F.wave * 128 + k4); acc[r] += sv.x * wv[0]; acc[r] += sv.y * wv[1]; acc[r] += sv.z * wv[2]; acc[r] += sv.w * wv[3]; }
        }
#pragma unroll
        for (int r = 0; r < 9; ++r) part[(F.wave * 9 + r) * 64 + F.lane] = acc[r];
        __syncthreads();
        for (int i = F.tid; i < 9 * 64; i += NTHR) { const int r = i >> 6, l = i & 63; float sum = 0.f;
#pragma unroll
            for (int w = 0; w < 8; ++w) sum += part[(w * 9 + r) * 64 + l];
            modx[r * 6144 + F.vcu * 64 + l] = sum + p.b_mod[F.vcu * 64 + l]; }
        __syncthreads();
    }
    if (F.vcu == 96) {
        float2* tab = (float2*)(p.ws + WS_ROPE);
        for (int idx = F.tid; idx < 96 * 16; idx += NTHR) {
            const int pos = idx >> 4, i = idx & 15;
            const float invf = exp2f(-(float)i * (13.287712379549449f / 16.f));
            const float pv = (float)(pos < 32 ? pos : pos - 32);
            float rev = pv * invf * 0.15915494309189535f; rev -= rintf(rev);
            tab[idx] = make_float2(__builtin_amdgcn_cosf(rev), __builtin_amdgcn_sinf(rev));
        }
    }
    for (int nb = F.vcu - 97; nb >= 0 && nb < 48; nb += F.G) {
        bf16* wr = (bf16*)(p.ws + WS_WR);
        for (int i = nb * 1024 + F.tid; i < (nb + 1) * 1024; i += NTHR) {
            const int j = i & 7, ln = (i >> 3) & 63, q = i >> 9, nt = q % 3, ks = q / 3;
            const int k = 32 * ks + 8 * (ln >> 4) + j, n = 16 * nt + (ln & 15);
            const float w = n < 4 ? p.w_group[k * 4 + n] : n < 36 ? p.w_router[k * 32 + (n - 4)] : 0.f;
            const unsigned hi = f2bf(w); const unsigned lo = f2bf(w - bf2f((bf16)hi));
            wr[i] = (bf16)hi; wr[48 * D + i] = (bf16)lo; }
    }
    LAS float* scr = (LAS float*)(F.lds + F.wave * 16384);
    const int gw = F.vcu * NWAVES + F.wave, NGW = F.G * NWAVES;
    constexpr int I_IN = 16 * 48, I_OUT = 16 * 32, I_G = 32 * 256, I_D = 32 * 256, NITEMS = WCONV_IN_ATTN ? I_IN + I_OUT : I_IN + I_OUT + 2 * I_G + I_D;
    for (int it = gw; it < NITEMS; it += NGW) {
        int r = it;
        if (r < I_IN) { const int kb = r / 48, nb = r % 48; p0_transpose_item(p.w_in, NQKV, (bf16*)(p.ws + WS_WQKV), D, qkv_row(nb * 32), kb * 64, nb * 32, scr, F.lane, nullptr); continue; } r -= I_IN;
        if (r < I_OUT) { const int kb = r / 32, nb = r % 32; const float* g = kb < 8 ? p.aon + kb * 64 : p.bon + (kb - 8) * 64;
            p0_transpose_item(p.w_out, D, (bf16*)(p.ws + WS_WO), D, nb * 32, kb * 64, nb * 32, scr, F.lane, g); continue; } r -= I_OUT;
        if (r < 2 * I_G) { const int up = r >= I_G; if (up) r -= I_G; const int e = r >> 8, q = r & 255, kb = q >> 4, nb = q & 15; const int j0 = nb * 32;
            p0_transpose_item((up ? p.w_up : p.w_gate) + (size_t)e * 1024 * 512, 512, (bf16*)(p.ws + WS_WGU) + (size_t)e * 1024 * 1024, D, (j0 >> 7) * 256 + up * 128 + (j0 & 127), kb * 64, j0, scr, F.lane, nullptr); continue; } r -= 2 * I_G;
        { const int e = r >> 8, q = r & 255, kb = q >> 5, nb = q & 31;
            p0_transpose_item(p.w_down + (size_t)e * 512 * 1024, D, (bf16*)(p.ws + WS_WD) + (size_t)e * 1024 * 512, EFF, nb * 32, kb * 64, nb * 32, scr, F.lane, nullptr); }
    }
}
__device__ __forceinline__ void p1_norm(const P& p, Frame& F) {
    const int gw = F.vcu * NWAVES + F.wave, NGW = F.G * NWAVES;
    const float* modall = (const float*)(p.ws + WS_MODX);
    for (int r = gw; r < MT; r += NGW) {
        const float* src = r < ML ? p.x + (size_t)r * D : p.ctx + (size_t)(r - ML) * D;
        const float* modx = modall + (r < ML ? (r / T) : 8) * 6144;
        const GAS f32x4* xr = (const GAS f32x4*)src + F.lane;
        f32x4 v[4]; float s = 0.f;
#pragma unroll
        for (int j = 0; j < 4; ++j) { v[j] = __builtin_nontemporal_load((const f32x4*)((const float*)src + 4 * (F.lane + 64 * j))); s += (v[j].x * v[j].x + v[j].y * v[j].y) + (v[j].z * v[j].z + v[j].w * v[j].w); }
        const float rn = rsqrtf(wave_sum(s) * (1.f / D) + EPS);
        GAS v2u* o8 = (GAS v2u*)((bf16*)(p.ws + WS_XN) + (size_t)r * D) + F.lane;
#pragma unroll
        for (int j = 0; j < 4; ++j) { const int k = 4 * (F.lane + 64 * j);
            const f32x4 g = *(const f32x4*)(p.pre1 + k), sc = *(const f32x4*)(modx + 1024 + k), sh = *(const f32x4*)(modx + k);
            const f32x4 h = v[j] * rn * g * (sc + 1.f) + sh;
            v2u w; w.x = pk2(h.x, h.y); w.y = pk2(h.z, h.w); st8((void*)(o8 + 64 * j), w); }
    }
}


constexpr int LDS_X = 147456;
__device__ __forceinline__ void p4_outproj(const P& p, Frame& F) {
    LAS float* tab = (LAS float*)(F.lds + LDS_X);
    for (int i = 0;; ++i) {
        const int L = i * F.G + (int)blockIdx.x; if (L >= 256) break;
        const int xcd = L & 7, off = L >> 3, w = xcd * 32 + off;
        pg8::Unit u; u.pm = (w >> 5) * 8 + (w & 7); u.pn = (w & 31) >> 3;
        if (F.tid < 256) {
            const f32x4* s4 = (const f32x4*)((const float*)(p.ws + WS_SSQ) + (size_t)(u.pm * 256 + F.tid) * 16);
            const f32x4 a0 = s4[0], a1 = s4[1], b0 = s4[2], b1 = s4[3];
            const float sa = ((a0.x + a0.y) + (a0.z + a0.w)) + ((a1.x + a1.y) + (a1.z + a1.w)), sb = ((b0.x + b0.y) + (b0.z + b0.w)) + ((b1.x + b1.y) + (b1.z + b1.w));
            const float ra = rsqrtf(sa * (1.f / 512.f) + EPS), rb = rsqrtf(sb * (1.f / 512.f) + EPS);
            tab[2 * F.tid] = ra / rb; tab[2 * F.tid + 1] = rb;
        }
        __syncthreads();
        pg8::Gemm g{(const pg8::bf16_t*)(p.ws + WS_O), (const pg8::bf16_t*)(p.ws + WS_WO), ML, D, D};
        pg8::SchedOne S{u};
        pg8::EpiOut E{(bf16*)(p.ws + WS_OX), tab};
        pg8::gemm_phase<pg8::EpiOut, pg8::SchedOne, false, true, false>((PG8_LAS unsigned char*)F.lds, g, S, E);
    }
}
constexpr int P5_PITCH = 2064;
constexpr int P5_PART = 64 * P5_PITCH, P5_LG = 0;
static_assert(P5_PART + 8 * 16 * 48 * 4 <= MISC_OFF && 64 * 48 * 4 <= P5_PART, "P5 LDS map");
__device__ __forceinline__ void p5_rowpass(const P& p, Frame& F, int abl = 0) {
    LAS unsigned char* LO = F.lds;
    LAS float* PART = (LAS float*)(F.lds + P5_PART); LAS float* LG = (LAS float*)(F.lds + P5_LG);
    LAS int* hist = (LAS int*)(F.lds + MISC_OFF) + 64;
    const bf16* WRh = (const bf16*)(p.ws + WS_WR); const bf16* WRl = WRh + 48 * D;
    for (int rb = F.vcu; rb < ML / 64; rb += F.G) {
        if (F.tid < 32) hist[F.tid] = 0;
        const int b = (rb * 64) / T;
        const float* modx = (const float*)(p.ws + WS_MODX) + b * 6144;
        if (!(abl & 2)) {
            f32x4 gp[4], mp[4], ap[4];
#pragma unroll
            for (int j = 0; j < 4; ++j) { const int k = 256 * j + 4 * F.lane;
                gp[j] = *(const f32x4*)(modx + 2048 + k) * *(const f32x4*)(p.post1 + k);
                mp[j] = *(const f32x4*)(p.pre2 + k) * (*(const f32x4*)(modx + 4096 + k) + 1.f);
                ap[j] = *(const f32x4*)(modx + 3072 + k); }
            f32x4 xn[4]; v2u on[4];
#define P5_LOAD(rw) do { _Pragma("unroll") for (int j = 0; j < 4; ++j) { xn[j] = __builtin_nontemporal_load((const f32x4*)(p.x + (size_t)(rw) * D + 256 * j + 4 * F.lane)); \
                on[j] = __builtin_nontemporal_load((const v2u*)((const bf16*)(p.ws + WS_OX) + (size_t)(rw) * D + 256 * j + 4 * F.lane)); } } while (0)
            P5_LOAD(rb * 64 + F.wave * 8);
            for (int rr = 0; rr < 8; ++rr) {
                const int rl = F.wave * 8 + rr, row = rb * 64 + rl;
                f32x4 xv[4], ox[4]; v2u oc[4]; float ss = 0.f;
#pragma unroll
                for (int j = 0; j < 4; ++j) { xv[j] = xn[j]; oc[j] = on[j]; }
                if (rr + 1 < 8) P5_LOAD(row + 1);
#pragma unroll
                for (int j = 0; j < 4; ++j) { const v2u o2 = oc[j];
                    ox[j] = (f32x4){__uint_as_float(o2.x << 16), __uint_as_float(o2.x & 0xffff0000u), __uint_as_float(o2.y << 16), __uint_as_float(o2.y & 0xffff0000u)};
                    ss += (ox[j].x * ox[j].x + ox[j].y * ox[j].y) + (ox[j].z * ox[j].z + ox[j].w * ox[j].w); }
                const float r1 = rsqrtf(wave_sum(ss) * (1.f / D) + EPS);
                float ss2 = 0.f;
#pragma unroll
                for (int j = 0; j < 4; ++j) { xv[j] = xv[j] + gp[j] * (ox[j] * r1);
                    ss2 += (xv[j].x * xv[j].x + xv[j].y * xv[j].y) + (xv[j].z * xv[j].z + xv[j].w * xv[j].w); }
                const float r2 = rsqrtf(wave_sum(ss2) * (1.f / D) + EPS);
                if (F.lane == 0) ((float*)(p.ws + WS_R1))[row] = r1;
#pragma unroll
                for (int j = 0; j < 4; ++j) {
                    const f32x4 h = xv[j] * r2 * mp[j] + ap[j];
                    v2u wh; wh.x = att::cvtpk(h.x, h.y); wh.y = att::cvtpk(h.z, h.w);
                    const f32x4 hb = (f32x4){__uint_as_float(wh.x << 16), __uint_as_float(wh.x & 0xffff0000u), __uint_as_float(wh.y << 16), __uint_as_float(wh.y & 0xffff0000u)};
                    const f32x4 dl = h - hb;
                    v2u wl; wl.x = att::cvtpk(dl.x, dl.y); wl.y = att::cvtpk(dl.z, dl.w);
                    st8((bf16*)(p.ws + WS_XN) + (size_t)row * D + 256 * j + 4 * F.lane, wh);
                    *(LAS v2u*)(LO + rl * P5_PITCH + (256 * j + 4 * F.lane) * 2) = wl;
                }
            }
#undef P5_LOAD
        }
        asm volatile("s_waitcnt vmcnt(0)" ::: "memory");
        __syncthreads();
        if (F.tid == 0) { __builtin_amdgcn_fence(__ATOMIC_ACQUIRE, "agent"); asm volatile("s_waitcnt vmcnt(0)" ::: "memory"); }
        __syncthreads();
        if (abl & 1) continue;
        {
            const int gI = F.wave >> 1, kq = F.wave & 1, r16 = F.lane & 15, g4 = F.lane >> 4;
            f32x4 acc[3];
#pragma unroll
            for (int nt = 0; nt < 3; ++nt) acc[nt] = (f32x4){0.f, 0.f, 0.f, 0.f};
            const bf16* ah = (const bf16*)(p.ws + WS_XN) + (size_t)(rb * 64 + 16 * gI + r16) * D + 512 * kq + 8 * g4;
            const LAS unsigned char* al = LO + (16 * gI + r16) * P5_PITCH + (512 * kq + 8 * g4) * 2;
            const bf16* bh = WRh + (size_t)(16 * kq) * 3 * 512 + F.lane * 8; const bf16* bl = WRl + (size_t)(16 * kq) * 3 * 512 + F.lane * 8;
#pragma unroll 8
            for (int ks = 0; ks < 16; ++ks) {
                const bf16x8 a_hi = *(const bf16x8*)(ah + ks * 32), a_lo = *(const LAS bf16x8*)(al + ks * 64);
#pragma unroll
                for (int nt = 0; nt < 3; ++nt) {
                    const bf16x8 b_hi = *(const bf16x8*)(bh + (ks * 3 + nt) * 512), b_lo = *(const bf16x8*)(bl + (ks * 3 + nt) * 512);
                    acc[nt] = __builtin_amdgcn_mfma_f32_16x16x32_bf16(a_hi, b_hi, acc[nt], 0, 0, 0);
                    acc[nt] = __builtin_amdgcn_mfma_f32_16x16x32_bf16(a_hi, b_lo, acc[nt], 0, 0, 0);
                    acc[nt] = __builtin_amdgcn_mfma_f32_16x16x32_bf16(a_lo, b_hi, acc[nt], 0, 0, 0);
                }
            }
#pragma unroll
            for (int nt = 0; nt < 3; ++nt)
#pragma unroll
                for (int q = 0; q < 4; ++q) PART[(F.wave * 16 + 4 * g4 + q) * 48 + 16 * nt + r16] = acc[nt][q];
        }
        __syncthreads();
        for (int i = F.tid; i < 64 * 48; i += NTHR) { const int row = i / 48, n = i - row * 48, gI = row >> 4, r16 = row & 15;
            LG[i] = (PART[((gI * 2 + 0) * 16 + r16) * 48 + n] + PART[((gI * 2 + 1) * 16 + r16) * 48 + n]) + (n < 4 ? p.b_group[n] : n < 36 ? p.b_router[n - 4] : 0.f); }
        __syncthreads();
        if (F.tid < 64) {
            float lg[36];
#pragma unroll
            for (int c = 0; c < 36; ++c) lg[c] = LG[F.tid * 48 + c];
            int e1, e2; float w1, w2;
            {
                int g = 0; float gm = lg[0];
#pragma unroll
                for (int q = 1; q < 4; ++q) if (lg[q] > gm) { gm = lg[q]; g = q; }
                float gs = 0.f;
#pragma unroll
                for (int q = 0; q < 4; ++q) gs += __expf(lg[q] - gm);
                const float gw = 1.f / gs;
                float el[8];
#pragma unroll
                for (int q = 0; q < 8; ++q) el[q] = g == 0 ? lg[4 + q] : g == 1 ? lg[12 + q] : g == 2 ? lg[20 + q] : lg[28 + q];
                int i1 = 0; float m1 = el[0];
#pragma unroll
                for (int q = 1; q < 8; ++q) if (el[q] > m1) { m1 = el[q]; i1 = q; }
                int i2 = -1; float m2 = -3.0e38f;
#pragma unroll
                for (int q = 0; q < 8; ++q) if (q != i1 && el[q] > m2) { m2 = el[q]; i2 = q; }
                const float ex = __expf(m2 - m1);
                w1 = gw / (1.f + ex); w2 = gw * ex / (1.f + ex); e1 = g * 8 + i1; e2 = g * 8 + i2;
            }
            const int row = rb * 64 + F.tid;
            if (!(abl & 2)) { int* te = (int*)(p.ws + WS_TOKE) + row * 2; float* tw = (float*)(p.ws + WS_TOKW) + row * 2; te[0] = e1; te[1] = e2; tw[0] = w1; tw[1] = w2; }
            atomicAdd((int*)&hist[e1 & 31], 1); atomicAdd((int*)&hist[e2 & 31], 1);
        }
        __syncthreads();
        if (F.tid < 32 && !(abl & 2)) ((int*)(p.ws + WS_BLKCNT))[rb * 32 + F.tid] = hist[F.tid];
        __syncthreads();
    }
}
__device__ __forceinline__ void p6_lists(const P& p, Frame& F) {
    LAS int* ps = (LAS int*)F.lds;
    LAS int* pp = ps + 512;
    LAS int* tot = pp + 512; LAS int* pre = tot + 32; LAS int* ebase = pre + 32;
    LAS int* es = ebase + 40;
    const int* blk = (const int*)(p.ws + WS_BLKCNT);
    int* meta = (int*)(p.ws + WS_META);
    for (int rb = F.vcu; rb < ML / 64; rb += F.G) {
        { const int e = F.tid & 31, part = F.tid >> 5; int s = 0, q = 0;
#pragma unroll 4
          for (int j = 0; j < 16; ++j) { const int bb = part * 16 + j; const int v = blk[bb * 32 + e]; s += v; q += bb < rb ? v : 0; }
          ps[part * 32 + e] = s; pp[part * 32 + e] = q; }
        __syncthreads();
        if (F.tid < 32) { int s = 0, q = 0;
#pragma unroll
            for (int part = 0; part < 16; ++part) { s += ps[part * 32 + F.tid]; q += pp[part * 32 + F.tid]; }
            tot[F.tid] = s; pre[F.tid] = q; }
        __syncthreads();
        if (F.tid == 0) { int tb = 0; for (int e = 0; e < 32; ++e) { ebase[e] = tb; tb += (tot[e] + 255) >> 8; } ebase[32] = tb; }
        if (F.tid < 128) es[F.tid] = ((const int*)(p.ws + WS_TOKE))[rb * 128 + F.tid];
        __syncthreads();
        if (F.tid < 128) {
            const int e = es[F.tid]; int rank = 0;
            for (int a = 0; a < F.tid; ++a) rank += es[a] == e ? 1 : 0;
            const int pos = ebase[e] * 256 + pre[e] + rank;
            ((int*)(p.ws + WS_ROWIDX))[pos] = rb * 64 + (F.tid >> 1);
            ((float*)(p.ws + WS_ROWW))[pos] = ((const float*)(p.ws + WS_TOKW))[rb * 128 + F.tid];
            ((int*)(p.ws + WS_TOKPOS))[rb * 128 + F.tid] = pos;
        }
        if (rb < 32) {
            const int e = rb, lo = ebase[e] * 256 + tot[e], hi = ebase[e + 1] * 256;
            for (int pos = lo + F.tid; pos < hi; pos += NTHR) { ((int*)(p.ws + WS_ROWIDX))[pos] = 0; ((float*)(p.ws + WS_ROWW))[pos] = 0.f; }
            for (int t = ebase[e] + F.tid; t < ebase[e + 1]; t += NTHR) meta[128 + t] = e;
            if (F.tid == 0) { meta[e] = tot[e]; meta[64 + e] = ebase[e]; if (e == 31) { meta[64 + 32] = ebase[32]; meta[320] = ebase[32]; } }
        }
        __syncthreads();
    }
}
__device__ __forceinline__ void p78_moe(const P& p, Frame& F, bool down) {
    LAS int* tile_e = (LAS int*)(F.lds + LDS_X);
    const int* meta = (const int*)(p.ws + WS_META);
    for (int t = F.tid; t < MAXTILES; t += NTHR) tile_e[t] = meta[128 + t] & 31;
    __syncthreads();
    const int ntiles = meta[320];
    pg8::SchedMoE S{F.G, (int)blockIdx.x, ntiles * 4, tile_e, (const int*)(p.ws + WS_ROWIDX)};
    if (!down) {
        pg8::Gemm g{(const pg8::bf16_t*)(p.ws + WS_XN), (const pg8::bf16_t*)(p.ws + WS_WGU), MAXPOS, NE * 1024, D};
        pg8::EpiGU E{(bf16*)(p.ws + WS_ACT), (const float*)(p.ws + WS_ROWW)};
        pg8::gemm_phase<pg8::EpiGU, pg8::SchedMoE, true, true, true>((PG8_LAS unsigned char*)F.lds, g, S, E);
    } else {
        pg8::Gemm g{(const pg8::bf16_t*)(p.ws + WS_ACT), (const pg8::bf16_t*)(p.ws + WS_WD), MAXPOS, NE * 1024, EFF};
        pg8::EpiY E{(bf16*)(p.ws + WS_Y)};
        pg8::gemm_phase<pg8::EpiY, pg8::SchedMoE, true, true, false>((PG8_LAS unsigned char*)F.lds, g, S, E);
    }
}
__device__ __forceinline__ void p9_final(const P& p, Frame& F, float* dst) {
    const bf16* Y = (const bf16*)(p.ws + WS_Y); const bf16* OX = (const bf16*)(p.ws + WS_OX); const float* R1 = (const float*)(p.ws + WS_R1);
    for (int rb = F.vcu; rb < ML / 64; rb += F.G) {
        const int b = (rb * 64) / T;
        const float* modx = (const float*)(p.ws + WS_MODX) + b * 6144;
        const int row0 = rb * 64 + F.wave * 8;
        f32x4 gp[4], g1p[4];
#pragma unroll
        for (int j = 0; j < 4; ++j) { const int k = 256 * j + 4 * F.lane; gp[j] = *(const f32x4*)(modx + 5120 + k) * *(const f32x4*)(p.post2 + k); g1p[j] = *(const f32x4*)(modx + 2048 + k) * *(const f32x4*)(p.post1 + k); }
        v2u ya[2][4], yc[2][4], oo[2][4]; f32x4 xo[2][4]; float r1v[2];
        const int* tpp = (const int*)(p.ws + WS_TOKPOS) + row0 * 2;
#define P9_LOAD(buf, rw, t2) do { r1v[buf] = R1[rw]; _Pragma("unroll") for (int j = 0; j < 4; ++j) { \
            ya[buf][j] = __builtin_nontemporal_load((const v2u*)(Y + (size_t)(t2).x * D + 256 * j + 4 * F.lane)); yc[buf][j] = __builtin_nontemporal_load((const v2u*)(Y + (size_t)(t2).y * D + 256 * j + 4 * F.lane)); \
            oo[buf][j] = __builtin_nontemporal_load((const v2u*)(OX + (size_t)(rw) * D + 256 * j + 4 * F.lane)); xo[buf][j] = __builtin_nontemporal_load((const f32x4*)(p.x + (size_t)(rw) * D + 256 * j + 4 * F.lane)); } } while (0)
#define P9_COMP(buf, rw) do { f32x4 y[4]; float ss = 0.f; \
            _Pragma("unroll") for (int j = 0; j < 4; ++j) { const v2u a = ya[buf][j], c = yc[buf][j]; \
                y[j] = (f32x4){__uint_as_float(a.x << 16) + __uint_as_float(c.x << 16), __uint_as_float(a.x & 0xffff0000u) + __uint_as_float(c.x & 0xffff0000u), \
                               __uint_as_float(a.y << 16) + __uint_as_float(c.y << 16), __uint_as_float(a.y & 0xffff0000u) + __uint_as_float(c.y & 0xffff0000u)}; \
                ss += (y[j].x * y[j].x + y[j].y * y[j].y) + (y[j].z * y[j].z + y[j].w * y[j].w); } \
            const float rn = rsqrtf(wave_sum(ss) * (1.f / D) + EPS); \
            _Pragma("unroll") for (int j = 0; j < 4; ++j) { const v2u o2 = oo[buf][j]; \
                const f32x4 oxv = (f32x4){__uint_as_float(o2.x << 16), __uint_as_float(o2.x & 0xffff0000u), __uint_as_float(o2.y << 16), __uint_as_float(o2.y & 0xffff0000u)}; \
                const f32x4 x1 = xo[buf][j] + g1p[j] * (oxv * r1v[buf]);                   \
                __builtin_nontemporal_store(x1 + gp[j] * (y[j] * rn), (f32x4*)(dst + (size_t)(rw) * D + 256 * j + 4 * F.lane)); } } while (0)
        int2 tpA = *(const int2*)(tpp), tpB = *(const int2*)(tpp + 2);
        P9_LOAD(0, row0, tpA);
#pragma unroll 1
        for (int rp = 0; rp < 4; ++rp) {
            const int ra = row0 + 2 * rp;
            P9_LOAD(1, ra + 1, tpB);
            int2 tpA2 = tpA, tpB2 = tpB;
            if (rp < 3) { tpA2 = *(const int2*)(tpp + 4 * rp + 4); tpB2 = *(const int2*)(tpp + 4 * rp + 6); }
            P9_COMP(0, ra);
            if (rp < 3) P9_LOAD(0, ra + 2, tpA2);
            P9_COMP(1, ra + 1);
            tpA = tpA2; tpB = tpB2;
        }
#undef P9_COMP
#undef P9_LOAD
    }
}

struct Args { P p; int ph_lo, ph_hi, li, pad; };
__global__ void __launch_bounds__(NTHR, 2) mega(Args args) {
    extern __shared__ __attribute__((aligned(16))) unsigned char lds_raw[];
    Frame F;
    F.lds = (LAS unsigned char*)lds_raw;
    F.MISC = (volatile LAS unsigned*)(F.lds + MISC_OFF);
    F.tid = threadIdx.x; F.lane = F.tid & 63; F.wave = __builtin_amdgcn_readfirstlane(F.tid >> 6);
    F.G = gridDim.x; { const int bx = blockIdx.x; F.vcu = (F.G % 8 == 0) ? (bx % 8) * (F.G / 8) + bx / 8 : bx; }
    const P& p = args.p;
    unsigned* ctl = (unsigned*)(p.ws + WS_CTL);
    for (int u = F.tid; u < (LDS_BYTES - MISC_OFF) / 4; u += NTHR) ((LAS unsigned*)(F.lds + MISC_OFF))[u] = 0u;
    __syncthreads();
    const int lo = args.ph_lo, hi = args.ph_hi;
    XcdBarrier bar; bar.bar = ctl + CW_BAR + args.li * XCD_BAR_WORDS; bar.x = 0; bar.st = nullptr;
    if (hi - lo > 1) bar = xcd_barrier_post(ctl + CW_BAR + args.li * XCD_BAR_WORDS, F.MISC + 8);
#define IN(k) (lo <= (k) && (k) < hi)
#define SEAM(k) do { if (IN(k) && IN((k) + 1)) xcd_barrier(bar); } while (0)
    if (IN(0)) { p0_prologue(p, F); SEAM(0); }
    if (IN(1)) { p1_norm(p, F); SEAM(1); }
    if (IN(2)) {
        pg8::Gemm g{(const pg8::bf16_t*)(p.ws + WS_XN), (const pg8::bf16_t*)(p.ws + WS_WQKV), MT, NQKV, D};
        pg8::SchedQKV S{F.G, (int)blockIdx.x};
        pg8::EpiQKV E{p.ws, p.bqn, p.bkn};
        pg8::gemm_phase<pg8::EpiQKV, pg8::SchedQKV, true, true, false>((PG8_LAS unsigned char*)F.lds, g, S, E);
        SEAM(2);
    }
#ifdef PROBE_ABL
    if (IN(3) && args.pad) { att::attn_phase<PROBE_ABL>(p, F.lds, F.vcu, F.G); } else
#endif
    if (IN(3)) { att::attn_phase<0>(p, F.lds, F.vcu, F.G); SEAM(3); }
    if (IN(4)) { p4_outproj(p, F); SEAM(4); }
#ifdef PROBE_ABL5
    if (IN(5) && args.pad) { p5_rowpass(p, F, PROBE_ABL5); } else
#endif
    if (IN(5)) { p5_rowpass(p, F); SEAM(5); }
    if (IN(6)) { p6_lists(p, F); SEAM(6); }
    if (IN(7)) { p78_moe(p, F, false); SEAM(7); }
    if (IN(8)) { p78_moe(p, F, true); SEAM(8); }
    if (IN(9)) { p9_final(p, F, args.pad ? (float*)(p.ws + WS_WGU) : p.out); }
#undef IN
#undef SEAM
}

#ifndef ONE_LAUNCH
#define ONE_LAUNCH 1
#endif
#ifndef FAST_MASK
#define FAST_MASK 0x3ff
#endif
static void launch_mega(const P& p, int lo, int hi, int li, int grid, hipStream_t stream) {
    Args a{}; a.p = p; a.ph_lo = lo; a.ph_hi = hi; a.li = li; a.pad = 0;
    hipLaunchKernelGGL(mega, dim3(grid), dim3(NTHR), LDS_BYTES, stream, a);
}
extern "C" void kernel_launch(void* const* d_in, const int* in_sizes, int n_in, void* d_out, int out_size, void* d_ws, size_t ws_size, hipStream_t stream) {
    static int grid = 0;
    if (grid == 0) {
        if (n_in != 24 || out_size != ML * D || ws_size < WS_END) { fprintf(stderr, "kernel_launch: unexpected shapes (n_in %d out %d ws %zu)\n", n_in, out_size, ws_size); grid = -1; return; }
        int dev = 0, cus = 0, per_cu = 0;
        if (hipGetDevice(&dev) != hipSuccess || hipDeviceGetAttribute(&cus, hipDeviceAttributeMultiprocessorCount, dev) != hipSuccess) { grid = -1; return; }
        if (hipFuncSetAttribute((const void*)mega, hipFuncAttributeMaxDynamicSharedMemorySize, LDS_BYTES) != hipSuccess) { fprintf(stderr, "kernel_launch: hipFuncSetAttribute failed\n"); grid = -1; return; }
        if (hipOccupancyMaxActiveBlocksPerMultiprocessor(&per_cu, (const void*)mega, NTHR, LDS_BYTES) != hipSuccess || per_cu < 1) { fprintf(stderr, "kernel_launch: occupancy query says %d blocks/CU\n", per_cu); (void)hipGetLastError(); grid = -1; return; }
        grid = cus;
    }
    if (grid < 0) return;
    P p{};
    const float** f = (const float**)&p;
    for (int i = 0; i < 24; ++i) f[i] = (const float*)d_in[i];
    p.out = (float*)d_out; p.ws = (unsigned char*)d_ws;
    (void)hipMemsetAsync((char*)d_ws + WS_CTL, 0, 64 * 1024, stream);
#if ONE_LAUNCH
    launch_mega(p, 0, 10, 0, grid, stream);
#else
    for (int k = 0; k < 10; ++k) {
        launch_mega(p, k, k + 1, 0, grid, stream);
#ifdef PROBE_DUP
        if (k == PROBE_DUP) for (int r_ = 0; r_ < 3; ++r_) { Args a{}; a.p = p; a.ph_lo = k; a.ph_hi = k + 1; a.li = 0; a.pad = 1; hipLaunchKernelGGL(mega, dim3(grid), dim3(NTHR), LDS_BYTES, stream, a); }
#endif
    }
#endif
}
```

```cpp
#include <hip/hip_runtime.h>
#include <cstdio>
#include <cstdint>
#ifndef WCONV_IN_ATTN
#define WCONV_IN_ATTN 1
#endif

constexpr int NB = 8, T = 2048, D = 1024, CL = 256;
constexpr int ML = NB * T;
constexpr int MC = NB * CL;
constexpr int MT = ML + MC;
constexpr int NKEY = T + CL;
constexpr int NTILE = NKEY / 64;
constexpr int NQKV = 1536;
constexpr int NE = 32, EFF = 512;
constexpr int MAXPOS = 40960;
constexpr int MAXTILES = MAXPOS / 256;
constexpr float EPS = 1e-6f;
constexpr float LOG2E = 1.4426950408889634f;
constexpr float C2 = 0.125f * LOG2E;

typedef unsigned short bf16;

constexpr size_t MiB = 1u << 20;
constexpr size_t WS_CTL = 0;
constexpr size_t WS_MODX = 1 * MiB;
constexpr size_t WS_ROPE = 1 * MiB + 512 * 1024;
constexpr size_t WS_WR = 1 * MiB + 768 * 1024;
constexpr size_t WS_TOKE = 2 * MiB;
constexpr size_t WS_TOKW = WS_TOKE + 128 * 1024;
constexpr size_t WS_TOKPOS = WS_TOKW + 128 * 1024;
constexpr size_t WS_ROWIDX = WS_TOKPOS + 128 * 1024;
constexpr size_t WS_ROWW = WS_ROWIDX + 160 * 1024;
constexpr size_t WS_BLKCNT = WS_ROWW + 160 * 1024;
constexpr size_t WS_META = WS_BLKCNT + 32 * 1024;
constexpr size_t WS_WQKV = 4 * MiB;
constexpr size_t WS_WO = 7 * MiB;
constexpr size_t WS_WGU = 9 * MiB;
constexpr size_t WS_WD = 73 * MiB;
constexpr size_t WS_XN = 105 * MiB;
constexpr size_t WS_QA = 141 * MiB;
constexpr size_t WS_QB = 157 * MiB;
constexpr size_t WS_KA = 173 * MiB;
constexpr size_t WS_VA = WS_KA + 4608 * 1024;
constexpr size_t WS_KB = WS_VA + 4608 * 1024;
constexpr size_t WS_VB = WS_KB + 4608 * 1024;
constexpr size_t WS_O = 191 * MiB;
constexpr size_t WS_SSQ = 223 * MiB;
constexpr size_t WS_OX = 261 * MiB;
constexpr size_t WS_R1 = 293 * MiB;
constexpr size_t WS_ACT = 141 * MiB;
constexpr size_t WS_Y = 181 * MiB;
constexpr size_t WS_END = 294 * MiB;

__device__ __forceinline__ unsigned f2bf(float f) { unsigned u = __builtin_bit_cast(unsigned, f); return (u + 0x7fffu + ((u >> 16) & 1u)) >> 16; }
__device__ __forceinline__ float bf2f(bf16 h) { return __builtin_bit_cast(float, (unsigned)h << 16); }
__device__ __forceinline__ float dpp_add(float v, const int ctrl_sel) {
    const int x = __builtin_bit_cast(int, v); int y;
    switch (ctrl_sel) { case 0: y = __builtin_amdgcn_update_dpp(x, x, 0xB1, 0xF, 0xF, false); break;
                        case 1: y = __builtin_amdgcn_update_dpp(x, x, 0x4E, 0xF, 0xF, false); break;
                        case 2: y = __builtin_amdgcn_update_dpp(x, x, 0x141, 0xF, 0xF, false); break;
                        default: y = __builtin_amdgcn_update_dpp(x, x, 0x140, 0xF, 0xF, false); break; }
    return v + __builtin_bit_cast(float, y);
}
__device__ __forceinline__ float wave_sum(float v) {
    v = dpp_add(v, 0); v = dpp_add(v, 1); v = dpp_add(v, 2); v = dpp_add(v, 3);
    const int x = __builtin_bit_cast(int, v);
    const float r0 = __builtin_bit_cast(float, __builtin_amdgcn_readlane(x, 0)), r1 = __builtin_bit_cast(float, __builtin_amdgcn_readlane(x, 16));
    const float r2 = __builtin_bit_cast(float, __builtin_amdgcn_readlane(x, 32)), r3 = __builtin_bit_cast(float, __builtin_amdgcn_readlane(x, 48));
    return (r0 + r1) + (r2 + r3);
}
__device__ __forceinline__ float wave_max(float v) {
#pragma unroll
    for (int o = 1; o < 64; o <<= 1) v = fmaxf(v, __shfl_xor(v, o));
    return v;
}
__device__ __forceinline__ float silu_f(float v) { return v / (1.f + __expf(-v)); }

__host__ __device__ __forceinline__ int qkv_row(int n) { const int pn = n >> 8, j = n & 255, hh = j >> 6, d = j & 63; return pn * 256 + (d >> 5) * 128 + hh * 32 + (d & 31); }
__host__ __device__ __forceinline__ size_t q_off(int b, int h, int t, int d) { return (((size_t)(b * 8 + h) * T + t) * 64 + d); }
__host__ __device__ __forceinline__ size_t k_off(int b, int kvh, int pos, int d) { return ((size_t)((b * 2 + kvh) * NTILE + (pos >> 6)) * 4096 + (d >> 3) * 512 + (pos & 63) * 8 + (d & 7)); }
__host__ __device__ __forceinline__ size_t v_off(int b, int kvh, int pos, int d) { return ((size_t)((b * 2 + kvh) * NTILE + (pos >> 6)) * 4096 + (d >> 5) * 2048 + (pos & 63) * 32 + (d & 31)); }

struct P {
    const float *x, *c, *ctx, *c_ctx, *w_mod, *b_mod, *pre1, *post1, *w_in, *a_sink, *bqn, *bkn, *aon, *bon, *w_out, *pre2, *post2, *w_group, *b_group, *w_router, *b_router, *w_gate, *w_up, *w_down;
    float* out; unsigned char* ws;
};

#define GAS __attribute__((address_space(1)))
#define LAS __attribute__((address_space(3)))
typedef unsigned v4u __attribute__((ext_vector_type(4)));
typedef unsigned v2u __attribute__((ext_vector_type(2)));
typedef float f32x4 __attribute__((ext_vector_type(4)));
typedef float f32x16 __attribute__((ext_vector_type(16)));
typedef short bf16x8 __attribute__((ext_vector_type(8)));
typedef short s16x4 __attribute__((ext_vector_type(4)));
constexpr int NWAVES = 8, NTHR = 512;
constexpr int LDS_BYTES = 163840;
constexpr int RING_BYTES = 131072;
constexpr int MISC_OFF = 159 * 1024;
constexpr int CW_TMO = 0, CW_CODE = 1, CW_BAR = 4096;
static_assert((CW_BAR + 3456) * 4 <= 64 * 1024, "control words inside the per-call memset");
#define LDS_WAIT() asm volatile("s_waitcnt lgkmcnt(0)" ::: "memory")
#define VM_WAIT() asm volatile("s_waitcnt vmcnt(0)" ::: "memory")
__device__ __forceinline__ unsigned pk2(float lo, float hi) { return f2bf(lo) | (f2bf(hi) << 16); }
#ifndef WT_STORES
#define WT_STORES 0
#endif
__device__ __forceinline__ void st16(void* p, v4u v) {
#if WT_STORES
    asm volatile("global_store_dwordx4 %0, %1, off sc1\n\ts_nop 1" :: "v"(p), "v"(v) : "memory");
#else
    *(v4u*)p = v;
#endif
}
__device__ __forceinline__ void st16_nt(void* p, v4u v) { __builtin_nontemporal_store(v, (v4u*)p); }
__device__ __forceinline__ void st16f(void* p, f32x4 v) { st16(p, __builtin_bit_cast(v4u, v)); }
__device__ __forceinline__ void st8(void* p, v2u v) {
#if WT_STORES
    asm volatile("global_store_dwordx2 %0, %1, off sc1\n\ts_nop 1" :: "v"(p), "v"(v) : "memory");
#else
    *(v2u*)p = v;
#endif
}

#define XB_TMO      128
#define XB_XCNT(j)  (256  + 64 * (j))
#define XB_XSUB(j)  (1280 + 64 * (j))
#define XB_XGEN(j)  (2304 + 64 * (j))
#define XB_TOP      3328
#define XB_TOPGEN   3392
#define XCD_BAR_WORDS 3456
#define XB_SPIN_CAP (1u << 18)
__device__ __forceinline__ unsigned xb_ld(unsigned* p)              { return __hip_atomic_load(p, __ATOMIC_RELAXED, __HIP_MEMORY_SCOPE_AGENT); }
__device__ __forceinline__ unsigned xb_add(unsigned* p, unsigned v) { return __hip_atomic_fetch_add(p, v, __ATOMIC_RELAXED, __HIP_MEMORY_SCOPE_AGENT); }
__device__ __forceinline__ unsigned xb_xcc_id() { return (unsigned)__builtin_amdgcn_s_getreg((3 << 11) | 20) & 0xFu; }
#define XB_SPIN(cond, bar) do { unsigned _sp = 0; while (cond) { __builtin_amdgcn_s_sleep(1); \
    if ((++_sp & 255u) == 0u) { if (xb_ld(&(bar)[XB_TMO])) break; if (_sp > XB_SPIN_CAP) { atomicAdd(&(bar)[XB_TMO], 1u); break; } } } } while (0)
struct XcdBarrier { unsigned* bar; unsigned x; volatile LAS unsigned* st; };
__device__ __forceinline__ XcdBarrier xcd_barrier_post(unsigned* bar, volatile LAS unsigned* st) {
    XcdBarrier b; b.bar = bar; b.x = xb_xcc_id(); b.st = st;
    if (threadIdx.x == 0) (void)xb_add(&bar[XB_XCNT(b.x)], 1u);
    return b;
}
__device__ __forceinline__ void xcd_barrier_complete(unsigned* bar, unsigned x, unsigned& nloc, unsigned& nx) {
    const unsigned G = gridDim.x * gridDim.y * gridDim.z;
    unsigned sum, cnt, mine, sp = 0u;
    for (;;) {
        sum = 0u; cnt = 0u; mine = 0u;
#pragma unroll
        for (unsigned j = 0; j < 16; ++j) { const unsigned c = xb_ld(&bar[XB_XCNT(j)]); sum += c; cnt += (c > 0u) ? 1u : 0u; mine = (j == x) ? c : mine; }
        if (sum == G) break;
        __builtin_amdgcn_s_sleep(1);
        if ((++sp & 255u) == 0u) { if (xb_ld(&bar[XB_TMO])) break; if (sp > XB_SPIN_CAP) { atomicAdd(&bar[XB_TMO], 1u); break; } }
    }
    nloc = mine > 0u ? mine : 1u; nx = cnt > 0u ? cnt : 1u;
}
__device__ __forceinline__ void xcd_barrier(const XcdBarrier& b) {
    asm volatile("s_waitcnt vmcnt(0)" ::: "memory");
    __syncthreads();
    if (threadIdx.x == 0) {
        unsigned* bar = b.bar;
        __builtin_amdgcn_s_waitcnt(0);
        unsigned nloc = b.st[0], nx = b.st[1];
        if (nloc == 0u) { xcd_barrier_complete(bar, b.x, nloc, nx); b.st[0] = nloc; b.st[1] = nx; }
        const unsigned old = xb_add(&bar[XB_XSUB(b.x)], 1u);
        const unsigned gen = old / nloc;
        if (old + 1u == (gen + 1u) * nloc) {
            __builtin_amdgcn_fence(__ATOMIC_RELEASE, "agent");
            asm volatile("s_waitcnt vmcnt(0)" ::: "memory");
            const unsigned og = xb_add(&bar[XB_TOP], 1u);
            const unsigned tg = og / nx;
            if (og + 1u == (tg + 1u) * nx) xb_add(&bar[XB_TOPGEN], 1u);
            else XB_SPIN(xb_ld(&bar[XB_TOPGEN]) == tg, bar);
            __builtin_amdgcn_fence(__ATOMIC_ACQUIRE, "agent");
            xb_add(&bar[XB_XGEN(b.x)], 1u);
            asm volatile("s_waitcnt vmcnt(0)" ::: "memory");
        } else {
            XB_SPIN(xb_ld(&bar[XB_XGEN(b.x)]) == gen, bar);
            __builtin_amdgcn_fence(__ATOMIC_ACQUIRE, "agent");
            asm volatile("s_waitcnt vmcnt(0)" ::: "memory");
        }
    }
    __syncthreads();
}

namespace pg8 {
#define PG8_LAS __attribute__((address_space(3)))
typedef unsigned short bf16_t;
typedef short bf16x8 __attribute__((ext_vector_type(8)));
typedef float f32x4 __attribute__((ext_vector_type(4)));
typedef unsigned u32x4 __attribute__((ext_vector_type(4)));
constexpr int BM = 256, BK = 64, HALF = 128, HTB = HALF * BK * 2  , STAGE_BYTES = 8 * HTB, NXCD = 8, WGM = 8;

__host__ __device__ __forceinline__ int lds_byte(int r, int c) { const int st = (r >> 4) * 2 + (c >> 5), rr = r & 15, cc = c & 31, ob = rr * 64 + cc * 2; return st * 1024 + (ob ^ (((ob >> 9) & 1) << 5)); }
__host__ __device__ __forceinline__ void stage_rc(int b, int& R, int& C) { const int st = b / 1024, sb = b % 1024, swz = sb ^ (((sb >> 9) & 1) << 5); R = (st >> 1) * 16 + swz / 64; C = (st & 1) * 32 + (swz % 64) / 2; }
__host__ __device__ __forceinline__ int perm32(int rho) { const int n = rho >> 4, i = rho & 15; return 8 * (i >> 2) + 4 * n + (i & 3); }

struct Unit { int pm, pn; };
struct Gemm { const bf16_t* A; const bf16_t* Bt; int M, N, K; };
__device__ __forceinline__ unsigned cvt_pk_bf16(float lo, float hi) { unsigned r; asm volatile("v_cvt_pk_bf16_f32 %0, %1, %2" : "=v"(r) : "v"(lo), "v"(hi)); return r; }
template <class Epi, class Sched, bool ALIGN_EPI = false, bool SP2 = false, bool GATHER = false>
__device__ __forceinline__ void gemm_phase(PG8_LAS unsigned char* lds, const Gemm g, const Sched& S, const Epi& E) {
    const int tid = threadIdx.x, wid = __builtin_amdgcn_readfirstlane(tid >> 6), lane = tid & 63, wr = wid >> 2, wc = wid & 3, fr = lane & 15, fq = lane >> 4;
    const int K = g.K, nt = K / BK;
    unsigned voffA[2], voffB[2]; int RA[2], CA[2];
#pragma unroll
    for (int i = 0; i < 2; ++i) { int R, C; stage_rc(tid * 16 + i * 8192, R, C); const int Rb = Epi::PERM ? ((R & ~31) + perm32(R & 31)) : R;
        voffA[i] = (unsigned)(R * K + C) * 2u; voffB[i] = (unsigned)(Rb * K + C) * 2u; RA[i] = R; CA[i] = C; }
    const size_t kstep = (size_t)(BK * 2);
    const size_t hstep = (size_t)HALF * K * 2;
    const size_t tstep = 2 * hstep;
    const unsigned ldsw = (unsigned)wid * 1024u;
    const int aoff = lds_byte(wr * 64 + fr, fq * 8), boff = lds_byte(wc * 32 + fr, fq * 8);
#define PG8_SA(b, h) (((b) * 2 + (h)) * HTB)
#define PG8_SB(b, h) ((4 + (b) * 2 + (h)) * HTB)
#define PG8_STAGE(bufoff, gbase, voff) do { _Pragma("unroll") for (int _i = 0; _i < 2; ++_i) \
        __builtin_amdgcn_global_load_lds((const unsigned*)((const char*)(gbase) + (voff)[_i]), (PG8_LAS unsigned*)(lds + (bufoff) + ldsw + _i * 8192), 16, 0, 0); } while (0)
#define PG8_STAGE_A(bufoff, gbase, h, VO) do { if constexpr (GATHER) { PG8_STAGE(bufoff, gbase, VO[h]); } else { PG8_STAGE(bufoff, (gbase) + (h) * hstep, voffA); } } while (0)
#define PG8_LDA(dst, b, h) do { _Pragma("unroll") for (int m = 0; m < 4; ++m) _Pragma("unroll") for (int k = 0; k < 2; ++k) dst[m][k] = *(const PG8_LAS bf16x8*)(lds + PG8_SA(b, h) + aoff + m * 2048 + k * 1024); } while (0)
#define PG8_LDB(dst, b, h) do { _Pragma("unroll") for (int n = 0; n < 2; ++n) _Pragma("unroll") for (int k = 0; k < 2; ++k) dst[n][k] = *(const PG8_LAS bf16x8*)(lds + PG8_SB(b, h) + boff + n * 2048 + k * 1024); } while (0)
#define PG8_MMA(ai, bj, At, Bt) do { __builtin_amdgcn_s_setprio(1); _Pragma("unroll") for (int m = 0; m < 4; ++m) _Pragma("unroll") for (int n = 0; n < 2; ++n) _Pragma("unroll") for (int k = 0; k < 2; ++k) \
        acc[ai][bj][m][n] = __builtin_amdgcn_mfma_f32_16x16x32_bf16(Bt[n][k], At[m][k], acc[ai][bj][m][n], 0, 0, 0); __builtin_amdgcn_s_setprio(0); } while (0)
#define PG8_WAIT_V(n) asm volatile("s_waitcnt vmcnt(" #n ")" ::: "memory")
#define PG8_WAIT_L(n) asm volatile("s_waitcnt lgkmcnt(" #n ")" ::: "memory")
#define PG8_BAR __builtin_amdgcn_s_barrier()
#define PG8_SCHED __builtin_amdgcn_sched_barrier(0)
    Unit cur, nxt; int ui = 0;
    if (!S.next(0, cur)) return;
    f32x4 acc[2][2][4][2];
#pragma unroll
    for (int a = 0; a < 2; ++a)
#pragma unroll
        for (int b = 0; b < 2; ++b)
#pragma unroll
            for (int m = 0; m < 4; ++m)
#pragma unroll
                for (int n = 0; n < 2; ++n) acc[a][b][m][n] = (f32x4){0.f, 0.f, 0.f, 0.f};
    bf16x8 At[4][2], B0[2][2], B1[2][2];
    const char* cA = (const char*)g.A + (GATHER ? (size_t)0 : (size_t)cur.pm * tstep); const char* cB = (const char*)g.Bt + (size_t)cur.pn * tstep;
    unsigned vcur[2][2], vnxt[2][2], vsel[2][2];
#pragma unroll
    for (int h = 0; h < 2; ++h)
#pragma unroll
        for (int i = 0; i < 2; ++i) { vcur[h][i] = 0u; vnxt[h][i] = 0u; vsel[h][i] = 0u; }
    if constexpr (GATHER) {
#pragma unroll
        for (int h = 0; h < 2; ++h)
#pragma unroll
            for (int i = 0; i < 2; ++i) vcur[h][i] = ((unsigned)S.rowidx[cur.pm * BM + h * HALF + RA[i]] * (unsigned)K + (unsigned)CA[i]) * 2u;
    }
    S.a_ready(cur);
    if constexpr (SP2) {
        PG8_STAGE(PG8_SB(0, 0), cB, voffB); PG8_STAGE(PG8_SB(0, 1), cB + hstep, voffB); PG8_STAGE_A(PG8_SA(0, 0), cA, 0, vcur); PG8_STAGE_A(PG8_SA(0, 1), cA, 1, vcur);
        if (wr == 1) PG8_BAR;
        PG8_WAIT_V(2); PG8_BAR;
        PG8_STAGE(PG8_SB(1, 0), cB + kstep, voffB); PG8_STAGE_A(PG8_SA(1, 0), cA + kstep, 0, vcur); PG8_STAGE(PG8_SB(1, 1), cB + hstep + kstep, voffB);
        PG8_WAIT_V(6); PG8_BAR;
    } else {
        PG8_STAGE(PG8_SB(0, 0), cB, voffB); PG8_STAGE_A(PG8_SA(0, 0), cA, 0, vcur); PG8_STAGE(PG8_SB(0, 1), cB + hstep, voffB); PG8_STAGE_A(PG8_SA(0, 1), cA, 1, vcur);
        if (wr == 1) PG8_BAR;
        PG8_WAIT_V(4); PG8_BAR;
        PG8_STAGE(PG8_SB(1, 0), cB + kstep, voffB); PG8_STAGE_A(PG8_SA(1, 0), cA + kstep, 0, vcur); PG8_STAGE(PG8_SB(1, 1), cB + hstep + kstep, voffB);
        PG8_WAIT_V(6); PG8_BAR;
    }
    for (;;) {
        const bool has_next = S.next(ui + 1, nxt);
        if constexpr (GATHER) {
#pragma unroll
            for (int h = 0; h < 2; ++h)
#pragma unroll
                for (int i = 0; i < 2; ++i) vnxt[h][i] = has_next ? ((unsigned)S.rowidx[nxt.pm * BM + h * HALF + RA[i]] * (unsigned)K + (unsigned)CA[i]) * 2u : vcur[h][i];
        }
        const char* nA = has_next ? (const char*)g.A + (GATHER ? (size_t)0 : (size_t)nxt.pm * tstep) : cA; const char* nB = has_next ? (const char*)g.Bt + (size_t)nxt.pn * tstep : cB;
        for (int t = 0; t < nt; t += 2) {
            const bool last = (t == nt - 2);
            if constexpr (GATHER) {
#pragma unroll
                for (int h = 0; h < 2; ++h)
#pragma unroll
                    for (int i = 0; i < 2; ++i) vsel[h][i] = last ? vnxt[h][i] : vcur[h][i];
            }
            if constexpr (Epi::HAS_MID) { if (t == nt / 2) E.mid(acc, cur, wr, wc, fr, fq); }
            const char* a1 = cA + (size_t)(t + 1) * kstep;
            const char* a2 = last ? nA : cA + (size_t)(t + 2) * kstep; const char* b2 = last ? nB : cB + (size_t)(t + 2) * kstep;
            const char* a3 = a2 + kstep; const char* b3 = b2 + kstep;
            if (last && has_next) S.a_ready(nxt);
            if constexpr (SP2) {
            PG8_LDB(B0, 0, 0); PG8_LDB(B1, 0, 1); PG8_SCHED; PG8_LDA(At, 0, 0); PG8_STAGE_A(PG8_SA(1, 1), a1, 1, vcur);
            PG8_WAIT_V(8); PG8_WAIT_L(0); PG8_BAR; PG8_MMA(0, 0, At, B0); PG8_MMA(0, 1, At, B1); PG8_BAR; PG8_SCHED;
            PG8_LDA(At, 0, 1); PG8_STAGE(PG8_SB(0, 0), b2, voffB); PG8_STAGE(PG8_SB(0, 1), b2 + hstep, voffB); PG8_STAGE_A(PG8_SA(0, 0), a2, 0, vsel);
            PG8_WAIT_V(8); PG8_WAIT_L(0); PG8_BAR; PG8_MMA(1, 0, At, B0); PG8_MMA(1, 1, At, B1); PG8_BAR; PG8_SCHED;
            PG8_LDB(B0, 1, 0); PG8_LDB(B1, 1, 1); PG8_SCHED; PG8_LDA(At, 1, 0); PG8_STAGE_A(PG8_SA(0, 1), a2, 1, vsel);
            PG8_WAIT_V(8); PG8_WAIT_L(0); PG8_BAR; PG8_MMA(0, 0, At, B0); PG8_MMA(0, 1, At, B1); PG8_BAR; PG8_SCHED;
            PG8_LDA(At, 1, 1); PG8_STAGE(PG8_SB(1, 0), b3, voffB); PG8_STAGE(PG8_SB(1, 1), b3 + hstep, voffB); PG8_STAGE_A(PG8_SA(1, 0), a3, 0, vsel);
            PG8_WAIT_V(8); PG8_WAIT_L(0); PG8_BAR; PG8_MMA(1, 0, At, B0); PG8_MMA(1, 1, At, B1); PG8_BAR; PG8_SCHED;
            } else {
            PG8_LDB(B0, 0, 0); PG8_SCHED; PG8_LDA(At, 0, 0); PG8_STAGE_A(PG8_SA(1, 1), a1, 1, vcur);
            PG8_WAIT_L(8); PG8_BAR; PG8_WAIT_L(0); PG8_MMA(0, 0, At, B0); PG8_BAR; PG8_SCHED;
            PG8_LDB(B1, 0, 1); PG8_STAGE(PG8_SB(0, 0), b2, voffB);
            PG8_BAR; PG8_WAIT_L(0); PG8_MMA(0, 1, At, B1); PG8_BAR;
            PG8_LDA(At, 0, 1); PG8_STAGE_A(PG8_SA(0, 0), a2, 0, vsel);
            PG8_BAR; PG8_WAIT_L(0); PG8_MMA(1, 0, At, B0); PG8_BAR; PG8_SCHED;
            PG8_STAGE(PG8_SB(0, 1), b2 + hstep, voffB);
            PG8_WAIT_V(6); PG8_BAR; PG8_MMA(1, 1, At, B1); PG8_BAR;
            PG8_LDB(B0, 1, 0); PG8_SCHED; PG8_LDA(At, 1, 0); PG8_STAGE_A(PG8_SA(0, 1), a2, 1, vsel);
            PG8_WAIT_L(8); PG8_BAR; PG8_WAIT_L(0); PG8_MMA(0, 0, At, B0); PG8_BAR; PG8_SCHED;
            PG8_LDB(B1, 1, 1); PG8_STAGE(PG8_SB(1, 0), b3, voffB);
            PG8_BAR; PG8_WAIT_L(0); PG8_MMA(0, 1, At, B1); PG8_BAR;
            PG8_LDA(At, 1, 1); PG8_STAGE_A(PG8_SA(1, 0), a3, 0, vsel);
            PG8_BAR; PG8_WAIT_L(0); PG8_MMA(1, 0, At, B0); PG8_BAR; PG8_SCHED;
            PG8_STAGE(PG8_SB(1, 1), b3 + hstep, voffB);
            PG8_WAIT_V(6); PG8_BAR; PG8_MMA(1, 1, At, B1); PG8_BAR;
            }
        }
        if constexpr (ALIGN_EPI) { if (wr == 0) PG8_BAR; }
        if constexpr (!Epi::AFTER_DRAIN) { E(acc, cur, wr, wc, fr, fq); S.done(cur); }
        if (!has_next) break;
#pragma unroll
        for (int a = 0; a < 2; ++a)
#pragma unroll
            for (int b = 0; b < 2; ++b)
#pragma unroll
                for (int m = 0; m < 4; ++m)
#pragma unroll
                    for (int n = 0; n < 2; ++n) acc[a][b][m][n] = (f32x4){0.f, 0.f, 0.f, 0.f};
        cur = nxt; cA = nA; cB = nB; ++ui;
        if constexpr (GATHER) {
#pragma unroll
            for (int h = 0; h < 2; ++h)
#pragma unroll
                for (int i = 0; i < 2; ++i) vcur[h][i] = vnxt[h][i];
        }
        if constexpr (ALIGN_EPI) { if (wr == 1) PG8_BAR; }
    }
    PG8_WAIT_V(0);
    if constexpr (!ALIGN_EPI) { if (wr == 0) PG8_BAR; }
    PG8_BAR;
    if constexpr (Epi::AFTER_DRAIN) { E.fused(acc, cur, wr, wc, fr, fq, lds, wid, lane); S.done(cur); }
#undef PG8_SA
#undef PG8_SB
#undef PG8_STAGE
#undef PG8_STAGE_A
#undef PG8_LDA
#undef PG8_LDB
#undef PG8_MMA
#undef PG8_WAIT_V
#undef PG8_WAIT_L
#undef PG8_BAR
#undef PG8_SCHED
}
}

namespace pg8 {
struct SchedQKV {
    int G, c;
    __device__ __forceinline__ bool next(int i, Unit& u) const {
        const int L = i * G + c; if (L >= 400) return false;
        if (L < 384) { const int xcd = L & 7, off = L >> 3, w = xcd * 48 + off; u.pm = (w / 48) * 8 + ((w % 48) & 7); u.pn = (w % 48) >> 3; }
        else { const int j = L - 384; u.pm = 64 + (j >> 1); u.pn = (j & 1) ? 5 : 2; }
        return true;
    }
    __device__ __forceinline__ void a_ready(const Unit&) const {}
    __device__ __forceinline__ void done(const Unit&) const {}
};
struct EpiQKV {
    static constexpr bool PERM = true, AFTER_DRAIN = false, HAS_MID = false;
    unsigned char* ws; const float* bqn; const float* bkn;
    __device__ __forceinline__ void operator()(const f32x4 (&acc)[2][2][4][2], const Unit& u, int wr, int wc, int fr, int fq) const {
        const int pn = u.pn; const bool isctx = u.pm >= 64;
        int kind, hh;
        if (pn < 2) { kind = 0; hh = pn * 4 + wc; } else if (pn == 2) { kind = wc < 2 ? 2 : 4; hh = wc & 1; } else if (pn < 5) { kind = 1; hh = (pn - 3) * 4 + wc; } else { kind = wc < 2 ? 3 : 5; hh = wc & 1; }
        const bool rms = kind == 1 || kind == 3, rope = !isctx && kind <= 3;
        const float* gp = kind == 1 ? bqn : bkn;
        f32x4 gain[2][2];
#pragma unroll
        for (int bj = 0; bj < 2; ++bj)
#pragma unroll
            for (int n = 0; n < 2; ++n) gain[bj][n] = rms ? *(const f32x4*)(gp + 32 * bj + 8 * fq + 4 * n) : (f32x4){1.f, 1.f, 1.f, 1.f};
        const float* tab = (const float*)(ws + WS_ROPE);
        bf16* base = (bf16*)(ws + (kind == 0 ? WS_QA : kind == 1 ? WS_QB : kind == 2 ? WS_KA : kind == 3 ? WS_KB : kind == 4 ? WS_VA : WS_VB));
        const float qs = kind <= 1 ? C2 : 1.f;
#pragma unroll
        for (int ai = 0; ai < 2; ++ai)
#pragma unroll
            for (int m = 0; m < 4; ++m) {
                const int row = u.pm * BM + ai * HALF + wr * 64 + m * 16 + fr;
                int b, t, pos;
                if (!isctx) { b = row >> 11; t = row & 2047; pos = t; } else { const int cr = row - ML; b = cr >> 8; t = 0; pos = T + (cr & 255); }
                f32x4 v[2][2];
#pragma unroll
                for (int bj = 0; bj < 2; ++bj)
#pragma unroll
                    for (int n = 0; n < 2; ++n) v[bj][n] = acc[ai][bj][m][n];
                if (rms) {
                    float ss = 0.f;
#pragma unroll
                    for (int bj = 0; bj < 2; ++bj)
#pragma unroll
                        for (int n = 0; n < 2; ++n) ss += (v[bj][n].x * v[bj][n].x + v[bj][n].y * v[bj][n].y) + (v[bj][n].z * v[bj][n].z + v[bj][n].w * v[bj][n].w);
                    ss += __shfl_xor(ss, 16); ss += __shfl_xor(ss, 32);
                    const float rn = rsqrtf(ss * (1.f / 64.f) + EPS);
#pragma unroll
                    for (int bj = 0; bj < 2; ++bj)
#pragma unroll
                        for (int n = 0; n < 2; ++n) v[bj][n] = v[bj][n] * rn * gain[bj][n];
                }
                if (rope) {
#pragma unroll
                    for (int bj = 0; bj < 2; ++bj)
#pragma unroll
                        for (int n = 0; n < 2; ++n) {
                            const int tp = bj == 0 ? (t >> 6) : 32 + (t & 63);
                            const f32x4 cs = *(const f32x4*)(tab + (tp * 16 + 4 * fq + 2 * n) * 2);
                            const f32x4 x = v[bj][n];
                            v[bj][n] = (f32x4){x.x * cs.x - x.y * cs.y, x.x * cs.y + x.y * cs.x, x.z * cs.z - x.w * cs.w, x.z * cs.w + x.w * cs.z};
                        }
                }
#pragma unroll
                for (int bj = 0; bj < 2; ++bj) {
                    const f32x4 v0 = v[bj][0] * qs, v1 = v[bj][1] * qs;
                    u32x4 w; w.x = pk2(v0.x, v0.y); w.y = pk2(v0.z, v0.w); w.z = pk2(v1.x, v1.y); w.w = pk2(v1.z, v1.w);
                    const int d0 = 32 * bj + 8 * fq;
                    bf16* dst = kind <= 1 ? base + q_off(b, hh, t, d0) : kind <= 3 ? base + k_off(b, hh, pos, d0) : base + v_off(b, hh, pos, d0);
                    if (kind <= 1) st16_nt(dst, w); else st16(dst, w);
                }
            }
    }
};
}


namespace pg8 {
struct SchedOne { Unit u;
    __device__ __forceinline__ bool next(int i, Unit& o) const { if (i) return false; o = u; return true; }
    __device__ __forceinline__ void a_ready(const Unit&) const {}
    __device__ __forceinline__ void done(const Unit&) const {} };
struct EpiOut {
    static constexpr bool PERM = true, AFTER_DRAIN = false, HAS_MID = true;
    bf16* OX; const LAS float* tab;
    __device__ __forceinline__ void mid(f32x4 (&acc)[2][2][4][2], const Unit&, int wr, int, int fr, int) const {
#pragma unroll
        for (int ai = 0; ai < 2; ++ai)
#pragma unroll
            for (int m = 0; m < 4; ++m) { const float f = tab[2 * (ai * HALF + wr * 64 + m * 16 + fr)];
#pragma unroll
                for (int bj = 0; bj < 2; ++bj)
#pragma unroll
                    for (int n = 0; n < 2; ++n) acc[ai][bj][m][n] = acc[ai][bj][m][n] * f; }
    }
    __device__ __forceinline__ void operator()(const f32x4 (&acc)[2][2][4][2], const Unit& u, int wr, int wc, int fr, int fq) const {
#pragma unroll
        for (int ai = 0; ai < 2; ++ai)
#pragma unroll
            for (int m = 0; m < 4; ++m) { const int r = ai * HALF + wr * 64 + m * 16 + fr; const float f = tab[2 * r + 1];
                bf16* rowp = OX + (size_t)(u.pm * BM + r) * D + u.pn * BM + wc * 32 + 8 * fq;
#pragma unroll
                for (int bj = 0; bj < 2; ++bj) { const f32x4 v0 = acc[ai][bj][m][0] * f, v1 = acc[ai][bj][m][1] * f;
                    u32x4 w; w.x = pk2(v0.x, v0.y); w.y = pk2(v0.z, v0.w); w.z = pk2(v1.x, v1.y); w.w = pk2(v1.z, v1.w);
                    st16(rowp + bj * HALF, w); } }
    }
};
struct SchedMoE {
    int G, c, nwg; const LAS int* tile_e; const int* rowidx;
    __device__ __forceinline__ bool next(int i, Unit& u) const {
        const int L = i * G + c; if (L >= nwg) return false;
        const int q = nwg >> 3, r = nwg & 7, xcd = L & 7, off = L >> 3;
        const int w = (xcd < r ? xcd * (q + 1) : r * (q + 1) + (xcd - r) * q) + off;
        u.pm = w >> 2; u.pn = tile_e[w >> 2] * 4 + (w & 3); return true;
    }
    __device__ __forceinline__ void a_ready(const Unit&) const {}
    __device__ __forceinline__ void done(const Unit&) const {}
};
__device__ __forceinline__ float silu_fast(float g) { return g * __builtin_amdgcn_rcpf(1.f + __builtin_amdgcn_exp2f(-g * LOG2E)); }
struct EpiGU {
    static constexpr bool PERM = true, AFTER_DRAIN = false, HAS_MID = false;
    bf16* ACT; const float* roww;
    __device__ __forceinline__ void operator()(const f32x4 (&acc)[2][2][4][2], const Unit& u, int wr, int wc, int fr, int fq) const {
#pragma unroll
        for (int ai = 0; ai < 2; ++ai)
#pragma unroll
            for (int m = 0; m < 4; ++m) { const int pos = u.pm * BM + ai * HALF + wr * 64 + m * 16 + fr; const float w = roww[pos];
                const f32x4 g0 = acc[ai][0][m][0], g1 = acc[ai][0][m][1], u0 = acc[ai][1][m][0], u1 = acc[ai][1][m][1];
                u32x4 o;
                o.x = pk2(silu_fast(g0.x) * u0.x * w, silu_fast(g0.y) * u0.y * w); o.y = pk2(silu_fast(g0.z) * u0.z * w, silu_fast(g0.w) * u0.w * w);
                o.z = pk2(silu_fast(g1.x) * u1.x * w, silu_fast(g1.y) * u1.y * w); o.w = pk2(silu_fast(g1.z) * u1.z * w, silu_fast(g1.w) * u1.w * w);
                st16(ACT + (size_t)pos * EFF + (u.pn & 3) * 128 + wc * 32 + 8 * fq, o); }
    }
};
struct EpiY {
    static constexpr bool PERM = true, AFTER_DRAIN = false, HAS_MID = false;
    bf16* Y;
    __device__ __forceinline__ void operator()(const f32x4 (&acc)[2][2][4][2], const Unit& u, int wr, int wc, int fr, int fq) const {
#pragma unroll
        for (int ai = 0; ai < 2; ++ai)
#pragma unroll
            for (int m = 0; m < 4; ++m) { bf16* rowp = Y + (size_t)(u.pm * BM + ai * HALF + wr * 64 + m * 16 + fr) * D + (u.pn & 3) * BM + wc * 32 + 8 * fq;
#pragma unroll
                for (int bj = 0; bj < 2; ++bj) { const f32x4 v0 = acc[ai][bj][m][0], v1 = acc[ai][bj][m][1];
                    u32x4 w; w.x = pk2(v0.x, v0.y); w.y = pk2(v0.z, v0.w); w.z = pk2(v1.x, v1.y); w.w = pk2(v1.z, v1.w);
                    st16(rowp + bj * HALF, w); } }
    }
};
}

namespace att {
typedef __attribute__((address_space(3))) const char* lds_cptr;
typedef short v4i16_t __attribute__((ext_vector_type(4)));
constexpr int NSLOT = 4, SLOTB = 16384, OST_PITCH = 144, OST_WAVE = 32 * OST_PITCH;
static_assert(8 * OST_WAVE <= 3 * SLOTB && NSLOT * SLOTB <= 65536, "attention LDS");
__device__ __forceinline__ int crow(int r, int hi) { return (r & 3) + 8 * (r >> 2) + 4 * hi; }
__device__ __forceinline__ unsigned cvtpk(float lo, float hi) { typedef float f2 __attribute__((ext_vector_type(2))); typedef __bf16 b2 __attribute__((ext_vector_type(2))); f2 v = {lo, hi}; b2 b = __builtin_convertvector(v, b2); return __builtin_bit_cast(unsigned, b); }
__device__ __forceinline__ s16x4 vtr(lds_cptr p) { return __builtin_bit_cast(s16x4, __builtin_amdgcn_ds_read_tr16_b64_v4i16((__attribute__((address_space(3))) v4i16_t*)p)); }
__device__ __forceinline__ float swapmax(float m) { auto rr = __builtin_amdgcn_permlane32_swap(__float_as_uint(m), __float_as_uint(m), false, false); return fmaxf(__uint_as_float(rr[0]), __uint_as_float(rr[1])); }
__device__ __forceinline__ float swapsum(float m) { auto rr = __builtin_amdgcn_permlane32_swap(__float_as_uint(m), __float_as_uint(m), false, false); return __uint_as_float(rr[0]) + __uint_as_float(rr[1]); }

__device__ __forceinline__ void glds16(const void* gsrc, unsigned lds_dst) { unsigned keep;
    asm volatile("s_mov_b32 %0, m0\n\ts_mov_b32 m0, %2\n\ts_nop 0\n\tglobal_load_lds_dwordx4 %1, off\n\ts_mov_b32 m0, %0" : "=&s"(keep) : "v"(gsrc), "s"(lds_dst) : "memory"); }
__device__ __forceinline__ float max3f(float a, float b, float c) { float r; asm("v_max3_f32 %0, %1, %2, %3" : "=v"(r) : "v"(a), "v"(b), "v"(c)); return r; }
__device__ __forceinline__ float max2f(float a, float b) { float r; asm("v_max_f32_e32 %0, %1, %2" : "=v"(r) : "v"(a), "v"(b)); return r; }
constexpr int WC_PER_WAVE = 24, WC_LDS = 65536;
struct WConv { int next, j0, j1, gstep, cm1, cm2; };
struct WItem { const float* src; int N; bf16* dst; int dpitch; };
__device__ __forceinline__ WItem wc_decode(const P& p, int hidx, int& k0, int& n0, int& drow0) {
    const int item = hidx >> 1, kh = hidx & 1; WItem w;
    if (item < 16384) { const int up = item >= 8192, r = item & 8191, e = r >> 8, q = r & 255, kb = q >> 4, nb = q & 15; n0 = nb * 32;
        w.src = (up ? p.w_up : p.w_gate) + (size_t)e * 1024 * 512; w.N = 512; w.dst = (bf16*)(p.ws + WS_WGU) + (size_t)e * 1024 * 1024; w.dpitch = 1024;
        drow0 = (n0 >> 7) * 256 + up * 128 + (n0 & 127); k0 = kb * 64 + kh * 32; }
    else { const int r = item - 16384, e = r >> 8, q = r & 255, kb = q >> 5, nb = q & 31; n0 = nb * 32;
        w.src = p.w_down + (size_t)e * 512 * 1024; w.N = 1024; w.dst = (bf16*)(p.ws + WS_WD) + (size_t)e * 1024 * 512; w.dpitch = 512; drow0 = n0; k0 = kb * 64 + kh * 32; }
    return w;
}
__device__ __forceinline__ void glds16(const void* gsrc, unsigned lds_dst);
__device__ __forceinline__ void glds16_nt(const void* gsrc, unsigned lds_dst) { unsigned keep;
    asm volatile("s_mov_b32 %0, m0\n\ts_mov_b32 m0, %2\n\ts_nop 0\n\tglobal_load_lds_dwordx4 %1, off nt\n\ts_mov_b32 m0, %0" : "=&s"(keep) : "v"(gsrc), "s"(lds_dst) : "memory"); }
__device__ __forceinline__ void wc_issue(const P& p, int gw, int ord, unsigned ldsbuf, int lane) {
    int k0, n0, drow0; const WItem w = wc_decode(p, gw + 2048 * ord, k0, n0, drow0);
#pragma unroll
    for (int q = 0; q < 4; ++q) { const int kl = 8 * q + (lane >> 3), f4 = (lane & 7) ^ ((q >> 1) * 4);
        glds16_nt(w.src + (size_t)(k0 + kl) * w.N + n0 + f4 * 4, (unsigned)__builtin_amdgcn_readfirstlane(ldsbuf + q * 1024)); }
}
__device__ __forceinline__ void wc_consume(const P& p, int gw, int ord, LAS unsigned char* buf, int lane) {
    int k0, n0, drow0; const WItem w = wc_decode(p, gw + 2048 * ord, k0, n0, drow0);
    const int n = lane >> 1, kh = lane & 1;
    const LAS float* s = (const LAS float*)buf + (16 * kh) * 32 + 4 * ((n >> 2) ^ (4 * kh)) + (n & 3);
    float v[16];
#pragma unroll
    for (int i = 0; i < 16; ++i) v[i] = s[i * 32];
    v4u o0, o1;
    o0.x = cvtpk(v[0], v[1]); o0.y = cvtpk(v[2], v[3]); o0.z = cvtpk(v[4], v[5]); o0.w = cvtpk(v[6], v[7]);
    o1.x = cvtpk(v[8], v[9]); o1.y = cvtpk(v[10], v[11]); o1.z = cvtpk(v[12], v[13]); o1.w = cvtpk(v[14], v[15]);
    bf16* d = w.dst + (size_t)(drow0 + n) * w.dpitch + k0 + 16 * kh;
    __builtin_nontemporal_store(o0, (v4u*)d); __builtin_nontemporal_store(o1, (v4u*)(d + 8));
}
constexpr float THR = 8.f;
template <int GRP, int ABL = 0>
__device__ __forceinline__ void attn_unit(const P& p, LAS unsigned char* lds, int b, int kvh, int qb, WConv& wc, int gw) {
    const int tid = threadIdx.x, lane = tid & 63, r32 = lane & 31, hi = lane >> 5;
    const int wid = __builtin_amdgcn_readfirstlane(tid >> 6);
    const int h = kvh * 4 + (wid >> 1);
    const int q0w = qb * 64 + (wid & 1) * 32, qpos = q0w + r32;
    const bf16* Qp = (const bf16*)(p.ws + (GRP ? WS_QB : WS_QA)) + q_off(b, h, qpos, 0);
    bf16x8 qr[4];
#pragma unroll
    for (int d0 = 0; d0 < 4; ++d0) qr[d0] = __builtin_nontemporal_load((const bf16x8*)(Qp + 16 * d0 + 8 * hi));
    asm volatile("" : "+v"(qr[0]), "+v"(qr[1]), "+v"(qr[2]), "+v"(qr[3]));
    const char* Kt = (const char*)(p.ws + (GRP ? WS_KB : WS_KA)) + (size_t)(b * 2 + kvh) * NTILE * 8192 + wid * 1024 + lane * 16;
    const char* Vt = (const char*)(p.ws + (GRP ? WS_VB : WS_VA)) + (size_t)(b * 2 + kvh) * NTILE * 8192 + wid * 1024 + lane * 16;
    const unsigned lds0 = (unsigned)(uintptr_t)lds;
    int jlo = 0, nband = NTILE, NT = NTILE;
    if (GRP == 0) { jlo = qb - 2 < 0 ? 0 : qb - 2; const int jhi = qb + 2 > 31 ? 31 : qb + 2; nband = jhi - jlo + 1; NT = nband + 4; }
#define ATT_TILE(i) ((i) < nband ? jlo + (i) : 32 + ((i) - nband))
#define ATT_ISSUE(i) do { if (ABL & 1) break; const int tl_ = ATT_TILE(i); const int sl_ = ((i) & 3) * SLOTB; \
        glds16(Kt + (size_t)tl_ * 8192, (unsigned)__builtin_amdgcn_readfirstlane(lds0 + sl_ + wid * 1024)); \
        glds16(Vt + (size_t)tl_ * 8192, (unsigned)__builtin_amdgcn_readfirstlane(lds0 + sl_ + 8192 + wid * 1024)); } while (0)
#define ATT_WAIT(n) do { if (ABL & 1) break; if ((n) >= 2) asm volatile("s_waitcnt vmcnt(4)" ::: "memory"); else if ((n) == 1) asm volatile("s_waitcnt vmcnt(2)" ::: "memory"); else asm volatile("s_waitcnt vmcnt(0)" ::: "memory"); } while (0)
#define ATT_WAITN(n) do { if (ABL & 1) break; switch (n) { case 0: asm volatile("s_waitcnt vmcnt(0)" ::: "memory"); break; case 2: asm volatile("s_waitcnt vmcnt(2)" ::: "memory"); break; \
        case 4: asm volatile("s_waitcnt vmcnt(4)" ::: "memory"); break; case 6: asm volatile("s_waitcnt vmcnt(6)" ::: "memory"); break; case 8: asm volatile("s_waitcnt vmcnt(8)" ::: "memory"); break; \
        case 10: asm volatile("s_waitcnt vmcnt(10)" ::: "memory"); break; case 12: asm volatile("s_waitcnt vmcnt(12)" ::: "memory"); break; default: asm volatile("s_waitcnt vmcnt(14)" ::: "memory"); break; } } while (0)
#define ATT_BAR() do { asm volatile("" ::: "memory"); __builtin_amdgcn_s_barrier(); asm volatile("" ::: "memory"); } while (0)
#define SBAR() __builtin_amdgcn_sched_barrier(0)
#define MF(a, b, c) __builtin_amdgcn_mfma_f32_32x32x16_bf16(a, b, c, 0, 0, 0)
#define KFRAG(dst, base, k) dst = *(const __attribute__((address_space(3))) bf16x8*)((base) + ((k) >> 1) * 2048 + ((k) & 1) * 512)
    float m, l;
    m = 0.f; l = 0.f;
    f32x16 o0, o1, sA0, sA1, sB0, sB1; const f32x16 zero16 = {0.f, 0.f, 0.f, 0.f, 0.f, 0.f, 0.f, 0.f, 0.f, 0.f, 0.f, 0.f, 0.f, 0.f, 0.f, 0.f};
#pragma unroll
    for (int r = 0; r < 16; ++r) { o0[r] = 0.f; o1[r] = 0.f; sB0[r] = 0.f; sB1[r] = 0.f; }
    const lds_cptr kp0 = (lds_cptr)lds + hi * 1024 + r32 * 16;
    const lds_cptr vp0 = (lds_cptr)lds + 8192 + ((lane >> 4) & 1) * 32 + (lane & 3) * 8 + (4 * hi + ((lane & 15) >> 2)) * 64;
#define ATT_MASK(S0, S1, t) do { if (GRP == 0) { const int tl = ATT_TILE(t); if (tl < 32 && (tl == qb - 2 || tl == qb + 2)) { const int kb = tl * 64; \
        _Pragma("unroll") for (int r = 0; r < 16; ++r) { const int dd = kb + crow(r, hi) - qpos; if (dd > 128 || dd < -128) S0[r] = -1e30f; if (dd + 32 > 128 || dd + 32 < -128) S1[r] = -1e30f; } } } } while (0)
#define ATT_DECIDE(S0, S1, mxv) do { float mx_ = swapmax(mxv); \
        if (__builtin_expect(__any(mx_ > THR), 0)) { const float dl = fmaxf(mx_, 0.f), alpha = __builtin_amdgcn_exp2f(-dl); m += dl; l *= alpha; \
            _Pragma("unroll") for (int r = 0; r < 16; ++r) { S0[r] -= dl; S1[r] -= dl; o0[r] *= alpha; o1[r] *= alpha; } } } while (0)
    if (wid >= 4) __builtin_amdgcn_s_setprio(1);
    wc.cm1 = 0; wc.cm2 = 0;
    ATT_ISSUE(0); ATT_ISSUE(1); ATT_ISSUE(2);
    ATT_WAIT(2); ATT_BAR();
    {
        bf16x8 kf[8];
#pragma unroll
        for (int k = 0; k < 8; ++k) KFRAG(kf[k], kp0, k);
        SBAR();
        sA0 = MF(kf[0], qr[0], zero16); sA1 = MF(kf[1], qr[0], zero16);
#pragma unroll
        for (int d0 = 1; d0 < 4; ++d0) { sA0 = MF(kf[2 * d0], qr[d0], sA0); sA1 = MF(kf[2 * d0 + 1], qr[d0], sA1); }
        ATT_MASK(sA0, sA1, 0);
        asm volatile("s_nop 15\n\ts_nop 7" : "+v"(sA0), "+v"(sA1));
        float a = max3f(sA0[0], sA0[1], sA1[0]), c = max3f(sA0[2], sA0[3], sA1[1]); a = max3f(a, sA1[2], sA1[3]);
#pragma unroll
        for (int r = 4; r < 16; r += 4) { a = max3f(a, sA0[r], sA0[r + 1]); c = max3f(c, sA0[r + 2], sA0[r + 3]); a = max3f(a, sA1[r], sA1[r + 1]); c = max3f(c, sA1[r + 2], sA1[r + 3]); }
        ATT_DECIDE(sA0, sA1, max2f(a, c));
    }
#define ATT_STEP(SC0, SC1, SN0, SN1, t, HN) do { \
        constexpr bool hn_ = HN;                                      \
        ATT_WAITN(wc.cm2 + wc.cm1 + ((t) + 2 < NT ? 2 : 0));         \
        ATT_BAR(); \
        if ((t) + 3 < NT) ATT_ISSUE((t) + 3); \
        if (WCONV_IN_ATTN) { int c_ = 0; const int r7_ = wc.gstep % 7, bs_ = r7_ == 0 ? 0 : r7_ == 3 ? 1 : 2;     \
            if (bs_ < 2) { LAS unsigned char* wb_ = lds + WC_LDS + wid * 8192 + bs_ * 4096; int jb_ = bs_ ? wc.j1 : wc.j0; \
                if (jb_ >= 0) { wc_consume(p, gw, jb_, wb_, lane); jb_ = -1; c_ += 2; } \
                if (wc.next < WC_PER_WAVE) { asm volatile("s_waitcnt lgkmcnt(0)" ::: "memory"); wc_issue(p, gw, wc.next, lds0 + WC_LDS + wid * 8192 + bs_ * 4096, lane); jb_ = wc.next++; c_ += 4; } \
                if (bs_) wc.j1 = jb_; else wc.j0 = jb_; } \
            wc.cm2 = wc.cm1; wc.cm1 = c_; wc.gstep++; } \
        const lds_cptr kp_ = kp0 + (((t) + 1) & 3) * SLOTB; const lds_cptr vp_ = vp0 + ((t) & 3) * SLOTB; \
        bf16x8 kf[8]; s16x4 vlo[8], vhi[8]; \
        if (hn_) { _Pragma("unroll") for (int k = 0; k < 8; ++k) KFRAG(kf[k], kp_, k); } \
        SBAR(); \
        float rs_ = 0.f; v4u pw[4]; _Pragma("unroll") for (int q_ = 0; q_ < 4; ++q_) pw[q_] = (v4u){0u, 0u, 0u, 0u}; \
        _Pragma("unroll") for (int g = 0; g < 8; ++g) {             \
            if (hn_) { if (g == 0) SN0 = MF(kf[0], qr[0], zero16); else if (g == 1) SN1 = MF(kf[1], qr[0], zero16); else if (g & 1) SN1 = MF(kf[g], qr[g >> 1], SN1); else SN0 = MF(kf[g], qr[g >> 1], SN0); } \
            if (g < 4) { _Pragma("unroll") for (int e = 0; e < 4; ++e) { SC0[4 * g + e] = __builtin_amdgcn_exp2f(SC0[4 * g + e]); rs_ += SC0[4 * g + e]; } \
                         pw[g >> 1][2 * (g & 1)] = cvtpk(SC0[4 * g], SC0[4 * g + 1]); pw[g >> 1][2 * (g & 1) + 1] = cvtpk(SC0[4 * g + 2], SC0[4 * g + 3]); \
                         asm volatile("" : "+v"(SC0), "+v"(pw[g >> 1]), "+v"(rs_)); } \
            else { const int g4 = g - 4;   \
                         vlo[g4] = vtr(vp_ + g4 * 1024); vhi[g4] = vtr(vp_ + g4 * 1024 + 512); vlo[4 + g4] = vtr(vp_ + 4096 + g4 * 1024); vhi[4 + g4] = vtr(vp_ + 4096 + g4 * 1024 + 512); \
                         _Pragma("unroll") for (int e = 0; e < 4; ++e) { SC1[4 * g4 + e] = __builtin_amdgcn_exp2f(SC1[4 * g4 + e]); rs_ += SC1[4 * g4 + e]; } \
                         pw[2 + (g4 >> 1)][2 * (g4 & 1)] = cvtpk(SC1[4 * g4], SC1[4 * g4 + 1]); pw[2 + (g4 >> 1)][2 * (g4 & 1) + 1] = cvtpk(SC1[4 * g4 + 2], SC1[4 * g4 + 3]); \
                         asm volatile("" : "+v"(SC1), "+v"(pw[2 + (g4 >> 1)]), "+v"(rs_)); } \
            SBAR(); } \
        l += rs_; \
        if (hn_) { ATT_MASK(SN0, SN1, (t) + 1); if (__builtin_expect(__any(m != 0.f), 0)) { _Pragma("unroll") for (int r = 0; r < 16; ++r) { SN0[r] -= m; SN1[r] -= m; } } \
                   asm volatile("s_nop 15\n\ts_nop 7" : "+v"(SN0), "+v"(SN1)); } \
        float ma_ = -3.0e38f, mc_ = -3.0e38f; \
        _Pragma("unroll") for (int g = 0; g < 8; ++g) {             \
            const int ks = g >> 1; const bf16x8 pf = __builtin_bit_cast(bf16x8, pw[ks]); \
            if (g & 1) { const bf16x8 v1 = (bf16x8){vlo[4 + ks][0], vlo[4 + ks][1], vlo[4 + ks][2], vlo[4 + ks][3], vhi[4 + ks][0], vhi[4 + ks][1], vhi[4 + ks][2], vhi[4 + ks][3]}; o1 = MF(v1, pf, o1); } \
            else { const bf16x8 v0 = (bf16x8){vlo[ks][0], vlo[ks][1], vlo[ks][2], vlo[ks][3], vhi[ks][0], vhi[ks][1], vhi[ks][2], vhi[ks][3]}; o0 = MF(v0, pf, o0); } \
            if (hn_) { if (g < 4) { ma_ = max3f(ma_, SN0[4 * g], SN0[4 * g + 1]); mc_ = max3f(mc_, SN0[4 * g + 2], SN0[4 * g + 3]); } \
                       else { ma_ = max3f(ma_, SN1[4 * (g - 4)], SN1[4 * (g - 4) + 1]); mc_ = max3f(mc_, SN1[4 * (g - 4) + 2], SN1[4 * (g - 4) + 3]); } \
                       asm volatile("" : "+v"(ma_), "+v"(mc_)); } \
            SBAR(); } \
        if (hn_) ATT_DECIDE(SN0, SN1, max2f(ma_, mc_)); \
    } while (0)
    {
        int t = 0;
        for (; t + 2 < NT; t += 2) { ATT_STEP(sA0, sA1, sB0, sB1, t, true); ATT_STEP(sB0, sB1, sA0, sA1, t + 1, true); }
        if (t + 2 == NT) { ATT_STEP(sA0, sA1, sB0, sB1, t, true); ATT_STEP(sB0, sB1, sA0, sA1, t + 1, false); }
        else { ATT_STEP(sA0, sA1, sB0, sB1, t, false); }
    }
#undef ATT_STEP
#undef ATT_DECIDE
#undef ATT_MASK
#undef KFRAG
#undef MF
#undef SBAR
#undef ATT_TILE
#undef ATT_ISSUE
#undef ATT_WAIT
    if (wid >= 4) __builtin_amdgcn_s_setprio(0);
    ATT_BAR();
    float ltot = swapsum(l); if (GRP == 0) ltot += __builtin_amdgcn_exp2f(p.a_sink[h] * LOG2E - m);
    const float inv = 1.f / ltot;
    int lane_e = lane; asm volatile("" : "+v"(lane_e));
    const int r32e = lane_e & 31, hie = lane_e >> 5;
    LAS unsigned char* ost = lds + wid * OST_WAVE;
#pragma unroll
    for (int g = 0; g < 4; ++g) {
        v2u w0, w1;
        w0.x = cvtpk(o0[4 * g] * inv, o0[4 * g + 1] * inv); w0.y = cvtpk(o0[4 * g + 2] * inv, o0[4 * g + 3] * inv);
        w1.x = cvtpk(o1[4 * g] * inv, o1[4 * g + 1] * inv); w1.y = cvtpk(o1[4 * g + 2] * inv, o1[4 * g + 3] * inv);
        *(LAS v2u*)(ost + r32e * OST_PITCH + (8 * g + 4 * hie) * 2) = w0;
        *(LAS v2u*)(ost + r32e * OST_PITCH + (32 + 8 * g + 4 * hie) * 2) = w1;
    }
    asm volatile("s_waitcnt lgkmcnt(0)" ::: "memory");
    bf16* Ob = (bf16*)(p.ws + (ABL ? WS_OX : WS_O)) + ((size_t)b * T + q0w) * D + GRP * 512 + h * 64;
    float* ssq = (float*)(p.ws + (ABL ? 256 * MiB : WS_SSQ)) + ((size_t)b * T + q0w) * 16 + GRP * 8 + h;
#pragma unroll
    for (int i = 0; i < 4; ++i) {
        const int row = i * 8 + (lane_e >> 3), ch = lane_e & 7;
        const v4u v = *(const LAS v4u*)(ost + row * OST_PITCH + ch * 16);
        st16(Ob + (size_t)row * D + ch * 8, v);
        float ss = 0.f;
#pragma unroll
        for (int q = 0; q < 4; ++q) { const float a = __uint_as_float(v[q] << 16), c = __uint_as_float(v[q] & 0xffff0000u); ss += a * a + c * c; }
        ss += __shfl_xor(ss, 1); ss += __shfl_xor(ss, 2); ss += __shfl_xor(ss, 4);
        if (ch == 0) ssq[(size_t)row * 16] = ss;
    }
    asm volatile("s_waitcnt vmcnt(0) lgkmcnt(0)" ::: "memory");
    ATT_BAR();
#undef ATT_BAR
}
template <int ABL = 0>
__device__ __forceinline__ void attn_phase(const P& p, LAS unsigned char* lds, int vcu, int G) {
    if (ABL & 64) return;
    const int wid = __builtin_amdgcn_readfirstlane(threadIdx.x >> 6), lane = threadIdx.x & 63, gw = vcu * 8 + wid;
    WConv wc; wc.next = (WCONV_IN_ATTN && G * 8 == 2048 && ABL == 0) ? 0 : WC_PER_WAVE; wc.j0 = -1; wc.j1 = -1; wc.gstep = 0; wc.cm1 = 0; wc.cm2 = 0;
    for (int u = vcu; u < 512; u += G) attn_unit<1, ABL>(p, lds, (u >> 5) >> 1, (u >> 5) & 1, u & 31, wc, gw);
    for (int u = vcu; u < 512; u += G) attn_unit<0, ABL>(p, lds, (u >> 5) >> 1, (u >> 5) & 1, u & 31, wc, gw);
    if (WCONV_IN_ATTN && ABL == 0) {
        if (G * 8 == 2048) {
            if (wc.j0 >= 0) wc_consume(p, gw, wc.j0, lds + WC_LDS + wid * 8192, lane);
            if (wc.j1 >= 0) wc_consume(p, gw, wc.j1, lds + WC_LDS + wid * 8192 + 4096, lane);
            for (; wc.next < WC_PER_WAVE; ++wc.next) { asm volatile("s_waitcnt lgkmcnt(0)" ::: "memory"); wc_issue(p, gw, wc.next, (unsigned)(uintptr_t)lds + WC_LDS + wid * 8192, lane);
                asm volatile("s_waitcnt vmcnt(0)" ::: "memory"); wc_consume(p, gw, wc.next, lds + WC_LDS + wid * 8192, lane); }
        } else {
            for (int hx = gw; hx < 49152; hx += G * 8) { asm volatile("s_waitcnt lgkmcnt(0)" ::: "memory"); wc_issue(p, hx & 2047, hx >> 11, (unsigned)(uintptr_t)lds + WC_LDS + wid * 8192, lane);
                asm volatile("s_waitcnt vmcnt(0)" ::: "memory"); wc_consume(p, hx & 2047, hx >> 11, lds + WC_LDS + wid * 8192, lane); }
        }
    }
}
}

struct Frame {
    LAS unsigned char* lds;
    volatile LAS unsigned* MISC;
    int tid, lane, wave, vcu, G;
};

__device__ __forceinline__ void p0_transpose_item(const float* W, int N, bf16* WT, int dpitch, int drow0, int k0, int n0, LAS float* scr, int lane, const float* gain) {
#pragma unroll
    for (int i = 0; i < 32; ++i) { const int kk = 2 * i + (lane >> 5); float v = __builtin_nontemporal_load(W + (size_t)(k0 + kk) * N + n0 + (lane & 31)); if (gain) v *= gain[kk]; scr[kk * 33 + (lane & 31)] = v; }
    LDS_WAIT(); asm volatile("" ::: "memory");
    const int c = lane & 7;
#pragma unroll
    for (int j = 0; j < 4; ++j) { const int n = (lane >> 3) + 8 * j; const LAS float* s = scr + (8 * c) * 33 + n;
        v4u o; o.x = pk2(s[0 * 33], s[1 * 33]); o.y = pk2(s[2 * 33], s[3 * 33]); o.z = pk2(s[4 * 33], s[5 * 33]); o.w = pk2(s[6 * 33], s[7 * 33]);
        *(GAS v4u*)(WT + (size_t)(drow0 + n) * dpitch + k0 + 8 * c) = o; }
    LDS_WAIT(); asm volatile("" ::: "memory");
}
__device__ __forceinline__ void p0_prologue(const P& p, Frame& F) {
    float* modx = (float*)(p.ws + WS_MODX);
    if (F.vcu < 96) {
        LAS float* s = (LAS float*)F.lds;
        LAS float* part = (LAS float*)(F.lds + 40960);
        for (int i = F.tid; i < 9 * D; i += NTHR) { const int r = i >> 10, k = i & 1023; const float v = r < 8 ? p.c[r * D + k] : p.c_ctx[k]; s[i] = silu_f(v); }
        __syncthreads();
        const int n = F.vcu * 64 + F.lane; float acc[9];
#pragma unroll
        for (int r = 0; r < 9; ++r) acc[r] = 0.f;
        const float* wp = p.w_mod + (size_t)(F.wave * 128) * 6144 + n;
#pragma unroll 4
        for (int k4 = 0; k4 < 128; k4 += 4) {
            float wv[4];
#pragma unroll
            for (int j = 0; j < 4; ++j) wv[j] = __builtin_nontemporal_load(wp + (size_t)(k4 + j) * 6144);
#pragma unroll
            for (int r = 0; r < 9; ++r) { const f32x4 sv = *(const LAS f32x4*)(s + r * D + F.wave * 128 + k4); acc[r] += sv.x * wv[0]; acc[r] += sv.y * wv[1]; acc[r] += sv.z * wv[2]; acc[r] += sv.w * wv[3]; }
        }
#pragma unroll
        for (int r = 0; r < 9; ++r) part[(F.wave * 9 + r) * 64 + F.lane] = acc[r];
        __syncthreads();
        for (int i = F.tid; i < 9 * 64; i += NTHR) { const int r = i >> 6, l = i & 63; float sum = 0.f;
#pragma unroll
            for (int w = 0; w < 8; ++w) sum += part[(w * 9 + r) * 64 + l];
            modx[r * 6144 + F.vcu * 64 + l] = sum + p.b_mod[F.vcu * 64 + l]; }
        __syncthreads();
    }
    if (F.vcu == 96) {
        float2* tab = (float2*)(p.ws + WS_ROPE);
        for (int idx = F.tid; idx < 96 * 16; idx += NTHR) {
            const int pos = idx >> 4, i = idx & 15;
            const float invf = exp2f(-(float)i * (13.287712379549449f / 16.f));
            const float pv = (float)(pos < 32 ? pos : pos - 32);
            float rev = pv * invf * 0.15915494309189535f; rev -= rintf(rev);
            tab[idx] = make_float2(__builtin_amdgcn_cosf(rev), __builtin_amdgcn_sinf(rev));
        }
    }
    for (int nb = F.vcu - 97; nb >= 0 && nb < 48; nb += F.G) {
        bf16* wr = (bf16*)(p.ws + WS_WR);
        for (int i = nb * 1024 + F.tid; i < (nb + 1) * 1024; i += NTHR) {
            const int j = i & 7, ln = (i >> 3) & 63, q = i >> 9, nt = q % 3, ks = q / 3;
            const int k = 32 * ks + 8 * (ln >> 4) + j, n = 16 * nt + (ln & 15);
            const float w = n < 4 ? p.w_group[k * 4 + n] : n < 36 ? p.w_router[k * 32 + (n - 4)] : 0.f;
            const unsigned hi = f2bf(w); const unsigned lo = f2bf(w - bf2f((bf16)hi));
            wr[i] = (bf16)hi; wr[48 * D + i] = (bf16)lo; }
    }
    LAS float* scr = (LAS float*)(F.lds + F.wave * 16384);
    const int gw = F.vcu * NWAVES + F.wave, NGW = F.G * NWAVES;
    constexpr int I_IN = 16 * 48, I_OUT = 16 * 32, I_G = 32 * 256, I_D = 32 * 256, NITEMS = WCONV_IN_ATTN ? I_IN + I_OUT : I_IN + I_OUT + 2 * I_G + I_D;
    for (int it = gw; it < NITEMS; it += NGW) {
        int r = it;
        if (r < I_IN) { const int kb = r / 48, nb = r % 48; p0_transpose_item(p.w_in, NQKV, (bf16*)(p.ws + WS_WQKV), D, qkv_row(nb * 32), kb * 64, nb * 32, scr, F.lane, nullptr); continue; } r -= I_IN;
        if (r < I_OUT) { const int kb = r / 32, nb = r % 32; const float* g = kb < 8 ? p.aon + kb * 64 : p.bon + (kb - 8) * 64;
            p0_transpose_item(p.w_out, D, (bf16*)(p.ws + WS_WO), D, nb * 32, kb * 64, nb * 32, scr, F.lane, g); continue; } r -= I_OUT;
        if (r < 2 * I_G) { const int up = r >= I_G; if (up) r -= I_G; const int e = r >> 8, q = r & 255, kb = q >> 4, nb = q & 15; const int j0 = nb * 32;
            p0_transpose_item((up ? p.w_up : p.w_gate) + (size_t)e * 1024 * 512, 512, (bf16*)(p.ws + WS_WGU) + (size_t)e * 1024 * 1024, D, (j0 >> 7) * 256 + up * 128 + (j0 & 127), kb * 64, j0, scr, F.lane, nullptr); continue; } r -= 2 * I_G;
        { const int e = r >> 8, q = r & 255, kb = q >> 5, nb = q & 31;
            p0_transpose_item(p.w_down + (size_t)e * 512 * 1024, D, (bf16*)(p.ws + WS_WD) + (size_t)e * 1024 * 512, EFF, nb * 32, kb * 64, nb * 32, scr, F.lane, nullptr); }
    }
}
__device__ __forceinline__ void p1_norm(const P& p, Frame& F) {
    const int gw = F.vcu * NWAVES + F.wave, NGW = F.G * NWAVES;
    const float* modall = (const float*)(p.ws + WS_MODX);
    for (int r = gw; r < MT; r += NGW) {
        const float* src = r < ML ? p.x + (size_t)r * D : p.ctx + (size_t)(r - ML) * D;
        const float* modx = modall + (r < ML ? (r / T) : 8) * 6144;
        const GAS f32x4* xr = (const GAS f32x4*)src + F.lane;
        f32x4 v[4]; float s = 0.f;
#pragma unroll
        for (int j = 0; j < 4; ++j) { v[j] = __builtin_nontemporal_load((const f32x4*)((const float*)src + 4 * (F.lane + 64 * j))); s += (v[j].x * v[j].x + v[j].y * v[j].y) + (v[j].z * v[j].z + v[j].w * v[j].w); }
        const float rn = rsqrtf(wave_sum(s) * (1.f / D) + EPS);
        GAS v2u* o8 = (GAS v2u*)((bf16*)(p.ws + WS_XN) + (size_t)r * D) + F.lane;
#pragma unroll
        for (int j = 0; j < 4; ++j) { const int k = 4 * (F.lane + 64 * j);
            const f32x4 g = *(const f32x4*)(p.pre1 + k), sc = *(const f32x4*)(modx + 1024 + k), sh = *(const f32x4*)(modx + k);
            const f32x4 h = v[j] * rn * g * (sc + 1.f) + sh;
            v2u w; w.x = pk2(h.x, h.y); w.y = pk2(h.z, h.w); st8((void*)(o8 + 64 * j), w); }
    }
}


constexpr int LDS_X = 147456;
__device__ __forceinline__ void p4_outproj(const P& p, Frame& F) {
    LAS float* tab = (LAS float*)(F.lds + LDS_X);
    for (int i = 0;; ++i) {
        const int L = i * F.G + (int)blockIdx.x; if (L >= 256) break;
        const int xcd = L & 7, off = L >> 3, w = xcd * 32 + off;
        pg8::Unit u; u.pm = (w >> 5) * 8 + (w & 7); u.pn = (w & 31) >> 3;
        if (F.tid < 256) {
            const f32x4* s4 = (const f32x4*)((const float*)(p.ws + WS_SSQ) + (size_t)(u.pm * 256 + F.tid) * 16);
            const f32x4 a0 = s4[0], a1 = s4[1], b0 = s4[2], b1 = s4[3];
            const float sa = ((a0.x + a0.y) + (a0.z + a0.w)) + ((a1.x + a1.y) + (a1.z + a1.w)), sb = ((b0.x + b0.y) + (b0.z + b0.w)) + ((b1.x + b1.y) + (b1.z + b1.w));
            const float ra = rsqrtf(sa * (1.f / 512.f) + EPS), rb = rsqrtf(sb * (1.f / 512.f) + EPS);
            tab[2 * F.tid] = ra / rb; tab[2 * F.tid + 1] = rb;
        }
        __syncthreads();
        pg8::Gemm g{(const pg8::bf16_t*)(p.ws + WS_O), (const pg8::bf16_t*)(p.ws + WS_WO), ML, D, D};
        pg8::SchedOne S{u};
        pg8::EpiOut E{(bf16*)(p.ws + WS_OX), tab};
        pg8::gemm_phase<pg8::EpiOut, pg8::SchedOne, false, true, false>((PG8_LAS unsigned char*)F.lds, g, S, E);
    }
}
constexpr int P5_PITCH = 2064;
constexpr int P5_PART = 64 * P5_PITCH, P5_LG = 0;
static_assert(P5_PART + 8 * 16 * 48 * 4 <= MISC_OFF && 64 * 48 * 4 <= P5_PART, "P5 LDS map");
__device__ __forceinline__ void p5_rowpass(const P& p, Frame& F, int abl = 0) {
    LAS unsigned char* LO = F.lds;
    LAS float* PART = (LAS float*)(F.lds + P5_PART); LAS float* LG = (LAS float*)(F.lds + P5_LG);
    LAS int* hist = (LAS int*)(F.lds + MISC_OFF) + 64;
    const bf16* WRh = (const bf16*)(p.ws + WS_WR); const bf16* WRl = WRh + 48 * D;
    for (int rb = F.vcu; rb < ML / 64; rb += F.G) {
        if (F.tid < 32) hist[F.tid] = 0;
        const int b = (rb * 64) / T;
        const float* modx = (const float*)(p.ws + WS_MODX) + b * 6144;
        if (!(abl & 2)) {
            f32x4 gp[4], mp[4], ap[4];
#pragma unroll
            for (int j = 0; j < 4; ++j) { const int k = 256 * j + 4 * F.lane;
                gp[j] = *(const f32x4*)(modx + 2048 + k) * *(const f32x4*)(p.post1 + k);
                mp[j] = *(const f32x4*)(p.pre2 + k) * (*(const f32x4*)(modx + 4096 + k) + 1.f);
                ap[j] = *(const f32x4*)(modx + 3072 + k); }
            f32x4 xn[4]; v2u on[4];
#define P5_LOAD(rw) do { _Pragma("unroll") for (int j = 0; j < 4; ++j) { xn[j] = __builtin_nontemporal_load((const f32x4*)(p.x + (size_t)(rw) * D + 256 * j + 4 * F.lane)); \
                on[j] = __builtin_nontemporal_load((const v2u*)((const bf16*)(p.ws + WS_OX) + (size_t)(rw) * D + 256 * j + 4 * F.lane)); } } while (0)
            P5_LOAD(rb * 64 + F.wave * 8);
            for (int rr = 0; rr < 8; ++rr) {
                const int rl = F.wave * 8 + rr, row = rb * 64 + rl;
                f32x4 xv[4], ox[4]; v2u oc[4]; float ss = 0.f;
#pragma unroll
                for (int j = 0; j < 4; ++j) { xv[j] = xn[j]; oc[j] = on[j]; }
                if (rr + 1 < 8) P5_LOAD(row + 1);
#pragma unroll
                for (int j = 0; j < 4; ++j) { const v2u o2 = oc[j];
                    ox[j] = (f32x4){__uint_as_float(o2.x << 16), __uint_as_float(o2.x & 0xffff0000u), __uint_as_float(o2.y << 16), __uint_as_float(o2.y & 0xffff0000u)};
                    ss += (ox[j].x * ox[j].x + ox[j].y * ox[j].y) + (ox[j].z * ox[j].z + ox[j].w * ox[j].w); }
                const float r1 = rsqrtf(wave_sum(ss) * (1.f / D) + EPS);
                float ss2 = 0.f;
#pragma unroll
                for (int j = 0; j < 4; ++j) { xv[j] = xv[j] + gp[j] * (ox[j] * r1);
                    ss2 += (xv[j].x * xv[j].x + xv[j].y * xv[j].y) + (xv[j].z * xv[j].z + xv[j].w * xv[j].w); }
                const float r2 = rsqrtf(wave_sum(ss2) * (1.f / D) + EPS);
                if (F.lane == 0) ((float*)(p.ws + WS_R1))[row] = r1;
#pragma unroll
                for (int j = 0; j < 4; ++j) {
                    const f32x4 h = xv[j] * r2 * mp[j] + ap[j];
                    v2u wh; wh.x = att::cvtpk(h.x, h.y); wh.y = att::cvtpk(h.z, h.w);
                    const f32x4 hb = (f32x4){__uint_as_float(wh.x << 16), __uint_as_float(wh.x & 0xffff0000u), __uint_as_float(wh.y << 16), __uint_as_float(wh.y & 0xffff0000u)};
                    const f32x4 dl = h - hb;
                    v2u wl; wl.x = att::cvtpk(dl.x, dl.y); wl.y = att::cvtpk(dl.z, dl.w);
                    st8((bf16*)(p.ws + WS_XN) + (size_t)row * D + 256 * j + 4 * F.lane, wh);
                    *(LAS v2u*)(LO + rl * P5_PITCH + (256 * j + 4 * F.lane) * 2) = wl;
                }
            }
#undef P5_LOAD
        }
        asm volatile("s_waitcnt vmcnt(0)" ::: "memory");
        __syncthreads();
        if (F.tid == 0) { __builtin_amdgcn_fence(__ATOMIC_ACQUIRE, "agent"); asm volatile("s_waitcnt vmcnt(0)" ::: "memory"); }
        __syncthreads();
        if (abl & 1) continue;
        {
            const int gI = F.wave >> 1, kq = F.wave & 1, r16 = F.lane & 15, g4 = F.lane >> 4;
            f32x4 acc[3];
#pragma unroll
            for (int nt = 0; nt < 3; ++nt) acc[nt] = (f32x4){0.f, 0.f, 0.f, 0.f};
            const bf16* ah = (const bf16*)(p.ws + WS_XN) + (size_t)(rb * 64 + 16 * gI + r16) * D + 512 * kq + 8 * g4;
            const LAS unsigned char* al = LO + (16 * gI + r16) * P5_PITCH + (512 * kq + 8 * g4) * 2;
            const bf16* bh = WRh + (size_t)(16 * kq) * 3 * 512 + F.lane * 8; const bf16* bl = WRl + (size_t)(16 * kq) * 3 * 512 + F.lane * 8;
#pragma unroll 8
            for (int ks = 0; ks < 16; ++ks) {
                const bf16x8 a_hi = *(const bf16x8*)(ah + ks * 32), a_lo = *(const LAS bf16x8*)(al + ks * 64);
#pragma unroll
                for (int nt = 0; nt < 3; ++nt) {
                    const bf16x8 b_hi = *(const bf16x8*)(bh + (ks * 3 + nt) * 512), b_lo = *(const bf16x8*)(bl + (ks * 3 + nt) * 512);
                    acc[nt] = __builtin_amdgcn_mfma_f32_16x16x32_bf16(a_hi, b_hi, acc[nt], 0, 0, 0);
                    acc[nt] = __builtin_amdgcn_mfma_f32_16x16x32_bf16(a_hi, b_lo, acc[nt], 0, 0, 0);
                    acc[nt] = __builtin_amdgcn_mfma_f32_16x16x32_bf16(a_lo, b_hi, acc[nt], 0, 0, 0);
                }
            }
#pragma unroll
            for (int nt = 0; nt < 3; ++nt)
#pragma unroll
                for (int q = 0; q < 4; ++q) PART[(F.wave * 16 + 4 * g4 + q) * 48 + 16 * nt + r16] = acc[nt][q];
        }
        __syncthreads();
        for (int i = F.tid; i < 64 * 48; i += NTHR) { const int row = i / 48, n = i - row * 48, gI = row >> 4, r16 = row & 15;
            LG[i] = (PART[((gI * 2 + 0) * 16 + r16) * 48 + n] + PART[((gI * 2 + 1) * 16 + r16) * 48 + n]) + (n < 4 ? p.b_group[n] : n < 36 ? p.b_router[n - 4] : 0.f); }
        __syncthreads();
        if (F.tid < 64) {
            float lg[36];
#pragma unroll
            for (int c = 0; c < 36; ++c) lg[c] = LG[F.tid * 48 + c];
            int e1, e2; float w1, w2;
            {
                int g = 0; float gm = lg[0];
#pragma unroll
                for (int q = 1; q < 4; ++q) if (lg[q] > gm) { gm = lg[q]; g = q; }
                float gs = 0.f;
#pragma unroll
                for (int q = 0; q < 4; ++q) gs += __expf(lg[q] - gm);
                const float gw = 1.f / gs;
                float el[8];
#pragma unroll
                for (int q = 0; q < 8; ++q) el[q] = g == 0 ? lg[4 + q] : g == 1 ? lg[12 + q] : g == 2 ? lg[20 + q] : lg[28 + q];
                int i1 = 0; float m1 = el[0];
#pragma unroll
                for (int q = 1; q < 8; ++q) if (el[q] > m1) { m1 = el[q]; i1 = q; }
                int i2 = -1; float m2 = -3.0e38f;
#pragma unroll
                for (int q = 0; q < 8; ++q) if (q != i1 && el[q] > m2) { m2 = el[q]; i2 = q; }
                const float ex = __expf(m2 - m1);
                w1 = gw / (1.f + ex); w2 = gw * ex / (1.f + ex); e1 = g * 8 + i1; e2 = g * 8 + i2;
            }
            const int row = rb * 64 + F.tid;
            if (!(abl & 2)) { int* te = (int*)(p.ws + WS_TOKE) + row * 2; float* tw = (float*)(p.ws + WS_TOKW) + row * 2; te[0] = e1; te[1] = e2; tw[0] = w1; tw[1] = w2; }
            atomicAdd((int*)&hist[e1 & 31], 1); atomicAdd((int*)&hist[e2 & 31], 1);
        }
        __syncthreads();
        if (F.tid < 32 && !(abl & 2)) ((int*)(p.ws + WS_BLKCNT))[rb * 32 + F.tid] = hist[F.tid];
        __syncthreads();
    }
}
__device__ __forceinline__ void p6_lists(const P& p, Frame& F) {
    LAS int* ps = (LAS int*)F.lds;
    LAS int* pp = ps + 512;
    LAS int* tot = pp + 512; LAS int* pre = tot + 32; LAS int* ebase = pre + 32;
    LAS int* es = ebase + 40;
    const int* blk = (const int*)(p.ws + WS_BLKCNT);
    int* meta = (int*)(p.ws + WS_META);
    for (int rb = F.vcu; rb < ML / 64; rb += F.G) {
        { const int e = F.tid & 31, part = F.tid >> 5; int s = 0, q = 0;
#pragma unroll 4
          for (int j = 0; j < 16; ++j) { const int bb = part * 16 + j; const int v = blk[bb * 32 + e]; s += v; q += bb < rb ? v : 0; }
          ps[part * 32 + e] = s; pp[part * 32 + e] = q; }
        __syncthreads();
        if (F.tid < 32) { int s = 0, q = 0;
#pragma unroll
            for (int part = 0; part < 16; ++part) { s += ps[part * 32 + F.tid]; q += pp[part * 32 + F.tid]; }
            tot[F.tid] = s; pre[F.tid] = q; }
        __syncthreads();
        if (F.tid == 0) { int tb = 0; for (int e = 0; e < 32; ++e) { ebase[e] = tb; tb += (tot[e] + 255) >> 8; } ebase[32] = tb; }
        if (F.tid < 128) es[F.tid] = ((const int*)(p.ws + WS_TOKE))[rb * 128 + F.tid];
        __syncthreads();
        if (F.tid < 128) {
            const int e = es[F.tid]; int rank = 0;
            for (int a = 0; a < F.tid; ++a) rank += es[a] == e ? 1 : 0;
            const int pos = ebase[e] * 256 + pre[e] + rank;
            ((int*)(p.ws + WS_ROWIDX))[pos] = rb * 64 + (F.tid >> 1);
            ((float*)(p.ws + WS_ROWW))[pos] = ((const float*)(p.ws + WS_TOKW))[rb * 128 + F.tid];
            ((int*)(p.ws + WS_TOKPOS))[rb * 128 + F.tid] = pos;
        }
        if (rb < 32) {
            const int e = rb, lo = ebase[e] * 256 + tot[e], hi = ebase[e + 1] * 256;
            for (int pos = lo + F.tid; pos < hi; pos += NTHR) { ((int*)(p.ws + WS_ROWIDX))[pos] = 0; ((float*)(p.ws + WS_ROWW))[pos] = 0.f; }
            for (int t = ebase[e] + F.tid; t < ebase[e + 1]; t += NTHR) meta[128 + t] = e;
            if (F.tid == 0) { meta[e] = tot[e]; meta[64 + e] = ebase[e]; if (e == 31) { meta[64 + 32] = ebase[32]; meta[320] = ebase[32]; } }
        }
        __syncthreads();
    }
}
__device__ __forceinline__ void p78_moe(const P& p, Frame& F, bool down) {
    LAS int* tile_e = (LAS int*)(F.lds + LDS_X);
    const int* meta = (const int*)(p.ws + WS_META);
    for (int t = F.tid; t < MAXTILES; t += NTHR) tile_e[t] = meta[128 + t] & 31;
    __syncthreads();
    const int ntiles = meta[320];
    pg8::SchedMoE S{F.G, (int)blockIdx.x, ntiles * 4, tile_e, (const int*)(p.ws + WS_ROWIDX)};
    if (!down) {
        pg8::Gemm g{(const pg8::bf16_t*)(p.ws + WS_XN), (const pg8::bf16_t*)(p.ws + WS_WGU), MAXPOS, NE * 1024, D};
        pg8::EpiGU E{(bf16*)(p.ws + WS_ACT), (const float*)(p.ws + WS_ROWW)};
        pg8::gemm_phase<pg8::EpiGU, pg8::SchedMoE, true, true, true>((PG8_LAS unsigned char*)F.lds, g, S, E);
    } else {
        pg8::Gemm g{(const pg8::bf16_t*)(p.ws + WS_ACT), (const pg8::bf16_t*)(p.ws + WS_WD), MAXPOS, NE * 1024, EFF};
        pg8::EpiY E{(bf16*)(p.ws + WS_Y)};
        pg8::gemm_phase<pg8::EpiY, pg8::SchedMoE, true, true, false>((PG8_LAS unsigned char*)F.lds, g, S, E);
    }
}
__device__ __forceinline__ void p9_final(const P& p, Frame& F, float* dst) {
    const bf16* Y = (const bf16*)(p.ws + WS_Y); const bf16* OX = (const bf16*)(p.ws + WS_OX); const float* R1 = (const float*)(p.ws + WS_R1);
    for (int rb = F.vcu; rb < ML / 64; rb += F.G) {
        const int b = (rb * 64) / T;
        const float* modx = (const float*)(p.ws + WS_MODX) + b * 6144;
        const int row0 = rb * 64 + F.wave * 8;
        f32x4 gp[4], g1p[4];
#pragma unroll
        for (int j = 0; j < 4; ++j) { const int k = 256 * j + 4 * F.lane; gp[j] = *(const f32x4*)(modx + 5120 + k) * *(const f32x4*)(p.post2 + k); g1p[j] = *(const f32x4*)(modx + 2048 + k) * *(const f32x4*)(p.post1 + k); }
        v2u ya[2][4], yc[2][4], oo[2][4]; f32x4 xo[2][4]; float r1v[2];
        const int* tpp = (const int*)(p.ws + WS_TOKPOS) + row0 * 2;
#define P9_LOAD(buf, rw, t2) do { r1v[buf] = R1[rw]; _Pragma("unroll") for (int j = 0; j < 4; ++j) { \
            ya[buf][j] = __builtin_nontemporal_load((const v2u*)(Y + (size_t)(t2).x * D + 256 * j + 4 * F.lane)); yc[buf][j] = __builtin_nontemporal_load((const v2u*)(Y + (size_t)(t2).y * D + 256 * j + 4 * F.lane)); \
            oo[buf][j] = __builtin_nontemporal_load((const v2u*)(OX + (size_t)(rw) * D + 256 * j + 4 * F.lane)); xo[buf][j] = __builtin_nontemporal_load((const f32x4*)(p.x + (size_t)(rw) * D + 256 * j + 4 * F.lane)); } } while (0)
#define P9_COMP(buf, rw) do { f32x4 y[4]; float ss = 0.f; \
            _Pragma("unroll") for (int j = 0; j < 4; ++j) { const v2u a = ya[buf][j], c = yc[buf][j]; \
                y[j] = (f32x4){__uint_as_float(a.x << 16) + __uint_as_float(c.x << 16), __uint_as_float(a.x & 0xffff0000u) + __uint_as_float(c.x & 0xffff0000u), \
                               __uint_as_float(a.y << 16) + __uint_as_float(c.y << 16), __uint_as_float(a.y & 0xffff0000u) + __uint_as_float(c.y & 0xffff0000u)}; \
                ss += (y[j].x * y[j].x + y[j].y * y[j].y) + (y[j].z * y[j].z + y[j].w * y[j].w); } \
            const float rn = rsqrtf(wave_sum(ss) * (1.f / D) + EPS); \
            _Pragma("unroll") for (int j = 0; j < 4; ++j) { const v2u o2 = oo[buf][j]; \
                const f32x4 oxv = (f32x4){__uint_as_float(o2.x << 16), __uint_as_float(o2.x & 0xffff0000u), __uint_as_float(o2.y << 16), __uint_as_float(o2.y & 0xffff0000u)}; \
                const f32x4 x1 = xo[buf][j] + g1p[j] * (oxv * r1v[buf]);                   \
                __builtin_nontemporal_store(x1 + gp[j] * (y[j] * rn), (f32x4*)(dst + (size_t)(rw) * D + 256 * j + 4 * F.lane)); } } while (0)
        int2 tpA = *(const int2*)(tpp), tpB = *(const int2*)(tpp + 2);
        P9_LOAD(0, row0, tpA);
#pragma unroll 1
        for (int rp = 0; rp < 4; ++rp) {
            const int ra = row0 + 2 * rp;
            P9_LOAD(1, ra + 1, tpB);
            int2 tpA2 = tpA, tpB2 = tpB;
            if (rp < 3) { tpA2 = *(const int2*)(tpp + 4 * rp + 4); tpB2 = *(const int2*)(tpp + 4 * rp + 6); }
            P9_COMP(0, ra);
            if (rp < 3) P9_LOAD(0, ra + 2, tpA2);
            P9_COMP(1, ra + 1);
            tpA = tpA2; tpB = tpB2;
        }
#undef P9_COMP
#undef P9_LOAD
    }
}

struct Args { P p; int ph_lo, ph_hi, li, pad; };
__global__ void __launch_bounds__(NTHR, 2) mega(Args args) {
    extern __shared__ __attribute__((aligned(16))) unsigned char lds_raw[];
    Frame F;
    F.lds = (LAS unsigned char*)lds_raw;
    F.MISC = (volatile LAS unsigned*)(F.lds + MISC_OFF);
    F.tid = threadIdx.x; F.lane = F.tid & 63; F.wave = __builtin_amdgcn_readfirstlane(F.tid >> 6);
    F.G = gridDim.x; { const int bx = blockIdx.x; F.vcu = (F.G % 8 == 0) ? (bx % 8) * (F.G / 8) + bx / 8 : bx; }
    const P& p = args.p;
    unsigned* ctl = (unsigned*)(p.ws + WS_CTL);
    for (int u = F.tid; u < (LDS_BYTES - MISC_OFF) / 4; u += NTHR) ((LAS unsigned*)(F.lds + MISC_OFF))[u] = 0u;
    __syncthreads();
    const int lo = args.ph_lo, hi = args.ph_hi;
    XcdBarrier bar; bar.bar = ctl + CW_BAR + args.li * XCD_BAR_WORDS; bar.x = 0; bar.st = nullptr;
    if (hi - lo > 1) bar = xcd_barrier_post(ctl + CW_BAR + args.li * XCD_BAR_WORDS, F.MISC + 8);
#define IN(k) (lo <= (k) && (k) < hi)
#define SEAM(k) do { if (IN(k) && IN((k) + 1)) xcd_barrier(bar); } while (0)
    if (IN(0)) { p0_prologue(p, F); SEAM(0); }
    if (IN(1)) { p1_norm(p, F); SEAM(1); }
    if (IN(2)) {
        pg8::Gemm g{(const pg8::bf16_t*)(p.ws + WS_XN), (const pg8::bf16_t*)(p.ws + WS_WQKV), MT, NQKV, D};
        pg8::SchedQKV S{F.G, (int)blockIdx.x};
        pg8::EpiQKV E{p.ws, p.bqn, p.bkn};
        pg8::gemm_phase<pg8::EpiQKV, pg8::SchedQKV, true, true, false>((PG8_LAS unsigned char*)F.lds, g, S, E);
        SEAM(2);
    }
#ifdef PROBE_ABL
    if (IN(3) && args.pad) { att::attn_phase<PROBE_ABL>(p, F.lds, F.vcu, F.G); } else
#endif
    if (IN(3)) { att::attn_phase<0>(p, F.lds, F.vcu, F.G); SEAM(3); }
    if (IN(4)) { p4_outproj(p, F); SEAM(4); }
#ifdef PROBE_ABL5
    if (IN(5) && args.pad) { p5_rowpass(p, F, PROBE_ABL5); } else
#endif
    if (IN(5)) { p5_rowpass(p, F); SEAM(5); }
    if (IN(6)) { p6_lists(p, F); SEAM(6); }
    if (IN(7)) { p78_moe(p, F, false); SEAM(7); }
    if (IN(8)) { p78_moe(p, F, true); SEAM(8); }
    if (IN(9)) { p9_final(p, F, args.pad ? (float*)(p.ws + WS_WGU) : p.out); }
#undef IN
#undef SEAM
}

#ifndef ONE_LAUNCH
#define ONE_LAUNCH 1
#endif
#ifndef FAST_MASK
#define FAST_MASK 0x3ff
#endif
static void launch_mega(const P& p, int lo, int hi, int li, int grid, hipStream_t stream) {
    Args a{}; a.p = p; a.ph_lo = lo; a.ph_hi = hi; a.li = li; a.pad = 0;
    hipLaunchKernelGGL(mega, dim3(grid), dim3(NTHR), LDS_BYTES, stream, a);
}
extern "C" void kernel_launch(void* const* d_in, const int* in_sizes, int n_in, void* d_out, int out_size, void* d_ws, size_t ws_size, hipStream_t stream) {
    static int grid = 0;
    if (grid == 0) {
        if (n_in != 24 || out_size != ML * D || ws_size < WS_END) { fprintf(stderr, "kernel_launch: unexpected shapes (n_in %d out %d ws %zu)\n", n_in, out_size, ws_size); grid = -1; return; }
        int dev = 0, cus = 0, per_cu = 0;
        if (hipGetDevice(&dev) != hipSuccess || hipDeviceGetAttribute(&cus, hipDeviceAttributeMultiprocessorCount, dev) != hipSuccess) { grid = -1; return; }
        if (hipFuncSetAttribute((const void*)mega, hipFuncAttributeMaxDynamicSharedMemorySize, LDS_BYTES) != hipSuccess) { fprintf(stderr, "kernel_launch: hipFuncSetAttribute failed\n"); grid = -1; return; }
        if (hipOccupancyMaxActiveBlocksPerMultiprocessor(&per_cu, (const void*)mega, NTHR, LDS_BYTES) != hipSuccess || per_cu < 1) { fprintf(stderr, "kernel_launch: occupancy query says %d blocks/CU\n", per_cu); (void)hipGetLastError(); grid = -1; return; }
        grid = cus;
    }
    if (grid < 0) return;
    P p{};
    const float** f = (const float**)&p;
    for (int i = 0; i < 24; ++i) f[i] = (const float*)d_in[i];
    p.out = (float*)d_out; p.ws = (unsigned char*)d_ws;
    (void)hipMemsetAsync((char*)d_ws + WS_CTL, 0, 64 * 1024, stream);
#if ONE_LAUNCH
    launch_mega(p, 0, 10, 0, grid, stream);
#else
    for (int k = 0; k < 10; ++k) {
        launch_mega(p, k, k + 1, 0, grid, stream);
#ifdef PROBE_DUP
        if (k == PROBE_DUP) for (int r_ = 0; r_ < 3; ++r_) { Args a{}; a.p = p; a.ph_lo = k; a.ph_hi = k + 1; a.li = 0; a.pad = 1; hipLaunchKernelGGL(mega, dim3(grid), dim3(NTHR), LDS_BYTES, stream, a); }
#endif
    }
#endif
}
```

```cpp
#include <hip/hip_runtime.h>
#include <cstdio>
#include <cstdint>
#ifndef WCONV_IN_ATTN
#define WCONV_IN_ATTN 1
#endif

constexpr int NB = 8, T = 2048, D = 1024, CL = 256;
constexpr int ML = NB * T;
constexpr int MC = NB * CL;
constexpr int MT = ML + MC;
constexpr int NKEY = T + CL;
constexpr int NTILE = NKEY / 64;
constexpr int NQKV = 1536;
constexpr int NE = 32, EFF = 512;
constexpr int MAXPOS = 40960;
constexpr int MAXTILES = MAXPOS / 256;
constexpr float EPS = 1e-6f;
constexpr float LOG2E = 1.4426950408889634f;
constexpr float C2 = 0.125f * LOG2E;

typedef unsigned short bf16;

constexpr size_t MiB = 1u << 20;
constexpr size_t WS_CTL = 0;
constexpr size_t WS_MODX = 1 * MiB;
constexpr size_t WS_ROPE = 1 * MiB + 512 * 1024;
constexpr size_t WS_WR = 1 * MiB + 768 * 1024;
constexpr size_t WS_TOKE = 2 * MiB;
constexpr size_t WS_TOKW = WS_TOKE + 128 * 1024;
constexpr size_t WS_TOKPOS = WS_TOKW + 128 * 1024;
constexpr size_t WS_ROWIDX = WS_TOKPOS + 128 * 1024;
constexpr size_t WS_ROWW = WS_ROWIDX + 160 * 1024;
constexpr size_t WS_BLKCNT = WS_ROWW + 160 * 1024;
constexpr size_t WS_META = WS_BLKCNT + 32 * 1024;
constexpr size_t WS_WQKV = 4 * MiB;
constexpr size_t WS_WO = 7 * MiB;
constexpr size_t WS_WGU = 9 * MiB;
constexpr size_t WS_WD = 73 * MiB;
constexpr size_t WS_XN = 105 * MiB;
constexpr size_t WS_QA = 141 * MiB;
constexpr size_t WS_QB = 157 * MiB;
constexpr size_t WS_KA = 173 * MiB;
constexpr size_t WS_VA = WS_KA + 4608 * 1024;
constexpr size_t WS_KB = WS_VA + 4608 * 1024;
constexpr size_t WS_VB = WS_KB + 4608 * 1024;
constexpr size_t WS_O = 191 * MiB;
constexpr size_t WS_SSQ = 223 * MiB;
constexpr size_t WS_OX = 261 * MiB;
constexpr size_t WS_R1 = 293 * MiB;
constexpr size_t WS_ACT = 141 * MiB;
constexpr size_t WS_Y = 181 * MiB;
constexpr size_t WS_END = 294 * MiB;

__device__ __forceinline__ unsigned f2bf(float f) { unsigned u = __builtin_bit_cast(unsigned, f); return (u + 0x7fffu + ((u >> 16) & 1u)) >> 16; }
__device__ __forceinline__ float bf2f(bf16 h) { return __builtin_bit_cast(float, (unsigned)h << 16); }
__device__ __forceinline__ float dpp_add(float v, const int ctrl_sel) {
    const int x = __builtin_bit_cast(int, v); int y;
    switch (ctrl_sel) { case 0: y = __builtin_amdgcn_update_dpp(x, x, 0xB1, 0xF, 0xF, false); break;
                        case 1: y = __builtin_amdgcn_update_dpp(x, x, 0x4E, 0xF, 0xF, false); break;
                        case 2: y = __builtin_amdgcn_update_dpp(x, x, 0x141, 0xF, 0xF, false); break;
                        default: y = __builtin_amdgcn_update_dpp(x, x, 0x140, 0xF, 0xF, false); break; }
    return v + __builtin_bit_cast(float, y);
}
__device__ __forceinline__ float wave_sum(float v) {
    v = dpp_add(v, 0); v = dpp_add(v, 1); v = dpp_add(v, 2); v = dpp_add(v, 3);
    const int x = __builtin_bit_cast(int, v);
    const float r0 = __builtin_bit_cast(float, __builtin_amdgcn_readlane(x, 0)), r1 = __builtin_bit_cast(float, __builtin_amdgcn_readlane(x, 16));
    const float r2 = __builtin_bit_cast(float, __builtin_amdgcn_readlane(x, 32)), r3 = __builtin_bit_cast(float, __builtin_amdgcn_readlane(x, 48));
    return (r0 + r1) + (r2 + r3);
}
__device__ __forceinline__ float wave_max(float v) {
#pragma unroll
    for (int o = 1; o < 64; o <<= 1) v = fmaxf(v, __shfl_xor(v, o));
    return v;
}
__device__ __forceinline__ float silu_f(float v) { return v / (1.f + __expf(-v)); }

__host__ __device__ __forceinline__ int qkv_row(int n) { const int pn = n >> 8, j = n & 255, hh = j >> 6, d = j & 63; return pn * 256 + (d >> 5) * 128 + hh * 32 + (d & 31); }
__host__ __device__ __forceinline__ size_t q_off(int b, int h, int t, int d) { return (((size_t)(b * 8 + h) * T + t) * 64 + d); }
__host__ __device__ __forceinline__ size_t k_off(int b, int kvh, int pos, int d) { return ((size_t)((b * 2 + kvh) * NTILE + (pos >> 6)) * 4096 + (d >> 3) * 512 + (pos & 63) * 8 + (d & 7)); }
__host__ __device__ __forceinline__ size_t v_off(int b, int kvh, int pos, int d) { return ((size_t)((b * 2 + kvh) * NTILE + (pos >> 6)) * 4096 + (d >> 5) * 2048 + (pos & 63) * 32 + (d & 31)); }

struct P {
    const float *x, *c, *ctx, *c_ctx, *w_mod, *b_mod, *pre1, *post1, *w_in, *a_sink, *bqn, *bkn, *aon, *bon, *w_out, *pre2, *post2, *w_group, *b_group, *w_router, *b_router, *w_gate, *w_up, *w_down;
    float* out; unsigned char* ws;
};

#define GAS __attribute__((address_space(1)))
#define LAS __attribute__((address_space(3)))
typedef unsigned v4u __attribute__((ext_vector_type(4)));
typedef unsigned v2u __attribute__((ext_vector_type(2)));
typedef float f32x4 __attribute__((ext_vector_type(4)));
typedef float f32x16 __attribute__((ext_vector_type(16)));
typedef short bf16x8 __attribute__((ext_vector_type(8)));
typedef short s16x4 __attribute__((ext_vector_type(4)));
constexpr int NWAVES = 8, NTHR = 512;
constexpr int LDS_BYTES = 163840;
constexpr int RING_BYTES = 131072;
constexpr int MISC_OFF = 159 * 1024;
constexpr int CW_TMO = 0, CW_CODE = 1, CW_BAR = 4096;
static_assert((CW_BAR + 3456) * 4 <= 64 * 1024, "control words inside the per-call memset");
#define LDS_WAIT() asm volatile("s_waitcnt lgkmcnt(0)" ::: "memory")
#define VM_WAIT() asm volatile("s_waitcnt vmcnt(0)" ::: "memory")
__device__ __forceinline__ unsigned pk2(float lo, float hi) { return f2bf(lo) | (f2bf(hi) << 16); }
#ifndef WT_STORES
#define WT_STORES 0
#endif
__device__ __forceinline__ void st16(void* p, v4u v) {
#if WT_STORES
    asm volatile("global_store_dwordx4 %0, %1, off sc1\n\ts_nop 1" :: "v"(p), "v"(v) : "memory");
#else
    *(v4u*)p = v;
#endif
}
__device__ __forceinline__ void st16_nt(void* p, v4u v) { __builtin_nontemporal_store(v, (v4u*)p); }
__device__ __forceinline__ void st16f(void* p, f32x4 v) { st16(p, __builtin_bit_cast(v4u, v)); }
__device__ __forceinline__ void st8(void* p, v2u v) {
#if WT_STORES
    asm volatile("global_store_dwordx2 %0, %1, off sc1\n\ts_nop 1" :: "v"(p), "v"(v) : "memory");
#else
    *(v2u*)p = v;
#endif
}

#define XB_TMO      128
#define XB_XCNT(j)  (256  + 64 * (j))
#define XB_XSUB(j)  (1280 + 64 * (j))
#define XB_XGEN(j)  (2304 + 64 * (j))
#define XB_TOP      3328
#define XB_TOPGEN   3392
#define XCD_BAR_WORDS 3456
#define XB_SPIN_CAP (1u << 18)
__device__ __forceinline__ unsigned xb_ld(unsigned* p)              { return __hip_atomic_load(p, __ATOMIC_RELAXED, __HIP_MEMORY_SCOPE_AGENT); }
__device__ __forceinline__ unsigned xb_add(unsigned* p, unsigned v) { return __hip_atomic_fetch_add(p, v, __ATOMIC_RELAXED, __HIP_MEMORY_SCOPE_AGENT); }
__device__ __forceinline__ unsigned xb_xcc_id() { return (unsigned)__builtin_amdgcn_s_getreg((3 << 11) | 20) & 0xFu; }
#define XB_SPIN(cond, bar) do { unsigned _sp = 0; while (cond) { __builtin_amdgcn_s_sleep(1); \
    if ((++_sp & 255u) == 0u) { if (xb_ld(&(bar)[XB_TMO])) break; if (_sp > XB_SPIN_CAP) { atomicAdd(&(bar)[XB_TMO], 1u); break; } } } } while (0)
struct XcdBarrier { unsigned* bar; unsigned x; volatile LAS unsigned* st; };
__device__ __forceinline__ XcdBarrier xcd_barrier_post(unsigned* bar, volatile LAS unsigned* st) {
    XcdBarrier b; b.bar = bar; b.x = xb_xcc_id(); b.st = st;
    if (threadIdx.x == 0) (void)xb_add(&bar[XB_XCNT(b.x)], 1u);
    return b;
}
__device__ __forceinline__ void xcd_barrier_complete(unsigned* bar, unsigned x, unsigned& nloc, unsigned& nx) {
    const unsigned G = gridDim.x * gridDim.y * gridDim.z;
    unsigned sum, cnt, mine, sp = 0u;
    for (;;) {
        sum = 0u; cnt = 0u; mine = 0u;
#pragma unroll
        for (unsigned j = 0; j < 16; ++j) { const unsigned c = xb_ld(&bar[XB_XCNT(j)]); sum += c; cnt += (c > 0u) ? 1u : 0u; mine = (j == x) ? c : mine; }
        if (sum == G) break;
        __builtin_amdgcn_s_sleep(1);
        if ((++sp & 255u) == 0u) { if (xb_ld(&bar[XB_TMO])) break; if (sp > XB_SPIN_CAP) { atomicAdd(&bar[XB_TMO], 1u); break; } }
    }
    nloc = mine > 0u ? mine : 1u; nx = cnt > 0u ? cnt : 1u;
}
__device__ __forceinline__ void xcd_barrier(const XcdBarrier& b) {
    asm volatile("s_waitcnt vmcnt(0)" ::: "memory");
    __syncthreads();
    if (threadIdx.x == 0) {
        unsigned* bar = b.bar;
        __builtin_amdgcn_s_waitcnt(0);
        unsigned nloc = b.st[0], nx = b.st[1];
        if (nloc == 0u) { xcd_barrier_complete(bar, b.x, nloc, nx); b.st[0] = nloc; b.st[1] = nx; }
        const unsigned old = xb_add(&bar[XB_XSUB(b.x)], 1u);
        const unsigned gen = old / nloc;
        if (old + 1u == (gen + 1u) * nloc) {
            __builtin_amdgcn_fence(__ATOMIC_RELEASE, "agent");
            asm volatile("s_waitcnt vmcnt(0)" ::: "memory");
            const unsigned og = xb_add(&bar[XB_TOP], 1u);
            const unsigned tg = og / nx;
            if (og + 1u == (tg + 1u) * nx) xb_add(&bar[XB_TOPGEN], 1u);
            else XB_SPIN(xb_ld(&bar[XB_TOPGEN]) == tg, bar);
            __builtin_amdgcn_fence(__ATOMIC_ACQUIRE, "agent");
            xb_add(&bar[XB_XGEN(b.x)], 1u);
            asm volatile("s_waitcnt vmcnt(0)" ::: "memory");
        } else {
            XB_SPIN(xb_ld(&bar[XB_XGEN(b.x)]) == gen, bar);
            __builtin_amdgcn_fence(__ATOMIC_ACQUIRE, "agent");
            asm volatile("s_waitcnt vmcnt(0)" ::: "memory");
        }
    }
    __syncthreads();
}

namespace pg8 {
#define PG8_LAS __attribute__((address_space(3)))
typedef unsigned short bf16_t;
typedef short bf16x8 __attribute__((ext_vector_type(8)));
typedef float f32x4 __attribute__((ext_vector_type(4)));
typedef unsigned u32x4 __attribute__((ext_vector_type(4)));
constexpr int BM = 256, BK = 64, HALF = 128, HTB = HALF * BK * 2  , STAGE_BYTES = 8 * HTB, NXCD = 8, WGM = 8;

__host__ __device__ __forceinline__ int lds_byte(int r, int c) { const int st = (r >> 4) * 2 + (c >> 5), rr = r & 15, cc = c & 31, ob = rr * 64 + cc * 2; return st * 1024 + (ob ^ (((ob >> 9) & 1) << 5)); }
__host__ __device__ __forceinline__ void stage_rc(int b, int& R, int& C) { const int st = b / 1024, sb = b % 1024, swz = sb ^ (((sb >> 9) & 1) << 5); R = (st >> 1) * 16 + swz / 64; C = (st & 1) * 32 + (swz % 64) / 2; }
__host__ __device__ __forceinline__ int perm32(int rho) { const int n = rho >> 4, i = rho & 15; return 8 * (i >> 2) + 4 * n + (i & 3); }

struct Unit { int pm, pn; };
struct Gemm { const bf16_t* A; const bf16_t* Bt; int M, N, K; };
__device__ __forceinline__ unsigned cvt_pk_bf16(float lo, float hi) { unsigned r; asm volatile("v_cvt_pk_bf16_f32 %0, %1, %2" : "=v"(r) : "v"(lo), "v"(hi)); return r; }
template <class Epi, class Sched, bool ALIGN_EPI = false, bool SP2 = false, bool GATHER = false>
__device__ __forceinline__ void gemm_phase(PG8_LAS unsigned char* lds, const Gemm g, const Sched& S, const Epi& E) {
    const int tid = threadIdx.x, wid = __builtin_amdgcn_readfirstlane(tid >> 6), lane = tid & 63, wr = wid >> 2, wc = wid & 3, fr = lane & 15, fq = lane >> 4;
    const int K = g.K, nt = K / BK;
    unsigned voffA[2], voffB[2]; int RA[2], CA[2];
#pragma unroll
    for (int i = 0; i < 2; ++i) { int R, C; stage_rc(tid * 16 + i * 8192, R, C); const int Rb = Epi::PERM ? ((R & ~31) + perm32(R & 31)) : R;
        voffA[i] = (unsigned)(R * K + C) * 2u; voffB[i] = (unsigned)(Rb * K + C) * 2u; RA[i] = R; CA[i] = C; }
    const size_t kstep = (size_t)(BK * 2);
    const size_t hstep = (size_t)HALF * K * 2;
    const size_t tstep = 2 * hstep;
    const unsigned ldsw = (unsigned)wid * 1024u;
    const int aoff = lds_byte(wr * 64 + fr, fq * 8), boff = lds_byte(wc * 32 + fr, fq * 8);
#define PG8_SA(b, h) (((b) * 2 + (h)) * HTB)
#define PG8_SB(b, h) ((4 + (b) * 2 + (h)) * HTB)
#define PG8_STAGE(bufoff, gbase, voff) do { _Pragma("unroll") for (int _i = 0; _i < 2; ++_i) \
        __builtin_amdgcn_global_load_lds((const unsigned*)((const char*)(gbase) + (voff)[_i]), (PG8_LAS unsigned*)(lds + (bufoff) + ldsw + _i * 8192), 16, 0, 0); } while (0)
#define PG8_STAGE_A(bufoff, gbase, h, VO) do { if constexpr (GATHER) { PG8_STAGE(bufoff, gbase, VO[h]); } else { PG8_STAGE(bufoff, (gbase) + (h) * hstep, voffA); } } while (0)
#define PG8_LDA(dst, b, h) do { _Pragma("unroll") for (int m = 0; m < 4; ++m) _Pragma("unroll") for (int k = 0; k < 2; ++k) dst[m][k] = *(const PG8_LAS bf16x8*)(lds + PG8_SA(b, h) + aoff + m * 2048 + k * 1024); } while (0)
#define PG8_LDB(dst, b, h) do { _Pragma("unroll") for (int n = 0; n < 2; ++n) _Pragma("unroll") for (int k = 0; k < 2; ++k) dst[n][k] = *(const PG8_LAS bf16x8*)(lds + PG8_SB(b, h) + boff + n * 2048 + k * 1024); } while (0)
#define PG8_MMA(ai, bj, At, Bt) do { __builtin_amdgcn_s_setprio(1); _Pragma("unroll") for (int m = 0; m < 4; ++m) _Pragma("unroll") for (int n = 0; n < 2; ++n) _Pragma("unroll") for (int k = 0; k < 2; ++k) \
        acc[ai][bj][m][n] = __builtin_amdgcn_mfma_f32_16x16x32_bf16(Bt[n][k], At[m][k], acc[ai][bj][m][n], 0, 0, 0); __builtin_amdgcn_s_setprio(0); } while (0)
#define PG8_WAIT_V(n) asm volatile("s_waitcnt vmcnt(" #n ")" ::: "memory")
#define PG8_WAIT_L(n) asm volatile("s_waitcnt lgkmcnt(" #n ")" ::: "memory")
#define PG8_BAR __builtin_amdgcn_s_barrier()
#define PG8_SCHED __builtin_amdgcn_sched_barrier(0)
    Unit cur, nxt; int ui = 0;
    if (!S.next(0, cur)) return;
    f32x4 acc[2][2][4][2];
#pragma unroll
    for (int a = 0; a < 2; ++a)
#pragma unroll
        for (int b = 0; b < 2; ++b)
#pragma unroll
            for (int m = 0; m < 4; ++m)
#pragma unroll
                for (int n = 0; n < 2; ++n) acc[a][b][m][n] = (f32x4){0.f, 0.f, 0.f, 0.f};
    bf16x8 At[4][2], B0[2][2], B1[2][2];
    const char* cA = (const char*)g.A + (GATHER ? (size_t)0 : (size_t)cur.pm * tstep); const char* cB = (const char*)g.Bt + (size_t)cur.pn * tstep;
    unsigned vcur[2][2], vnxt[2][2], vsel[2][2];
#pragma unroll
    for (int h = 0; h < 2; ++h)
#pragma unroll
        for (int i = 0; i < 2; ++i) { vcur[h][i] = 0u; vnxt[h][i] = 0u; vsel[h][i] = 0u; }
    if constexpr (GATHER) {
#pragma unroll
        for (int h = 0; h < 2; ++h)
#pragma unroll
            for (int i = 0; i < 2; ++i) vcur[h][i] = ((unsigned)S.rowidx[cur.pm * BM + h * HALF + RA[i]] * (unsigned)K + (unsigned)CA[i]) * 2u;
    }
    S.a_ready(cur);
    if constexpr (SP2) {
        PG8_STAGE(PG8_SB(0, 0), cB, voffB); PG8_STAGE(PG8_SB(0, 1), cB + hstep, voffB); PG8_STAGE_A(PG8_SA(0, 0), cA, 0, vcur); PG8_STAGE_A(PG8_SA(0, 1), cA, 1, vcur);
        if (wr == 1) PG8_BAR;
        PG8_WAIT_V(2); PG8_BAR;
        PG8_STAGE(PG8_SB(1, 0), cB + kstep, voffB); PG8_STAGE_A(PG8_SA(1, 0), cA + kstep, 0, vcur); PG8_STAGE(PG8_SB(1, 1), cB + hstep + kstep, voffB);
        PG8_WAIT_V(6); PG8_BAR;
    } else {
        PG8_STAGE(PG8_SB(0, 0), cB, voffB); PG8_STAGE_A(PG8_SA(0, 0), cA, 0, vcur); PG8_STAGE(PG8_SB(0, 1), cB + hstep, voffB); PG8_STAGE_A(PG8_SA(0, 1), cA, 1, vcur);
        if (wr == 1) PG8_BAR;
        PG8_WAIT_V(4); PG8_BAR;
        PG8_STAGE(PG8_SB(1, 0), cB + kstep, voffB); PG8_STAGE_A(PG8_SA(1, 0), cA + kstep, 0, vcur); PG8_STAGE(PG8_SB(1, 1), cB + hstep + kstep, voffB);
        PG8_WAIT_V(6); PG8_BAR;
    }
    for (;;) {
        const bool has_next = S.next(ui + 1, nxt);
        if constexpr (GATHER) {
#pragma unroll
            for (int h = 0; h < 2; ++h)
#pragma unroll
                for (int i = 0; i < 2; ++i) vnxt[h][i] = has_next ? ((unsigned)S.rowidx[nxt.pm * BM + h * HALF + RA[i]] * (unsigned)K + (unsigned)CA[i]) * 2u : vcur[h][i];
        }
        const char* nA = has_next ? (const char*)g.A + (GATHER ? (size_t)0 : (size_t)nxt.pm * tstep) : cA; const char* nB = has_next ? (const char*)g.Bt + (size_t)nxt.pn * tstep : cB;
        for (int t = 0; t < nt; t += 2) {
            const bool last = (t == nt - 2);
            if constexpr (GATHER) {
#pragma unroll
                for (int h = 0; h < 2; ++h)
#pragma unroll
                    for (int i = 0; i < 2; ++i) vsel[h][i] = last ? vnxt[h][i] : vcur[h][i];
            }
            if constexpr (Epi::HAS_MID) { if (t == nt / 2) E.mid(acc, cur, wr, wc, fr, fq); }
            const char* a1 = cA + (size_t)(t + 1) * kstep;
            const char* a2 = last ? nA : cA + (size_t)(t + 2) * kstep; const char* b2 = last ? nB : cB + (size_t)(t + 2) * kstep;
            const char* a3 = a2 + kstep; const char* b3 = b2 + kstep;
            if (last && has_next) S.a_ready(nxt);
            if constexpr (SP2) {
            PG8_LDB(B0, 0, 0); PG8_LDB(B1, 0, 1); PG8_SCHED; PG8_LDA(At, 0, 0); PG8_STAGE_A(PG8_SA(1, 1), a1, 1, vcur);
            PG8_WAIT_V(8); PG8_WAIT_L(0); PG8_BAR; PG8_MMA(0, 0, At, B0); PG8_MMA(0, 1, At, B1); PG8_BAR; PG8_SCHED;
            PG8_LDA(At, 0, 1); PG8_STAGE(PG8_SB(0, 0), b2, voffB); PG8_STAGE(PG8_SB(0, 1), b2 + hstep, voffB); PG8_STAGE_A(PG8_SA(0, 0), a2, 0, vsel);
            PG8_WAIT_V(8); PG8_WAIT_L(0); PG8_BAR; PG8_MMA(1, 0, At, B0); PG8_MMA(1, 1, At, B1); PG8_BAR; PG8_SCHED;
            PG8_LDB(B0, 1, 0); PG8_LDB(B1, 1, 1); PG8_SCHED; PG8_LDA(At, 1, 0); PG8_STAGE_A(PG8_SA(0, 1), a2, 1, vsel);
            PG8_WAIT_V(8); PG8_WAIT_L(0); PG8_BAR; PG8_MMA(0, 0, At, B0); PG8_MMA(0, 1, At, B1); PG8_BAR; PG8_SCHED;
            PG8_LDA(At, 1, 1); PG8_STAGE(PG8_SB(1, 0), b3, voffB); PG8_STAGE(PG8_SB(1, 1), b3 + hstep, voffB); PG8_STAGE_A(PG8_SA(1, 0), a3, 0, vsel);
            PG8_WAIT_V(8); PG8_WAIT_L(0); PG8_BAR; PG8_MMA(1, 0, At, B0); PG8_MMA(1, 1, At, B1); PG8_BAR; PG8_SCHED;
            } else {
            PG8_LDB(B0, 0, 0); PG8_SCHED; PG8_LDA(At, 0, 0); PG8_STAGE_A(PG8_SA(1, 1), a1, 1, vcur);
            PG8_WAIT_L(8); PG8_BAR; PG8_WAIT_L(0); PG8_MMA(0, 0, At, B0); PG8_BAR; PG8_SCHED;
            PG8_LDB(B1, 0, 1); PG8_STAGE(PG8_SB(0, 0), b2, voffB);
            PG8_BAR; PG8_WAIT_L(0); PG8_MMA(0, 1, At, B1); PG8_BAR;
            PG8_LDA(At, 0, 1); PG8_STAGE_A(PG8_SA(0, 0), a2, 0, vsel);
            PG8_BAR; PG8_WAIT_L(0); PG8_MMA(1, 0, At, B0); PG8_BAR; PG8_SCHED;
            PG8_STAGE(PG8_SB(0, 1), b2 + hstep, voffB);
            PG8_WAIT_V(6); PG8_BAR; PG8_MMA(1, 1, At, B1); PG8_BAR;
            PG8_LDB(B0, 1, 0); PG8_SCHED; PG8_LDA(At, 1, 0); PG8_STAGE_A(PG8_SA(0, 1), a2, 1, vsel);
            PG8_WAIT_L(8); PG8_BAR; PG8_WAIT_L(0); PG8_MMA(0, 0, At, B0); PG8_BAR; PG8_SCHED;
            PG8_LDB(B1, 1, 1); PG8_STAGE(PG8_SB(1, 0), b3, voffB);
            PG8_BAR; PG8_WAIT_L(0); PG8_MMA(0, 1, At, B1); PG8_BAR;
            PG8_LDA(At, 1, 1); PG8_STAGE_A(PG8_SA(1, 0), a3, 0, vsel);
            PG8_BAR; PG8_WAIT_L(0); PG8_MMA(1, 0, At, B0); PG8_BAR; PG8_SCHED;
            PG8_STAGE(PG8_SB(1, 1), b3 + hstep, voffB);
            PG8_WAIT_V(6); PG8_BAR; PG8_MMA(1, 1, At, B1); PG8_BAR;
            }
        }
        if constexpr (ALIGN_EPI) { if (wr == 0) PG8_BAR; }
        if constexpr (!Epi::AFTER_DRAIN) { E(acc, cur, wr, wc, fr, fq); S.done(cur); }
        if (!has_next) break;
#pragma unroll
        for (int a = 0; a < 2; ++a)
#pragma unroll
            for (int b = 0; b < 2; ++b)
#pragma unroll
                for (int m = 0; m < 4; ++m)
#pragma unroll
                    for (int n = 0; n < 2; ++n) acc[a][b][m][n] = (f32x4){0.f, 0.f, 0.f, 0.f};
        cur = nxt; cA = nA; cB = nB; ++ui;
        if constexpr (GATHER) {
#pragma unroll
            for (int h = 0; h < 2; ++h)
#pragma unroll
                for (int i = 0; i < 2; ++i) vcur[h][i] = vnxt[h][i];
        }
        if constexpr (ALIGN_EPI) { if (wr == 1) PG8_BAR; }
    }
    PG8_WAIT_V(0);
    if constexpr (!ALIGN_EPI) { if (wr == 0) PG8_BAR; }
    PG8_BAR;
    if constexpr (Epi::AFTER_DRAIN) { E.fused(acc, cur, wr, wc, fr, fq, lds, wid, lane); S.done(cur); }
#undef PG8_SA
#undef PG8_SB
#undef PG8_STAGE
#undef PG8_STAGE_A
#undef PG8_LDA
#undef PG8_LDB
#undef PG8_MMA
#undef PG8_WAIT_V
#undef PG8_WAIT_L
#undef PG8_BAR
#undef PG8_SCHED
}
}

namespace pg8 {
struct SchedQKV {
    int G, c;
    __device__ __forceinline__ bool next(int i, Unit& u) const {
        const int L = i * G + c; if (L >= 400) return false;
        if (L < 384) { const int xcd = L & 7, off = L >> 3, w = xcd * 48 + off; u.pm = (w / 48) * 8 + ((w % 48) & 7); u.pn = (w % 48) >> 3; }
        else { const int j = L - 384; u.pm = 64 + (j >> 1); u.pn = (j & 1) ? 5 : 2; }
        return true;
    }
    __device__ __forceinline__ void a_ready(const Unit&) const {}
    __device__ __forceinline__ void done(const Unit&) const {}
};
struct EpiQKV {
    static constexpr bool PERM = true, AFTER_DRAIN = false, HAS_MID = false;
    unsigned char* ws; const float* bqn; const float* bkn;
    __device__ __forceinline__ void operator()(const f32x4 (&acc)[2][2][4][2], const Unit& u, int wr, int wc, int fr, int fq) const {
        const int pn = u.pn; const bool isctx = u.pm >= 64;
        int kind, hh;
        if (pn < 2) { kind = 0; hh = pn * 4 + wc; } else if (pn == 2) { kind = wc < 2 ? 2 : 4; hh = wc & 1; } else if (pn < 5) { kind = 1; hh = (pn - 3) * 4 + wc; } else { kind = wc < 2 ? 3 : 5; hh = wc & 1; }
        const bool rms = kind == 1 || kind == 3, rope = !isctx && kind <= 3;
        const float* gp = kind == 1 ? bqn : bkn;
        f32x4 gain[2][2];
#pragma unroll
        for (int bj = 0; bj < 2; ++bj)
#pragma unroll
            for (int n = 0; n < 2; ++n) gain[bj][n] = rms ? *(const f32x4*)(gp + 32 * bj + 8 * fq + 4 * n) : (f32x4){1.f, 1.f, 1.f, 1.f};
        const float* tab = (const float*)(ws + WS_ROPE);
        bf16* base = (bf16*)(ws + (kind == 0 ? WS_QA : kind == 1 ? WS_QB : kind == 2 ? WS_KA : kind == 3 ? WS_KB : kind == 4 ? WS_VA : WS_VB));
        const float qs = kind <= 1 ? C2 : 1.f;
#pragma unroll
        for (int ai = 0; ai < 2; ++ai)
#pragma unroll
            for (int m = 0; m < 4; ++m) {
                const int row = u.pm * BM + ai * HALF + wr * 64 + m * 16 + fr;
                int b, t, pos;
                if (!isctx) { b = row >> 11; t = row & 2047; pos = t; } else { const int cr = row - ML; b = cr >> 8; t = 0; pos = T + (cr & 255); }
                f32x4 v[2][2];
#pragma unroll
                for (int bj = 0; bj < 2; ++bj)
#pragma unroll
                    for (int n = 0; n < 2; ++n) v[bj][n] = acc[ai][bj][m][n];
                if (rms) {
                    float ss = 0.f;
#pragma unroll
                    for (int bj = 0; bj < 2; ++bj)
#pragma unroll
                        for (int n = 0; n < 2; ++n) ss += (v[bj][n].x * v[bj][n].x + v[bj][n].y * v[bj][n].y) + (v[bj][n].z * v[bj][n].z + v[bj][n].w * v[bj][n].w);
                    ss += __shfl_xor(ss, 16); ss += __shfl_xor(ss, 32);
                    const float rn = rsqrtf(ss * (1.f / 64.f) + EPS);
#pragma unroll
                    for (int bj = 0; bj < 2; ++bj)
#pragma unroll
                        for (int n = 0; n < 2; ++n) v[bj][n] = v[bj][n] * rn * gain[bj][n];
                }
                if (rope) {
#pragma unroll
                    for (int bj = 0; bj < 2; ++bj)
#pragma unroll
                        for (int n = 0; n < 2; ++n) {
                            const int tp = bj == 0 ? (t >> 6) : 32 + (t & 63);
                            const f32x4 cs = *(const f32x4*)(tab + (tp * 16 + 4 * fq + 2 * n) * 2);
                            const f32x4 x = v[bj][n];
                            v[bj][n] = (f32x4){x.x * cs.x - x.y * cs.y, x.x * cs.y + x.y * cs.x, x.z * cs.z - x.w * cs.w, x.z * cs.w + x.w * cs.z};
                        }
                }
#pragma unroll
                for (int bj = 0; bj < 2; ++bj) {
                    const f32x4 v0 = v[bj][0] * qs, v1 = v[bj][1] * qs;
                    u32x4 w; w.x = pk2(v0.x, v0.y); w.y = pk2(v0.z, v0.w); w.z = pk2(v1.x, v1.y); w.w = pk2(v1.z, v1.w);
                    const int d0 = 32 * bj + 8 * fq;
                    bf16* dst = kind <= 1 ? base + q_off(b, hh, t, d0) : kind <= 3 ? base + k_off(b, hh, pos, d0) : base + v_off(b, hh, pos, d0);
                    if (kind <= 1) st16_nt(dst, w); else st16(dst, w);
                }
            }
    }
};
}


namespace pg8 {
struct SchedOne { Unit u;
    __device__ __forceinline__ bool next(int i, Unit& o) const { if (i) return false; o = u; return true; }
    __device__ __forceinline__ void a_ready(const Unit&) const {}
    __device__ __forceinline__ void done(const Unit&) const {} };
struct EpiOut {
    static constexpr bool PERM = true, AFTER_DRAIN = false, HAS_MID = true;
    bf16* OX; const LAS float* tab;
    __device__ __forceinline__ void mid(f32x4 (&acc)[2][2][4][2], const Unit&, int wr, int, int fr, int) const {
#pragma unroll
        for (int ai = 0; ai < 2; ++ai)
#pragma unroll
            for (int m = 0; m < 4; ++m) { const float f = tab[2 * (ai * HALF + wr * 64 + m * 16 + fr)];
#pragma unroll
                for (int bj = 0; bj < 2; ++bj)
#pragma unroll
                    for (int n = 0; n < 2; ++n) acc[ai][bj][m][n] = acc[ai][bj][m][n] * f; }
    }
    __device__ __forceinline__ void operator()(const f32x4 (&acc)[2][2][4][2], const Unit& u, int wr, int wc, int fr, int fq) const {
#pragma unroll
        for (int ai = 0; ai < 2; ++ai)
#pragma unroll
            for (int m = 0; m < 4; ++m) { const int r = ai * HALF + wr * 64 + m * 16 + fr; const float f = tab[2 * r + 1];
                bf16* rowp = OX + (size_t)(u.pm * BM + r) * D + u.pn * BM + wc * 32 + 8 * fq;
#pragma unroll
                for (int bj = 0; bj < 2; ++bj) { const f32x4 v0 = acc[ai][bj][m][0] * f, v1 = acc[ai][bj][m][1] * f;
                    u32x4 w; w.x = pk2(v0.x, v0.y); w.y = pk2(v0.z, v0.w); w.z = pk2(v1.x, v1.y); w.w = pk2(v1.z, v1.w);
                    st16(rowp + bj * HALF, w); } }
    }
};
struct SchedMoE {
    int G, c, nwg; const LAS int* tile_e; const int* rowidx;
    __device__ __forceinline__ bool next(int i, Unit& u) const {
        const int L = i * G + c; if (L >= nwg) return false;
        const int q = nwg >> 3, r = nwg & 7, xcd = L & 7, off = L >> 3;
        const int w = (xcd < r ? xcd * (q + 1) : r * (q + 1) + (xcd - r) * q) + off;
        u.pm = w >> 2; u.pn = tile_e[w >> 2] * 4 + (w & 3); return true;
    }
    __device__ __forceinline__ void a_ready(const Unit&) const {}
    __device__ __forceinline__ void done(const Unit&) const {}
};
__device__ __forceinline__ float silu_fast(float g) { return g * __builtin_amdgcn_rcpf(1.f + __builtin_amdgcn_exp2f(-g * LOG2E)); }
struct EpiGU {
    static constexpr bool PERM = true, AFTER_DRAIN = false, HAS_MID = false;
    bf16* ACT; const float* roww;
    __device__ __forceinline__ void operator()(const f32x4 (&acc)[2][2][4][2], const Unit& u, int wr, int wc, int fr, int fq) const {
#pragma unroll
        for (int ai = 0; ai < 2; ++ai)
#pragma unroll
            for (int m = 0; m < 4; ++m) { const int pos = u.pm * BM + ai * HALF + wr * 64 + m * 16 + fr; const float w = roww[pos];
                const f32x4 g0 = acc[ai][0][m][0], g1 = acc[ai][0][m][1], u0 = acc[ai][1][m][0], u1 = acc[ai][1][m][1];
                u32x4 o;
                o.x = pk2(silu_fast(g0.x) * u0.x * w, silu_fast(g0.y) * u0.y * w); o.y = pk2(silu_fast(g0.z) * u0.z * w, silu_fast(g0.w) * u0.w * w);
                o.z = pk2(silu_fast(g1.x) * u1.x * w, silu_fast(g1.y) * u1.y * w); o.w = pk2(silu_fast(g1.z) * u1.z * w, silu_fast(g1.w) * u1.w * w);
                st16(ACT + (size_t)pos * EFF + (u.pn & 3) * 128 + wc * 32 + 8 * fq, o); }
    }
};
struct EpiY {
    static constexpr bool PERM = true, AFTER_DRAIN = false, HAS_MID = false;
    bf16* Y;
    __device__ __forceinline__ void operator()(const f32x4 (&acc)[2][2][4][2], const Unit& u, int wr, int wc, int fr, int fq) const {
#pragma unroll
        for (int ai = 0; ai < 2; ++ai)
#pragma unroll
            for (int m = 0; m < 4; ++m) { bf16* rowp = Y + (size_t)(u.pm * BM + ai * HALF + wr * 64 + m * 16 + fr) * D + (u.pn & 3) * BM + wc * 32 + 8 * fq;
#pragma unroll
                for (int bj = 0; bj < 2; ++bj) { const f32x4 v0 = acc[ai][bj][m][0], v1 = acc[ai][bj][m][1];
                    u32x4 w; w.x = pk2(v0.x, v0.y); w.y = pk2(v0.z, v0.w); w.z = pk2(v1.x, v1.y); w.w = pk2(v1.z, v1.w);
                    st16(rowp + bj * HALF, w); } }
    }
};
}

namespace att {
typedef __attribute__((address_space(3))) const char* lds_cptr;
typedef short v4i16_t __attribute__((ext_vector_type(4)));
constexpr int NSLOT = 4, SLOTB = 16384, OST_PITCH = 144, OST_WAVE = 32 * OST_PITCH;
static_assert(8 * OST_WAVE <= 3 * SLOTB && NSLOT * SLOTB <= 65536, "attention LDS");
__device__ __forceinline__ int crow(int r, int hi) { return (r & 3) + 8 * (r >> 2) + 4 * hi; }
__device__ __forceinline__ unsigned cvtpk(float lo, float hi) { typedef float f2 __attribute__((ext_vector_type(2))); typedef __bf16 b2 __attribute__((ext_vector_type(2))); f2 v = {lo, hi}; b2 b = __builtin_convertvector(v, b2); return __builtin_bit_cast(unsigned, b); }
__device__ __forceinline__ s16x4 vtr(lds_cptr p) { return __builtin_bit_cast(s16x4, __builtin_amdgcn_ds_read_tr16_b64_v4i16((__attribute__((address_space(3))) v4i16_t*)p)); }
__device__ __forceinline__ float swapmax(float m) { auto rr = __builtin_amdgcn_permlane32_swap(__float_as_uint(m), __float_as_uint(m), false, false); return fmaxf(__uint_as_float(rr[0]), __uint_as_float(rr[1])); }
__device__ __forceinline__ float swapsum(float m) { auto rr = __builtin_amdgcn_permlane32_swap(__float_as_uint(m), __float_as_uint(m), false, false); return __uint_as_float(rr[0]) + __uint_as_float(rr[1]); }

__device__ __forceinline__ void glds16(const void* gsrc, unsigned lds_dst) { unsigned keep;
    asm volatile("s_mov_b32 %0, m0\n\ts_mov_b32 m0, %2\n\ts_nop 0\n\tglobal_load_lds_dwordx4 %1, off\n\ts_mov_b32 m0, %0" : "=&s"(keep) : "v"(gsrc), "s"(lds_dst) : "memory"); }
__device__ __forceinline__ float max3f(float a, float b, float c) { float r; asm("v_max3_f32 %0, %1, %2, %3" : "=v"(r) : "v"(a), "v"(b), "v"(c)); return r; }
__device__ __forceinline__ float max2f(float a, float b) { float r; asm("v_max_f32_e32 %0, %1, %2" : "=v"(r) : "v"(a), "v"(b)); return r; }
constexpr int WC_PER_WAVE = 24, WC_LDS = 65536;
struct WConv { int next, j0, j1, gstep, cm1, cm2; };
struct WItem { const float* src; int N; bf16* dst; int dpitch; };
__device__ __forceinline__ WItem wc_decode(const P& p, int hidx, int& k0, int& n0, int& drow0) {
    const int item = hidx >> 1, kh = hidx & 1; WItem w;
    if (item < 16384) { const int up = item >= 8192, r = item & 8191, e = r >> 8, q = r & 255, kb = q >> 4, nb = q & 15; n0 = nb * 32;
        w.src = (up ? p.w_up : p.w_gate) + (size_t)e * 1024 * 512; w.N = 512; w.dst = (bf16*)(p.ws + WS_WGU) + (size_t)e * 1024 * 1024; w.dpitch = 1024;
        drow0 = (n0 >> 7) * 256 + up * 128 + (n0 & 127); k0 = kb * 64 + kh * 32; }
    else { const int r = item - 16384, e = r >> 8, q = r & 255, kb = q >> 5, nb = q & 31; n0 = nb * 32;
        w.src = p.w_down + (size_t)e * 512 * 1024; w.N = 1024; w.dst = (bf16*)(p.ws + WS_WD) + (size_t)e * 1024 * 512; w.dpitch = 512; drow0 = n0; k0 = kb * 64 + kh * 32; }
    return w;
}
__device__ __forceinline__ void glds16(const void* gsrc, unsigned lds_dst);
__device__ __forceinline__ void glds16_nt(const void* gsrc, unsigned lds_dst) { unsigned keep;
    asm volatile("s_mov_b32 %0, m0\n\ts_mov_b32 m0, %2\n\ts_nop 0\n\tglobal_load_lds_dwordx4 %1, off nt\n\ts_mov_b32 m0, %0" : "=&s"(keep) : "v"(gsrc), "s"(lds_dst) : "memory"); }
__device__ __forceinline__ void wc_issue(const P& p, int gw, int ord, unsigned ldsbuf, int lane) {
    int k0, n0, drow0; const WItem w = wc_decode(p, gw + 2048 * ord, k0, n0, drow0);
#pragma unroll
    for (int q = 0; q < 4; ++q) { const int kl = 8 * q + (lane >> 3), f4 = (lane & 7) ^ ((q >> 1) * 4);
        glds16_nt(w.src + (size_t)(k0 + kl) * w.N + n0 + f4 * 4, (unsigned)__builtin_amdgcn_readfirstlane(ldsbuf + q * 1024)); }
}
__device__ __forceinline__ void wc_consume(const P& p, int gw, int ord, LAS unsigned char* buf, int lane) {
    int k0, n0, drow0; const WItem w = wc_decode(p, gw + 2048 * ord, k0, n0, drow0);
    const int n = lane >> 1, kh = lane & 1;
    const LAS float* s = (const LAS float*)buf + (16 * kh) * 32 + 4 * ((n >> 2) ^ (4 * kh)) + (n & 3);
    float v[16];
#pragma unroll
    for (int i = 0; i < 16; ++i) v[i] = s[i * 32];
    v4u o0, o1;
    o0.x = cvtpk(v[0], v[1]); o0.y = cvtpk(v[2], v[3]); o0.z = cvtpk(v[4], v[5]); o0.w = cvtpk(v[6], v[7]);
    o1.x = cvtpk(v[8], v[9]); o1.y = cvtpk(v[10], v[11]); o1.z = cvtpk(v[12], v[13]); o1.w = cvtpk(v[14], v[15]);
    bf16* d = w.dst + (size_t)(drow0 + n) * w.dpitch + k0 + 16 * kh;
    __builtin_nontemporal_store(o0, (v4u*)d); __builtin_nontemporal_store(o1, (v4u*)(d + 8));
}
constexpr float THR = 8.f;
template <int GRP, int ABL = 0>
__device__ __forceinline__ void attn_unit(const P& p, LAS unsigned char* lds, int b, int kvh, int qb, WConv& wc, int gw) {
    const int tid = threadIdx.x, lane = tid & 63, r32 = lane & 31, hi = lane >> 5;
    const int wid = __builtin_amdgcn_readfirstlane(tid >> 6);
    const int h = kvh * 4 + (wid >> 1);
    const int q0w = qb * 64 + (wid & 1) * 32, qpos = q0w + r32;
    const bf16* Qp = (const bf16*)(p.ws + (GRP ? WS_QB : WS_QA)) + q_off(b, h, qpos, 0);
    bf16x8 qr[4];
#pragma unroll
    for (int d0 = 0; d0 < 4; ++d0) qr[d0] = __builtin_nontemporal_load((const bf16x8*)(Qp + 16 * d0 + 8 * hi));
    asm volatile("" : "+v"(qr[0]), "+v"(qr[1]), "+v"(qr[2]), "+v"(qr[3]));
    const char* Kt = (const char*)(p.ws + (GRP ? WS_KB : WS_KA)) + (size_t)(b * 2 + kvh) * NTILE * 8192 + wid * 1024 + lane * 16;
    const char* Vt = (const char*)(p.ws + (GRP ? WS_VB : WS_VA)) + (size_t)(b * 2 + kvh) * NTILE * 8192 + wid * 1024 + lane * 16;
    const unsigned lds0 = (unsigned)(uintptr_t)lds;
    int jlo = 0, nband = NTILE, NT = NTILE;
    if (GRP == 0) { jlo = qb - 2 < 0 ? 0 : qb - 2; const int jhi = qb + 2 > 31 ? 31 : qb + 2; nband = jhi - jlo + 1; NT = nband + 4; }
#define ATT_TILE(i) ((i) < nband ? jlo + (i) : 32 + ((i) - nband))
#define ATT_ISSUE(i) do { if (ABL & 1) break; const int tl_ = ATT_TILE(i); const int sl_ = ((i) & 3) * SLOTB; \
        glds16(Kt + (size_t)tl_ * 8192, (unsigned)__builtin_amdgcn_readfirstlane(lds0 + sl_ + wid * 1024)); \
        glds16(Vt + (size_t)tl_ * 8192, (unsigned)__builtin_amdgcn_readfirstlane(lds0 + sl_ + 8192 + wid * 1024)); } while (0)
#define ATT_WAIT(n) do { if (ABL & 1) break; if ((n) >= 2) asm volatile("s_waitcnt vmcnt(4)" ::: "memory"); else if ((n) == 1) asm volatile("s_waitcnt vmcnt(2)" ::: "memory"); else asm volatile("s_waitcnt vmcnt(0)" ::: "memory"); } while (0)
#define ATT_WAITN(n) do { if (ABL & 1) break; switch (n) { case 0: asm volatile("s_waitcnt vmcnt(0)" ::: "memory"); break; case 2: asm volatile("s_waitcnt vmcnt(2)" ::: "memory"); break; \
        case 4: asm volatile("s_waitcnt vmcnt(4)" ::: "memory"); break; case 6: asm volatile("s_waitcnt vmcnt(6)" ::: "memory"); break; case 8: asm volatile("s_waitcnt vmcnt(8)" ::: "memory"); break; \
        case 10: asm volatile("s_waitcnt vmcnt(10)" ::: "memory"); break; case 12: asm volatile("s_waitcnt vmcnt(12)" ::: "memory"); break; default: asm volatile("s_waitcnt vmcnt(14)" ::: "memory"); break; } } while (0)
#define ATT_BAR() do { asm volatile("" ::: "memory"); __builtin_amdgcn_s_barrier(); asm volatile("" ::: "memory"); } while (0)
#define SBAR() __builtin_amdgcn_sched_barrier(0)
#define MF(a, b, c) __builtin_amdgcn_mfma_f32_32x32x16_bf16(a, b, c, 0, 0, 0)
#define KFRAG(dst, base, k) dst = *(const __attribute__((address_space(3))) bf16x8*)((base) + ((k) >> 1) * 2048 + ((k) & 1) * 512)
    float m, l;
    m = 0.f; l = 0.f;
    f32x16 o0, o1, sA0, sA1, sB0, sB1; const f32x16 zero16 = {0.f, 0.f, 0.f, 0.f, 0.f, 0.f, 0.f, 0.f, 0.f, 0.f, 0.f, 0.f, 0.f, 0.f, 0.f, 0.f};
#pragma unroll
    for (int r = 0; r < 16; ++r) { o0[r] = 0.f; o1[r] = 0.f; sB0[r] = 0.f; sB1[r] = 0.f; }
    const lds_cptr kp0 = (lds_cptr)lds + hi * 1024 + r32 * 16;
    const lds_cptr vp0 = (lds_cptr)lds + 8192 + ((lane >> 4) & 1) * 32 + (lane & 3) * 8 + (4 * hi + ((lane & 15) >> 2)) * 64;
#define ATT_MASK(S0, S1, t) do { if (GRP == 0) { const int tl = ATT_TILE(t); if (tl < 32 && (tl == qb - 2 || tl == qb + 2)) { const int kb = tl * 64; \
        _Pragma("unroll") for (int r = 0; r < 16; ++r) { const int dd = kb + crow(r, hi) - qpos; if (dd > 128 || dd < -128) S0[r] = -1e30f; if (dd + 32 > 128 || dd + 32 < -128) S1[r] = -1e30f; } } } } while (0)
#define ATT_DECIDE(S0, S1, mxv) do { float mx_ = swapmax(mxv); \
        if (__builtin_expect(__any(mx_ > THR), 0)) { const float dl = fmaxf(mx_, 0.f), alpha = __builtin_amdgcn_exp2f(-dl); m += dl; l *= alpha; \
            _Pragma("unroll") for (int r = 0; r < 16; ++r) { S0[r] -= dl; S1[r] -= dl; o0[r] *= alpha; o1[r] *= alpha; } } } while (0)
    if (wid >= 4) __builtin_amdgcn_s_setprio(1);
    wc.cm1 = 0; wc.cm2 = 0;
    ATT_ISSUE(0); ATT_ISSUE(1); ATT_ISSUE(2);
    ATT_WAIT(2); ATT_BAR();
    {
        bf16x8 kf[8];
#pragma unroll
        for (int k = 0; k < 8; ++k) KFRAG(kf[k], kp0, k);
        SBAR();
        sA0 = MF(kf[0], qr[0], zero16); sA1 = MF(kf[1], qr[0], zero16);
#pragma unroll
        for (int d0 = 1; d0 < 4; ++d0) { sA0 = MF(kf[2 * d0], qr[d0], sA0); sA1 = MF(kf[2 * d0 + 1], qr[d0], sA1); }
        ATT_MASK(sA0, sA1, 0);
        asm volatile("s_nop 15\n\ts_nop 7" : "+v"(sA0), "+v"(sA1));
        float a = max3f(sA0[0], sA0[1], sA1[0]), c = max3f(sA0[2], sA0[3], sA1[1]); a = max3f(a, sA1[2], sA1[3]);
#pragma unroll
        for (int r = 4; r < 16; r += 4) { a = max3f(a, sA0[r], sA0[r + 1]); c = max3f(c, sA0[r + 2], sA0[r + 3]); a = max3f(a, sA1[r], sA1[r + 1]); c = max3f(c, sA1[r + 2], sA1[r + 3]); }
        ATT_DECIDE(sA0, sA1, max2f(a, c));
    }
#define ATT_STEP(SC0, SC1, SN0, SN1, t, HN) do { \
        constexpr bool hn_ = HN;                                      \
        ATT_WAITN(wc.cm2 + wc.cm1 + ((t) + 2 < NT ? 2 : 0));         \
        ATT_BAR(); \
        if ((t) + 3 < NT) ATT_ISSUE((t) + 3); \
        if (WCONV_IN_ATTN) { int c_ = 0; const int r7_ = wc.gstep % 7, bs_ = r7_ == 0 ? 0 : r7_ == 3 ? 1 : 2;     \
            if (bs_ < 2) { LAS unsigned char* wb_ = lds + WC_LDS + wid * 8192 + bs_ * 4096; int jb_ = bs_ ? wc.j1 : wc.j0; \
                if (jb_ >= 0) { wc_consume(p, gw, jb_, wb_, lane); jb_ = -1; c_ += 2; } \
                if (wc.next < WC_PER_WAVE) { asm volatile("s_waitcnt lgkmcnt(0)" ::: "memory"); wc_issue(p, gw, wc.next, lds0 + WC_LDS + wid * 8192 + bs_ * 4096, lane); jb_ = wc.next++; c_ += 4; } \
                if (bs_) wc.j1 = jb_; else wc.j0 = jb_; } \
            wc.cm2 = wc.cm1; wc.cm1 = c_; wc.gstep++; } \
        const lds_cptr kp_ = kp0 + (((t) + 1) & 3) * SLOTB; const lds_cptr vp_ = vp0 + ((t) & 3) * SLOTB; \
        bf16x8 kf[8]; s16x4 vlo[8], vhi[8]; \
        if (hn_) { _Pragma("unroll") for (int k = 0; k < 8; ++k) KFRAG(kf[k], kp_, k); } \
        SBAR(); \
        float rs_ = 0.f; v4u pw[4]; _Pragma("unroll") for (int q_ = 0; q_ < 4; ++q_) pw[q_] = (v4u){0u, 0u, 0u, 0u}; \
        _Pragma("unroll") for (int g = 0; g < 8; ++g) {             \
            if (hn_) { if (g == 0) SN0 = MF(kf[0], qr[0], zero16); else if (g == 1) SN1 = MF(kf[1], qr[0], zero16); else if (g & 1) SN1 = MF(kf[g], qr[g >> 1], SN1); else SN0 = MF(kf[g], qr[g >> 1], SN0); } \
            if (g < 4) { _Pragma("unroll") for (int e = 0; e < 4; ++e) { SC0[4 * g + e] = __builtin_amdgcn_exp2f(SC0[4 * g + e]); rs_ += SC0[4 * g + e]; } \
                         pw[g >> 1][2 * (g & 1)] = cvtpk(SC0[4 * g], SC0[4 * g + 1]); pw[g >> 1][2 * (g & 1) + 1] = cvtpk(SC0[4 * g + 2], SC0[4 * g + 3]); \
                         asm volatile("" : "+v"(SC0), "+v"(pw[g >> 1]), "+v"(rs_)); } \
            else { const int g4 = g - 4;   \
                         vlo[g4] = vtr(vp_ + g4 * 1024); vhi[g4] = vtr(vp_ + g4 * 1024 + 512); vlo[4 + g4] = vtr(vp_ + 4096 + g4 * 1024); vhi[4 + g4] = vtr(vp_ + 4096 + g4 * 1024 + 512); \
                         _Pragma("unroll") for (int e = 0; e < 4; ++e) { SC1[4 * g4 + e] = __builtin_amdgcn_exp2f(SC1[4 * g4 + e]); rs_ += SC1[4 * g4 + e]; } \
                         pw[2 + (g4 >> 1)][2 * (g4 & 1)] = cvtpk(SC1[4 * g4], SC1[4 * g4 + 1]); pw[2 + (g4 >> 1)][2 * (g4 & 1) + 1] = cvtpk(SC1[4 * g4 + 2], SC1[4 * g4 + 3]); \
                         asm volatile("" : "+v"(SC1), "+v"(pw[2 + (g4 >> 1)]), "+v"(rs_)); } \
            SBAR(); } \
        l += rs_; \
        if (hn_) { ATT_MASK(SN0, SN1, (t) + 1); if (__builtin_expect(__any(m != 0.f), 0)) { _Pragma("unroll") for (int r = 0; r < 16; ++r) { SN0[r] -= m; SN1[r] -= m; } } \
                   asm volatile("s_nop 15\n\ts_nop 7" : "+v"(SN0), "+v"(SN1)); } \
        float ma_ = -3.0e38f, mc_ = -3.0e38f; \
        _Pragma("unroll") for (int g = 0; g < 8; ++g) {             \
            const int ks = g >> 1; const bf16x8 pf = __builtin_bit_cast(bf16x8, pw[ks]); \
            if (g & 1) { const bf16x8 v1 = (bf16x8){vlo[4 + ks][0], vlo[4 + ks][1], vlo[4 + ks][2], vlo[4 + ks][3], vhi[4 + ks][0], vhi[4 + ks][1], vhi[4 + ks][2], vhi[4 + ks][3]}; o1 = MF(v1, pf, o1); } \
            else { const bf16x8 v0 = (bf16x8){vlo[ks][0], vlo[ks][1], vlo[ks][2], vlo[ks][3], vhi[ks][0], vhi[ks][1], vhi[ks][2], vhi[ks][3]}; o0 = MF(v0, pf, o0); } \
            if (hn_) { if (g < 4) { ma_ = max3f(ma_, SN0[4 * g], SN0[4 * g + 1]); mc_ = max3f(mc_, SN0[4 * g + 2], SN0[4 * g + 3]); } \
                       else { ma_ = max3f(ma_, SN1[4 * (g - 4)], SN1[4 * (g - 4) + 1]); mc_ = max3f(mc_, SN1[4 * (g - 4) + 2], SN1[4 * (g - 4) + 3]); } \
                       asm volatile("" : "+v"(ma_), "+v"(mc_)); } \
            SBAR(); } \
        if (hn_) ATT_DECIDE(SN0, SN1, max2f(ma_, mc_)); \
    } while (0)
    {
        int t = 0;
        for (; t + 2 < NT; t += 2) { ATT_STEP(sA0, sA1, sB0, sB1, t, true); ATT_STEP(sB0, sB1, sA0, sA1, t + 1, true); }
        if (t + 2 == NT) { ATT_STEP(sA0, sA1, sB0, sB1, t, true); ATT_STEP(sB0, sB1, sA0, sA1, t + 1, false); }
        else { ATT_STEP(sA0, sA1, sB0, sB1, t, false); }
    }
#undef ATT_STEP
#undef ATT_DECIDE
#undef ATT_MASK
#undef KFRAG
#undef MF
#undef SBAR
#undef ATT_TILE
#undef ATT_ISSUE
#undef ATT_WAIT
    if (wid >= 4) __builtin_amdgcn_s_setprio(0);
    ATT_BAR();
    float ltot = swapsum(l); if (GRP == 0) ltot += __builtin_amdgcn_exp2f(p.a_sink[h] * LOG2E - m);
    const float inv = 1.f / ltot;
    int lane_e = lane; asm volatile("" : "+v"(lane_e));
    const int r32e = lane_e & 31, hie = lane_e >> 5;
    LAS unsigned char* ost = lds + wid * OST_WAVE;
#pragma unroll
    for (int g = 0; g < 4; ++g) {
        v2u w0, w1;
        w0.x = cvtpk(o0[4 * g] * inv, o0[4 * g + 1] * inv); w0.y = cvtpk(o0[4 * g + 2] * inv, o0[4 * g + 3] * inv);
        w1.x = cvtpk(o1[4 * g] * inv, o1[4 * g + 1] * inv); w1.y = cvtpk(o1[4 * g + 2] * inv, o1[4 * g + 3] * inv);
        *(LAS v2u*)(ost + r32e * OST_PITCH + (8 * g + 4 * hie) * 2) = w0;
        *(LAS v2u*)(ost + r32e * OST_PITCH + (32 + 8 * g + 4 * hie) * 2) = w1;
    }
    asm volatile("s_waitcnt lgkmcnt(0)" ::: "memory");
    bf16* Ob = (bf16*)(p.ws + (ABL ? WS_OX : WS_O)) + ((size_t)b * T + q0w) * D + GRP * 512 + h * 64;
    float* ssq = (float*)(p.ws + (ABL ? 256 * MiB : WS_SSQ)) + ((size_t)b * T + q0w) * 16 + GRP * 8 + h;
#pragma unroll
    for (int i = 0; i < 4; ++i) {
        const int row = i * 8 + (lane_e >> 3), ch = lane_e & 7;
        const v4u v = *(const LAS v4u*)(ost + row * OST_PITCH + ch * 16);
        st16(Ob + (size_t)row * D + ch * 8, v);
        float ss = 0.f;
#pragma unroll
        for (int q = 0; q < 4; ++q) { const float a = __uint_as_float(v[q] << 16), c = __uint_as_float(v[q] & 0xffff0000u); ss += a * a + c * c; }
        ss += __shfl_xor(ss, 1); ss += __shfl_xor(ss, 2); ss += __shfl_xor(ss, 4);
        if (ch == 0) ssq[(size_t)row * 16] = ss;
    }
    asm volatile("s_waitcnt vmcnt(0) lgkmcnt(0)" ::: "memory");
    ATT_BAR();
#undef ATT_BAR
}
template <int ABL = 0>
__device__ __forceinline__ void attn_phase(const P& p, LAS unsigned char* lds, int vcu, int G) {
    if (ABL & 64) return;
    const int wid = __builtin_amdgcn_readfirstlane(threadIdx.x >> 6), lane = threadIdx.x & 63, gw = vcu * 8 + wid;
    WConv wc; wc.next = (WCONV_IN_ATTN && G * 8 == 2048 && ABL == 0) ? 0 : WC_PER_WAVE; wc.j0 = -1; wc.j1 = -1; wc.gstep = 0; wc.cm1 = 0; wc.cm2 = 0;
    for (int u = vcu; u < 512; u += G) attn_unit<1, ABL>(p, lds, (u >> 5) >> 1, (u >> 5) & 1, u & 31, wc, gw);
    for (int u = vcu; u < 512; u += G) attn_unit<0, ABL>(p, lds, (u >> 5) >> 1, (u >> 5) & 1, u & 31, wc, gw);
    if (WCONV_IN_ATTN && ABL == 0) {
        if (G * 8 == 2048) {
            if (wc.j0 >= 0) wc_consume(p, gw, wc.j0, lds + WC_LDS + wid * 8192, lane);
            if (wc.j1 >= 0) wc_consume(p, gw, wc.j1, lds + WC_LDS + wid * 8192 + 4096, lane);
            for (; wc.next < WC_PER_WAVE; ++wc.next) { asm volatile("s_waitcnt lgkmcnt(0)" ::: "memory"); wc_issue(p, gw, wc.next, (unsigned)(uintptr_t)lds + WC_LDS + wid * 8192, lane);
                asm volatile("s_waitcnt vmcnt(0)" ::: "memory"); wc_consume(p, gw, wc.next, lds + WC_LDS + wid * 8192, lane); }
        } else {
            for (int hx = gw; hx < 49152; hx += G * 8) { asm volatile("s_waitcnt lgkmcnt(0)" ::: "memory"); wc_issue(p, hx & 2047, hx >> 11, (unsigned)(uintptr_t)lds + WC_LDS + wid * 8192, lane);
                asm volatile("s_waitcnt vmcnt(0)" ::: "memory"); wc_consume(p, hx & 2047, hx >> 11, lds + WC_LDS + wid * 8192, lane); }
        }
    }
}
}

struct Frame {
    LAS unsigned char* lds;
    volatile LAS unsigned* MISC;
    int tid, lane, wave, vcu, G;
};

__device__ __forceinline__ void p0_transpose_item(const float* W, int N, bf16* WT, int dpitch, int drow0, int k0, int n0, LAS float* scr, int lane, const float* gain) {
#pragma unroll
    for (int i = 0; i < 32; ++i) { const int kk = 2 * i + (lane >> 5); float v = __builtin_nontemporal_load(W + (size_t)(k0 + kk) * N + n0 + (lane & 31)); if (gain) v *= gain[kk]; scr[kk * 33 + (lane & 31)] = v; }
    LDS_WAIT(); asm volatile("" ::: "memory");
    const int c = lane & 7;
#pragma unroll
    for (int j = 0; j < 4; ++j) { const int n = (lane >> 3) + 8 * j; const LAS float* s = scr + (8 * c) * 33 + n;
        v4u o; o.x = pk2(s[0 * 33], s[1 * 33]); o.y = pk2(s[2 * 33], s[3 * 33]); o.z = pk2(s[4 * 33], s[5 * 33]); o.w = pk2(s[6 * 33], s[7 * 33]);
        *(GAS v4u*)(WT + (size_t)(drow0 + n) * dpitch + k0 + 8 * c) = o; }
    LDS_WAIT(); asm volatile("" ::: "memory");
}
__device__ __forceinline__ void p0_prologue(const P& p, Frame& F) {
    float* modx = (float*)(p.ws + WS_MODX);
    if (F.vcu < 96) {
        LAS float* s = (LAS float*)F.lds;
        LAS float* part = (LAS float*)(F.lds + 40960);
        for (int i = F.tid; i < 9 * D; i += NTHR) { const int r = i >> 10, k = i & 1023; const float v = r < 8 ? p.c[r * D + k] : p.c_ctx[k]; s[i] = silu_f(v); }
        __syncthreads();
        const int n = F.vcu * 64 + F.lane; float acc[9];
#pragma unroll
        for (int r = 0; r < 9; ++r) acc[r] = 0.f;
        const float* wp = p.w_mod + (size_t)(F.wave * 128) * 6144 + n;
#pragma unroll 4
        for (int k4 = 0; k4 < 128; k4 += 4) {
            float wv[4];
#pragma unroll
            for (int j = 0; j < 4; ++j) wv[j] = __builtin_nontemporal_load(wp + (size_t)(k4 + j) * 6144);
#pragma unroll
            for (int r = 0; r < 9; ++r) { const f32x4 sv = *(const LAS f32x4*)(s + r * D + F.wave * 128 + k4); acc[r] += sv.x * wv[0]; acc[r] += sv.y * wv[1]; acc[r] += sv.z * wv[2]; acc[r] += sv.w * wv[3]; }
        }
#pragma unroll
        for (int r = 0; r < 9; ++r) part[(F.wave * 9 + r) * 64 + F.lane] = acc[r];
        __syncthreads();
        for (int i = F.tid; i < 9 * 64; i += NTHR) { const int r = i >> 6, l = i & 63; float sum = 0.f;
#pragma unroll
            for (int w = 0; w < 8; ++w) sum += part[(w * 9 + r) * 64 + l];
            modx[r * 6144 + F.vcu * 64 + l] = sum + p.b_mod[F.vcu * 64 + l]; }
        __syncthreads();
    }
    if (F.vcu == 96) {
        float2* tab = (float2*)(p.ws + WS_ROPE);
        for (int idx = F.tid; idx < 96 * 16; idx += NTHR) {
            const int pos = idx >> 4, i = idx & 15;
            const float invf = exp2f(-(float)i * (13.287712379549449f / 16.f));
            const float pv = (float)(pos < 32 ? pos : pos - 32);
            float rev = pv * invf * 0.15915494309189535f; rev -= rintf(rev);
            tab[idx] = make_float2(__builtin_amdgcn_cosf(rev), __builtin_amdgcn_sinf(rev));
        }
    }
    for (int nb = F.vcu - 97; nb >= 0 && nb < 48; nb += F.G) {
        bf16* wr = (bf16*)(p.ws + WS_WR);
        for (int i = nb * 1024 + F.tid; i < (nb + 1) * 1024; i += NTHR) {
            const int j = i & 7, ln = (i >> 3) & 63, q = i >> 9, nt = q % 3, ks = q / 3;
            const int k = 32 * ks + 8 * (ln >> 4) + j, n = 16 * nt + (ln & 15);
            const float w = n < 4 ? p.w_group[k * 4 + n] : n < 36 ? p.w_router[k * 32 + (n - 4)] : 0.f;
            const unsigned hi = f2bf(w); const unsigned lo = f2bf(w - bf2f((bf16)hi));
            wr[i] = (bf16)hi; wr[48 * D + i] = (bf16)lo; }
    }
    LAS float* scr = (LAS float*)(F.lds + F.wave * 16384);
    const int gw = F.vcu * NWAVES + F.wave, NGW = F.G * NWAVES;
    constexpr int I_IN = 16 * 48, I_OUT = 16 * 32, I_G = 32 * 256, I_D = 32 * 256, NITEMS = WCONV_IN_ATTN ? I_IN + I_OUT : I_IN + I_OUT + 2 * I_G + I_D;
    for (int it = gw; it < NITEMS; it += NGW) {
        int r = it;
        if (r < I_IN) { const int kb = r / 48, nb = r % 48; p0_transpose_item(p.w_in, NQKV, (bf16*)(p.ws + WS_WQKV), D, qkv_row(nb * 32), kb * 64, nb * 32, scr, F.lane, nullptr); continue; } r -= I_IN;
        if (r < I_OUT) { const int kb = r / 32, nb = r % 32; const float* g = kb < 8 ? p.aon + kb * 64 : p.bon + (kb - 8) * 64;
            p0_transpose_item(p.w_out, D, (bf16*)(p.ws + WS_WO), D, nb * 32, kb * 64, nb * 32, scr, F.lane, g); continue; } r -= I_OUT;
        if (r < 2 * I_G) { const int up = r >= I_G; if (up) r -= I_G; const int e = r >> 8, q = r & 255, kb = q >> 4, nb = q & 15; const int j0 = nb * 32;
            p0_transpose_item((up ? p.w_up : p.w_gate) + (size_t)e * 1024 * 512, 512, (bf16*)(p.ws + WS_WGU) + (size_t)e * 1024 * 1024, D, (j0 >> 7) * 256 + up * 128 + (j0 & 127), kb * 64, j0, scr, F.lane, nullptr); continue; } r -= 2 * I_G;
        { const int e = r >> 8, q = r & 255, kb = q >> 5, nb = q & 31;
            p0_transpose_item(p.w_down + (size_t)e * 512 * 1024, D, (bf16*)(p.ws + WS_WD) + (size_t)e * 1024 * 512, EFF, nb * 32, kb * 64, nb * 32, scr, F.lane, nullptr); }
    }
}
__device__ __forceinline__ void p1_norm(const P& p, Frame& F) {
    const int gw = F.vcu * NWAVES + F.wave, NGW = F.G * NWAVES, rpw = (MT + NGW - 1) / NGW;
    const int r0 = gw * rpw, r1 = r0 + rpw < MT ? r0 + rpw : MT;
    const float* modall = (const float*)(p.ws + WS_MODX);
    if (r0 >= r1) return;
    f32x4 xn[4], gm[4], sh[4]; int curb = -1;
#define P1_LOAD(rw) do { const float* s_ = (rw) < ML ? p.x + (size_t)(rw) * D : p.ctx + (size_t)((rw) - ML) * D; \
        _Pragma("unroll") for (int j = 0; j < 4; ++j) xn[j] = __builtin_nontemporal_load((const f32x4*)(s_ + 4 * (F.lane + 64 * j))); } while (0)
    P1_LOAD(r0);
    for (int r = r0; r < r1; ++r) {
        f32x4 v[4]; float s = 0.f;
#pragma unroll
        for (int j = 0; j < 4; ++j) v[j] = xn[j];
        if (r + 1 < r1) P1_LOAD(r + 1);
        const int b = r < ML ? r / T : 8;
        if (b != curb) { curb = b; const float* modx = modall + b * 6144;
#pragma unroll
            for (int j = 0; j < 4; ++j) { const int k = 4 * (F.lane + 64 * j); gm[j] = *(const f32x4*)(p.pre1 + k) * (*(const f32x4*)(modx + 1024 + k) + 1.f); sh[j] = *(const f32x4*)(modx + k); } }
#pragma unroll
        for (int j = 0; j < 4; ++j) s += (v[j].x * v[j].x + v[j].y * v[j].y) + (v[j].z * v[j].z + v[j].w * v[j].w);
        const float rn = rsqrtf(wave_sum(s) * (1.f / D) + EPS);
        GAS v2u* o8 = (GAS v2u*)((bf16*)(p.ws + WS_XN) + (size_t)r * D) + F.lane;
#pragma unroll
        for (int j = 0; j < 4; ++j) { const f32x4 h = v[j] * rn * gm[j] + sh[j];
            v2u w; w.x = pk2(h.x, h.y); w.y = pk2(h.z, h.w); st8((void*)(o8 + 64 * j), w); }
    }
#undef P1_LOAD
}

constexpr int LDS_X = 147456;
__device__ __forceinline__ void p4_outproj(const P& p, Frame& F) {
    LAS float* tab = (LAS float*)(F.lds + LDS_X);
    for (int i = 0;; ++i) {
        const int L = i * F.G + (int)blockIdx.x; if (L >= 256) break;
        const int xcd = L & 7, off = L >> 3, w = xcd * 32 + off;
        pg8::Unit u; u.pm = (w >> 5) * 8 + (w & 7); u.pn = (w & 31) >> 3;
        if (F.tid < 256) {
            const f32x4* s4 = (const f32x4*)((const float*)(p.ws + WS_SSQ) + (size_t)(u.pm * 256 + F.tid) * 16);
            const f32x4 a0 = s4[0], a1 = s4[1], b0 = s4[2], b1 = s4[3];
            const float sa = ((a0.x + a0.y) + (a0.z + a0.w)) + ((a1.x + a1.y) + (a1.z + a1.w)), sb = ((b0.x + b0.y) + (b0.z + b0.w)) + ((b1.x + b1.y) + (b1.z + b1.w));
            const float ra = rsqrtf(sa * (1.f / 512.f) + EPS), rb = rsqrtf(sb * (1.f / 512.f) + EPS);
            tab[2 * F.tid] = ra / rb; tab[2 * F.tid + 1] = rb;
        }
        __syncthreads();
        pg8::Gemm g{(const pg8::bf16_t*)(p.ws + WS_O), (const pg8::bf16_t*)(p.ws + WS_WO), ML, D, D};
        pg8::SchedOne S{u};
        pg8::EpiOut E{(bf16*)(p.ws + WS_OX), tab};
        pg8::gemm_phase<pg8::EpiOut, pg8::SchedOne, false, true, false>((PG8_LAS unsigned char*)F.lds, g, S, E);
    }
}
constexpr int P5_PITCH = 2064;
constexpr int P5_PART = 64 * P5_PITCH, P5_LG = 0;
static_assert(P5_PART + 8 * 16 * 48 * 4 <= MISC_OFF && 64 * 48 * 4 <= P5_PART, "P5 LDS map");
__device__ __forceinline__ void p5_rowpass(const P& p, Frame& F, int abl = 0) {
    LAS unsigned char* LO = F.lds;
    LAS float* PART = (LAS float*)(F.lds + P5_PART); LAS float* LG = (LAS float*)(F.lds + P5_LG);
    LAS int* hist = (LAS int*)(F.lds + MISC_OFF) + 64;
    const bf16* WRh = (const bf16*)(p.ws + WS_WR); const bf16* WRl = WRh + 48 * D;
    for (int rb = F.vcu; rb < ML / 64; rb += F.G) {
        if (F.tid < 32) hist[F.tid] = 0;
        const int b = (rb * 64) / T;
        const float* modx = (const float*)(p.ws + WS_MODX) + b * 6144;
        if (!(abl & 2)) {
            f32x4 gp[4], mp[4], ap[4];
#pragma unroll
            for (int j = 0; j < 4; ++j) { const int k = 256 * j + 4 * F.lane;
                gp[j] = *(const f32x4*)(modx + 2048 + k) * *(const f32x4*)(p.post1 + k);
                mp[j] = *(const f32x4*)(p.pre2 + k) * (*(const f32x4*)(modx + 4096 + k) + 1.f);
                ap[j] = *(const f32x4*)(modx + 3072 + k); }
            f32x4 xn[4]; v2u on[4];
#define P5_LOAD(rw) do { _Pragma("unroll") for (int j = 0; j < 4; ++j) { xn[j] = __builtin_nontemporal_load((const f32x4*)(p.x + (size_t)(rw) * D + 256 * j + 4 * F.lane)); \
                on[j] = __builtin_nontemporal_load((const v2u*)((const bf16*)(p.ws + WS_OX) + (size_t)(rw) * D + 256 * j + 4 * F.lane)); } } while (0)
            P5_LOAD(rb * 64 + F.wave * 8);
            for (int rr = 0; rr < 8; ++rr) {
                const int rl = F.wave * 8 + rr, row = rb * 64 + rl;
                f32x4 xv[4], ox[4]; v2u oc[4]; float ss = 0.f;
#pragma unroll
                for (int j = 0; j < 4; ++j) { xv[j] = xn[j]; oc[j] = on[j]; }
                if (rr + 1 < 8) P5_LOAD(row + 1);
#pragma unroll
                for (int j = 0; j < 4; ++j) { const v2u o2 = oc[j];
                    ox[j] = (f32x4){__uint_as_float(o2.x << 16), __uint_as_float(o2.x & 0xffff0000u), __uint_as_float(o2.y << 16), __uint_as_float(o2.y & 0xffff0000u)};
                    ss += (ox[j].x * ox[j].x + ox[j].y * ox[j].y) + (ox[j].z * ox[j].z + ox[j].w * ox[j].w); }
                const float r1 = rsqrtf(wave_sum(ss) * (1.f / D) + EPS);
                float ss2 = 0.f;
#pragma unroll
                for (int j = 0; j < 4; ++j) { xv[j] = xv[j] + gp[j] * (ox[j] * r1);
                    ss2 += (xv[j].x * xv[j].x + xv[j].y * xv[j].y) + (xv[j].z * xv[j].z + xv[j].w * xv[j].w); }
                const float r2 = rsqrtf(wave_sum(ss2) * (1.f / D) + EPS);
                if (F.lane == 0) ((float*)(p.ws + WS_R1))[row] = r1;
#pragma unroll
                for (int j = 0; j < 4; ++j) {
                    const f32x4 h = xv[j] * r2 * mp[j] + ap[j];
                    v2u wh; wh.x = att::cvtpk(h.x, h.y); wh.y = att::cvtpk(h.z, h.w);
                    const f32x4 hb = (f32x4){__uint_as_float(wh.x << 16), __uint_as_float(wh.x & 0xffff0000u), __uint_as_float(wh.y << 16), __uint_as_float(wh.y & 0xffff0000u)};
                    const f32x4 dl = h - hb;
                    v2u wl; wl.x = att::cvtpk(dl.x, dl.y); wl.y = att::cvtpk(dl.z, dl.w);
                    st8((bf16*)(p.ws + WS_XN) + (size_t)row * D + 256 * j + 4 * F.lane, wh);
                    *(LAS v2u*)(LO + rl * P5_PITCH + (256 * j + 4 * F.lane) * 2) = wl;
                }
            }
#undef P5_LOAD
        }
        asm volatile("s_waitcnt vmcnt(0)" ::: "memory");
        __syncthreads();
        if (F.tid == 0) { __builtin_amdgcn_fence(__ATOMIC_ACQUIRE, "agent"); asm volatile("s_waitcnt vmcnt(0)" ::: "memory"); }
        __syncthreads();
        if (abl & 1) continue;
        {
            const int gI = F.wave >> 1, kq = F.wave & 1, r16 = F.lane & 15, g4 = F.lane >> 4;
            f32x4 acc[3];
#pragma unroll
            for (int nt = 0; nt < 3; ++nt) acc[nt] = (f32x4){0.f, 0.f, 0.f, 0.f};
            const bf16* ah = (const bf16*)(p.ws + WS_XN) + (size_t)(rb * 64 + 16 * gI + r16) * D + 512 * kq + 8 * g4;
            const LAS unsigned char* al = LO + (16 * gI + r16) * P5_PITCH + (512 * kq + 8 * g4) * 2;
            const bf16* bh = WRh + (size_t)(16 * kq) * 3 * 512 + F.lane * 8; const bf16* bl = WRl + (size_t)(16 * kq) * 3 * 512 + F.lane * 8;
#pragma unroll 8
            for (int ks = 0; ks < 16; ++ks) {
                const bf16x8 a_hi = *(const bf16x8*)(ah + ks * 32), a_lo = *(const LAS bf16x8*)(al + ks * 64);
#pragma unroll
                for (int nt = 0; nt < 3; ++nt) {
                    const bf16x8 b_hi = *(const bf16x8*)(bh + (ks * 3 + nt) * 512), b_lo = *(const bf16x8*)(bl + (ks * 3 + nt) * 512);
                    acc[nt] = __builtin_amdgcn_mfma_f32_16x16x32_bf16(a_hi, b_hi, acc[nt], 0, 0, 0);
                    acc[nt] = __builtin_amdgcn_mfma_f32_16x16x32_bf16(a_hi, b_lo, acc[nt], 0, 0, 0);
                    acc[nt] = __builtin_amdgcn_mfma_f32_16x16x32_bf16(a_lo, b_hi, acc[nt], 0, 0, 0);
                }
            }
#pragma unroll
            for (int nt = 0; nt < 3; ++nt)
#pragma unroll
                for (int q = 0; q < 4; ++q) PART[(F.wave * 16 + 4 * g4 + q) * 48 + 16 * nt + r16] = acc[nt][q];
        }
        __syncthreads();
        for (int i = F.tid; i < 64 * 48; i += NTHR) { const int row = i / 48, n = i - row * 48, gI = row >> 4, r16 = row & 15;
            LG[i] = (PART[((gI * 2 + 0) * 16 + r16) * 48 + n] + PART[((gI * 2 + 1) * 16 + r16) * 48 + n]) + (n < 4 ? p.b_group[n] : n < 36 ? p.b_router[n - 4] : 0.f); }
        __syncthreads();
        if (F.tid < 64) {
            float lg[36];
#pragma unroll
            for (int c = 0; c < 36; ++c) lg[c] = LG[F.tid * 48 + c];
            int e1, e2; float w1, w2;
            {
                int g = 0; float gm = lg[0];
#pragma unroll
                for (int q = 1; q < 4; ++q) if (lg[q] > gm) { gm = lg[q]; g = q; }
                float gs = 0.f;
#pragma unroll
                for (int q = 0; q < 4; ++q) gs += __expf(lg[q] - gm);
                const float gw = 1.f / gs;
                float el[8];
#pragma unroll
                for (int q = 0; q < 8; ++q) el[q] = g == 0 ? lg[4 + q] : g == 1 ? lg[12 + q] : g == 2 ? lg[20 + q] : lg[28 + q];
                int i1 = 0; float m1 = el[0];
#pragma unroll
                for (int q = 1; q < 8; ++q) if (el[q] > m1) { m1 = el[q]; i1 = q; }
                int i2 = -1; float m2 = -3.0e38f;
#pragma unroll
                for (int q = 0; q < 8; ++q) if (q != i1 && el[q] > m2) { m2 = el[q]; i2 = q; }
                const float ex = __expf(m2 - m1);
                w1 = gw / (1.f + ex); w2 = gw * ex / (1.f + ex); e1 = g * 8 + i1; e2 = g * 8 + i2;
            }
            const int row = rb * 64 + F.tid;
            if (!(abl & 2)) { int* te = (int*)(p.ws + WS_TOKE) + row * 2; float* tw = (float*)(p.ws + WS_TOKW) + row * 2; te[0] = e1; te[1] = e2; tw[0] = w1; tw[1] = w2; }
            atomicAdd((int*)&hist[e1 & 31], 1); atomicAdd((int*)&hist[e2 & 31], 1);
        }
        __syncthreads();
        if (F.tid < 32 && !(abl & 2)) ((int*)(p.ws + WS_BLKCNT))[rb * 32 + F.tid] = hist[F.tid];
        __syncthreads();
    }
}
__device__ __forceinline__ void p6_lists(const P& p, Frame& F) {
    LAS int* ps = (LAS int*)F.lds;
    LAS int* pp = ps + 512;
    LAS int* tot = pp + 512; LAS int* pre = tot + 32; LAS int* ebase = pre + 32;
    LAS int* es = ebase + 40;
    const int* blk = (const int*)(p.ws + WS_BLKCNT);
    int* meta = (int*)(p.ws + WS_META);
    for (int rb = F.vcu; rb < ML / 64; rb += F.G) {
        { const int e = F.tid & 31, part = F.tid >> 5; int s = 0, q = 0;
#pragma unroll 4
          for (int j = 0; j < 16; ++j) { const int bb = part * 16 + j; const int v = blk[bb * 32 + e]; s += v; q += bb < rb ? v : 0; }
          ps[part * 32 + e] = s; pp[part * 32 + e] = q; }
        __syncthreads();
        if (F.tid < 32) { int s = 0, q = 0;
#pragma unroll
            for (int part = 0; part < 16; ++part) { s += ps[part * 32 + F.tid]; q += pp[part * 32 + F.tid]; }
            tot[F.tid] = s; pre[F.tid] = q; }
        __syncthreads();
        if (F.tid == 0) { int tb = 0; for (int e = 0; e < 32; ++e) { ebase[e] = tb; tb += (tot[e] + 255) >> 8; } ebase[32] = tb; }
        if (F.tid < 128) es[F.tid] = ((const int*)(p.ws + WS_TOKE))[rb * 128 + F.tid];
        __syncthreads();
        if (F.tid < 128) {
            const int e = es[F.tid]; int rank = 0;
            for (int a = 0; a < F.tid; ++a) rank += es[a] == e ? 1 : 0;
            const int pos = ebase[e] * 256 + pre[e] + rank;
            ((int*)(p.ws + WS_ROWIDX))[pos] = rb * 64 + (F.tid >> 1);
            ((float*)(p.ws + WS_ROWW))[pos] = ((const float*)(p.ws + WS_TOKW))[rb * 128 + F.tid];
            ((int*)(p.ws + WS_TOKPOS))[rb * 128 + F.tid] = pos;
        }
        if (rb < 32) {
            const int e = rb, lo = ebase[e] * 256 + tot[e], hi = ebase[e + 1] * 256;
            for (int pos = lo + F.tid; pos < hi; pos += NTHR) { ((int*)(p.ws + WS_ROWIDX))[pos] = 0; ((float*)(p.ws + WS_ROWW))[pos] = 0.f; }
            for (int t = ebase[e] + F.tid; t < ebase[e + 1]; t += NTHR) meta[128 + t] = e;
            if (F.tid == 0) { meta[e] = tot[e]; meta[64 + e] = ebase[e]; if (e == 31) { meta[64 + 32] = ebase[32]; meta[320] = ebase[32]; } }
        }
        __syncthreads();
    }
}
__device__ __forceinline__ void p78_moe(const P& p, Frame& F, bool down) {
    LAS int* tile_e = (LAS int*)(F.lds + LDS_X);
    const int* meta = (const int*)(p.ws + WS_META);
    for (int t = F.tid; t < MAXTILES; t += NTHR) tile_e[t] = meta[128 + t] & 31;
    __syncthreads();
    const int ntiles = meta[320];
    pg8::SchedMoE S{F.G, (int)blockIdx.x, ntiles * 4, tile_e, (const int*)(p.ws + WS_ROWIDX)};
    if (!down) {
        pg8::Gemm g{(const pg8::bf16_t*)(p.ws + WS_XN), (const pg8::bf16_t*)(p.ws + WS_WGU), MAXPOS, NE * 1024, D};
        pg8::EpiGU E{(bf16*)(p.ws + WS_ACT), (const float*)(p.ws + WS_ROWW)};
        pg8::gemm_phase<pg8::EpiGU, pg8::SchedMoE, true, true, true>((PG8_LAS unsigned char*)F.lds, g, S, E);
    } else {
        pg8::Gemm g{(const pg8::bf16_t*)(p.ws + WS_ACT), (const pg8::bf16_t*)(p.ws + WS_WD), MAXPOS, NE * 1024, EFF};
        pg8::EpiY E{(bf16*)(p.ws + WS_Y)};
        pg8::gemm_phase<pg8::EpiY, pg8::SchedMoE, true, true, false>((PG8_LAS unsigned char*)F.lds, g, S, E);
    }
}
__device__ __forceinline__ void p9_final(const P& p, Frame& F, float* dst) {
    const bf16* Y = (const bf16*)(p.ws + WS_Y); const bf16* OX = (const bf16*)(p.ws + WS_OX); const float* R1 = (const float*)(p.ws + WS_R1);
    for (int rb = F.vcu; rb < ML / 64; rb += F.G) {
        const int b = (rb * 64) / T;
        const float* modx = (const float*)(p.ws + WS_MODX) + b * 6144;
        const int row0 = rb * 64 + F.wave * 8;
        f32x4 gp[4], g1p[4];
#pragma unroll
        for (int j = 0; j < 4; ++j) { const int k = 256 * j + 4 * F.lane; gp[j] = *(const f32x4*)(modx + 5120 + k) * *(const f32x4*)(p.post2 + k); g1p[j] = *(const f32x4*)(modx + 2048 + k) * *(const f32x4*)(p.post1 + k); }
        v2u ya[2][4], yc[2][4], oo[2][4]; f32x4 xo[2][4]; float r1v[2];
        const int* tpp = (const int*)(p.ws + WS_TOKPOS) + row0 * 2;
#define P9_LOAD(buf, rw, t2) do { r1v[buf] = R1[rw]; _Pragma("unroll") for (int j = 0; j < 4; ++j) { \
            ya[buf][j] = __builtin_nontemporal_load((const v2u*)(Y + (size_t)(t2).x * D + 256 * j + 4 * F.lane)); yc[buf][j] = __builtin_nontemporal_load((const v2u*)(Y + (size_t)(t2).y * D + 256 * j + 4 * F.lane)); \
            oo[buf][j] = __builtin_nontemporal_load((const v2u*)(OX + (size_t)(rw) * D + 256 * j + 4 * F.lane)); xo[buf][j] = __builtin_nontemporal_load((const f32x4*)(p.x + (size_t)(rw) * D + 256 * j + 4 * F.lane)); } } while (0)
#define P9_COMP(buf, rw) do { f32x4 y[4]; float ss = 0.f; \
            _Pragma("unroll") for (int j = 0; j < 4; ++j) { const v2u a = ya[buf][j], c = yc[buf][j]; \
                y[j] = (f32x4){__uint_as_float(a.x << 16) + __uint_as_float(c.x << 16), __uint_as_float(a.x & 0xffff0000u) + __uint_as_float(c.x & 0xffff0000u), \
                               __uint_as_float(a.y << 16) + __uint_as_float(c.y << 16), __uint_as_float(a.y & 0xffff0000u) + __uint_as_float(c.y & 0xffff0000u)}; \
                ss += (y[j].x * y[j].x + y[j].y * y[j].y) + (y[j].z * y[j].z + y[j].w * y[j].w); } \
            const float rn = rsqrtf(wave_sum(ss) * (1.f / D) + EPS); \
            _Pragma("unroll") for (int j = 0; j < 4; ++j) { const v2u o2 = oo[buf][j]; \
                const f32x4 oxv = (f32x4){__uint_as_float(o2.x << 16), __uint_as_float(o2.x & 0xffff0000u), __uint_as_float(o2.y << 16), __uint_as_float(o2.y & 0xffff0000u)}; \
                const f32x4 x1 = xo[buf][j] + g1p[j] * (oxv * r1v[buf]);                   \
                __builtin_nontemporal_store(x1 + gp[j] * (y[j] * rn), (f32x4*)(dst + (size_t)(rw) * D + 256 * j + 4 * F.lane)); } } while (0)
        int2 tpA = *(const int2*)(tpp), tpB = *(const int2*)(tpp + 2);
        P9_LOAD(0, row0, tpA);
#pragma unroll 1
        for (int rp = 0; rp < 4; ++rp) {
            const int ra = row0 + 2 * rp;
            P9_LOAD(1, ra + 1, tpB);
            int2 tpA2 = tpA, tpB2 = tpB;
            if (rp < 3) { tpA2 = *(const int2*)(tpp + 4 * rp + 4); tpB2 = *(const int2*)(tpp + 4 * rp + 6); }
            P9_COMP(0, ra);
            if (rp < 3) P9_LOAD(0, ra + 2, tpA2);
            P9_COMP(1, ra + 1);
            tpA = tpA2; tpB = tpB2;
        }
#undef P9_COMP
#undef P9_LOAD
    }
}

struct Args { P p; int ph_lo, ph_hi, li, pad; };
__global__ void __launch_bounds__(NTHR, 2) mega(Args args) {
    extern __shared__ __attribute__((aligned(16))) unsigned char lds_raw[];
    Frame F;
    F.lds = (LAS unsigned char*)lds_raw;
    F.MISC = (volatile LAS unsigned*)(F.lds + MISC_OFF);
    F.tid = threadIdx.x; F.lane = F.tid & 63; F.wave = __builtin_amdgcn_readfirstlane(F.tid >> 6);
    F.G = gridDim.x; { const int bx = blockIdx.x; F.vcu = (F.G % 8 == 0) ? (bx % 8) * (F.G / 8) + bx / 8 : bx; }
    const P& p = args.p;
    unsigned* ctl = (unsigned*)(p.ws + WS_CTL);
    for (int u = F.tid; u < (LDS_BYTES - MISC_OFF) / 4; u += NTHR) ((LAS unsigned*)(F.lds + MISC_OFF))[u] = 0u;
    __syncthreads();
    const int lo = args.ph_lo, hi = args.ph_hi;
    XcdBarrier bar; bar.bar = ctl + CW_BAR + args.li * XCD_BAR_WORDS; bar.x = 0; bar.st = nullptr;
    if (hi - lo > 1) bar = xcd_barrier_post(ctl + CW_BAR + args.li * XCD_BAR_WORDS, F.MISC + 8);
#define IN(k) (lo <= (k) && (k) < hi)
#define SEAM(k) do { if (IN(k) && IN((k) + 1)) xcd_barrier(bar); } while (0)
    if (IN(0)) { p0_prologue(p, F); SEAM(0); }
    if (IN(1)) { p1_norm(p, F); SEAM(1); }
    if (IN(2)) {
        pg8::Gemm g{(const pg8::bf16_t*)(p.ws + WS_XN), (const pg8::bf16_t*)(p.ws + WS_WQKV), MT, NQKV, D};
        pg8::SchedQKV S{F.G, (int)blockIdx.x};
        pg8::EpiQKV E{p.ws, p.bqn, p.bkn};
        pg8::gemm_phase<pg8::EpiQKV, pg8::SchedQKV, true, true, false>((PG8_LAS unsigned char*)F.lds, g, S, E);
        SEAM(2);
    }
#ifdef PROBE_ABL
    if (IN(3) && args.pad) { att::attn_phase<PROBE_ABL>(p, F.lds, F.vcu, F.G); } else
#endif
    if (IN(3)) { att::attn_phase<0>(p, F.lds, F.vcu, F.G); SEAM(3); }
    if (IN(4)) { p4_outproj(p, F); SEAM(4); }
#ifdef PROBE_ABL5
    if (IN(5) && args.pad) { p5_rowpass(p, F, PROBE_ABL5); } else
#endif
    if (IN(5)) { p5_rowpass(p, F); SEAM(5); }
    if (IN(6)) { p6_lists(p, F); SEAM(6); }
    if (IN(7)) { p78_moe(p, F, false); SEAM(7); }
    if (IN(8)) { p78_moe(p, F, true); SEAM(8); }
    if (IN(9)) { p9_final(p, F, args.pad ? (float*)(p.ws + WS_WGU) : p.out); }
#undef IN
#undef SEAM
}

#ifndef ONE_LAUNCH
#define ONE_LAUNCH 1
#endif
#ifndef FAST_MASK
#define FAST_MASK 0x3ff
#endif
static void launch_mega(const P& p, int lo, int hi, int li, int grid, hipStream_t stream) {
    Args a{}; a.p = p; a.ph_lo = lo; a.ph_hi = hi; a.li = li; a.pad = 0;
    hipLaunchKernelGGL(mega, dim3(grid), dim3(NTHR), LDS_BYTES, stream, a);
}
extern "C" void kernel_launch(void* const* d_in, const int* in_sizes, int n_in, void* d_out, int out_size, void* d_ws, size_t ws_size, hipStream_t stream) {
    static int grid = 0;
    if (grid == 0) {
        if (n_in != 24 || out_size != ML * D || ws_size < WS_END) { fprintf(stderr, "kernel_launch: unexpected shapes (n_in %d out %d ws %zu)\n", n_in, out_size, ws_size); grid = -1; return; }
        int dev = 0, cus = 0, per_cu = 0;
        if (hipGetDevice(&dev) != hipSuccess || hipDeviceGetAttribute(&cus, hipDeviceAttributeMultiprocessorCount, dev) != hipSuccess) { grid = -1; return; }
        if (hipFuncSetAttribute((const void*)mega, hipFuncAttributeMaxDynamicSharedMemorySize, LDS_BYTES) != hipSuccess) { fprintf(stderr, "kernel_launch: hipFuncSetAttribute failed\n"); grid = -1; return; }
        if (hipOccupancyMaxActiveBlocksPerMultiprocessor(&per_cu, (const void*)mega, NTHR, LDS_BYTES) != hipSuccess || per_cu < 1) { fprintf(stderr, "kernel_launch: occupancy query says %d blocks/CU\n", per_cu); (void)hipGetLastError(); grid = -1; return; }
        grid = cus;
    }
    if (grid < 0) return;
    P p{};
    const float** f = (const float**)&p;
    for (int i = 0; i < 24; ++i) f[i] = (const float*)d_in[i];
    p.out = (float*)d_out; p.ws = (unsigned char*)d_ws;
    (void)hipMemsetAsync((char*)d_ws + WS_CTL, 0, 64 * 1024, stream);
#if ONE_LAUNCH
    launch_mega(p, 0, 10, 0, grid, stream);
#else
    for (int k = 0; k < 10; ++k) {
        launch_mega(p, k, k + 1, 0, grid, stream);
#ifdef PROBE_DUP
        if (k == PROBE_DUP) for (int r_ = 0; r_ < 3; ++r_) { Args a{}; a.p = p; a.ph_lo = k; a.ph_hi = k + 1; a.li = 0; a.pad = 1; hipLaunchKernelGGL(mega, dim3(grid), dim3(NTHR), LDS_BYTES, stream, a); }
#endif
    }
#endif
}
```
